# Optimizing an MI355X kernel written in HIP

```python
import math
import jax, jax.numpy as jnp
from jax import lax
import numpy as np

D_MODEL = 1024
BATCH = 16
SEQ = 2048
DEPTH = 1
DEC_BATCH = 128
DEC_SEQ = 8
PAST_LEN = 8192
PAGE_SIZE = 128

N_MEM = 256
GLA_HEADS = 4
GLA_DV = D_MODEL // (2 * GLA_HEADS)
GLA_DK = GLA_DV // 2
GLA_GATE_RANK = 16
GLA_TAU = 16.0
GLA_CHUNK = 64
MLA_HEADS = 8
MLA_V = D_MODEL // (2 * MLA_HEADS)
MLA_NOPE = MLA_V
MLA_ROPE = MLA_V // 2
MLA_Q_RANK = 3 * D_MODEL // 8
MLA_KV_RANK = D_MODEL // 4
ROPE_THETA = 10000.0
Q_BLOCK = 128
X_HEADS = 4
X_DIM = D_MODEL // 8
D_FF = 4 * D_MODEL
EPS = 1e-6

GLA_WIDTH = GLA_HEADS * GLA_DV
MLA_WIDTH = MLA_HEADS * MLA_V
MIX_WIDTH = GLA_WIDTH + MLA_WIDTH
IN_SIZES = (GLA_HEADS * GLA_DK, GLA_HEADS * GLA_DK, GLA_WIDTH, GLA_WIDTH, GLA_GATE_RANK,
            MLA_Q_RANK, MLA_KV_RANK, MLA_ROPE)
SPLIT_POINTS = tuple(int(v) for v in np.cumsum(IN_SIZES)[:-1])
D_IN = sum(IN_SIZES)
MLA_SCALE = (MLA_NOPE + MLA_ROPE) ** -0.5

kernel_name = 'hymba_gla_mla_memory_decoder_step'


def rms_norm(x, g):
    xf = x.astype(jnp.float32)
    y = xf * lax.rsqrt(jnp.mean(xf * xf, axis=-1, keepdims=True) + EPS)
    return (y * g.astype(jnp.float32)).astype(x.dtype)


def rope(x, pos):
    half = x.shape[-1] // 2
    inv = ROPE_THETA ** (-jnp.arange(half, dtype=jnp.float32) / half)
    ang = pos.astype(jnp.float32)[:, None] * inv[None, :]
    cos = jnp.cos(ang)[None, :, None, :]
    sin = jnp.sin(ang)[None, :, None, :]
    xf = x.astype(jnp.float32)
    x1, x2 = xf[..., :half], xf[..., half:]
    return jnp.concatenate([x1 * cos - x2 * sin, x2 * cos + x1 * sin], axis=-1).astype(x.dtype)


def gla_recurrence(q, k, v, log_a, s0):
    B, T = q.shape[:2]
    c = math.gcd(T, GLA_CHUNK)
    n = T // c

    def to_chunks(t):
        return jnp.moveaxis(t.reshape(B, n, c, *t.shape[2:]), 1, 0).astype(jnp.float32)

    qc, kc, vc, ac = to_chunks(q), to_chunks(k), to_chunks(v), to_chunks(log_a)
    causal = jnp.tril(jnp.ones((c, c), dtype=bool))[None, :, :, None, None]

    def step(s, inp):
        qi, ki, vi, ai = inp
        b = jnp.cumsum(ai, axis=1)
        o_inter = jnp.einsum('bthk,bhkv->bthv', qi * jnp.exp(b), s)
        diff = jnp.where(causal, b[:, :, None] - b[:, None, :], -jnp.inf)
        att = jnp.einsum('bthk,bshk,btshk->bhts', qi, ki, jnp.exp(diff))
        o_intra = jnp.einsum('bhts,bshv->bthv', att, vi)
        b_last = b[:, -1]
        s_new = s * jnp.exp(b_last)[..., None] + jnp.einsum(
            'bshk,bshv->bhkv', ki * jnp.exp(b_last[:, None] - b), vi)
        return s_new, o_inter + o_intra

    s_fin, o = lax.scan(step, s0.astype(jnp.float32), (qc, kc, vc, ac))
    o = jnp.moveaxis(o, 0, 1).reshape(B, T, GLA_HEADS, GLA_DV)
    return o, s_fin


def mix_inputs(h, pos, lp):
    B, T, _ = h.shape
    z = h @ lp['w_in']
    q, k, v, r, a, qa, kva, kpe = jnp.split(z, SPLIT_POINTS, axis=-1)
    q = q.reshape(B, T, GLA_HEADS, GLA_DK) * (GLA_DK ** -0.5)
    k = k.reshape(B, T, GLA_HEADS, GLA_DK)
    v = v.reshape(B, T, GLA_HEADS, GLA_DV)
    gate_pre = (a @ lp['w_gla_a2'] + lp['b_gla_a']).astype(jnp.float32)
    log_a = (jax.nn.log_sigmoid(gate_pre) / GLA_TAU).reshape(B, T, GLA_HEADS, GLA_DK)
    qf = (rms_norm(qa, lp['g_mla_qa']) @ lp['w_mla_qb']).reshape(B, T, MLA_HEADS, MLA_NOPE + MLA_ROPE)
    qn = rms_norm(qf[..., :MLA_NOPE], lp['g_q_nope'])
    qp = rope(rms_norm(qf[..., MLA_NOPE:], lp['g_q_rope']), pos)
    ckv = rms_norm(kva, lp['g_mla_kva'])
    kp = rope(rms_norm(kpe, lp['g_k_rope'])[:, :, None, :], pos)[:, :, 0]
    return (q, k, v, r, log_a), (qn, qp, ckv, kp)


def mla_decompress(ckv, lp):
    B, S, _ = ckv.shape
    kv = (ckv @ lp['w_mla_kvb']).reshape(B, S, MLA_HEADS, MLA_NOPE + MLA_V)
    kn = rms_norm(kv[..., :MLA_NOPE], lp['g_k_nope'])
    return kn, kv[..., MLA_NOPE:]


def mla_scores(qn, qp, kn, kp):
    s = jnp.einsum('bthd,bshd->bhts', qn, kn) + jnp.einsum('bthd,bsd->bhts', qp, kp)
    return s.astype(jnp.float32) * MLA_SCALE


def mla_prompt_attention(qn, qp, kn, kp, v):
    B, T = qn.shape[:2]
    qb = math.gcd(T, Q_BLOCK)
    nb = T // qb
    qn_b = qn.reshape(B, nb, qb, MLA_HEADS, MLA_NOPE).swapaxes(0, 1)
    qp_b = qp.reshape(B, nb, qb, MLA_HEADS, MLA_ROPE).swapaxes(0, 1)
    kpos = jnp.arange(T)

    def block(args):
        i, qn_i, qp_i = args
        s = mla_scores(qn_i, qp_i, kn, kp)
        qpos = i * qb + jnp.arange(qb)
        s = jnp.where(kpos[None, :] <= qpos[:, None], s, -jnp.inf)
        p = jax.nn.softmax(s, axis=-1).astype(v.dtype)
        return jnp.einsum('bhts,bshd->bthd', p, v)

    o = lax.map(block, (jnp.arange(nb), qn_b, qp_b))
    return o.swapaxes(0, 1).reshape(B, T, MLA_HEADS, MLA_V)


def online_update(carry, s, v):
    m, l, acc = carry
    m_new = jnp.maximum(m, jnp.max(s, axis=-1))
    corr = jnp.exp(m - m_new)
    p = jnp.exp(s - m_new[..., None])
    l = l * corr + jnp.sum(p, axis=-1)
    acc = acc * corr[..., None] + jnp.einsum('bhts,bshd->bhtd', p, v.astype(jnp.float32))
    return (m_new, l, acc)


def mla_sample_attention(qn, qp, ckv_new, kp_new, pool_ckv, pool_kpe, page_table, lp):
    B, T = qn.shape[:2]
    carry = (jnp.full((B, MLA_HEADS, T), -jnp.inf, jnp.float32),
             jnp.zeros((B, MLA_HEADS, T), jnp.float32),
             jnp.zeros((B, MLA_HEADS, T, MLA_V), jnp.float32))

    def page_step(c, pages):
        ckv = pool_ckv[pages]
        kp = pool_kpe[pages]
        kn, v = mla_decompress(ckv, lp)
        return online_update(c, mla_scores(qn, qp, kn, kp), v), None

    carry, _ = lax.scan(page_step, carry, page_table.T)
    kn, v = mla_decompress(ckv_new, lp)
    s = mla_scores(qn, qp, kn, kp_new)
    s = jnp.where(jnp.tril(jnp.ones((T, T), dtype=bool)), s, -jnp.inf)
    m, l, acc = online_update(carry, s, v)
    o = acc / l[..., None]
    return o.transpose(0, 2, 1, 3).astype(qn.dtype)


def mix_output(o_gla, r, o_mla, lp):
    B, T = r.shape[:2]
    og = rms_norm(o_gla.astype(r.dtype), lp['g_gla_o']).reshape(B, T, GLA_WIDTH) * jax.nn.silu(r)
    om = o_mla.reshape(B, T, MLA_WIDTH)
    return jnp.concatenate([og, om], axis=-1) @ lp['w_out']


def memory_kv(mem, lp):
    B, N, _ = mem.shape
    m = rms_norm(mem, lp['g_mem'])
    k = rms_norm((m @ lp['w_xk']).reshape(B, N, X_HEADS, X_DIM), lp['g_xk'])
    v = (m @ lp['w_xv']).reshape(B, N, X_HEADS, X_DIM)
    return k, v


def cross_attend(h, mk, mv, lp):
    B, T, _ = h.shape
    q = rms_norm((h @ lp['w_xq']).reshape(B, T, X_HEADS, X_DIM), lp['g_xq'])
    s = jnp.einsum('bthd,bnhd->bhtn', q, mk).astype(jnp.float32) * (X_DIM ** -0.5)
    p = jax.nn.softmax(s, axis=-1).astype(mv.dtype)
    o = jnp.einsum('bhtn,bnhd->bthd', p, mv).reshape(B, T, X_HEADS * X_DIM)
    return o @ lp['w_xo']


def ffn(h, lp):
    u = jnp.maximum(h @ lp['w_ff1'], 0)
    return (u * u) @ lp['w_ff2']


def prompt_layer(x, mem, lp):
    B, T, _ = x.shape
    pos = jnp.arange(T)
    h = rms_norm(x, lp['g_mix'])
    (q, k, v, r, log_a), (qn, qp, ckv, kp) = mix_inputs(h, pos, lp)
    s0 = jnp.zeros((B, GLA_HEADS, GLA_DK, GLA_DV), jnp.float32)
    o_gla, s_gla = gla_recurrence(q, k, v, log_a, s0)
    kn, vm = mla_decompress(ckv, lp)
    o_mla = mla_prompt_attention(qn, qp, kn, kp, vm)
    x = x + mix_output(o_gla, r, o_mla, lp)
    mk, mv = memory_kv(mem, lp)
    x = x + cross_attend(rms_norm(x, lp['g_x']), mk, mv, lp)
    x = x + ffn(rms_norm(x, lp['g_ff']), lp)
    return x, ckv, kp, mk, mv, s_gla.astype(x.dtype)


def sample_layer(x, pool_ckv, pool_kpe, page_table, mk, mv, s_prev, lp):
    B, T, _ = x.shape
    pos = PAST_LEN + jnp.arange(T)
    h = rms_norm(x, lp['g_mix'])
    (q, k, v, r, log_a), (qn, qp, ckv, kp) = mix_inputs(h, pos, lp)
    o_gla, s_gla = gla_recurrence(q, k, v, log_a, s_prev)
    o_mla = mla_sample_attention(qn, qp, ckv, kp, pool_ckv, pool_kpe, page_table, lp)
    x = x + mix_output(o_gla, r, o_mla, lp)
    x = x + cross_attend(rms_norm(x, lp['g_x']), mk, mv, lp)
    x = x + ffn(rms_norm(x, lp['g_ff']), lp)
    return x, ckv, kp, s_gla.astype(x.dtype)


def setup_inputs(seed: int = 0) -> dict:
    key = jax.random.key(seed)
    ks = iter(jax.random.split(key, 48))

    def nrm(shape, scale=1.0):
        return jax.random.normal(next(ks), shape, jnp.float32) * scale

    def gain(n):
        return 1.0 + nrm((DEPTH, n), 0.02)

    def lin(fi, fo):
        return nrm((DEPTH, fi, fo), fi ** -0.5)

    n_pages = PAST_LEN // PAGE_SIZE
    n_used = DEC_BATCH * n_pages
    n_pool = n_used + n_used // 4
    x_prompt = nrm((BATCH, SEQ, D_MODEL))
    x_sample = nrm((DEC_BATCH, DEC_SEQ, D_MODEL))
    mem_prompt = nrm((BATCH, N_MEM, D_MODEL))
    cache_ckv = nrm((DEPTH, n_pool, PAGE_SIZE, MLA_KV_RANK))
    cache_kpe = nrm((DEPTH, n_pool, PAGE_SIZE, MLA_ROPE))
    cache_mem_k = nrm((DEPTH, DEC_BATCH, N_MEM, X_HEADS, X_DIM))
    cache_mem_v = nrm((DEPTH, DEC_BATCH, N_MEM, X_HEADS, X_DIM))
    state_gla = nrm((DEPTH, DEC_BATCH, GLA_HEADS, GLA_DK, GLA_DV), 0.5)
    page_table = jax.random.permutation(next(ks), n_pool)[:n_used].reshape(DEC_BATCH, n_pages).astype(jnp.int32)
    return {
        'x_prompt': x_prompt, 'x_sample': x_sample, 'mem_prompt': mem_prompt,
        'cache_ckv': cache_ckv, 'cache_kpe': cache_kpe,
        'cache_mem_k': cache_mem_k, 'cache_mem_v': cache_mem_v,
        'state_gla': state_gla, 'page_table': page_table,
        'g_mix': gain(D_MODEL), 'w_in': lin(D_MODEL, D_IN),
        'w_gla_a2': lin(GLA_GATE_RANK, GLA_HEADS * GLA_DK), 'b_gla_a': nrm((DEPTH, GLA_HEADS * GLA_DK), 0.01),
        'g_gla_o': gain(GLA_DV),
        'g_mla_qa': gain(MLA_Q_RANK), 'w_mla_qb': lin(MLA_Q_RANK, MLA_HEADS * (MLA_NOPE + MLA_ROPE)),
        'g_mla_kva': gain(MLA_KV_RANK), 'w_mla_kvb': lin(MLA_KV_RANK, MLA_HEADS * (MLA_NOPE + MLA_V)),
        'g_q_nope': gain(MLA_NOPE), 'g_k_nope': gain(MLA_NOPE),
        'g_q_rope': gain(MLA_ROPE), 'g_k_rope': gain(MLA_ROPE),
        'w_out': lin(MIX_WIDTH, D_MODEL),
        'g_x': gain(D_MODEL), 'g_mem': gain(D_MODEL),
        'w_xq': lin(D_MODEL, X_HEADS * X_DIM), 'w_xk': lin(D_MODEL, X_HEADS * X_DIM),
        'w_xv': lin(D_MODEL, X_HEADS * X_DIM), 'g_xq': gain(X_DIM), 'g_xk': gain(X_DIM),
        'w_xo': lin(X_HEADS * X_DIM, D_MODEL),
        'g_ff': gain(D_MODEL), 'w_ff1': lin(D_MODEL, D_FF), 'w_ff2': lin(D_FF, D_MODEL),
    }


def reference(x_prompt, x_sample, mem_prompt, cache_ckv, cache_kpe, cache_mem_k, cache_mem_v,
              state_gla, page_table, g_mix, w_in, w_gla_a2, b_gla_a, g_gla_o, g_mla_qa, w_mla_qb,
              g_mla_kva, w_mla_kvb, g_q_nope, g_k_nope, g_q_rope, g_k_rope, w_out, g_x, g_mem,
              w_xq, w_xk, w_xv, g_xq, g_xk, w_xo, g_ff, w_ff1, w_ff2):
    yp, ys = x_prompt, x_sample
    ckv_p, kpe_p, mk_p, mv_p, gla_p = [], [], [], [], []
    ckv_s, kpe_s, gla_s = [], [], []
    for l in range(DEPTH):
        lp = {
            'g_mix': g_mix[l], 'w_in': w_in[l], 'w_gla_a2': w_gla_a2[l], 'b_gla_a': b_gla_a[l],
            'g_gla_o': g_gla_o[l], 'g_mla_qa': g_mla_qa[l], 'w_mla_qb': w_mla_qb[l],
            'g_mla_kva': g_mla_kva[l], 'w_mla_kvb': w_mla_kvb[l], 'g_q_nope': g_q_nope[l],
            'g_k_nope': g_k_nope[l], 'g_q_rope': g_q_rope[l], 'g_k_rope': g_k_rope[l],
            'w_out': w_out[l], 'g_x': g_x[l], 'g_mem': g_mem[l], 'w_xq': w_xq[l], 'w_xk': w_xk[l],
            'w_xv': w_xv[l], 'g_xq': g_xq[l], 'g_xk': g_xk[l], 'w_xo': w_xo[l],
            'g_ff': g_ff[l], 'w_ff1': w_ff1[l], 'w_ff2': w_ff2[l],
        }
        yp, c1, c2, c3, c4, c5 = prompt_layer(yp, mem_prompt, lp)
        ckv_p.append(c1); kpe_p.append(c2); mk_p.append(c3); mv_p.append(c4); gla_p.append(c5)
        ys, d1, d2, d3 = sample_layer(ys, cache_ckv[l], cache_kpe[l], page_table,
                                      cache_mem_k[l], cache_mem_v[l], state_gla[l], lp)
        ckv_s.append(d1); kpe_s.append(d2); gla_s.append(d3)
    return (yp, ys, jnp.stack(ckv_p), jnp.stack(kpe_p), jnp.stack(mk_p), jnp.stack(mv_p), jnp.stack(gla_p),
            jnp.stack(ckv_s), jnp.stack(kpe_s), jnp.stack(gla_s))
```

```cpp
#ifdef EMU
#include "emu.h"
#define LDS
#else
#include <hip/hip_runtime.h>
#define LDS __attribute__((address_space(3)))
#define LAUNCH(kern, grid, block, smem, stream, ...) kern<<<grid, block, smem, stream>>>(__VA_ARGS__)
#endif
#include <cstdio>
#include <cstdint>
#include <cmath>
#define DI __device__ __forceinline__

#ifndef CFG_BATCH
#define CFG_BATCH 16
#define CFG_SEQ 2048
#define CFG_DECB 128
#define CFG_PAST 8192
#endif
#ifndef N_LAUNCH_MODE
#define N_LAUNCH_MODE 0
#endif

typedef unsigned short bf16;
typedef short bf16x8 __attribute__((ext_vector_type(8)));
typedef short s16x4 __attribute__((ext_vector_type(4)));
typedef float f32x4 __attribute__((ext_vector_type(4)));
typedef float f32x16 __attribute__((ext_vector_type(16)));
typedef unsigned u32x4 __attribute__((ext_vector_type(4)));
typedef unsigned u32x2 __attribute__((ext_vector_type(2)));

constexpr int DM = 1024, BATCH = CFG_BATCH, SEQ = CFG_SEQ, DECB = CFG_DECB, DECS = 8, PAST = CFG_PAST, PAGE = 128, NPAGES = PAST / PAGE;
constexpr int NMEM = 256, TP = BATCH * SEQ, TS = DECB * DECS, T = TP + TS, MROWS = BATCH * NMEM;
constexpr int DIN = 2224, DINP = 2304, DFF = 4096;
constexpr int ZQ = 0, ZK = 256, ZV = 512, ZR = 1024, ZA = 1536, ZQA = 1552, ZKVA = 1936, ZKPE = 2192;
constexpr float EPS = 1e-6f, MLA_SCALE = 0.10206207261596577f  , X_SCALE = 0.08838834764831845f  ;
constexpr int NC = SEQ / 64;
constexpr int NGP = BATCH * 4 * NC, NGS = DECB * 4, NGU = NGP + NGS;
constexpr int NSPLIT = NPAGES >= 8 ? 8 : NPAGES, PPS = NPAGES / NSPLIT;
constexpr int NU_SA = DECB * NSPLIT, NQB = SEQ / 256, NU_PA = BATCH * 8 * NQB;
constexpr int NU_XP = BATCH * 4 * NQB, NU_XS = DECB * 4;
static_assert(T % 256 == 0 && MROWS % 256 == 0 && SEQ % 256 == 0 && NPAGES % NSPLIT == 0, "shape assumptions");
constexpr int NTHREADS = 512, LDS_BYTES = 147456, LDS_CTL = LDS_BYTES - 256;

DI float bf2f(bf16 b) { return __uint_as_float(((unsigned)b) << 16); }
DI bf16 f2bf(float x) {
#ifdef EMU
    unsigned u = __float_as_uint(x); u += 0x7fffu + ((u >> 16) & 1u); return (bf16)(u >> 16);
#else
    return __builtin_bit_cast(unsigned short, (__bf16)x);
#endif
}
DI unsigned pk2(float a, float b) { return (unsigned)f2bf(a) | ((unsigned)f2bf(b) << 16); }
DI f32x16 zero16() { f32x16 z; for (int i = 0; i < 16; ++i) z[i] = 0.f; return z; }
DI f32x16 mfma32(bf16x8 a, bf16x8 b, f32x16 c) { return __builtin_amdgcn_mfma_f32_32x32x16_bf16(a, b, c, 0, 0, 0); }
DI int crow(int i, int h) { return (i & 3) + 8 * (i >> 2) + 4 * h; }
DI bf16x8 ld8(const LDS bf16* p) { return *(const LDS bf16x8*)p; }
DI bf16x8 ld8g(const bf16* p) { return *(const bf16x8*)p; }
DI bf16x8 ldperm(const LDS bf16* p16, int h) {
    const s16x4 lo = *(const LDS s16x4*)(p16 + 4 * h), hi = *(const LDS s16x4*)(p16 + 8 + 4 * h);
    return __builtin_shufflevector(lo, hi, 0, 1, 2, 3, 4, 5, 6, 7);
}
DI bf16x8 ldpermg(const bf16* p16, int h) {
    const s16x4 lo = *(const s16x4*)(p16 + 4 * h), hi = *(const s16x4*)(p16 + 8 + 4 * h);
    return __builtin_shufflevector(lo, hi, 0, 1, 2, 3, 4, 5, 6, 7);
}
DI bf16x8 pack8(float a0, float a1, float a2, float a3, float a4, float a5, float a6, float a7) {
    u32x4 p; p[0] = pk2(a0, a1); p[1] = pk2(a2, a3); p[2] = pk2(a4, a5); p[3] = pk2(a6, a7); return __builtin_bit_cast(bf16x8, p);
}
#define PACK(x, s) pack8((x)[8 * (s)], (x)[8 * (s) + 1], (x)[8 * (s) + 2], (x)[8 * (s) + 3], (x)[8 * (s) + 4], (x)[8 * (s) + 5], (x)[8 * (s) + 6], (x)[8 * (s) + 7])
DI float wsum(float v) { for (int o = 32; o >= 1; o >>= 1) v += __shfl_xor(v, o); return v; }
DI bf16x8 zero8() { bf16x8 z; for (int i = 0; i < 8; ++i) z[i] = 0; return z; }

namespace pg8 {
#define PG8_LAS LDS
typedef unsigned short bf16_t;
constexpr int BM = 256, BK = 64, HALF = 128, HTB = HALF * BK * 2  , STAGE_BYTES = 8 * HTB, NXCD = 8, WGM = 8;
__host__ __device__ __forceinline__ int lds_byte(int r, int c) { const int st = (r >> 4) * 2 + (c >> 5), rr = r & 15, cc = c & 31, ob = rr * 64 + cc * 2; return st * 1024 + (ob ^ (((ob >> 9) & 1) << 5)); }
__host__ __device__ __forceinline__ void stage_rc(int b, int& R, int& C) { const int st = b / 1024, sb = b % 1024, swz = sb ^ (((sb >> 9) & 1) << 5); R = (st >> 1) * 16 + swz / 64; C = (st & 1) * 32 + (swz % 64) / 2; }
__host__ __device__ __forceinline__ int perm32(int rho) { const int n = rho >> 4, i = rho & 15; return 8 * (i >> 2) + 4 * n + (i & 3); }
struct Unit { int pm, pn; };
struct Gemm { const bf16_t* A; const bf16_t* Bt; int M, N, K; };
struct StaticOrder {
    int nM, nN, nwg, G, c;
    __host__ __device__ void init(int M, int N, int G_, int c_) { nM = M / BM; nN = N / BM; nwg = nM * nN; G = G_; c = c_; }
    __host__ __device__ bool next(int i, Unit& u) const {
        const long L = (long)i * G + c; if (L >= nwg) return false;
        int wgid = (int)L; { const int q = nwg / NXCD, r = nwg % NXCD, xcd = wgid % NXCD, off = wgid / NXCD; wgid = (xcd < r ? xcd * (q + 1) : r * (q + 1) + (xcd - r) * q) + off; }
        const int nig = WGM * nN, gid = wgid / nig, fm = gid * WGM, gsz = (nM - fm) < WGM ? (nM - fm) : WGM;
        u.pm = fm + ((wgid % nig) % gsz); u.pn = (wgid % nig) / gsz; return true;
    }
    __device__ __forceinline__ void a_ready(const Unit&) const {}
    __device__ __forceinline__ void done(const Unit&) const {}
};
#ifdef EMU
template <class Epi, class Sched>
__device__ __forceinline__ void gemm_phase(PG8_LAS unsigned char* lds, const Gemm g, const Sched& S, const Epi& E) {
    const int tid = threadIdx.x, wid = tid >> 6, lane = tid & 63, wr = wid >> 2, wc = wid & 3, fr = lane & 15, fq = lane >> 4;
    Unit cur;
    for (int ui = 0; S.next(ui, cur); ++ui) {
        f32x4 acc[2][2][4][2];
        for (int ai = 0; ai < 2; ++ai) for (int bj = 0; bj < 2; ++bj) for (int m = 0; m < 4; ++m) for (int n = 0; n < 2; ++n) for (int j = 0; j < 4; ++j) {
            const int row = 256 * cur.pm + 128 * ai + 64 * wr + 16 * m + fr;
            const int col = Epi::PERM ? 256 * cur.pn + 128 * bj + 32 * wc + 8 * fq + 4 * n + j : 256 * cur.pn + 128 * bj + 32 * wc + 16 * n + 4 * fq + j;
            const bf16_t* a = g.A + (size_t)row * g.K; const bf16_t* b = g.Bt + (size_t)col * g.K; float s = 0.f;
            for (int k = 0; k < g.K; ++k) s += bf2f(a[k]) * bf2f(b[k]);
            acc[ai][bj][m][n][j] = s;
        }
        E(acc, cur, wr, wc, fr, fq);
    }
}
#else
template <class Epi, class Sched>
__device__ __forceinline__ void gemm_phase(PG8_LAS unsigned char* lds, const Gemm g, const Sched& S, const Epi& E) {
    const int tid = threadIdx.x, wid = __builtin_amdgcn_readfirstlane(tid >> 6), lane = tid & 63, wr = wid >> 2, wc = wid & 3, fr = lane & 15, fq = lane >> 4;
    const int K = g.K, nt = K / BK;
    unsigned voffA[2], voffB[2];
#pragma unroll
    for (int i = 0; i < 2; ++i) { int R, C; stage_rc(tid * 16 + i * 8192, R, C); const int Rb = Epi::PERM ? ((R & ~31) + perm32(R & 31)) : R;
        voffA[i] = (unsigned)(R * K + C) * 2u; voffB[i] = (unsigned)(Rb * K + C) * 2u; }
    const size_t kstep = (size_t)(BK * 2);
    const size_t hstep = (size_t)HALF * K * 2;
    const size_t tstep = 2 * hstep;
    const unsigned ldsw = (unsigned)wid * 1024u;
    const int aoff = lds_byte(wr * 64 + fr, fq * 8), boff = lds_byte(wc * 32 + fr, fq * 8);
#define PG8_SA(b, h) (((b) * 2 + (h)) * HTB)
#define PG8_SB(b, h) ((4 + (b) * 2 + (h)) * HTB)
#define PG8_STAGE(bufoff, gbase, voff) do { _Pragma("unroll") for (int _i = 0; _i < 2; ++_i) \
        __builtin_amdgcn_global_load_lds((const unsigned*)((const char*)(gbase) + (voff)[_i]), (PG8_LAS unsigned*)(lds + (bufoff) + ldsw + _i * 8192), 16, 0, 0); } while (0)
#define PG8_LDA(dst, b, h) do { _Pragma("unroll") for (int m = 0; m < 4; ++m) _Pragma("unroll") for (int k = 0; k < 2; ++k) dst[m][k] = *(const PG8_LAS bf16x8*)(lds + PG8_SA(b, h) + aoff + m * 2048 + k * 1024); } while (0)
#define PG8_LDB(dst, b, h) do { _Pragma("unroll") for (int n = 0; n < 2; ++n) _Pragma("unroll") for (int k = 0; k < 2; ++k) dst[n][k] = *(const PG8_LAS bf16x8*)(lds + PG8_SB(b, h) + boff + n * 2048 + k * 1024); } while (0)
#define PG8_MMA(ai, bj, At, Bt) do { __builtin_amdgcn_s_setprio(1); _Pragma("unroll") for (int m = 0; m < 4; ++m) _Pragma("unroll") for (int n = 0; n < 2; ++n) _Pragma("unroll") for (int k = 0; k < 2; ++k) \
        acc[ai][bj][m][n] = __builtin_amdgcn_mfma_f32_16x16x32_bf16(Bt[n][k], At[m][k], acc[ai][bj][m][n], 0, 0, 0); __builtin_amdgcn_s_setprio(0); } while (0)
#define PG8_WAIT_V(n) asm volatile("s_waitcnt vmcnt(" #n ")" ::: "memory")
#define PG8_WAIT_L(n) asm volatile("s_waitcnt lgkmcnt(" #n ")" ::: "memory")
#define PG8_BAR __builtin_amdgcn_s_barrier()
#define PG8_SCHED __builtin_amdgcn_sched_barrier(0)
    Unit cur, nxt; int ui = 0;
    if (!S.next(0, cur)) return;
    f32x4 acc[2][2][4][2];
#pragma unroll
    for (int a = 0; a < 2; ++a)
#pragma unroll
        for (int b = 0; b < 2; ++b)
#pragma unroll
            for (int m = 0; m < 4; ++m)
#pragma unroll
                for (int n = 0; n < 2; ++n) acc[a][b][m][n] = (f32x4){0.f, 0.f, 0.f, 0.f};
    bf16x8 At[4][2], B0[2][2], B1[2][2];
    const char* cA = (const char*)g.A + (size_t)cur.pm * tstep; const char* cB = (const char*)g.Bt + (size_t)cur.pn * tstep;
    S.a_ready(cur);
    PG8_STAGE(PG8_SB(0, 0), cB, voffB); PG8_STAGE(PG8_SA(0, 0), cA, voffA); PG8_STAGE(PG8_SB(0, 1), cB + hstep, voffB); PG8_STAGE(PG8_SA(0, 1), cA + hstep, voffA);
    if (wr == 1) PG8_BAR;
    PG8_WAIT_V(4); PG8_BAR;
    PG8_STAGE(PG8_SB(1, 0), cB + kstep, voffB); PG8_STAGE(PG8_SA(1, 0), cA + kstep, voffA); PG8_STAGE(PG8_SB(1, 1), cB + hstep + kstep, voffB);
    PG8_WAIT_V(6); PG8_BAR;
    for (;;) {
        const bool has_next = S.next(ui + 1, nxt);
        const char* nA = has_next ? (const char*)g.A + (size_t)nxt.pm * tstep : cA; const char* nB = has_next ? (const char*)g.Bt + (size_t)nxt.pn * tstep : cB;
        for (int t = 0; t < nt; t += 2) {
            const bool last = (t == nt - 2);
            const char* a1 = cA + (size_t)(t + 1) * kstep;
            const char* a2 = last ? nA : cA + (size_t)(t + 2) * kstep; const char* b2 = last ? nB : cB + (size_t)(t + 2) * kstep;
            const char* a3 = a2 + kstep; const char* b3 = b2 + kstep;
            if (last && has_next) S.a_ready(nxt);
            PG8_LDB(B0, 0, 0); PG8_SCHED; PG8_LDA(At, 0, 0); PG8_STAGE(PG8_SA(1, 1), a1 + hstep, voffA);
            PG8_WAIT_L(8); PG8_BAR; PG8_WAIT_L(0); PG8_MMA(0, 0, At, B0); PG8_BAR; PG8_SCHED;
            PG8_LDB(B1, 0, 1); PG8_STAGE(PG8_SB(0, 0), b2, voffB);
            PG8_BAR; PG8_WAIT_L(0); PG8_MMA(0, 1, At, B1); PG8_BAR;
            PG8_LDA(At, 0, 1); PG8_STAGE(PG8_SA(0, 0), a2, voffA);
            PG8_BAR; PG8_WAIT_L(0); PG8_MMA(1, 0, At, B0); PG8_BAR; PG8_SCHED;
            PG8_STAGE(PG8_SB(0, 1), b2 + hstep, voffB);
            PG8_WAIT_V(6); PG8_BAR; PG8_MMA(1, 1, At, B1); PG8_BAR;
            PG8_LDB(B0, 1, 0); PG8_SCHED; PG8_LDA(At, 1, 0); PG8_STAGE(PG8_SA(0, 1), a2 + hstep, voffA);
            PG8_WAIT_L(8); PG8_BAR; PG8_WAIT_L(0); PG8_MMA(0, 0, At, B0); PG8_BAR; PG8_SCHED;
            PG8_LDB(B1, 1, 1); PG8_STAGE(PG8_SB(1, 0), b3, voffB);
            PG8_BAR; PG8_WAIT_L(0); PG8_MMA(0, 1, At, B1); PG8_BAR;
            PG8_LDA(At, 1, 1); PG8_STAGE(PG8_SA(1, 0), a3, voffA);
            PG8_BAR; PG8_WAIT_L(0); PG8_MMA(1, 0, At, B0); PG8_BAR; PG8_SCHED;
            PG8_STAGE(PG8_SB(1, 1), b3 + hstep, voffB);
            PG8_WAIT_V(6); PG8_BAR; PG8_MMA(1, 1, At, B1); PG8_BAR;
        }
        if constexpr (!Epi::AFTER_DRAIN) { E(acc, cur, wr, wc, fr, fq); S.done(cur); }
        if (!has_next) break;
#pragma unroll
        for (int a = 0; a < 2; ++a)
#pragma unroll
            for (int b = 0; b < 2; ++b)
#pragma unroll
                for (int m = 0; m < 4; ++m)
#pragma unroll
                    for (int n = 0; n < 2; ++n) acc[a][b][m][n] = (f32x4){0.f, 0.f, 0.f, 0.f};
        cur = nxt; cA = nA; cB = nB; ++ui;
    }
    PG8_WAIT_V(0);
    if (wr == 0) PG8_BAR;
    PG8_BAR;
    if constexpr (Epi::AFTER_DRAIN) { E.fused(acc, cur, wr, wc, fr, fq, lds, wid, lane); S.done(cur); }
#undef PG8_SA
#undef PG8_SB
#undef PG8_STAGE
#undef PG8_LDA
#undef PG8_LDB
#undef PG8_MMA
#undef PG8_WAIT_V
#undef PG8_WAIT_L
#undef PG8_BAR
#undef PG8_SCHED
}
#endif
}

struct Params {
    const float *xp, *xs, *memp, *cckv, *ckpe, *cmk, *cmv, *sgla; const int* ptab;
    const float *g_mix, *w_a2, *b_a, *g_gla_o, *g_qa, *g_kva, *g_qn, *g_kn, *g_qr, *g_kr, *g_x, *g_mem, *g_xq, *g_xk, *g_ff;
    float *y, *o_ckvp, *o_kpep, *o_mkp, *o_mvp, *o_glap, *o_ckvs, *o_kpes, *o_glas;
    unsigned* ctl;
    bf16 *wt_in, *wt_qb, *wt_kvb, *wt_out, *wt_xq, *wt_xkv, *wt_xo, *wt_ff1, *wt_ff2;
    bf16 *H, *MEMN, *Z, *QAN, *CKVB, *KPB, *MKB, *MVB, *QF, *KV, *QN, *KN, *OMIX, *XQ, *XO, *U;
    float *MKV, *LOGA, *DS, *DDEC, *X1, *X2, *PACC, *PML;
    const float *w_in, *w_qb, *w_kvb, *w_out, *w_xq, *w_xk, *w_xv, *w_xo, *w_ff1, *w_ff2;
};
constexpr int CW_Q5 = 0, CW_QX = 256, CW_BAR = 4096;

template <int ACT  > struct EpiStoreBf16 {
    static constexpr bool PERM = true, AFTER_DRAIN = false;
    bf16* O; int ldc;
    DI void operator()(const f32x4 (&acc)[2][2][4][2], const pg8::Unit& u, int wr, int wc, int fr, int fq) const {
        const int row0 = u.pm * 256 + wr * 64 + fr, col0 = u.pn * 256 + wc * 32 + 8 * fq;
#pragma unroll
        for (int ai = 0; ai < 2; ++ai)
#pragma unroll
            for (int m = 0; m < 4; ++m) { bf16* rowp = O + (size_t)(row0 + ai * 128 + m * 16) * ldc + col0;
#pragma unroll
                for (int bj = 0; bj < 2; ++bj) { f32x4 v0 = acc[ai][bj][m][0], v1 = acc[ai][bj][m][1];
                    if (ACT == 1) {
#pragma unroll
                        for (int j = 0; j < 4; ++j) { const float a = fmaxf(v0[j], 0.f), b = fmaxf(v1[j], 0.f); v0[j] = a * a; v1[j] = b * b; } }
                    u32x4 w; w[0] = pk2(v0[0], v0[1]); w[1] = pk2(v0[2], v0[3]); w[2] = pk2(v1[0], v1[1]); w[3] = pk2(v1[2], v1[3]);
                    *(u32x4*)(rowp + bj * 128) = w; } }
    }
};
struct EpiStoreF32 {
    static constexpr bool PERM = false, AFTER_DRAIN = false;
    float* C; const float* R; int ldc;
    DI void operator()(const f32x4 (&acc)[2][2][4][2], const pg8::Unit& u, int wr, int wc, int fr, int fq) const {
        const int row0 = u.pm * 256 + wr * 64 + fr, col0 = u.pn * 256 + wc * 32 + 4 * fq;
#pragma unroll
        for (int ai = 0; ai < 2; ++ai)
#pragma unroll
            for (int m = 0; m < 4; ++m) { const size_t off = (size_t)(row0 + ai * 128 + m * 16) * ldc + col0;
#pragma unroll
                for (int bj = 0; bj < 2; ++bj)
#pragma unroll
                    for (int n = 0; n < 2; ++n) { f32x4 v = acc[ai][bj][m][n]; if (R) v += *(const f32x4*)(R + off + bj * 128 + n * 16); *(f32x4*)(C + off + bj * 128 + n * 16) = v; } }
    }
};
template <class Epi> DI void run_gemm(LDS unsigned char* lds, const bf16* A, const bf16* Bt, int M, int N, int K, const Epi& E, int rot) {
    pg8::Gemm g{A, Bt, M, N, K}; pg8::StaticOrder S; S.init(M, N, (int)gridDim.x, (int)((blockIdx.x + rot) % gridDim.x));
    pg8::gemm_phase<Epi, pg8::StaticOrder>(lds, g, S, E);
}

DI const float* xrow(const Params& p, int t) { return t < TP ? p.xp + (size_t)t * DM : p.xs + (size_t)(t - TP) * DM; }
DI void rmsnorm_row_1024(const float* src, const float* g, bf16* dst, int lane) {
    f32x4 v[4]; float ss = 0.f;
#pragma unroll
    for (int i = 0; i < 4; ++i) { v[i] = *(const f32x4*)(src + 4 * (lane + 64 * i)); ss += v[i][0] * v[i][0] + v[i][1] * v[i][1] + v[i][2] * v[i][2] + v[i][3] * v[i][3]; }
    ss = wsum(ss); const float rs = rsqrtf(ss * (1.0f / 1024.0f) + EPS);
#pragma unroll
    for (int i = 0; i < 4; ++i) { const f32x4 gg = *(const f32x4*)(g + 4 * (lane + 64 * i)); u32x2 w; w[0] = pk2(v[i][0] * rs * gg[0], v[i][1] * rs * gg[1]); w[1] = pk2(v[i][2] * rs * gg[2], v[i][3] * rs * gg[3]);
        *(u32x2*)(dst + 4 * (lane + 64 * i)) = w; }
}
template <int K, int N, int NPAD> DI void prep_job(const float* W, bf16* Wt, LDS float* tl, int rot) {
    const int tid = threadIdx.x; constexpr int nkt = K / 64, ntiles = (NPAD / 64) * nkt;
    for (int tile = (int)((blockIdx.x + rot) % gridDim.x); tile < ntiles; tile += gridDim.x) {
        const int tn = tile / nkt, tk = tile % nkt;
        { const int kk = tid >> 3, n8 = (tid & 7) * 8; const int n = tn * 64 + n8; const float* s = W + (size_t)(tk * 64 + kk) * N + n;
            f32x4 a = {0.f, 0.f, 0.f, 0.f}, b = a; if (n < N) { a = *(const f32x4*)s; b = *(const f32x4*)(s + 4); }
#pragma unroll
            for (int q = 0; q < 4; ++q) { tl[kk * 65 + n8 + q] = a[q]; tl[kk * 65 + n8 + 4 + q] = b[q]; } }
        __syncthreads();
        { const int nn = tid >> 3, k8 = (tid & 7) * 8; u32x4 w;
#pragma unroll
            for (int q = 0; q < 4; ++q) w[q] = pk2(tl[(k8 + 2 * q) * 65 + nn], tl[(k8 + 2 * q + 1) * 65 + nn]);
            *(u32x4*)(Wt + (size_t)(tn * 64 + nn) * K + tk * 64 + k8) = w; }
        __syncthreads();
    }
}
DI void phase_prep(const Params& p, LDS unsigned char* lds) {
    const int tid = threadIdx.x, wid = tid >> 6, lane = tid & 63;
    LDS float* tl = (LDS float*)lds;
    prep_job<DM, DIN, DINP>(p.w_in, p.wt_in, tl, 0); prep_job<384, 768, 768>(p.w_qb, p.wt_qb, tl, 64); prep_job<256, 1024, 1024>(p.w_kvb, p.wt_kvb, tl, 136); prep_job<DM, DM, DM>(p.w_out, p.wt_out, tl, 200);
    prep_job<DM, 512, 512>(p.w_xq, p.wt_xq, tl, 0); prep_job<DM, 512, 512>(p.w_xk, p.wt_xkv, tl, 128); prep_job<DM, 512, 512>(p.w_xv, p.wt_xkv + (size_t)512 * DM, tl, 0); prep_job<512, DM, DM>(p.w_xo, p.wt_xo, tl, 128);
    prep_job<DM, DFF, DFF>(p.w_ff1, p.wt_ff1, tl, 0); prep_job<DFF, DM, DM>(p.w_ff2, p.wt_ff2, tl, 0);
    for (int row = blockIdx.x * 8 + wid; row < T + MROWS; row += gridDim.x * 8) {
        if (row < T) rmsnorm_row_1024(xrow(p, row), p.g_mix, p.H + (size_t)row * DM, lane);
        else rmsnorm_row_1024(p.memp + (size_t)(row - T) * DM, p.g_mem, p.MEMN + (size_t)(row - T) * DM, lane);
    }
}

DI float rope32(float xn, int lane, int pos) {
    const float partner = __shfl_xor(xn, 16);
    const int i = lane & 15; const float inv = expf(-(float)i * (9.210340371976184f / 16.0f)); const float ang = (float)pos * inv;
    const float c = cosf(ang), s = sinf(ang);
    return (lane & 16) ? xn * c + partner * s : xn * c - partner * s;
}
DI int row_pos(int t) { return t < TP ? (t % SEQ) : PAST + ((t - TP) % DECS); }

DI void phase_post_in(const Params& p) {
    const int tid = threadIdx.x, wid = tid >> 6, lane = tid & 63;
    for (int row = blockIdx.x * 8 + wid; row < T + MROWS; row += gridDim.x * 8) {
        if (row < T) {
            const int t = row; const bf16* z = p.Z + (size_t)t * DINP;
            float a[16];
#pragma unroll
            for (int i = 0; i < 16; ++i) a[i] = bf2f(z[ZA + i]);
#pragma unroll
            for (int q = 0; q < 4; ++q) { const int c = lane + 64 * q; float gp = p.b_a[c];
#pragma unroll
                for (int i = 0; i < 16; ++i) gp += a[i] * p.w_a2[i * 256 + c];
                const float ls = fminf(gp, 0.f) - log1pf(expf(-fabsf(gp)));
                p.LOGA[(size_t)t * 256 + c] = ls * (1.0f / 16.0f); }
            { float v[6]; float ss = 0.f;
#pragma unroll
                for (int q = 0; q < 6; ++q) { v[q] = bf2f(z[ZQA + lane + 64 * q]); ss += v[q] * v[q]; }
                ss = wsum(ss); const float rs = rsqrtf(ss * (1.0f / 384.0f) + EPS);
#pragma unroll
                for (int q = 0; q < 6; ++q) p.QAN[(size_t)t * 384 + lane + 64 * q] = f2bf(v[q] * rs * p.g_qa[lane + 64 * q]); }
            { float v[4]; float ss = 0.f;
#pragma unroll
                for (int q = 0; q < 4; ++q) { v[q] = bf2f(z[ZKVA + lane + 64 * q]); ss += v[q] * v[q]; }
                ss = wsum(ss); const float rs = rsqrtf(ss * (1.0f / 256.0f) + EPS);
                float* oc = t < TP ? p.o_ckvp + (size_t)t * 256 : p.o_ckvs + (size_t)(t - TP) * 256;
#pragma unroll
                for (int q = 0; q < 4; ++q) { const float c = v[q] * rs * p.g_kva[lane + 64 * q]; oc[lane + 64 * q] = c; p.CKVB[(size_t)t * 256 + lane + 64 * q] = f2bf(c); } }
            { const float v = lane < 32 ? bf2f(z[ZKPE + lane]) : 0.f; const float ss = wsum(v * v); const float rs = rsqrtf(ss * (1.0f / 32.0f) + EPS);
                const float xn = v * rs * p.g_kr[lane & 31]; const float o = rope32(xn, lane, row_pos(t));
                if (lane < 32) { float* ok = t < TP ? p.o_kpep + (size_t)t * 32 : p.o_kpes + (size_t)(t - TP) * 32; ok[lane] = o; p.KPB[(size_t)t * 32 + lane] = f2bf(o); } }
        } else {
            const int r = row - T; const float* s = p.MKV + (size_t)r * 1024;
            float v[8]; float ss = 0.f;
#pragma unroll
            for (int q = 0; q < 8; ++q) { v[q] = s[lane * 8 + q]; ss += v[q] * v[q]; }
            ss += __shfl_xor(ss, 1); ss += __shfl_xor(ss, 2); ss += __shfl_xor(ss, 4); ss += __shfl_xor(ss, 8);
            const float rs = rsqrtf(ss * (1.0f / 128.0f) + EPS);
#pragma unroll
            for (int q = 0; q < 8; ++q) { const int c = lane * 8 + q; const float k = v[q] * rs * p.g_xk[c & 127]; p.o_mkp[(size_t)r * 512 + c] = k; p.MKB[(size_t)r * 512 + c] = f2bf(k);
                const float vv = s[512 + c]; p.o_mvp[(size_t)r * 512 + c] = vv; p.MVB[(size_t)r * 512 + c] = f2bf(vv); }
        }
    }
}

DI void phase_post_qkv(const Params& p) {
    const int tid = threadIdx.x, wid = tid >> 6, lane = tid & 63;
    for (int t = blockIdx.x * 8 + wid; t < T; t += gridDim.x * 8) {
        const bf16* qf = p.QF + (size_t)t * 768; const bf16* kv = p.KV + (size_t)t * 1024; const int pos = row_pos(t);
        for (int h = 0; h < 8; ++h) {
            const float v = bf2f(qf[h * 96 + lane]); const float ss = wsum(v * v); const float rs = rsqrtf(ss * (1.0f / 64.0f) + EPS);
            p.QN[((size_t)t * 8 + h) * 96 + lane] = f2bf(v * rs * p.g_qn[lane] * MLA_SCALE);
            const float vr = lane < 32 ? bf2f(qf[h * 96 + 64 + lane]) : 0.f; const float ssr = wsum(vr * vr); const float rsr = rsqrtf(ssr * (1.0f / 32.0f) + EPS);
            const float xr = vr * rsr * p.g_qr[lane & 31]; const float o = rope32(xr, lane, pos);
            if (lane < 32) p.QN[((size_t)t * 8 + h) * 96 + 64 + lane] = f2bf(o * MLA_SCALE);
            const float k = bf2f(kv[h * 128 + lane]); const float sk = wsum(k * k); const float rk = rsqrtf(sk * (1.0f / 64.0f) + EPS);
            p.KN[((size_t)t * 8 + h) * 64 + lane] = f2bf(k * rk * p.g_kn[lane]);
        }
    }
}
struct GlaUnit { int t0, h, nv; };
DI GlaUnit gla_unit(int u) { GlaUnit g; if (u < NGP) { const int b = u / (4 * NC), h = (u / NC) % 4, c = u % NC; g.t0 = b * SEQ + c * 64; g.h = h; g.nv = 64; } else { const int us = u - NGP; g.t0 = TP + (us >> 2) * DECS; g.h = us & 3; g.nv = DECS; } return g; }
DI void gla_cumsum(const Params& p, const GlaUnit& g, LDS float* LA, int tid) {
    for (int i = tid; i < 64 * 64; i += NTHREADS) { const int s = i >> 6, kd = i & 63; LA[s * 65 + kd] = s < g.nv ? p.LOGA[(size_t)(g.t0 + s) * 256 + g.h * 64 + kd] : 0.f; }
    __syncthreads();
    if (tid < 64) { float a = 0.f; for (int s = 0; s < 64; ++s) { a += LA[s * 65 + tid]; LA[s * 65 + tid] = a; } }
    __syncthreads();
}
constexpr int GL_LA = 0, GL_KH = 16640  , GL_VT = GL_KH + 64 * 72 * 2, GL_QT = GL_VT + 128 * 72 * 2, GL_ST = GL_QT + 64 * 72 * 2, GL_ATT = GL_ST + 128 * 72 * 2, GL_OB = GL_ATT + 64 * 72 * 2, GL_END = GL_OB + 64 * 129 * 4;
static_assert(GL_END <= LDS_CTL && GL_KH % 16 == 0 && GL_OB % 16 == 0, "GLA LDS map");
DI void phase_gla_a(const Params& p, LDS unsigned char* lds) {
    const int tid = threadIdx.x, wid = tid >> 6, lane = tid & 63, r = lane & 31, hh = lane >> 5;
    LDS float* LA = (LDS float*)(lds + GL_LA); LDS bf16* KH = (LDS bf16*)(lds + GL_KH); LDS bf16* VT = (LDS bf16*)(lds + GL_VT);
    for (int u = blockIdx.x; u < NGU; u += gridDim.x) {
        const GlaUnit g = gla_unit(u);
        gla_cumsum(p, g, LA, tid);
        for (int i = tid; i < 64 * 64; i += NTHREADS) { const int s = i >> 6, kd = i & 63;
            float v = 0.f; if (s < g.nv) v = bf2f(p.Z[(size_t)(g.t0 + s) * DINP + ZK + g.h * 64 + kd]) * expf(LA[63 * 65 + kd] - LA[s * 65 + kd]);
            KH[kd * 72 + s] = f2bf(v); }
        for (int i = tid; i < 64 * 128; i += NTHREADS) { const int s = i >> 7, dv = i & 127;
            VT[dv * 72 + s] = s < g.nv ? p.Z[(size_t)(g.t0 + s) * DINP + ZV + g.h * 128 + dv] : (bf16)0; }
        if (tid < 64) p.DDEC[(size_t)u * 64 + tid] = expf(LA[63 * 65 + tid]);
        __syncthreads();
        { const int mt = wid & 1, nt = wid >> 1; f32x16 acc = zero16();
#pragma unroll
            for (int ks = 0; ks < 4; ++ks) acc = mfma32(ld8(KH + (32 * mt + r) * 72 + 16 * ks + 8 * hh), ld8(VT + (32 * nt + r) * 72 + 16 * ks + 8 * hh), acc);
            float* d = p.DS + (size_t)u * 8192;
#pragma unroll
            for (int i = 0; i < 16; ++i) d[(32 * mt + crow(i, hh)) * 128 + 32 * nt + r] = acc[i]; }
        __syncthreads();
    }
}
DI void phase_gla_b(const Params& p) {
    const int gid = blockIdx.x * NTHREADS + threadIdx.x, gsz = gridDim.x * NTHREADS;
    for (int e = gid; e < BATCH * 4 * 8192; e += gsz) { const int bh = e >> 13, idx = e & 8191, kd = idx >> 7; float S = 0.f;
        for (int c = 0; c < NC; ++c) { const size_t u = (size_t)bh * NC + c; const float d = p.DS[u * 8192 + idx]; p.DS[u * 8192 + idx] = S; S = S * p.DDEC[u * 64 + kd] + d; }
        p.o_glap[e] = S; }
    for (int e = gid; e < DECB * 4 * 8192; e += gsz) { const int bh = e >> 13, idx = e & 8191, kd = idx >> 7; const size_t u = (size_t)NGP + bh;
        p.o_glas[e] = p.sgla[e] * p.DDEC[u * 64 + kd] + p.DS[u * 8192 + idx]; }
}
DI void gla_c_unit(const Params& p, LDS unsigned char* lds, int u) {
    const int tid = threadIdx.x, wid = tid >> 6, lane = tid & 63, r = lane & 31, hh = lane >> 5;
    LDS float* LA = (LDS float*)(lds + GL_LA); LDS bf16* KT = (LDS bf16*)(lds + GL_KH); LDS bf16* VT = (LDS bf16*)(lds + GL_VT); LDS bf16* QT = (LDS bf16*)(lds + GL_QT);
    LDS bf16* ST = (LDS bf16*)(lds + GL_ST); LDS bf16* ATT = (LDS bf16*)(lds + GL_ATT); LDS float* OB = (LDS float*)(lds + GL_OB);
    const GlaUnit g = gla_unit(u);
    gla_cumsum(p, g, LA, tid);
    for (int i = tid; i < 64 * 64; i += NTHREADS) { const int s = i >> 6, kd = i & 63; float q = 0.f, k = 0.f;
        if (s < g.nv) { const bf16* z = p.Z + (size_t)(g.t0 + s) * DINP; const float b = LA[s * 65 + kd]; q = bf2f(z[ZQ + g.h * 64 + kd]) * expf(b) * 0.125f; k = bf2f(z[ZK + g.h * 64 + kd]) * expf(-b); }
        QT[s * 72 + kd] = f2bf(q); KT[s * 72 + kd] = f2bf(k); }
    for (int i = tid; i < 64 * 128; i += NTHREADS) { const int s = i >> 7, dv = i & 127;
        VT[dv * 72 + s] = s < g.nv ? p.Z[(size_t)(g.t0 + s) * DINP + ZV + g.h * 128 + dv] : (bf16)0; }
    { const float* sp = u < NGP ? p.DS + (size_t)u * 8192 : p.sgla + (size_t)(u - NGP) * 8192;
        for (int i = tid; i < 8192; i += NTHREADS) { const int kd = i >> 7, dv = i & 127; ST[dv * 72 + kd] = f2bf(sp[i]); } }
    __syncthreads();
    if (wid < 4) { const int mt = wid & 1, nt = wid >> 1; f32x16 acc = zero16();
#pragma unroll
        for (int ks = 0; ks < 4; ++ks) acc = mfma32(ld8(QT + (32 * mt + r) * 72 + 16 * ks + 8 * hh), ld8(KT + (32 * nt + r) * 72 + 16 * ks + 8 * hh), acc);
#pragma unroll
        for (int i = 0; i < 16; ++i) { const int t = 32 * mt + crow(i, hh), s = 32 * nt + r; ATT[t * 72 + s] = f2bf(s <= t ? acc[i] : 0.f); } }
    __syncthreads();
    { const int mt = wid & 1, nt = wid >> 1; f32x16 acc = zero16();
#pragma unroll
        for (int ks = 0; ks < 4; ++ks) acc = mfma32(ld8(QT + (32 * mt + r) * 72 + 16 * ks + 8 * hh), ld8(ST + (32 * nt + r) * 72 + 16 * ks + 8 * hh), acc);
#pragma unroll
        for (int ks = 0; ks < 4; ++ks) acc = mfma32(ld8(ATT + (32 * mt + r) * 72 + 16 * ks + 8 * hh), ld8(VT + (32 * nt + r) * 72 + 16 * ks + 8 * hh), acc);
#pragma unroll
        for (int i = 0; i < 16; ++i) OB[(32 * mt + crow(i, hh)) * 129 + 32 * nt + r] = acc[i]; }
    __syncthreads();
    for (int t = wid; t < g.nv; t += 8) { const float o0 = OB[t * 129 + lane], o1 = OB[t * 129 + 64 + lane]; const float ss = wsum(o0 * o0 + o1 * o1); const float rs = rsqrtf(ss * (1.0f / 128.0f) + EPS);
        const bf16* z = p.Z + (size_t)(g.t0 + t) * DINP + ZR + g.h * 128; bf16* o = p.OMIX + (size_t)(g.t0 + t) * DM + g.h * 128;
        const float r0 = bf2f(z[lane]), r1 = bf2f(z[64 + lane]);
        o[lane] = f2bf(o0 * rs * p.g_gla_o[lane] * (r0 / (1.0f + expf(-r0)))); o[64 + lane] = f2bf(o1 * rs * p.g_gla_o[64 + lane] * (r1 / (1.0f + expf(-r1)))); }
}
constexpr int PA_KT = 0, PA_VT = 64 * 104 * 2, PA_END = PA_VT + 64 * 72 * 2;
DI void pattn_unit(const Params& p, LDS unsigned char* lds, int u) {
    const int tid = threadIdx.x, wid = tid >> 6, lane = tid & 63, r = lane & 31, hh = lane >> 5;
    LDS bf16* KT = (LDS bf16*)(lds + PA_KT); LDS bf16* VT = (LDS bf16*)(lds + PA_VT);
    const int qb = NQB - 1 - u / (BATCH * 8), bh = u % (BATCH * 8), b = bh >> 3, h = bh & 7;
    const int qw0 = qb * 256 + 32 * wid, qpos = qw0 + r; const size_t trow = (size_t)b * SEQ + qpos;
    bf16x8 qf[6];
#pragma unroll
    for (int ks = 0; ks < 6; ++ks) qf[ks] = ld8g(p.QN + (trow * 8 + h) * 96 + 16 * ks + 8 * hh);
    f32x16 o0 = zero16(), o1 = zero16(); float m = -INFINITY, l = 0.f;
    const int nkt = 4 * (qb + 1);
    for (int kt = 0; kt < nkt; ++kt) {
        const int k0 = kt * 64; const size_t kr0 = (size_t)b * SEQ + k0;
        for (int i = tid; i < 64 * 12; i += NTHREADS) { const int key = i / 12, c = i % 12;
            const bf16x8 v = c < 8 ? ld8g(p.KN + ((kr0 + key) * 8 + h) * 64 + c * 8) : ld8g(p.KPB + (kr0 + key) * 32 + (c - 8) * 8);
            *(LDS bf16x8*)(KT + key * 104 + c * 8) = v; }
        { const int key = tid >> 3, c8 = (tid & 7) * 8; const bf16x8 v = ld8g(p.KV + (kr0 + key) * 1024 + h * 128 + 64 + c8);
#pragma unroll
            for (int j = 0; j < 8; ++j) VT[(c8 + j) * 72 + key] = (bf16)v[j]; }
        __syncthreads();
        if (k0 <= qw0 + 31) {
            f32x16 s0 = zero16(), s1 = zero16();
#pragma unroll
            for (int ks = 0; ks < 6; ++ks) { s0 = mfma32(ld8(KT + r * 104 + 16 * ks + 8 * hh), qf[ks], s0); s1 = mfma32(ld8(KT + (32 + r) * 104 + 16 * ks + 8 * hh), qf[ks], s1); }
            float tmax = -INFINITY;
#pragma unroll
            for (int i = 0; i < 16; ++i) { const int key = k0 + crow(i, hh); if (key > qpos) s0[i] = -INFINITY; if (key + 32 > qpos) s1[i] = -INFINITY; tmax = fmaxf(tmax, fmaxf(s0[i], s1[i])); }
            tmax = fmaxf(tmax, __shfl_xor(tmax, 32));
            const float mn = fmaxf(m, tmax), corr = expf(m - mn); m = mn; float ps = 0.f;
#pragma unroll
            for (int i = 0; i < 16; ++i) { s0[i] = expf(s0[i] - mn); s1[i] = expf(s1[i] - mn); ps += s0[i] + s1[i]; }
            l = l * corr + ps;
#pragma unroll
            for (int i = 0; i < 16; ++i) { o0[i] *= corr; o1[i] *= corr; }
#pragma unroll
            for (int s = 0; s < 2; ++s) { const bf16x8 pa = PACK(s0, s), pb = PACK(s1, s);
                o0 = mfma32(ldperm(VT + r * 72 + 16 * s, hh), pa, o0); o1 = mfma32(ldperm(VT + (32 + r) * 72 + 16 * s, hh), pa, o1);
                o0 = mfma32(ldperm(VT + r * 72 + 32 + 16 * s, hh), pb, o0); o1 = mfma32(ldperm(VT + (32 + r) * 72 + 32 + 16 * s, hh), pb, o1); }
        }
        __syncthreads();
    }
    l += __shfl_xor(l, 32); const float il = 1.0f / l;
    bf16* o = p.OMIX + trow * DM + 512 + h * 64;
#pragma unroll
    for (int g = 0; g < 4; ++g) { u32x2 w0, w1; w0[0] = pk2(o0[4 * g] * il, o0[4 * g + 1] * il); w0[1] = pk2(o0[4 * g + 2] * il, o0[4 * g + 3] * il); w1[0] = pk2(o1[4 * g] * il, o1[4 * g + 1] * il); w1[1] = pk2(o1[4 * g + 2] * il, o1[4 * g + 3] * il);
        *(u32x2*)(o + 8 * g + 4 * hh) = w0; *(u32x2*)(o + 32 + 8 * g + 4 * hh) = w1; }
}

constexpr int XA_K = 0, XA_V = 256 * 136 * 2, XA_END = XA_V + 128 * 264 * 2;
static_assert(XA_END <= LDS_CTL && XA_V % 16 == 0, "cross-attention LDS map");
DI void xattn_unit(const Params& p, LDS unsigned char* lds, int u) {
    const int tid = threadIdx.x, wid = tid >> 6, lane = tid & 63, r = lane & 31, hh = lane >> 5;
    LDS bf16* KX = (LDS bf16*)(lds + XA_K); LDS bf16* VX = (LDS bf16*)(lds + XA_V);
    int b, h, nrows; size_t tbase;
    if (u < NU_XP) { b = u / (4 * NQB); h = (u / NQB) & 3; const int qc = u % NQB; nrows = 256; tbase = (size_t)b * SEQ + qc * 256;
        for (int i = tid; i < 256 * 16; i += NTHREADS) { const int key = i >> 4, c8 = (i & 15) * 8; const size_t src = ((size_t)b * 256 + key) * 512 + h * 128 + c8;
            *(LDS bf16x8*)(KX + key * 136 + c8) = ld8g(p.MKB + src); const bf16x8 v = ld8g(p.MVB + src);
#pragma unroll
            for (int j = 0; j < 8; ++j) VX[(c8 + j) * 264 + key] = (bf16)v[j]; }
    } else { const int us = u - NU_XP; b = us >> 2; h = us & 3; nrows = DECS; tbase = (size_t)TP + b * DECS;
        for (int i = tid; i < 256 * 32; i += NTHREADS) { const int key = i >> 5, c4 = (i & 31) * 4; const size_t src = (((size_t)b * 256 + key) * 4 + h) * 128 + c4;
            const f32x4 k = *(const f32x4*)(p.cmk + src), v = *(const f32x4*)(p.cmv + src); u32x2 w; w[0] = pk2(k[0], k[1]); w[1] = pk2(k[2], k[3]); *(LDS u32x2*)(KX + key * 136 + c4) = w;
#pragma unroll
            for (int j = 0; j < 4; ++j) VX[(c4 + j) * 264 + key] = f2bf(v[j]); }
    }
    __syncthreads();
    if (32 * wid < nrows) {
        const bool valid = 32 * wid + r < nrows; const size_t trow = tbase + 32 * wid + (valid ? r : 0);
        bf16x8 qf[8]; float ss = 0.f;
#pragma unroll
        for (int ks = 0; ks < 8; ++ks) { qf[ks] = ld8g(p.XQ + trow * 512 + h * 128 + 16 * ks + 8 * hh);
#pragma unroll
            for (int j = 0; j < 8; ++j) { const float v = bf2f((bf16)qf[ks][j]); ss += v * v; } }
        ss += __shfl_xor(ss, 32); const float rs = valid ? rsqrtf(ss * (1.0f / 128.0f) + EPS) * X_SCALE : 0.f;
#pragma unroll
        for (int ks = 0; ks < 8; ++ks) { float q[8];
#pragma unroll
            for (int j = 0; j < 8; ++j) q[j] = bf2f((bf16)qf[ks][j]) * rs * p.g_xq[16 * ks + 8 * hh + j];
            qf[ks] = pack8(q[0], q[1], q[2], q[3], q[4], q[5], q[6], q[7]); }
        f32x16 o[4];
#pragma unroll
        for (int d = 0; d < 4; ++d) o[d] = zero16();
        float m = -INFINITY, l = 0.f;
        for (int kt = 0; kt < 4; ++kt) {
            f32x16 s0 = zero16(), s1 = zero16();
#pragma unroll
            for (int ks = 0; ks < 8; ++ks) { s0 = mfma32(ld8(KX + (64 * kt + r) * 136 + 16 * ks + 8 * hh), qf[ks], s0); s1 = mfma32(ld8(KX + (64 * kt + 32 + r) * 136 + 16 * ks + 8 * hh), qf[ks], s1); }
            float tmax = -INFINITY;
#pragma unroll
            for (int i = 0; i < 16; ++i) tmax = fmaxf(tmax, fmaxf(s0[i], s1[i]));
            tmax = fmaxf(tmax, __shfl_xor(tmax, 32));
            const float mn = fmaxf(m, tmax), corr = expf(m - mn); m = mn; float ps = 0.f;
#pragma unroll
            for (int i = 0; i < 16; ++i) { s0[i] = expf(s0[i] - mn); s1[i] = expf(s1[i] - mn); ps += s0[i] + s1[i]; }
            l = l * corr + ps;
#pragma unroll
            for (int d = 0; d < 4; ++d)
#pragma unroll
                for (int i = 0; i < 16; ++i) o[d][i] *= corr;
#pragma unroll
            for (int s = 0; s < 2; ++s) { const bf16x8 pa = PACK(s0, s), pb = PACK(s1, s);
#pragma unroll
                for (int d = 0; d < 4; ++d) { o[d] = mfma32(ldperm(VX + (32 * d + r) * 264 + 64 * kt + 16 * s, hh), pa, o[d]); o[d] = mfma32(ldperm(VX + (32 * d + r) * 264 + 64 * kt + 32 + 16 * s, hh), pb, o[d]); } }
        }
        l += __shfl_xor(l, 32); const float il = 1.0f / l;
        if (valid) { bf16* op = p.XO + trow * 512 + h * 128;
#pragma unroll
            for (int d = 0; d < 4; ++d)
#pragma unroll
                for (int g = 0; g < 4; ++g) { u32x2 w; w[0] = pk2(o[d][4 * g] * il, o[d][4 * g + 1] * il); w[1] = pk2(o[d][4 * g + 2] * il, o[d][4 * g + 3] * il); *(u32x2*)(op + 32 * d + 8 * g + 4 * hh) = w; } }
    }
}
constexpr int SA_CK = 0, SA_CKT = SA_CK + 64 * 264 * 2, SA_KP = SA_CKT + 256 * 72 * 2, SA_P = SA_KP + 64 * 40 * 2, SA_QS = SA_P + 64 * 72 * 2, SA_CORR = SA_QS + 65 * 104 * 2, SA_END = SA_CORR + 256;
static_assert(SA_END <= LDS_CTL && SA_CKT % 16 == 0 && SA_KP % 16 == 0 && SA_P % 16 == 0 && SA_QS % 16 == 0 && SA_CORR % 16 == 0, "sample attention LDS map");
DI void sattn_unit(const Params& p, LDS unsigned char* lds, int u) {
    const int tid = threadIdx.x, wid = tid >> 6, lane = tid & 63, r = lane & 31, hh = lane >> 5;
    LDS bf16* CK = (LDS bf16*)(lds + SA_CK); LDS bf16* CKT = (LDS bf16*)(lds + SA_CKT); LDS bf16* KP = (LDS bf16*)(lds + SA_KP); LDS bf16* PA = (LDS bf16*)(lds + SA_P);
    LDS bf16* QS = (LDS bf16*)(lds + SA_QS); LDS float* CORR = (LDS float*)(lds + SA_CORR);
    const int b = u / NSPLIT, sp = u % NSPLIT; const int h = wid;
    for (int i = tid; i < 65 * 96; i += NTHREADS) { const int row = i / 96, d = i % 96; float v = 0.f;
        if (row < 64) { const int hq = row >> 3, q = row & 7; v = bf2f(p.QN[(((size_t)TP + b * DECS + q) * 8 + hq) * 96 + d]); if (d < 64) v *= p.g_kn[d]; }
        QS[row * 104 + d] = f2bf(v); }
    const int qrow = r < 8 ? h * 8 + r : 64;
    f32x16 acc0 = zero16(), acc1 = zero16(); float m = -INFINITY, l = 0.f;
    const int ntile = PPS * 2 + (sp == NSPLIT - 1 ? 1 : 0);
    for (int tile = 0; tile < ntile; ++tile) {
        const bool newt = tile == PPS * 2;
        if (!newt) { const int pid = p.ptab[b * NPAGES + sp * PPS + (tile >> 1)]; const size_t key0 = (size_t)pid * PAGE + (tile & 1) * 64;
            for (int i = tid; i < 64 * 64; i += NTHREADS) { const int key = i >> 6, c4 = (i & 63) * 4; const f32x4 v = *(const f32x4*)(p.cckv + (key0 + key) * 256 + c4);
                u32x2 w; w[0] = pk2(v[0], v[1]); w[1] = pk2(v[2], v[3]); *(LDS u32x2*)(CK + key * 264 + c4) = w;
#pragma unroll
                for (int j = 0; j < 4; ++j) CKT[(c4 + j) * 72 + key] = f2bf(v[j]); }
            { const int key = tid >> 3, c4 = (tid & 7) * 4; const f32x4 v = *(const f32x4*)(p.ckpe + (key0 + key) * 32 + c4); u32x2 w; w[0] = pk2(v[0], v[1]); w[1] = pk2(v[2], v[3]); *(LDS u32x2*)(KP + key * 40 + c4) = w; }
        } else { const size_t t0 = (size_t)TP + b * DECS;
            for (int i = tid; i < 64 * 256; i += NTHREADS) { const int key = i >> 8, c = i & 255; const bf16 v = key < DECS ? p.CKVB[(t0 + key) * 256 + c] : (bf16)0; CK[key * 264 + c] = v; CKT[c * 72 + key] = v; }
            for (int i = tid; i < 64 * 32; i += NTHREADS) { const int key = i >> 5, c = i & 31; KP[key * 40 + c] = key < DECS ? p.KPB[(t0 + key) * 32 + c] : (bf16)0; }
        }
        __syncthreads();
        f32x16 z0, z1;
        const bf16* wkp = p.wt_kvb + (size_t)(h * 128 + r) * 256 + 8 * hh;
#ifndef EMU
        asm volatile("" : "+v"(wkp));
#endif
#pragma unroll
        for (int kk = 0; kk < 2; ++kk) {
            f32x16 x0 = zero16(), x1 = zero16();
#pragma unroll
            for (int ks = 0; ks < 16; ++ks) { const bf16x8 cb = ld8(CK + (32 * kk + r) * 264 + 16 * ks + 8 * hh);
                x0 = mfma32(ld8g(wkp + 16 * ks), cb, x0);
                x1 = mfma32(ld8g(wkp + 32 * 256 + 16 * ks), cb, x1); }
            float ss = 0.f;
#pragma unroll
            for (int i = 0; i < 16; ++i) ss += x0[i] * x0[i] + x1[i] * x1[i];
            ss += __shfl_xor(ss, 32); const float inv = rsqrtf(ss * (1.0f / 64.0f) + EPS);
#pragma unroll
            for (int i = 0; i < 16; ++i) { x0[i] *= inv; x1[i] *= inv; }
            f32x16 z = zero16();
#pragma unroll
            for (int s = 0; s < 2; ++s) { z = mfma32(PACK(x0, s), ldperm(QS + qrow * 104 + 16 * s, hh), z); z = mfma32(PACK(x1, s), ldperm(QS + qrow * 104 + 32 + 16 * s, hh), z);
                z = mfma32(ld8(KP + (32 * kk + r) * 40 + 16 * s + 8 * hh), ld8(QS + qrow * 104 + 64 + 16 * s + 8 * hh), z); }
            if (kk == 0) z0 = z; else z1 = z;
        }
        float tmax = -INFINITY;
#pragma unroll
        for (int i = 0; i < 16; ++i) { const int key = crow(i, hh);
            if (newt) { if (key > r || key >= DECS) z0[i] = -INFINITY; z1[i] = -INFINITY; }
            tmax = fmaxf(tmax, fmaxf(z0[i], z1[i])); }
        tmax = fmaxf(tmax, __shfl_xor(tmax, 32));
        if (r >= 8) tmax = 0.f;
        const float mn = fmaxf(m, tmax), corr = expf(m - mn); m = mn; float ps = 0.f;
#pragma unroll
        for (int i = 0; i < 16; ++i) { z0[i] = expf(z0[i] - mn); z1[i] = expf(z1[i] - mn); ps += z0[i] + z1[i]; }
        l = l * corr + ps;
        if (r < 8) { LDS bf16* pr = PA + (h * 8 + r) * 72;
#pragma unroll
            for (int i = 0; i < 16; ++i) { pr[crow(i, hh)] = f2bf(z0[i]); pr[32 + crow(i, hh)] = f2bf(z1[i]); }
            if (hh == 0) CORR[h * 8 + r] = corr; }
        __syncthreads();
        { const float c0 = CORR[r], c1 = CORR[32 + r];
#pragma unroll
            for (int i = 0; i < 16; ++i) { acc0[i] *= c0; acc1[i] *= c1; }
#pragma unroll
            for (int ks = 0; ks < 4; ++ks) { const bf16x8 a = ld8(CKT + (32 * wid + r) * 72 + 16 * ks + 8 * hh);
                acc0 = mfma32(a, ld8(PA + r * 72 + 16 * ks + 8 * hh), acc0); acc1 = mfma32(a, ld8(PA + (32 + r) * 72 + 16 * ks + 8 * hh), acc1); } }
        __syncthreads();
    }
    float* pa = p.PACC + (size_t)u * 64 * 256;
#pragma unroll
    for (int g = 0; g < 4; ++g) { f32x4 v0 = {acc0[4 * g], acc0[4 * g + 1], acc0[4 * g + 2], acc0[4 * g + 3]}, v1 = {acc1[4 * g], acc1[4 * g + 1], acc1[4 * g + 2], acc1[4 * g + 3]};
        *(f32x4*)(pa + (size_t)r * 256 + 32 * wid + 8 * g + 4 * hh) = v0; *(f32x4*)(pa + (size_t)(32 + r) * 256 + 32 * wid + 8 * g + 4 * hh) = v1; }
    l += __shfl_xor(l, 32);
    if (lane < 8) { p.PML[((size_t)u * 64 + h * 8 + r) * 2] = m; p.PML[((size_t)u * 64 + h * 8 + r) * 2 + 1] = l; }
}
constexpr int SC_ACC = 0, SC_W = 64 * 257 * 4, SC_END = SC_W + 64 * NSPLIT * 4 + 256;
DI void phase_sattn_combine(const Params& p, LDS unsigned char* lds) {
    const int tid = threadIdx.x;
    LDS float* AC = (LDS float*)(lds + SC_ACC); LDS float* WS = (LDS float*)(lds + SC_W);
    for (int b = blockIdx.x; b < DECB; b += gridDim.x) {
        if (tid < 64) { float M = -INFINITY; for (int j = 0; j < NSPLIT; ++j) M = fmaxf(M, p.PML[((size_t)(b * NSPLIT + j) * 64 + tid) * 2]);
            float L = 0.f; for (int j = 0; j < NSPLIT; ++j) { const float w = expf(p.PML[((size_t)(b * NSPLIT + j) * 64 + tid) * 2] - M); WS[tid * NSPLIT + j] = w; L += w * p.PML[((size_t)(b * NSPLIT + j) * 64 + tid) * 2 + 1]; }
            const float iL = 1.0f / L; for (int j = 0; j < NSPLIT; ++j) WS[tid * NSPLIT + j] *= iL; }
        __syncthreads();
        for (int i = tid; i < 64 * 256; i += NTHREADS) { const int hq = i >> 8, lat = i & 255; float s = 0.f;
            for (int j = 0; j < NSPLIT; ++j) s += WS[hq * NSPLIT + j] * p.PACC[((size_t)(b * NSPLIT + j) * 64 + hq) * 256 + lat];
            AC[hq * 257 + lat] = s; }
        __syncthreads();
        for (int i = tid; i < 64 * 64; i += NTHREADS) { const int hq = i >> 6, dv = i & 63, h = hq >> 3, q = hq & 7; const bf16* w = p.wt_kvb + (size_t)(h * 128 + 64 + dv) * 256; float s = 0.f;
            for (int lat = 0; lat < 256; ++lat) s += AC[hq * 257 + lat] * bf2f(w[lat]);
            p.OMIX[((size_t)TP + b * DECS + q) * DM + 512 + h * 64 + dv] = f2bf(s); }
        __syncthreads();
    }
}
#ifndef EMU
#define XB_TMO      128
#define XB_XCNT(j)  (256  + 64 * (j))
#define XB_XSUB(j)  (1280 + 64 * (j))
#define XB_XGEN(j)  (2304 + 64 * (j))
#define XB_TOP      3328
#define XB_TOPGEN   3392
#define XCD_BAR_WORDS 3456
#define XB_SPIN_CAP (1u << 18)
#define LAS __attribute__((address_space(3)))
__device__ __forceinline__ unsigned xb_ld(unsigned* p)              { return __hip_atomic_load(p, __ATOMIC_RELAXED, __HIP_MEMORY_SCOPE_AGENT); }
__device__ __forceinline__ unsigned xb_add(unsigned* p, unsigned v) { return __hip_atomic_fetch_add(p, v, __ATOMIC_RELAXED, __HIP_MEMORY_SCOPE_AGENT); }
__device__ __forceinline__ unsigned xb_xcc_id() { return (unsigned)__builtin_amdgcn_s_getreg((3 << 11) | 20) & 0xFu; }
#define XB_SPIN(cond, bar) do { unsigned _sp = 0; while (cond) { __builtin_amdgcn_s_sleep(1); \
    if ((++_sp & 255u) == 0u) { if (xb_ld(&(bar)[XB_TMO])) break; if (_sp > XB_SPIN_CAP) { atomicAdd(&(bar)[XB_TMO], 1u); break; } } } } while (0)
struct XcdBarrier { unsigned* bar; unsigned x; volatile LAS unsigned* st; };
__device__ __forceinline__ XcdBarrier xcd_barrier_post(unsigned* bar, volatile LAS unsigned* st) {
    XcdBarrier b; b.bar = bar; b.x = xb_xcc_id(); b.st = st;
    if (threadIdx.x == 0) (void)xb_add(&bar[XB_XCNT(b.x)], 1u);
    return b;
}
__device__ __forceinline__ void xcd_barrier_complete(unsigned* bar, unsigned x, unsigned& nloc, unsigned& nx) {
    const unsigned G = gridDim.x * gridDim.y * gridDim.z;
    unsigned sum, cnt, mine, sp = 0u;
    for (;;) {
        sum = 0u; cnt = 0u; mine = 0u;
#pragma unroll
        for (unsigned j = 0; j < 16; ++j) { const unsigned c = xb_ld(&bar[XB_XCNT(j)]); sum += c; cnt += (c > 0u) ? 1u : 0u; mine = (j == x) ? c : mine; }
        if (sum == G) break;
        __builtin_amdgcn_s_sleep(1);
        if ((++sp & 255u) == 0u) { if (xb_ld(&bar[XB_TMO])) break; if (sp > XB_SPIN_CAP) { atomicAdd(&bar[XB_TMO], 1u); break; } }
    }
    nloc = mine > 0u ? mine : 1u; nx = cnt > 0u ? cnt : 1u;
}
__device__ __forceinline__ void xcd_barrier(const XcdBarrier& b) {
    asm volatile("s_waitcnt vmcnt(0)" ::: "memory");
    __syncthreads();
    if (threadIdx.x == 0) {
        unsigned* bar = b.bar;
        __builtin_amdgcn_s_waitcnt(0);
        unsigned nloc = b.st[0], nx = b.st[1];
        if (nloc == 0u) { xcd_barrier_complete(bar, b.x, nloc, nx); b.st[0] = nloc; b.st[1] = nx; }
        const unsigned old = xb_add(&bar[XB_XSUB(b.x)], 1u);
        const unsigned gen = old / nloc;
        if (old + 1u == (gen + 1u) * nloc) {
            __builtin_amdgcn_fence(__ATOMIC_RELEASE, "agent");
            asm volatile("s_waitcnt vmcnt(0)" ::: "memory");
            const unsigned og = xb_add(&bar[XB_TOP], 1u);
            const unsigned tg = og / nx;
            if (og + 1u == (tg + 1u) * nx) xb_add(&bar[XB_TOPGEN], 1u);
            else XB_SPIN(xb_ld(&bar[XB_TOPGEN]) == tg, bar);
            __builtin_amdgcn_fence(__ATOMIC_ACQUIRE, "agent");
            xb_add(&bar[XB_XGEN(b.x)], 1u);
            asm volatile("s_waitcnt vmcnt(0)" ::: "memory");
        } else {
            XB_SPIN(xb_ld(&bar[XB_XGEN(b.x)]) == gen, bar);
            __builtin_amdgcn_fence(__ATOMIC_ACQUIRE, "agent");
            asm volatile("s_waitcnt vmcnt(0)" ::: "memory");
        }
    }
    __syncthreads();
}
#endif

DI int wq_next(unsigned* ctr, LDS unsigned* slot) {
    __syncthreads();
    if (threadIdx.x == 0) *slot = atomicAdd(ctr, 1u);
    __syncthreads();
    return (int)*slot;
}
struct EpiResF32 {
    static constexpr bool PERM = false, AFTER_DRAIN = false;
    float* C; const float* R0; const float* R1; int split;
    DI void operator()(const f32x4 (&acc)[2][2][4][2], const pg8::Unit& u, int wr, int wc, int fr, int fq) const {
        const int row0 = u.pm * 256 + wr * 64 + fr, col0 = u.pn * 256 + wc * 32 + 4 * fq;
        const float* R = row0 < split ? R0 : R1 - (size_t)split * DM;
#pragma unroll
        for (int ai = 0; ai < 2; ++ai)
#pragma unroll
            for (int m = 0; m < 4; ++m) { const size_t off = (size_t)(row0 + ai * 128 + m * 16) * DM + col0;
#pragma unroll
                for (int bj = 0; bj < 2; ++bj)
#pragma unroll
                    for (int n = 0; n < 2; ++n) { const f32x4 v = acc[ai][bj][m][n] + *(const f32x4*)(R + off + bj * 128 + n * 16); *(f32x4*)(C + off + bj * 128 + n * 16) = v; } }
    }
};
DI void phase_norm_rows(const Params& p, const float* X, const float* g) {
    const int wid = threadIdx.x >> 6, lane = threadIdx.x & 63;
    for (int row = blockIdx.x * 8 + wid; row < T; row += gridDim.x * 8) rmsnorm_row_1024(X + (size_t)row * DM, g, p.H + (size_t)row * DM, lane);
}
constexpr int NPHASE = 15;
template <int PH> DI void run_phase(const Params& p, LDS unsigned char* lds) {
    LDS unsigned* slot = (LDS unsigned*)(lds + LDS_CTL + 64);
    if constexpr (PH == 0) phase_prep(p, lds);
    else if constexpr (PH == 1) { run_gemm(lds, p.H, p.wt_in, T, DINP, DM, EpiStoreBf16<0>{p.Z, DINP}, 0); run_gemm(lds, p.MEMN, p.wt_xkv, MROWS, 1024, DM, EpiStoreF32{p.MKV, nullptr, 1024}, 100); }
    else if constexpr (PH == 2) phase_post_in(p);
    else if constexpr (PH == 3) { run_gemm(lds, p.QAN, p.wt_qb, T, 768, 384, EpiStoreBf16<0>{p.QF, 768}, 0); run_gemm(lds, p.CKVB, p.wt_kvb, T, 1024, 256, EpiStoreBf16<0>{p.KV, 1024}, 140); __syncthreads(); phase_gla_a(p, lds); }
    else if constexpr (PH == 4) { phase_post_qkv(p); phase_gla_b(p); }
    else if constexpr (PH == 5) {
        for (;;) { const int u = wq_next(p.ctl + CW_Q5, slot); if (u >= NU_SA) break; sattn_unit(p, lds, u); }
        for (;;) { const int u = wq_next(p.ctl + CW_Q5 + 64, slot); if (u >= NU_PA) break; pattn_unit(p, lds, u); }
        for (;;) { const int u = wq_next(p.ctl + CW_Q5 + 128, slot); if (u >= NGU) break; gla_c_unit(p, lds, u); } }
    else if constexpr (PH == 6) phase_sattn_combine(p, lds);
    else if constexpr (PH == 7) run_gemm(lds, p.OMIX, p.wt_out, T, DM, DM, EpiResF32{p.X1, p.xp, p.xs, TP}, 0);
    else if constexpr (PH == 8) phase_norm_rows(p, p.X1, p.g_x);
    else if constexpr (PH == 9) run_gemm(lds, p.H, p.wt_xq, T, 512, DM, EpiStoreBf16<0>{p.XQ, 512}, 0);
    else if constexpr (PH == 10) { for (;;) { const int u = wq_next(p.ctl + CW_QX, slot); if (u >= NU_XS + NU_XP) break; xattn_unit(p, lds, u < NU_XS ? NU_XP + u : u - NU_XS); } }
    else if constexpr (PH == 11) run_gemm(lds, p.XO, p.wt_xo, T, DM, 512, EpiResF32{p.X2, p.X1, p.X1, T}, 0);
    else if constexpr (PH == 12) phase_norm_rows(p, p.X2, p.g_ff);
    else if constexpr (PH == 13) run_gemm(lds, p.H, p.wt_ff1, T, DFF, DM, EpiStoreBf16<1>{p.U, DFF}, 0);
    else if constexpr (PH == 14) run_gemm(lds, p.U, p.wt_ff2, T, DM, DFF, EpiResF32{p.y, p.X2, p.X2, T}, 0);
}
#ifdef EMU
#define GET_LDS() ((LDS unsigned char*)EMU_SMEM())
#define GRID_BAR() emu_grid_barrier()
#else
#define GET_LDS() ((LDS unsigned char*)lds_raw)
#define GRID_BAR() xcd_barrier(bar)
#endif
template <int PH> __global__ void __launch_bounds__(NTHREADS, 2) k_phase(Params p) {
#ifndef EMU
    extern __shared__ __attribute__((aligned(16))) unsigned char lds_raw[];
#endif
    run_phase<PH>(p, GET_LDS());
}
#if N_LAUNCH_MODE == 1
__global__ void __launch_bounds__(NTHREADS, 2) k_mega(Params p) {
#ifndef EMU
    extern __shared__ __attribute__((aligned(16))) unsigned char lds_raw[];
    LDS unsigned char* lds = GET_LDS();
    if (threadIdx.x < 64) ((LDS unsigned*)(lds + LDS_CTL))[threadIdx.x] = 0u;
    __syncthreads();
    XcdBarrier bar = xcd_barrier_post(p.ctl + CW_BAR, (volatile LDS unsigned*)(lds + LDS_CTL));
#else
    LDS unsigned char* lds = GET_LDS();
#endif
    run_phase<0>(p, lds); GRID_BAR();
    run_phase<1>(p, lds); GRID_BAR();
    run_phase<2>(p, lds); GRID_BAR();
    run_phase<3>(p, lds); GRID_BAR();
    run_phase<4>(p, lds); GRID_BAR();
    run_phase<5>(p, lds); GRID_BAR();
    run_phase<6>(p, lds); GRID_BAR();
    run_phase<7>(p, lds); GRID_BAR();
    run_phase<8>(p, lds); GRID_BAR();
    run_phase<9>(p, lds); GRID_BAR();
    run_phase<10>(p, lds); GRID_BAR();
    run_phase<11>(p, lds); GRID_BAR();
    run_phase<12>(p, lds); GRID_BAR();
    run_phase<13>(p, lds); GRID_BAR();
    run_phase<14>(p, lds);
}
#endif

static size_t ws_take(size_t& off, size_t bytes) { const size_t o = off; off = (off + bytes + 255) & ~(size_t)255; return o; }
template <int PH> static void launch_phase(const Params& p, int grid, hipStream_t stream) {
#ifndef EMU
    static bool attr = false; if (!attr) { (void)hipFuncSetAttribute((const void*)k_phase<PH>, hipFuncAttributeMaxDynamicSharedMemorySize, LDS_BYTES); attr = true; }
#endif
    LAUNCH(k_phase<PH>, dim3(grid), dim3(NTHREADS), LDS_BYTES, stream, p);
}
extern "C" void kernel_launch(void* const* d_in, const int* in_sizes, int n_in, void* d_out, int out_size, void* d_ws, size_t ws_size, hipStream_t stream) {
    Params p{};
    const float* const* in = (const float* const*)d_in;
    p.xp = in[0]; p.xs = in[1]; p.memp = in[2]; p.cckv = in[3]; p.ckpe = in[4]; p.cmk = in[5]; p.cmv = in[6]; p.sgla = in[7]; p.ptab = (const int*)d_in[8];
    p.g_mix = in[9]; p.w_a2 = in[11]; p.b_a = in[12]; p.g_gla_o = in[13]; p.g_qa = in[14]; p.g_kva = in[16]; p.g_qn = in[18]; p.g_kn = in[19]; p.g_qr = in[20]; p.g_kr = in[21];
    p.g_x = in[23]; p.g_mem = in[24]; p.g_xq = in[28]; p.g_xk = in[29]; p.g_ff = in[31];
    float* out = (float*)d_out; size_t oo = 0;
    p.y = out; oo += (size_t)T * DM; p.o_ckvp = out + oo; oo += (size_t)TP * 256; p.o_kpep = out + oo; oo += (size_t)TP * 32; p.o_mkp = out + oo; oo += (size_t)MROWS * 512; p.o_mvp = out + oo; oo += (size_t)MROWS * 512;
    p.o_glap = out + oo; oo += (size_t)BATCH * 4 * 8192; p.o_ckvs = out + oo; oo += (size_t)TS * 256; p.o_kpes = out + oo; oo += (size_t)TS * 32; p.o_glas = out + oo; oo += (size_t)DECB * 4 * 8192;
    if ((size_t)out_size != oo || n_in != 34) { fprintf(stderr, "kernel_launch: unexpected sizes (out %d vs %zu, n_in %d)\n", out_size, oo, n_in); }
    unsigned char* ws = (unsigned char*)d_ws; size_t off = 0;
    p.ctl = (unsigned*)(ws + ws_take(off, 1 << 20));
#define WSB(name, elems) p.name = (bf16*)(ws + ws_take(off, (size_t)(elems) * 2))
#define WSF(name, elems) p.name = (float*)(ws + ws_take(off, (size_t)(elems) * 4))
    WSB(wt_in, (size_t)DINP * DM); WSB(wt_qb, 768 * 384); WSB(wt_kvb, 1024 * 256); WSB(wt_out, DM * DM); WSB(wt_xq, 512 * DM); WSB(wt_xkv, 1024 * DM); WSB(wt_xo, DM * 512); WSB(wt_ff1, (size_t)DFF * DM); WSB(wt_ff2, (size_t)DM * DFF);
    WSB(H, (size_t)T * DM); WSB(MEMN, (size_t)MROWS * DM); WSB(Z, (size_t)T * DINP); WSB(QAN, (size_t)T * 384); WSB(CKVB, (size_t)T * 256); WSB(KPB, (size_t)T * 32); WSB(MKB, (size_t)MROWS * 512); WSB(MVB, (size_t)MROWS * 512);
    WSB(QF, (size_t)T * 768); WSB(KV, (size_t)T * 1024); WSB(QN, (size_t)T * 768); WSB(KN, (size_t)T * 512); WSB(OMIX, (size_t)T * DM); WSB(XQ, (size_t)T * 512); WSB(XO, (size_t)T * 512); WSB(U, (size_t)T * DFF);
    WSF(MKV, (size_t)MROWS * 1024); WSF(LOGA, (size_t)T * 256); WSF(DS, (size_t)NGU * 8192); WSF(DDEC, (size_t)NGU * 64); WSF(X1, (size_t)T * DM); WSF(X2, (size_t)T * DM); WSF(PACC, (size_t)NU_SA * 64 * 256); WSF(PML, (size_t)NU_SA * 128);
    if (off > ws_size) { fprintf(stderr, "kernel_launch: workspace too small (%zu > %zu)\n", off, ws_size); return; }
    p.w_in = in[10]; p.w_qb = in[15]; p.w_kvb = in[17]; p.w_out = in[22]; p.w_xq = in[25]; p.w_xk = in[26]; p.w_xv = in[27]; p.w_xo = in[30]; p.w_ff1 = in[32]; p.w_ff2 = in[33];
    (void)hipMemsetAsync(p.ctl, 0, 1 << 20, stream);
#ifdef EMU
    const int grid = EMU_GRID;
#else
    static int grid = 0;
    if (!grid) { int dev = 0, cus = 0; (void)hipGetDevice(&dev); (void)hipDeviceGetAttribute(&cus, hipDeviceAttributeMultiprocessorCount, dev); grid = cus > 0 ? cus : 256;
#if N_LAUNCH_MODE == 1
        (void)hipFuncSetAttribute((const void*)k_mega, hipFuncAttributeMaxDynamicSharedMemorySize, LDS_BYTES);
        int per_cu = 0; if (hipOccupancyMaxActiveBlocksPerMultiprocessor(&per_cu, (const void*)k_mega, NTHREADS, LDS_BYTES) != hipSuccess || per_cu < 1) fprintf(stderr, "kernel_launch: occupancy query reports %d workgroups per CU\n", per_cu);
#endif
    }
#endif
#if N_LAUNCH_MODE == 1
    LAUNCH(k_mega, dim3(grid), dim3(NTHREADS), LDS_BYTES, stream, p);
#else
    launch_phase<0>(p, grid, stream); launch_phase<1>(p, grid, stream); launch_phase<2>(p, grid, stream); launch_phase<3>(p, grid, stream); launch_phase<4>(p, grid, stream);
    launch_phase<5>(p, grid, stream); launch_phase<6>(p, grid, stream); launch_phase<7>(p, grid, stream); launch_phase<8>(p, grid, stream); launch_phase<9>(p, grid, stream);
    launch_phase<10>(p, grid, stream); launch_phase<11>(p, grid, stream); launch_phase<12>(p, grid, stream); launch_phase<13>(p, grid, stream); launch_phase<14>(p, grid, stream);
#endif
}
```

```cpp
#ifdef EMU
#include "emu.h"
#define LDS
#else
#include <hip/hip_runtime.h>
#define LDS __attribute__((address_space(3)))
#define LAUNCH(kern, grid, block, smem, stream, ...) kern<<<grid, block, smem, stream>>>(__VA_ARGS__)
#endif
#include <cstdio>
#include <cstdint>
#include <cmath>
#define DI __device__ __forceinline__

#ifndef CFG_BATCH
#define CFG_BATCH 16
#define CFG_SEQ 2048
#define CFG_DECB 128
#define CFG_PAST 8192
#endif
#ifndef N_LAUNCH_MODE
#define N_LAUNCH_MODE 1
#endif

typedef unsigned short bf16;
typedef short bf16x8 __attribute__((ext_vector_type(8)));
typedef short s16x4 __attribute__((ext_vector_type(4)));
typedef float f32x4 __attribute__((ext_vector_type(4)));
typedef float f32x16 __attribute__((ext_vector_type(16)));
typedef unsigned u32x4 __attribute__((ext_vector_type(4)));
typedef unsigned u32x2 __attribute__((ext_vector_type(2)));

constexpr int DM = 1024, BATCH = CFG_BATCH, SEQ = CFG_SEQ, DECB = CFG_DECB, DECS = 8, PAST = CFG_PAST, PAGE = 128, NPAGES = PAST / PAGE;
constexpr int NMEM = 256, TP = BATCH * SEQ, TS = DECB * DECS, T = TP + TS, MROWS = BATCH * NMEM;
constexpr int DIN = 2224, DINP = 2304, DFF = 4096;
constexpr int ZQ = 0, ZK = 256, ZV = 512, ZR = 1024, ZA = 1536, ZQA = 1552, ZKVA = 1936, ZKPE = 2192;
constexpr float EPS = 1e-6f, MLA_SCALE = 0.10206207261596577f  , X_SCALE = 0.08838834764831845f  ;
constexpr int NC = SEQ / 64;
constexpr int NGP = BATCH * 4 * NC, NGS = DECB * 4, NGU = NGP + NGS;
constexpr int NSPLIT = NPAGES >= 8 ? 8 : NPAGES, PPS = NPAGES / NSPLIT;
constexpr int NU_SA = DECB * NSPLIT, NQB = SEQ / 256, NU_PA = BATCH * 8 * NQB;
constexpr int NU_XP = BATCH * 4 * NQB, NU_XS = DECB * 4;
static_assert(T % 256 == 0 && MROWS % 256 == 0 && SEQ % 256 == 0 && NPAGES % NSPLIT == 0, "shape assumptions");
constexpr int NTHREADS = 512, LDS_BYTES = 147456, LDS_CTL = LDS_BYTES - 256;

DI int tid_opaque() {
    int t = threadIdx.x;
#ifndef EMU
    asm volatile("" : "+v"(t));
#endif
    return t;
}
DI float bf2f(bf16 b) { return __uint_as_float(((unsigned)b) << 16); }
DI bf16 f2bf(float x) {
#ifdef EMU
    unsigned u = __float_as_uint(x); u += 0x7fffu + ((u >> 16) & 1u); return (bf16)(u >> 16);
#else
    return __builtin_bit_cast(unsigned short, (__bf16)x);
#endif
}
DI unsigned pk2(float a, float b) { return (unsigned)f2bf(a) | ((unsigned)f2bf(b) << 16); }
DI f32x16 zero16() { f32x16 z; for (int i = 0; i < 16; ++i) z[i] = 0.f; return z; }
DI f32x16 mfma32(bf16x8 a, bf16x8 b, f32x16 c) { return __builtin_amdgcn_mfma_f32_32x32x16_bf16(a, b, c, 0, 0, 0); }
DI int crow(int i, int h) { return (i & 3) + 8 * (i >> 2) + 4 * h; }
DI bf16x8 ld8(const LDS bf16* p) { return *(const LDS bf16x8*)p; }
DI bf16x8 ld8g(const bf16* p) { return *(const bf16x8*)p; }
DI bf16x8 ldperm(const LDS bf16* p16, int h) {
    const s16x4 lo = *(const LDS s16x4*)(p16 + 4 * h), hi = *(const LDS s16x4*)(p16 + 8 + 4 * h);
    return __builtin_shufflevector(lo, hi, 0, 1, 2, 3, 4, 5, 6, 7);
}
DI bf16x8 ldpermg(const bf16* p16, int h) {
    const s16x4 lo = *(const s16x4*)(p16 + 4 * h), hi = *(const s16x4*)(p16 + 8 + 4 * h);
    return __builtin_shufflevector(lo, hi, 0, 1, 2, 3, 4, 5, 6, 7);
}
DI bf16x8 pack8(float a0, float a1, float a2, float a3, float a4, float a5, float a6, float a7) {
    u32x4 p; p[0] = pk2(a0, a1); p[1] = pk2(a2, a3); p[2] = pk2(a4, a5); p[3] = pk2(a6, a7); return __builtin_bit_cast(bf16x8, p);
}
#define PACK(x, s) pack8((x)[8 * (s)], (x)[8 * (s) + 1], (x)[8 * (s) + 2], (x)[8 * (s) + 3], (x)[8 * (s) + 4], (x)[8 * (s) + 5], (x)[8 * (s) + 6], (x)[8 * (s) + 7])
DI float wsum(float v) { for (int o = 32; o >= 1; o >>= 1) v += __shfl_xor(v, o); return v; }
DI bf16x8 zero8() { bf16x8 z; for (int i = 0; i < 8; ++i) z[i] = 0; return z; }

namespace pg8 {
#define PG8_LAS LDS
typedef unsigned short bf16_t;
constexpr int BM = 256, BK = 64, HALF = 128, HTB = HALF * BK * 2  , STAGE_BYTES = 8 * HTB, NXCD = 8, WGM = 8;
__host__ __device__ __forceinline__ int lds_byte(int r, int c) { const int st = (r >> 4) * 2 + (c >> 5), rr = r & 15, cc = c & 31, ob = rr * 64 + cc * 2; return st * 1024 + (ob ^ (((ob >> 9) & 1) << 5)); }
__host__ __device__ __forceinline__ void stage_rc(int b, int& R, int& C) { const int st = b / 1024, sb = b % 1024, swz = sb ^ (((sb >> 9) & 1) << 5); R = (st >> 1) * 16 + swz / 64; C = (st & 1) * 32 + (swz % 64) / 2; }
__host__ __device__ __forceinline__ int perm32(int rho) { const int n = rho >> 4, i = rho & 15; return 8 * (i >> 2) + 4 * n + (i & 3); }
struct Unit { int pm, pn; };
struct Gemm { const bf16_t* A; const bf16_t* Bt; int M, N, K; };
struct StaticOrder {
    int nM, nN, nwg, G, c;
    __host__ __device__ void init(int M, int N, int G_, int c_) { nM = M / BM; nN = N / BM; nwg = nM * nN; G = G_; c = c_; }
    __host__ __device__ bool next(int i, Unit& u) const {
        const long L = (long)i * G + c; if (L >= nwg) return false;
        int wgid = (int)L; { const int q = nwg / NXCD, r = nwg % NXCD, xcd = wgid % NXCD, off = wgid / NXCD; wgid = (xcd < r ? xcd * (q + 1) : r * (q + 1) + (xcd - r) * q) + off; }
        const int nig = WGM * nN, gid = wgid / nig, fm = gid * WGM, gsz = (nM - fm) < WGM ? (nM - fm) : WGM;
        u.pm = fm + ((wgid % nig) % gsz); u.pn = (wgid % nig) / gsz; return true;
    }
    __device__ __forceinline__ void a_ready(const Unit&) const {}
    __device__ __forceinline__ void done(const Unit&) const {}
};
#ifdef EMU
template <class Epi, class Sched>
__device__ __forceinline__ void gemm_phase(PG8_LAS unsigned char* lds, const Gemm g, const Sched& S, const Epi& E) {
    const int tid = tid_opaque(), wid = tid >> 6, lane = tid & 63, wr = wid >> 2, wc = wid & 3, fr = lane & 15, fq = lane >> 4;
    Unit cur;
    for (int ui = 0; S.next(ui, cur); ++ui) {
        f32x4 acc[2][2][4][2];
        for (int ai = 0; ai < 2; ++ai) for (int bj = 0; bj < 2; ++bj) for (int m = 0; m < 4; ++m) for (int n = 0; n < 2; ++n) for (int j = 0; j < 4; ++j) {
            const int row = 256 * cur.pm + 128 * ai + 64 * wr + 16 * m + fr;
            const int col = Epi::PERM ? 256 * cur.pn + 128 * bj + 32 * wc + 8 * fq + 4 * n + j : 256 * cur.pn + 128 * bj + 32 * wc + 16 * n + 4 * fq + j;
            const bf16_t* a = g.A + (size_t)row * g.K; const bf16_t* b = g.Bt + (size_t)col * g.K; float s = 0.f;
            for (int k = 0; k < g.K; ++k) s += bf2f(a[k]) * bf2f(b[k]);
            acc[ai][bj][m][n][j] = s;
        }
        E(acc, cur, wr, wc, fr, fq);
    }
}
#else
template <class Epi, class Sched>
__device__ __forceinline__ void gemm_phase(PG8_LAS unsigned char* lds, const Gemm g, const Sched& S, const Epi& E) {
    const int tid = tid_opaque(), wid = __builtin_amdgcn_readfirstlane(tid >> 6), lane = tid & 63, wr = wid >> 2, wc = wid & 3, fr = lane & 15, fq = lane >> 4;
    const int K = g.K, nt = K / BK;
    unsigned voffA[2], voffB[2];
#pragma unroll
    for (int i = 0; i < 2; ++i) { int R, C; stage_rc(tid * 16 + i * 8192, R, C); const int Rb = Epi::PERM ? ((R & ~31) + perm32(R & 31)) : R;
        voffA[i] = (unsigned)(R * K + C) * 2u; voffB[i] = (unsigned)(Rb * K + C) * 2u; }
    const size_t kstep = (size_t)(BK * 2);
    const size_t hstep = (size_t)HALF * K * 2;
    const size_t tstep = 2 * hstep;
    const unsigned ldsw = (unsigned)wid * 1024u;
    const int aoff = lds_byte(wr * 64 + fr, fq * 8), boff = lds_byte(wc * 32 + fr, fq * 8);
#define PG8_SA(b, h) (((b) * 2 + (h)) * HTB)
#define PG8_SB(b, h) ((4 + (b) * 2 + (h)) * HTB)
#define PG8_STAGE(bufoff, gbase, voff) do { _Pragma("unroll") for (int _i = 0; _i < 2; ++_i) \
        __builtin_amdgcn_global_load_lds((const unsigned*)((const char*)(gbase) + (voff)[_i]), (PG8_LAS unsigned*)(lds + (bufoff) + ldsw + _i * 8192), 16, 0, 0); } while (0)
#define PG8_LDA(dst, b, h) do { _Pragma("unroll") for (int m = 0; m < 4; ++m) _Pragma("unroll") for (int k = 0; k < 2; ++k) dst[m][k] = *(const PG8_LAS bf16x8*)(lds + PG8_SA(b, h) + aoff + m * 2048 + k * 1024); } while (0)
#define PG8_LDB(dst, b, h) do { _Pragma("unroll") for (int n = 0; n < 2; ++n) _Pragma("unroll") for (int k = 0; k < 2; ++k) dst[n][k] = *(const PG8_LAS bf16x8*)(lds + PG8_SB(b, h) + boff + n * 2048 + k * 1024); } while (0)
#define PG8_MMA(ai, bj, At, Bt) do { __builtin_amdgcn_s_setprio(1); _Pragma("unroll") for (int m = 0; m < 4; ++m) _Pragma("unroll") for (int n = 0; n < 2; ++n) _Pragma("unroll") for (int k = 0; k < 2; ++k) \
        acc[ai][bj][m][n] = __builtin_amdgcn_mfma_f32_16x16x32_bf16(Bt[n][k], At[m][k], acc[ai][bj][m][n], 0, 0, 0); __builtin_amdgcn_s_setprio(0); } while (0)
#define PG8_WAIT_V(n) asm volatile("s_waitcnt vmcnt(" #n ")" ::: "memory")
#define PG8_WAIT_L(n) asm volatile("s_waitcnt lgkmcnt(" #n ")" ::: "memory")
#define PG8_BAR __builtin_amdgcn_s_barrier()
#define PG8_SCHED __builtin_amdgcn_sched_barrier(0)
    Unit cur, nxt; int ui = 0;
    if (!S.next(0, cur)) return;
    f32x4 acc[2][2][4][2];
#pragma unroll
    for (int a = 0; a < 2; ++a)
#pragma unroll
        for (int b = 0; b < 2; ++b)
#pragma unroll
            for (int m = 0; m < 4; ++m)
#pragma unroll
                for (int n = 0; n < 2; ++n) acc[a][b][m][n] = (f32x4){0.f, 0.f, 0.f, 0.f};
    bf16x8 At[4][2], B0[2][2], B1[2][2];
    const char* cA = (const char*)g.A + (size_t)cur.pm * tstep; const char* cB = (const char*)g.Bt + (size_t)cur.pn * tstep;
    S.a_ready(cur);
    PG8_STAGE(PG8_SB(0, 0), cB, voffB); PG8_STAGE(PG8_SA(0, 0), cA, voffA); PG8_STAGE(PG8_SB(0, 1), cB + hstep, voffB); PG8_STAGE(PG8_SA(0, 1), cA + hstep, voffA);
    if (wr == 1) PG8_BAR;
    PG8_WAIT_V(4); PG8_BAR;
    PG8_STAGE(PG8_SB(1, 0), cB + kstep, voffB); PG8_STAGE(PG8_SA(1, 0), cA + kstep, voffA); PG8_STAGE(PG8_SB(1, 1), cB + hstep + kstep, voffB);
    PG8_WAIT_V(6); PG8_BAR;
    for (;;) {
        const bool has_next = S.next(ui + 1, nxt);
        const char* nA = has_next ? (const char*)g.A + (size_t)nxt.pm * tstep : cA; const char* nB = has_next ? (const char*)g.Bt + (size_t)nxt.pn * tstep : cB;
        for (int t = 0; t < nt; t += 2) {
            const bool last = (t == nt - 2);
            const char* a1 = cA + (size_t)(t + 1) * kstep;
            const char* a2 = last ? nA : cA + (size_t)(t + 2) * kstep; const char* b2 = last ? nB : cB + (size_t)(t + 2) * kstep;
            const char* a3 = a2 + kstep; const char* b3 = b2 + kstep;
            if (last && has_next) S.a_ready(nxt);
            PG8_LDB(B0, 0, 0); PG8_SCHED; PG8_LDA(At, 0, 0); PG8_STAGE(PG8_SA(1, 1), a1 + hstep, voffA);
            PG8_WAIT_L(8); PG8_BAR; PG8_WAIT_L(0); PG8_MMA(0, 0, At, B0); PG8_BAR; PG8_SCHED;
            PG8_LDB(B1, 0, 1); PG8_STAGE(PG8_SB(0, 0), b2, voffB);
            PG8_BAR; PG8_WAIT_L(0); PG8_MMA(0, 1, At, B1); PG8_BAR;
            PG8_LDA(At, 0, 1); PG8_STAGE(PG8_SA(0, 0), a2, voffA);
            PG8_BAR; PG8_WAIT_L(0); PG8_MMA(1, 0, At, B0); PG8_BAR; PG8_SCHED;
            PG8_STAGE(PG8_SB(0, 1), b2 + hstep, voffB);
            PG8_WAIT_V(6); PG8_BAR; PG8_MMA(1, 1, At, B1); PG8_BAR;
            PG8_LDB(B0, 1, 0); PG8_SCHED; PG8_LDA(At, 1, 0); PG8_STAGE(PG8_SA(0, 1), a2 + hstep, voffA);
            PG8_WAIT_L(8); PG8_BAR; PG8_WAIT_L(0); PG8_MMA(0, 0, At, B0); PG8_BAR; PG8_SCHED;
            PG8_LDB(B1, 1, 1); PG8_STAGE(PG8_SB(1, 0), b3, voffB);
            PG8_BAR; PG8_WAIT_L(0); PG8_MMA(0, 1, At, B1); PG8_BAR;
            PG8_LDA(At, 1, 1); PG8_STAGE(PG8_SA(1, 0), a3, voffA);
            PG8_BAR; PG8_WAIT_L(0); PG8_MMA(1, 0, At, B0); PG8_BAR; PG8_SCHED;
            PG8_STAGE(PG8_SB(1, 1), b3 + hstep, voffB);
            PG8_WAIT_V(6); PG8_BAR; PG8_MMA(1, 1, At, B1); PG8_BAR;
        }
        if constexpr (!Epi::AFTER_DRAIN) { E(acc, cur, wr, wc, fr, fq); S.done(cur); }
        if (!has_next) break;
#pragma unroll
        for (int a = 0; a < 2; ++a)
#pragma unroll
            for (int b = 0; b < 2; ++b)
#pragma unroll
                for (int m = 0; m < 4; ++m)
#pragma unroll
                    for (int n = 0; n < 2; ++n) acc[a][b][m][n] = (f32x4){0.f, 0.f, 0.f, 0.f};
        cur = nxt; cA = nA; cB = nB; ++ui;
    }
    PG8_WAIT_V(0);
    if (wr == 0) PG8_BAR;
    PG8_BAR;
    if constexpr (Epi::AFTER_DRAIN) { E.fused(acc, cur, wr, wc, fr, fq, lds, wid, lane); S.done(cur); }
#undef PG8_SA
#undef PG8_SB
#undef PG8_STAGE
#undef PG8_LDA
#undef PG8_LDB
#undef PG8_MMA
#undef PG8_WAIT_V
#undef PG8_WAIT_L
#undef PG8_BAR
#undef PG8_SCHED
}
#endif
}

struct Params {
    const float *xp, *xs, *memp, *cckv, *ckpe, *cmk, *cmv, *sgla; const int* ptab;
    const float *g_mix, *w_a2, *b_a, *g_gla_o, *g_qa, *g_kva, *g_qn, *g_kn, *g_qr, *g_kr, *g_x, *g_mem, *g_xq, *g_xk, *g_ff;
    float *y, *o_ckvp, *o_kpep, *o_mkp, *o_mvp, *o_glap, *o_ckvs, *o_kpes, *o_glas;
    unsigned* ctl;
    bf16 *wt_in, *wt_qb, *wt_kvb, *wt_out, *wt_xq, *wt_xkv, *wt_xo, *wt_ff1, *wt_ff2;
    bf16 *H, *MEMN, *Z, *QAN, *CKVB, *KPB, *MKB, *MVB, *QF, *KV, *QN, *KN, *OMIX, *XQ, *XO, *U;
    float *MKV, *LOGA, *DS, *DDEC, *X1, *X2, *PACC, *PML;
    const float *w_in, *w_qb, *w_kvb, *w_out, *w_xq, *w_xk, *w_xv, *w_xo, *w_ff1, *w_ff2;
};
constexpr int CW_Q5 = 0, CW_QX = 256, CW_BAR = 4096;

template <int ACT  > struct EpiStoreBf16 {
    static constexpr bool PERM = true, AFTER_DRAIN = false;
    bf16* O; int ldc;
    DI void operator()(const f32x4 (&acc)[2][2][4][2], const pg8::Unit& u, int wr, int wc, int fr, int fq) const {
        const int row0 = u.pm * 256 + wr * 64 + fr, col0 = u.pn * 256 + wc * 32 + 8 * fq;
#pragma unroll
        for (int ai = 0; ai < 2; ++ai)
#pragma unroll
            for (int m = 0; m < 4; ++m) { bf16* rowp = O + (size_t)(row0 + ai * 128 + m * 16) * ldc + col0;
#pragma unroll
                for (int bj = 0; bj < 2; ++bj) { f32x4 v0 = acc[ai][bj][m][0], v1 = acc[ai][bj][m][1];
                    if (ACT == 1) {
#pragma unroll
                        for (int j = 0; j < 4; ++j) { const float a = fmaxf(v0[j], 0.f), b = fmaxf(v1[j], 0.f); v0[j] = a * a; v1[j] = b * b; } }
                    u32x4 w; w[0] = pk2(v0[0], v0[1]); w[1] = pk2(v0[2], v0[3]); w[2] = pk2(v1[0], v1[1]); w[3] = pk2(v1[2], v1[3]);
                    *(u32x4*)(rowp + bj * 128) = w; } }
    }
};
struct EpiStoreF32 {
    static constexpr bool PERM = false, AFTER_DRAIN = false;
    float* C; const float* R; int ldc;
    DI void operator()(const f32x4 (&acc)[2][2][4][2], const pg8::Unit& u, int wr, int wc, int fr, int fq) const {
        const int row0 = u.pm * 256 + wr * 64 + fr, col0 = u.pn * 256 + wc * 32 + 4 * fq;
#pragma unroll
        for (int ai = 0; ai < 2; ++ai)
#pragma unroll
            for (int m = 0; m < 4; ++m) { const size_t off = (size_t)(row0 + ai * 128 + m * 16) * ldc + col0;
#pragma unroll
                for (int bj = 0; bj < 2; ++bj)
#pragma unroll
                    for (int n = 0; n < 2; ++n) { f32x4 v = acc[ai][bj][m][n]; if (R) v += *(const f32x4*)(R + off + bj * 128 + n * 16); *(f32x4*)(C + off + bj * 128 + n * 16) = v; } }
    }
};
template <class Epi> DI void run_gemm(LDS unsigned char* lds, const bf16* A, const bf16* Bt, int M, int N, int K, const Epi& E, int rot) {
    pg8::Gemm g{A, Bt, M, N, K}; pg8::StaticOrder S; S.init(M, N, (int)gridDim.x, (int)((blockIdx.x + rot) % gridDim.x));
    pg8::gemm_phase<Epi, pg8::StaticOrder>(lds, g, S, E);
}

DI const float* xrow(const Params& p, int t) { return t < TP ? p.xp + (size_t)t * DM : p.xs + (size_t)(t - TP) * DM; }
DI void rmsnorm_row_1024(const float* src, const float* g, bf16* dst, int lane) {
    f32x4 v[4]; float ss = 0.f;
#pragma unroll
    for (int i = 0; i < 4; ++i) { v[i] = *(const f32x4*)(src + 4 * (lane + 64 * i)); ss += v[i][0] * v[i][0] + v[i][1] * v[i][1] + v[i][2] * v[i][2] + v[i][3] * v[i][3]; }
    ss = wsum(ss); const float rs = rsqrtf(ss * (1.0f / 1024.0f) + EPS);
#pragma unroll
    for (int i = 0; i < 4; ++i) { const f32x4 gg = *(const f32x4*)(g + 4 * (lane + 64 * i)); u32x2 w; w[0] = pk2(v[i][0] * rs * gg[0], v[i][1] * rs * gg[1]); w[1] = pk2(v[i][2] * rs * gg[2], v[i][3] * rs * gg[3]);
        *(u32x2*)(dst + 4 * (lane + 64 * i)) = w; }
}
template <int K, int N, int NPAD> DI void prep_job(const float* W, bf16* Wt, LDS float* tl, int rot) {
    const int tid = tid_opaque(); constexpr int nkt = K / 64, ntiles = (NPAD / 64) * nkt;
    for (int tile = (int)((blockIdx.x + rot) % gridDim.x); tile < ntiles; tile += gridDim.x) {
        const int tn = tile / nkt, tk = tile % nkt;
        { const int kk = tid >> 3, n8 = (tid & 7) * 8; const int n = tn * 64 + n8; const float* s = W + (size_t)(tk * 64 + kk) * N + n;
            f32x4 a = {0.f, 0.f, 0.f, 0.f}, b = a; if (n < N) { a = *(const f32x4*)s; b = *(const f32x4*)(s + 4); }
#pragma unroll
            for (int q = 0; q < 4; ++q) { tl[kk * 65 + n8 + q] = a[q]; tl[kk * 65 + n8 + 4 + q] = b[q]; } }
        __syncthreads();
        { const int nn = tid >> 3, k8 = (tid & 7) * 8; u32x4 w;
#pragma unroll
            for (int q = 0; q < 4; ++q) w[q] = pk2(tl[(k8 + 2 * q) * 65 + nn], tl[(k8 + 2 * q + 1) * 65 + nn]);
            *(u32x4*)(Wt + (size_t)(tn * 64 + nn) * K + tk * 64 + k8) = w; }
        __syncthreads();
    }
}
DI void phase_prep(const Params& p, LDS unsigned char* lds) {
    const int tid = tid_opaque(), wid = tid >> 6, lane = tid & 63;
    LDS float* tl = (LDS float*)lds;
    prep_job<DM, DIN, DINP>(p.w_in, p.wt_in, tl, 0); prep_job<384, 768, 768>(p.w_qb, p.wt_qb, tl, 64); prep_job<256, 1024, 1024>(p.w_kvb, p.wt_kvb, tl, 136); prep_job<DM, DM, DM>(p.w_out, p.wt_out, tl, 200);
    prep_job<DM, 512, 512>(p.w_xq, p.wt_xq, tl, 0); prep_job<DM, 512, 512>(p.w_xk, p.wt_xkv, tl, 128); prep_job<DM, 512, 512>(p.w_xv, p.wt_xkv + (size_t)512 * DM, tl, 0); prep_job<512, DM, DM>(p.w_xo, p.wt_xo, tl, 128);
    prep_job<DM, DFF, DFF>(p.w_ff1, p.wt_ff1, tl, 0); prep_job<DFF, DM, DM>(p.w_ff2, p.wt_ff2, tl, 0);
    for (int row = blockIdx.x * 8 + wid; row < T + MROWS; row += gridDim.x * 8) {
        if (row < T) rmsnorm_row_1024(xrow(p, row), p.g_mix, p.H + (size_t)row * DM, lane);
        else rmsnorm_row_1024(p.memp + (size_t)(row - T) * DM, p.g_mem, p.MEMN + (size_t)(row - T) * DM, lane);
    }
}

DI float rope32(float xn, int lane, int pos) {
    const float partner = __shfl_xor(xn, 16);
    const int i = lane & 15; const float inv = expf(-(float)i * (9.210340371976184f / 16.0f)); const float ang = (float)pos * inv;
    const float c = cosf(ang), s = sinf(ang);
    return (lane & 16) ? xn * c + partner * s : xn * c - partner * s;
}
DI int row_pos(int t) { return t < TP ? (t % SEQ) : PAST + ((t - TP) % DECS); }

DI void phase_post_in(const Params& p) {
    const int tid = tid_opaque(), wid = tid >> 6, lane = tid & 63;
    for (int row = blockIdx.x * 8 + wid; row < T + MROWS; row += gridDim.x * 8) {
        if (row < T) {
            const int t = row; const bf16* z = p.Z + (size_t)t * DINP;
            float a[16];
#pragma unroll
            for (int i = 0; i < 16; ++i) a[i] = bf2f(z[ZA + i]);
#pragma unroll
            for (int q = 0; q < 4; ++q) { const int c = lane + 64 * q; float gp = p.b_a[c];
#pragma unroll
                for (int i = 0; i < 16; ++i) gp += a[i] * p.w_a2[i * 256 + c];
                const float ls = fminf(gp, 0.f) - log1pf(expf(-fabsf(gp)));
                p.LOGA[(size_t)t * 256 + c] = ls * (1.0f / 16.0f); }
            { float v[6]; float ss = 0.f;
#pragma unroll
                for (int q = 0; q < 6; ++q) { v[q] = bf2f(z[ZQA + lane + 64 * q]); ss += v[q] * v[q]; }
                ss = wsum(ss); const float rs = rsqrtf(ss * (1.0f / 384.0f) + EPS);
#pragma unroll
                for (int q = 0; q < 6; ++q) p.QAN[(size_t)t * 384 + lane + 64 * q] = f2bf(v[q] * rs * p.g_qa[lane + 64 * q]); }
            { float v[4]; float ss = 0.f;
#pragma unroll
                for (int q = 0; q < 4; ++q) { v[q] = bf2f(z[ZKVA + lane + 64 * q]); ss += v[q] * v[q]; }
                ss = wsum(ss); const float rs = rsqrtf(ss * (1.0f / 256.0f) + EPS);
                float* oc = t < TP ? p.o_ckvp + (size_t)t * 256 : p.o_ckvs + (size_t)(t - TP) * 256;
#pragma unroll
                for (int q = 0; q < 4; ++q) { const float c = v[q] * rs * p.g_kva[lane + 64 * q]; oc[lane + 64 * q] = c; p.CKVB[(size_t)t * 256 + lane + 64 * q] = f2bf(c); } }
            { const float v = lane < 32 ? bf2f(z[ZKPE + lane]) : 0.f; const float ss = wsum(v * v); const float rs = rsqrtf(ss * (1.0f / 32.0f) + EPS);
                const float xn = v * rs * p.g_kr[lane & 31]; const float o = rope32(xn, lane, row_pos(t));
                if (lane < 32) { float* ok = t < TP ? p.o_kpep + (size_t)t * 32 : p.o_kpes + (size_t)(t - TP) * 32; ok[lane] = o; p.KPB[(size_t)t * 32 + lane] = f2bf(o); } }
        } else {
            const int r = row - T; const float* s = p.MKV + (size_t)r * 1024;
            float v[8]; float ss = 0.f;
#pragma unroll
            for (int q = 0; q < 8; ++q) { v[q] = s[lane * 8 + q]; ss += v[q] * v[q]; }
            ss += __shfl_xor(ss, 1); ss += __shfl_xor(ss, 2); ss += __shfl_xor(ss, 4); ss += __shfl_xor(ss, 8);
            const float rs = rsqrtf(ss * (1.0f / 128.0f) + EPS);
#pragma unroll
            for (int q = 0; q < 8; ++q) { const int c = lane * 8 + q; const float k = v[q] * rs * p.g_xk[c & 127]; p.o_mkp[(size_t)r * 512 + c] = k; p.MKB[(size_t)r * 512 + c] = f2bf(k);
                const float vv = s[512 + c]; p.o_mvp[(size_t)r * 512 + c] = vv; p.MVB[(size_t)r * 512 + c] = f2bf(vv); }
        }
    }
}

DI void phase_post_qkv(const Params& p) {
    const int tid = tid_opaque(), wid = tid >> 6, lane = tid & 63;
    for (int t = blockIdx.x * 8 + wid; t < T; t += gridDim.x * 8) {
        const bf16* qf = p.QF + (size_t)t * 768; const bf16* kv = p.KV + (size_t)t * 1024; const int pos = row_pos(t);
        for (int h = 0; h < 8; ++h) {
            const float v = bf2f(qf[h * 96 + lane]); const float ss = wsum(v * v); const float rs = rsqrtf(ss * (1.0f / 64.0f) + EPS);
            p.QN[((size_t)t * 8 + h) * 96 + lane] = f2bf(v * rs * p.g_qn[lane] * MLA_SCALE);
            const float vr = lane < 32 ? bf2f(qf[h * 96 + 64 + lane]) : 0.f; const float ssr = wsum(vr * vr); const float rsr = rsqrtf(ssr * (1.0f / 32.0f) + EPS);
            const float xr = vr * rsr * p.g_qr[lane & 31]; const float o = rope32(xr, lane, pos);
            if (lane < 32) p.QN[((size_t)t * 8 + h) * 96 + 64 + lane] = f2bf(o * MLA_SCALE);
            const float k = bf2f(kv[h * 128 + lane]); const float sk = wsum(k * k); const float rk = rsqrtf(sk * (1.0f / 64.0f) + EPS);
            p.KN[((size_t)t * 8 + h) * 64 + lane] = f2bf(k * rk * p.g_kn[lane]);
        }
    }
}
struct GlaUnit { int t0, h, nv; };
DI GlaUnit gla_unit(int u) { GlaUnit g; if (u < NGP) { const int b = u / (4 * NC), h = (u / NC) % 4, c = u % NC; g.t0 = b * SEQ + c * 64; g.h = h; g.nv = 64; } else { const int us = u - NGP; g.t0 = TP + (us >> 2) * DECS; g.h = us & 3; g.nv = DECS; } return g; }
DI void gla_cumsum(const Params& p, const GlaUnit& g, LDS float* LA, int tid) {
    for (int i = tid; i < 64 * 64; i += NTHREADS) { const int s = i >> 6, kd = i & 63; LA[s * 65 + kd] = s < g.nv ? p.LOGA[(size_t)(g.t0 + s) * 256 + g.h * 64 + kd] : 0.f; }
    __syncthreads();
    if (tid < 64) { float a = 0.f; for (int s = 0; s < 64; ++s) { a += LA[s * 65 + tid]; LA[s * 65 + tid] = a; } }
    __syncthreads();
}
constexpr int GL_LA = 0, GL_KH = 16640  , GL_VT = GL_KH + 64 * 72 * 2, GL_QT = GL_VT + 128 * 72 * 2, GL_ST = GL_QT + 64 * 72 * 2, GL_ATT = GL_ST + 128 * 72 * 2, GL_OB = GL_ATT + 64 * 72 * 2, GL_END = GL_OB + 64 * 129 * 4;
static_assert(GL_END <= LDS_CTL && GL_KH % 16 == 0 && GL_OB % 16 == 0, "GLA LDS map");
DI void phase_gla_a(const Params& p, LDS unsigned char* lds) {
    const int tid = tid_opaque(), wid = tid >> 6, lane = tid & 63, r = lane & 31, hh = lane >> 5;
    LDS float* LA = (LDS float*)(lds + GL_LA); LDS bf16* KH = (LDS bf16*)(lds + GL_KH); LDS bf16* VT = (LDS bf16*)(lds + GL_VT);
    for (int u = blockIdx.x; u < NGU; u += gridDim.x) {
        const GlaUnit g = gla_unit(u);
        gla_cumsum(p, g, LA, tid);
        for (int i = tid; i < 64 * 64; i += NTHREADS) { const int s = i >> 6, kd = i & 63;
            float v = 0.f; if (s < g.nv) v = bf2f(p.Z[(size_t)(g.t0 + s) * DINP + ZK + g.h * 64 + kd]) * expf(LA[63 * 65 + kd] - LA[s * 65 + kd]);
            KH[kd * 72 + s] = f2bf(v); }
        for (int i = tid; i < 64 * 128; i += NTHREADS) { const int s = i >> 7, dv = i & 127;
            VT[dv * 72 + s] = s < g.nv ? p.Z[(size_t)(g.t0 + s) * DINP + ZV + g.h * 128 + dv] : (bf16)0; }
        if (tid < 64) p.DDEC[(size_t)u * 64 + tid] = expf(LA[63 * 65 + tid]);
        __syncthreads();
        { const int mt = wid & 1, nt = wid >> 1; f32x16 acc = zero16();
#pragma unroll
            for (int ks = 0; ks < 4; ++ks) acc = mfma32(ld8(KH + (32 * mt + r) * 72 + 16 * ks + 8 * hh), ld8(VT + (32 * nt + r) * 72 + 16 * ks + 8 * hh), acc);
            float* d = p.DS + (size_t)u * 8192;
#pragma unroll
            for (int i = 0; i < 16; ++i) d[(32 * mt + crow(i, hh)) * 128 + 32 * nt + r] = acc[i]; }
        __syncthreads();
    }
}
DI void phase_gla_b(const Params& p) {
    const int gid = blockIdx.x * NTHREADS + tid_opaque(), gsz = gridDim.x * NTHREADS;
    for (int e = gid; e < BATCH * 4 * 8192; e += gsz) { const int bh = e >> 13, idx = e & 8191, kd = idx >> 7; float S = 0.f;
        for (int c = 0; c < NC; ++c) { const size_t u = (size_t)bh * NC + c; const float d = p.DS[u * 8192 + idx]; p.DS[u * 8192 + idx] = S; S = S * p.DDEC[u * 64 + kd] + d; }
        p.o_glap[e] = S; }
    for (int e = gid; e < DECB * 4 * 8192; e += gsz) { const int bh = e >> 13, idx = e & 8191, kd = idx >> 7; const size_t u = (size_t)NGP + bh;
        p.o_glas[e] = p.sgla[e] * p.DDEC[u * 64 + kd] + p.DS[u * 8192 + idx]; }
}
DI void gla_c_unit(const Params& p, LDS unsigned char* lds, int u) {
    const int tid = tid_opaque(), wid = tid >> 6, lane = tid & 63, r = lane & 31, hh = lane >> 5;
    LDS float* LA = (LDS float*)(lds + GL_LA); LDS bf16* KT = (LDS bf16*)(lds + GL_KH); LDS bf16* VT = (LDS bf16*)(lds + GL_VT); LDS bf16* QT = (LDS bf16*)(lds + GL_QT);
    LDS bf16* ST = (LDS bf16*)(lds + GL_ST); LDS bf16* ATT = (LDS bf16*)(lds + GL_ATT); LDS float* OB = (LDS float*)(lds + GL_OB);
    const GlaUnit g = gla_unit(u);
    gla_cumsum(p, g, LA, tid);
    for (int i = tid; i < 64 * 64; i += NTHREADS) { const int s = i >> 6, kd = i & 63; float q = 0.f, k = 0.f;
        if (s < g.nv) { const bf16* z = p.Z + (size_t)(g.t0 + s) * DINP; const float b = LA[s * 65 + kd]; q = bf2f(z[ZQ + g.h * 64 + kd]) * expf(b) * 0.125f; k = bf2f(z[ZK + g.h * 64 + kd]) * expf(-b); }
        QT[s * 72 + kd] = f2bf(q); KT[s * 72 + kd] = f2bf(k); }
    for (int i = tid; i < 64 * 128; i += NTHREADS) { const int s = i >> 7, dv = i & 127;
        VT[dv * 72 + s] = s < g.nv ? p.Z[(size_t)(g.t0 + s) * DINP + ZV + g.h * 128 + dv] : (bf16)0; }
    { const float* sp = u < NGP ? p.DS + (size_t)u * 8192 : p.sgla + (size_t)(u - NGP) * 8192;
        for (int i = tid; i < 8192; i += NTHREADS) { const int kd = i >> 7, dv = i & 127; ST[dv * 72 + kd] = f2bf(sp[i]); } }
    __syncthreads();
    if (wid < 4) { const int mt = wid & 1, nt = wid >> 1; f32x16 acc = zero16();
#pragma unroll
        for (int ks = 0; ks < 4; ++ks) acc = mfma32(ld8(QT + (32 * mt + r) * 72 + 16 * ks + 8 * hh), ld8(KT + (32 * nt + r) * 72 + 16 * ks + 8 * hh), acc);
#pragma unroll
        for (int i = 0; i < 16; ++i) { const int t = 32 * mt + crow(i, hh), s = 32 * nt + r; ATT[t * 72 + s] = f2bf(s <= t ? acc[i] : 0.f); } }
    __syncthreads();
    { const int mt = wid & 1, nt = wid >> 1; f32x16 acc = zero16();
#pragma unroll
        for (int ks = 0; ks < 4; ++ks) acc = mfma32(ld8(QT + (32 * mt + r) * 72 + 16 * ks + 8 * hh), ld8(ST + (32 * nt + r) * 72 + 16 * ks + 8 * hh), acc);
#pragma unroll
        for (int ks = 0; ks < 4; ++ks) acc = mfma32(ld8(ATT + (32 * mt + r) * 72 + 16 * ks + 8 * hh), ld8(VT + (32 * nt + r) * 72 + 16 * ks + 8 * hh), acc);
#pragma unroll
        for (int i = 0; i < 16; ++i) OB[(32 * mt + crow(i, hh)) * 129 + 32 * nt + r] = acc[i]; }
    __syncthreads();
    for (int t = wid; t < g.nv; t += 8) { const float o0 = OB[t * 129 + lane], o1 = OB[t * 129 + 64 + lane]; const float ss = wsum(o0 * o0 + o1 * o1); const float rs = rsqrtf(ss * (1.0f / 128.0f) + EPS);
        const bf16* z = p.Z + (size_t)(g.t0 + t) * DINP + ZR + g.h * 128; bf16* o = p.OMIX + (size_t)(g.t0 + t) * DM + g.h * 128;
        const float r0 = bf2f(z[lane]), r1 = bf2f(z[64 + lane]);
        o[lane] = f2bf(o0 * rs * p.g_gla_o[lane] * (r0 / (1.0f + expf(-r0)))); o[64 + lane] = f2bf(o1 * rs * p.g_gla_o[64 + lane] * (r1 / (1.0f + expf(-r1)))); }
}
constexpr int PA_KT = 0, PA_VT = 64 * 104 * 2, PA_END = PA_VT + 64 * 72 * 2;
DI void pattn_unit(const Params& p, LDS unsigned char* lds, int u) {
    const int tid = tid_opaque(), wid = tid >> 6, lane = tid & 63, r = lane & 31, hh = lane >> 5;
    LDS bf16* KT = (LDS bf16*)(lds + PA_KT); LDS bf16* VT = (LDS bf16*)(lds + PA_VT);
    const int qb = NQB - 1 - u / (BATCH * 8), bh = u % (BATCH * 8), b = bh >> 3, h = bh & 7;
    const int qw0 = qb * 256 + 32 * wid, qpos = qw0 + r; const size_t trow = (size_t)b * SEQ + qpos;
    bf16x8 qf[6];
#pragma unroll
    for (int ks = 0; ks < 6; ++ks) qf[ks] = ld8g(p.QN + (trow * 8 + h) * 96 + 16 * ks + 8 * hh);
    f32x16 o0 = zero16(), o1 = zero16(); float m = -INFINITY, l = 0.f;
    const int nkt = 4 * (qb + 1);
    for (int kt = 0; kt < nkt; ++kt) {
        const int k0 = kt * 64; const size_t kr0 = (size_t)b * SEQ + k0;
        for (int i = tid; i < 64 * 12; i += NTHREADS) { const int key = i / 12, c = i % 12;
            const bf16x8 v = c < 8 ? ld8g(p.KN + ((kr0 + key) * 8 + h) * 64 + c * 8) : ld8g(p.KPB + (kr0 + key) * 32 + (c - 8) * 8);
            *(LDS bf16x8*)(KT + key * 104 + c * 8) = v; }
        { const int key = tid >> 3, c8 = (tid & 7) * 8; const bf16x8 v = ld8g(p.KV + (kr0 + key) * 1024 + h * 128 + 64 + c8);
#pragma unroll
            for (int j = 0; j < 8; ++j) VT[(c8 + j) * 72 + key] = (bf16)v[j]; }
        __syncthreads();
        if (k0 <= qw0 + 31) {
            f32x16 s0 = zero16(), s1 = zero16();
#pragma unroll
            for (int ks = 0; ks < 6; ++ks) { s0 = mfma32(ld8(KT + r * 104 + 16 * ks + 8 * hh), qf[ks], s0); s1 = mfma32(ld8(KT + (32 + r) * 104 + 16 * ks + 8 * hh), qf[ks], s1); }
            float tmax = -INFINITY;
#pragma unroll
            for (int i = 0; i < 16; ++i) { const int key = k0 + crow(i, hh); if (key > qpos) s0[i] = -INFINITY; if (key + 32 > qpos) s1[i] = -INFINITY; tmax = fmaxf(tmax, fmaxf(s0[i], s1[i])); }
            tmax = fmaxf(tmax, __shfl_xor(tmax, 32));
            const float mn = fmaxf(m, tmax), corr = expf(m - mn); m = mn; float ps = 0.f;
#pragma unroll
            for (int i = 0; i < 16; ++i) { s0[i] = expf(s0[i] - mn); s1[i] = expf(s1[i] - mn); ps += s0[i] + s1[i]; }
            l = l * corr + ps;
#pragma unroll
            for (int i = 0; i < 16; ++i) { o0[i] *= corr; o1[i] *= corr; }
#pragma unroll
            for (int s = 0; s < 2; ++s) { const bf16x8 pa = PACK(s0, s), pb = PACK(s1, s);
                o0 = mfma32(ldperm(VT + r * 72 + 16 * s, hh), pa, o0); o1 = mfma32(ldperm(VT + (32 + r) * 72 + 16 * s, hh), pa, o1);
                o0 = mfma32(ldperm(VT + r * 72 + 32 + 16 * s, hh), pb, o0); o1 = mfma32(ldperm(VT + (32 + r) * 72 + 32 + 16 * s, hh), pb, o1); }
        }
        __syncthreads();
    }
    l += __shfl_xor(l, 32); const float il = 1.0f / l;
    bf16* o = p.OMIX + trow * DM + 512 + h * 64;
#pragma unroll
    for (int g = 0; g < 4; ++g) { u32x2 w0, w1; w0[0] = pk2(o0[4 * g] * il, o0[4 * g + 1] * il); w0[1] = pk2(o0[4 * g + 2] * il, o0[4 * g + 3] * il); w1[0] = pk2(o1[4 * g] * il, o1[4 * g + 1] * il); w1[1] = pk2(o1[4 * g + 2] * il, o1[4 * g + 3] * il);
        *(u32x2*)(o + 8 * g + 4 * hh) = w0; *(u32x2*)(o + 32 + 8 * g + 4 * hh) = w1; }
}

constexpr int XA_K = 0, XA_V = 256 * 136 * 2, XA_END = XA_V + 128 * 264 * 2;
static_assert(XA_END <= LDS_CTL && XA_V % 16 == 0, "cross-attention LDS map");
DI void xattn_unit(const Params& p, LDS unsigned char* lds, int u) {
    const int tid = tid_opaque(), wid = tid >> 6, lane = tid & 63, r = lane & 31, hh = lane >> 5;
    LDS bf16* KX = (LDS bf16*)(lds + XA_K); LDS bf16* VX = (LDS bf16*)(lds + XA_V);
    int b, h, nrows; size_t tbase;
    if (u < NU_XP) { b = u / (4 * NQB); h = (u / NQB) & 3; const int qc = u % NQB; nrows = 256; tbase = (size_t)b * SEQ + qc * 256;
        for (int i = tid; i < 256 * 16; i += NTHREADS) { const int key = i >> 4, c8 = (i & 15) * 8; const size_t src = ((size_t)b * 256 + key) * 512 + h * 128 + c8;
            *(LDS bf16x8*)(KX + key * 136 + c8) = ld8g(p.MKB + src); const bf16x8 v = ld8g(p.MVB + src);
#pragma unroll
            for (int j = 0; j < 8; ++j) VX[(c8 + j) * 264 + key] = (bf16)v[j]; }
    } else { const int us = u - NU_XP; b = us >> 2; h = us & 3; nrows = DECS; tbase = (size_t)TP + b * DECS;
        for (int i = tid; i < 256 * 32; i += NTHREADS) { const int key = i >> 5, c4 = (i & 31) * 4; const size_t src = (((size_t)b * 256 + key) * 4 + h) * 128 + c4;
            const f32x4 k = *(const f32x4*)(p.cmk + src), v = *(const f32x4*)(p.cmv + src); u32x2 w; w[0] = pk2(k[0], k[1]); w[1] = pk2(k[2], k[3]); *(LDS u32x2*)(KX + key * 136 + c4) = w;
#pragma unroll
            for (int j = 0; j < 4; ++j) VX[(c4 + j) * 264 + key] = f2bf(v[j]); }
    }
    __syncthreads();
    if (32 * wid < nrows) {
        const bool valid = 32 * wid + r < nrows; const size_t trow = tbase + 32 * wid + (valid ? r : 0);
        bf16x8 qf[8]; float ss = 0.f;
#pragma unroll
        for (int ks = 0; ks < 8; ++ks) { qf[ks] = ld8g(p.XQ + trow * 512 + h * 128 + 16 * ks + 8 * hh);
#pragma unroll
            for (int j = 0; j < 8; ++j) { const float v = bf2f((bf16)qf[ks][j]); ss += v * v; } }
        ss += __shfl_xor(ss, 32); const float rs = valid ? rsqrtf(ss * (1.0f / 128.0f) + EPS) * X_SCALE : 0.f;
#pragma unroll
        for (int ks = 0; ks < 8; ++ks) { float q[8];
#pragma unroll
            for (int j = 0; j < 8; ++j) q[j] = bf2f((bf16)qf[ks][j]) * rs * p.g_xq[16 * ks + 8 * hh + j];
            qf[ks] = pack8(q[0], q[1], q[2], q[3], q[4], q[5], q[6], q[7]); }
        f32x16 o[4];
#pragma unroll
        for (int d = 0; d < 4; ++d) o[d] = zero16();
        float m = -INFINITY, l = 0.f;
        for (int kt = 0; kt < 4; ++kt) {
            f32x16 s0 = zero16(), s1 = zero16();
#pragma unroll
            for (int ks = 0; ks < 8; ++ks) { s0 = mfma32(ld8(KX + (64 * kt + r) * 136 + 16 * ks + 8 * hh), qf[ks], s0); s1 = mfma32(ld8(KX + (64 * kt + 32 + r) * 136 + 16 * ks + 8 * hh), qf[ks], s1); }
            float tmax = -INFINITY;
#pragma unroll
            for (int i = 0; i < 16; ++i) tmax = fmaxf(tmax, fmaxf(s0[i], s1[i]));
            tmax = fmaxf(tmax, __shfl_xor(tmax, 32));
            const float mn = fmaxf(m, tmax), corr = expf(m - mn); m = mn; float ps = 0.f;
#pragma unroll
            for (int i = 0; i < 16; ++i) { s0[i] = expf(s0[i] - mn); s1[i] = expf(s1[i] - mn); ps += s0[i] + s1[i]; }
            l = l * corr + ps;
#pragma unroll
            for (int d = 0; d < 4; ++d)
#pragma unroll
                for (int i = 0; i < 16; ++i) o[d][i] *= corr;
#pragma unroll
            for (int s = 0; s < 2; ++s) { const bf16x8 pa = PACK(s0, s), pb = PACK(s1, s);
#pragma unroll
                for (int d = 0; d < 4; ++d) { o[d] = mfma32(ldperm(VX + (32 * d + r) * 264 + 64 * kt + 16 * s, hh), pa, o[d]); o[d] = mfma32(ldperm(VX + (32 * d + r) * 264 + 64 * kt + 32 + 16 * s, hh), pb, o[d]); } }
        }
        l += __shfl_xor(l, 32); const float il = 1.0f / l;
        if (valid) { bf16* op = p.XO + trow * 512 + h * 128;
#pragma unroll
            for (int d = 0; d < 4; ++d)
#pragma unroll
                for (int g = 0; g < 4; ++g) { u32x2 w; w[0] = pk2(o[d][4 * g] * il, o[d][4 * g + 1] * il); w[1] = pk2(o[d][4 * g + 2] * il, o[d][4 * g + 3] * il); *(u32x2*)(op + 32 * d + 8 * g + 4 * hh) = w; } }
    }
}
constexpr int SA_CK = 0, SA_CKT = SA_CK + 64 * 264 * 2, SA_KP = SA_CKT + 256 * 72 * 2, SA_P = SA_KP + 64 * 40 * 2, SA_QS = SA_P + 64 * 72 * 2, SA_CORR = SA_QS + 65 * 104 * 2, SA_END = SA_CORR + 256;
static_assert(SA_END <= LDS_CTL && SA_CKT % 16 == 0 && SA_KP % 16 == 0 && SA_P % 16 == 0 && SA_QS % 16 == 0 && SA_CORR % 16 == 0, "sample attention LDS map");
DI void sattn_unit(const Params& p, LDS unsigned char* lds, int u) {
    const int tid = tid_opaque(), wid = tid >> 6, lane = tid & 63, r = lane & 31, hh = lane >> 5;
    LDS bf16* CK = (LDS bf16*)(lds + SA_CK); LDS bf16* CKT = (LDS bf16*)(lds + SA_CKT); LDS bf16* KP = (LDS bf16*)(lds + SA_KP); LDS bf16* PA = (LDS bf16*)(lds + SA_P);
    LDS bf16* QS = (LDS bf16*)(lds + SA_QS); LDS float* CORR = (LDS float*)(lds + SA_CORR);
    const int b = u / NSPLIT, sp = u % NSPLIT; const int h = wid;
    for (int i = tid; i < 65 * 96; i += NTHREADS) { const int row = i / 96, d = i % 96; float v = 0.f;
        if (row < 64) { const int hq = row >> 3, q = row & 7; v = bf2f(p.QN[(((size_t)TP + b * DECS + q) * 8 + hq) * 96 + d]); if (d < 64) v *= p.g_kn[d]; }
        QS[row * 104 + d] = f2bf(v); }
    const int qrow = r < 8 ? h * 8 + r : 64;
    f32x16 acc0 = zero16(), acc1 = zero16(); float m = -INFINITY, l = 0.f;
    const int ntile = PPS * 2 + (sp == NSPLIT - 1 ? 1 : 0);
    for (int tile = 0; tile < ntile; ++tile) {
        const bool newt = tile == PPS * 2;
        if (!newt) { const int pid = p.ptab[b * NPAGES + sp * PPS + (tile >> 1)]; const size_t key0 = (size_t)pid * PAGE + (tile & 1) * 64;
            for (int i = tid; i < 64 * 64; i += NTHREADS) { const int key = i >> 6, c4 = (i & 63) * 4; const f32x4 v = *(const f32x4*)(p.cckv + (key0 + key) * 256 + c4);
                u32x2 w; w[0] = pk2(v[0], v[1]); w[1] = pk2(v[2], v[3]); *(LDS u32x2*)(CK + key * 264 + c4) = w;
#pragma unroll
                for (int j = 0; j < 4; ++j) CKT[(c4 + j) * 72 + key] = f2bf(v[j]); }
            { const int key = tid >> 3, c4 = (tid & 7) * 4; const f32x4 v = *(const f32x4*)(p.ckpe + (key0 + key) * 32 + c4); u32x2 w; w[0] = pk2(v[0], v[1]); w[1] = pk2(v[2], v[3]); *(LDS u32x2*)(KP + key * 40 + c4) = w; }
        } else { const size_t t0 = (size_t)TP + b * DECS;
            for (int i = tid; i < 64 * 256; i += NTHREADS) { const int key = i >> 8, c = i & 255; const bf16 v = key < DECS ? p.CKVB[(t0 + key) * 256 + c] : (bf16)0; CK[key * 264 + c] = v; CKT[c * 72 + key] = v; }
            for (int i = tid; i < 64 * 32; i += NTHREADS) { const int key = i >> 5, c = i & 31; KP[key * 40 + c] = key < DECS ? p.KPB[(t0 + key) * 32 + c] : (bf16)0; }
        }
        __syncthreads();
        f32x16 z0, z1;
        const bf16* wkp = p.wt_kvb + (size_t)(h * 128 + r) * 256 + 8 * hh;
#ifndef EMU
        asm volatile("" : "+v"(wkp));
#endif
#pragma unroll
        for (int kk = 0; kk < 2; ++kk) {
            f32x16 x0 = zero16(), x1 = zero16();
#pragma unroll 4
            for (int ks = 0; ks < 16; ++ks) { const bf16x8 cb = ld8(CK + (32 * kk + r) * 264 + 16 * ks + 8 * hh);
                x0 = mfma32(ld8g(wkp + 16 * ks), cb, x0);
                x1 = mfma32(ld8g(wkp + 32 * 256 + 16 * ks), cb, x1); }
            float ss = 0.f;
#pragma unroll
            for (int i = 0; i < 16; ++i) ss += x0[i] * x0[i] + x1[i] * x1[i];
            ss += __shfl_xor(ss, 32); const float inv = rsqrtf(ss * (1.0f / 64.0f) + EPS);
#pragma unroll
            for (int i = 0; i < 16; ++i) { x0[i] *= inv; x1[i] *= inv; }
            f32x16 z = zero16();
#pragma unroll
            for (int s = 0; s < 2; ++s) { z = mfma32(PACK(x0, s), ldperm(QS + qrow * 104 + 16 * s, hh), z); z = mfma32(PACK(x1, s), ldperm(QS + qrow * 104 + 32 + 16 * s, hh), z);
                z = mfma32(ld8(KP + (32 * kk + r) * 40 + 16 * s + 8 * hh), ld8(QS + qrow * 104 + 64 + 16 * s + 8 * hh), z); }
            if (kk == 0) z0 = z; else z1 = z;
        }
        float tmax = -INFINITY;
#pragma unroll
        for (int i = 0; i < 16; ++i) { const int key = crow(i, hh);
            if (newt) { if (key > r || key >= DECS) z0[i] = -INFINITY; z1[i] = -INFINITY; }
            tmax = fmaxf(tmax, fmaxf(z0[i], z1[i])); }
        tmax = fmaxf(tmax, __shfl_xor(tmax, 32));
        if (r >= 8) tmax = 0.f;
        const float mn = fmaxf(m, tmax), corr = expf(m - mn); m = mn; float ps = 0.f;
#pragma unroll
        for (int i = 0; i < 16; ++i) { z0[i] = expf(z0[i] - mn); z1[i] = expf(z1[i] - mn); ps += z0[i] + z1[i]; }
        l = l * corr + ps;
        if (r < 8) { LDS bf16* pr = PA + (h * 8 + r) * 72;
#pragma unroll
            for (int i = 0; i < 16; ++i) { pr[crow(i, hh)] = f2bf(z0[i]); pr[32 + crow(i, hh)] = f2bf(z1[i]); }
            if (hh == 0) CORR[h * 8 + r] = corr; }
        __syncthreads();
        { const float c0 = CORR[r], c1 = CORR[32 + r];
#pragma unroll
            for (int i = 0; i < 16; ++i) { acc0[i] *= c0; acc1[i] *= c1; }
#pragma unroll
            for (int ks = 0; ks < 4; ++ks) { const bf16x8 a = ld8(CKT + (32 * wid + r) * 72 + 16 * ks + 8 * hh);
                acc0 = mfma32(a, ld8(PA + r * 72 + 16 * ks + 8 * hh), acc0); acc1 = mfma32(a, ld8(PA + (32 + r) * 72 + 16 * ks + 8 * hh), acc1); } }
        __syncthreads();
    }
    float* pa = p.PACC + (size_t)u * 64 * 256;
#pragma unroll
    for (int g = 0; g < 4; ++g) { f32x4 v0 = {acc0[4 * g], acc0[4 * g + 1], acc0[4 * g + 2], acc0[4 * g + 3]}, v1 = {acc1[4 * g], acc1[4 * g + 1], acc1[4 * g + 2], acc1[4 * g + 3]};
        *(f32x4*)(pa + (size_t)r * 256 + 32 * wid + 8 * g + 4 * hh) = v0; *(f32x4*)(pa + (size_t)(32 + r) * 256 + 32 * wid + 8 * g + 4 * hh) = v1; }
    l += __shfl_xor(l, 32);
    if (lane < 8) { p.PML[((size_t)u * 64 + h * 8 + r) * 2] = m; p.PML[((size_t)u * 64 + h * 8 + r) * 2 + 1] = l; }
}
constexpr int SC_ACC = 0, SC_W = 64 * 257 * 4, SC_END = SC_W + 64 * NSPLIT * 4 + 256;
DI void phase_sattn_combine(const Params& p, LDS unsigned char* lds) {
    const int tid = tid_opaque();
    LDS float* AC = (LDS float*)(lds + SC_ACC); LDS float* WS = (LDS float*)(lds + SC_W);
    for (int b = blockIdx.x; b < DECB; b += gridDim.x) {
        if (tid < 64) { float M = -INFINITY; for (int j = 0; j < NSPLIT; ++j) M = fmaxf(M, p.PML[((size_t)(b * NSPLIT + j) * 64 + tid) * 2]);
            float L = 0.f; for (int j = 0; j < NSPLIT; ++j) { const float w = expf(p.PML[((size_t)(b * NSPLIT + j) * 64 + tid) * 2] - M); WS[tid * NSPLIT + j] = w; L += w * p.PML[((size_t)(b * NSPLIT + j) * 64 + tid) * 2 + 1]; }
            const float iL = 1.0f / L; for (int j = 0; j < NSPLIT; ++j) WS[tid * NSPLIT + j] *= iL; }
        __syncthreads();
        for (int i = tid; i < 64 * 256; i += NTHREADS) { const int hq = i >> 8, lat = i & 255; float s = 0.f;
            for (int j = 0; j < NSPLIT; ++j) s += WS[hq * NSPLIT + j] * p.PACC[((size_t)(b * NSPLIT + j) * 64 + hq) * 256 + lat];
            AC[hq * 257 + lat] = s; }
        __syncthreads();
        for (int i = tid; i < 64 * 64; i += NTHREADS) { const int hq = i >> 6, dv = i & 63, h = hq >> 3, q = hq & 7; const bf16* w = p.wt_kvb + (size_t)(h * 128 + 64 + dv) * 256; float s = 0.f;
            for (int lat = 0; lat < 256; ++lat) s += AC[hq * 257 + lat] * bf2f(w[lat]);
            p.OMIX[((size_t)TP + b * DECS + q) * DM + 512 + h * 64 + dv] = f2bf(s); }
        __syncthreads();
    }
}
#ifndef EMU
#define XB_TMO      128
#define XB_XCNT(j)  (256  + 64 * (j))
#define XB_XSUB(j)  (1280 + 64 * (j))
#define XB_XGEN(j)  (2304 + 64 * (j))
#define XB_TOP      3328
#define XB_TOPGEN   3392
#define XCD_BAR_WORDS 3456
#define XB_SPIN_CAP (1u << 18)
#define LAS __attribute__((address_space(3)))
__device__ __forceinline__ unsigned xb_ld(unsigned* p)              { return __hip_atomic_load(p, __ATOMIC_RELAXED, __HIP_MEMORY_SCOPE_AGENT); }
__device__ __forceinline__ unsigned xb_add(unsigned* p, unsigned v) { return __hip_atomic_fetch_add(p, v, __ATOMIC_RELAXED, __HIP_MEMORY_SCOPE_AGENT); }
__device__ __forceinline__ unsigned xb_xcc_id() { return (unsigned)__builtin_amdgcn_s_getreg((3 << 11) | 20) & 0xFu; }
#define XB_SPIN(cond, bar) do { unsigned _sp = 0; while (cond) { __builtin_amdgcn_s_sleep(1); \
    if ((++_sp & 255u) == 0u) { if (xb_ld(&(bar)[XB_TMO])) break; if (_sp > XB_SPIN_CAP) { atomicAdd(&(bar)[XB_TMO], 1u); break; } } } } while (0)
struct XcdBarrier { unsigned* bar; unsigned x; volatile LAS unsigned* st; };
__device__ __forceinline__ XcdBarrier xcd_barrier_post(unsigned* bar, volatile LAS unsigned* st) {
    XcdBarrier b; b.bar = bar; b.x = xb_xcc_id(); b.st = st;
    if (threadIdx.x == 0) (void)xb_add(&bar[XB_XCNT(b.x)], 1u);
    return b;
}
__device__ __forceinline__ void xcd_barrier_complete(unsigned* bar, unsigned x, unsigned& nloc, unsigned& nx) {
    const unsigned G = gridDim.x * gridDim.y * gridDim.z;
    unsigned sum, cnt, mine, sp = 0u;
    for (;;) {
        sum = 0u; cnt = 0u; mine = 0u;
#pragma unroll
        for (unsigned j = 0; j < 16; ++j) { const unsigned c = xb_ld(&bar[XB_XCNT(j)]); sum += c; cnt += (c > 0u) ? 1u : 0u; mine = (j == x) ? c : mine; }
        if (sum == G) break;
        __builtin_amdgcn_s_sleep(1);
        if ((++sp & 255u) == 0u) { if (xb_ld(&bar[XB_TMO])) break; if (sp > XB_SPIN_CAP) { atomicAdd(&bar[XB_TMO], 1u); break; } }
    }
    nloc = mine > 0u ? mine : 1u; nx = cnt > 0u ? cnt : 1u;
}
__device__ __forceinline__ void xcd_barrier(const XcdBarrier& b) {
    asm volatile("s_waitcnt vmcnt(0)" ::: "memory");
    __syncthreads();
    if (threadIdx.x == 0) {
        unsigned* bar = b.bar;
        __builtin_amdgcn_s_waitcnt(0);
        unsigned nloc = b.st[0], nx = b.st[1];
        if (nloc == 0u) { xcd_barrier_complete(bar, b.x, nloc, nx); b.st[0] = nloc; b.st[1] = nx; }
        const unsigned old = xb_add(&bar[XB_XSUB(b.x)], 1u);
        const unsigned gen = old / nloc;
        if (old + 1u == (gen + 1u) * nloc) {
            __builtin_amdgcn_fence(__ATOMIC_RELEASE, "agent");
            asm volatile("s_waitcnt vmcnt(0)" ::: "memory");
            const unsigned og = xb_add(&bar[XB_TOP], 1u);
            const unsigned tg = og / nx;
            if (og + 1u == (tg + 1u) * nx) xb_add(&bar[XB_TOPGEN], 1u);
            else XB_SPIN(xb_ld(&bar[XB_TOPGEN]) == tg, bar);
            __builtin_amdgcn_fence(__ATOMIC_ACQUIRE, "agent");
            xb_add(&bar[XB_XGEN(b.x)], 1u);
            asm volatile("s_waitcnt vmcnt(0)" ::: "memory");
        } else {
            XB_SPIN(xb_ld(&bar[XB_XGEN(b.x)]) == gen, bar);
            __builtin_amdgcn_fence(__ATOMIC_ACQUIRE, "agent");
            asm volatile("s_waitcnt vmcnt(0)" ::: "memory");
        }
    }
    __syncthreads();
}
#endif

DI int wq_next(unsigned* ctr, LDS unsigned* slot) {
    __syncthreads();
    if (threadIdx.x == 0) *slot = atomicAdd(ctr, 1u);
    __syncthreads();
    return (int)*slot;
}
struct EpiResF32 {
    static constexpr bool PERM = false, AFTER_DRAIN = false;
    float* C; const float* R0; const float* R1; int split;
    DI void operator()(const f32x4 (&acc)[2][2][4][2], const pg8::Unit& u, int wr, int wc, int fr, int fq) const {
        const int row0 = u.pm * 256 + wr * 64 + fr, col0 = u.pn * 256 + wc * 32 + 4 * fq;
        const float* R = row0 < split ? R0 : R1 - (size_t)split * DM;
#pragma unroll
        for (int ai = 0; ai < 2; ++ai)
#pragma unroll
            for (int m = 0; m < 4; ++m) { const size_t off = (size_t)(row0 + ai * 128 + m * 16) * DM + col0;
#pragma unroll
                for (int bj = 0; bj < 2; ++bj)
#pragma unroll
                    for (int n = 0; n < 2; ++n) { const f32x4 v = acc[ai][bj][m][n] + *(const f32x4*)(R + off + bj * 128 + n * 16); *(f32x4*)(C + off + bj * 128 + n * 16) = v; } }
    }
};
DI void phase_norm_rows(const Params& p, const float* X, const float* g) {
    const int tid = tid_opaque(), wid = tid >> 6, lane = tid & 63;
    for (int row = blockIdx.x * 8 + wid; row < T; row += gridDim.x * 8) rmsnorm_row_1024(X + (size_t)row * DM, g, p.H + (size_t)row * DM, lane);
}
constexpr int NPHASE = 15;
template <int PH> DI void run_phase(const Params& p, LDS unsigned char* lds) {
    LDS unsigned* slot = (LDS unsigned*)(lds + LDS_CTL + 64);
    if constexpr (PH == 0) phase_prep(p, lds);
    else if constexpr (PH == 1) { run_gemm(lds, p.H, p.wt_in, T, DINP, DM, EpiStoreBf16<0>{p.Z, DINP}, 0); run_gemm(lds, p.MEMN, p.wt_xkv, MROWS, 1024, DM, EpiStoreF32{p.MKV, nullptr, 1024}, 100); }
    else if constexpr (PH == 2) phase_post_in(p);
    else if constexpr (PH == 3) { run_gemm(lds, p.QAN, p.wt_qb, T, 768, 384, EpiStoreBf16<0>{p.QF, 768}, 0); run_gemm(lds, p.CKVB, p.wt_kvb, T, 1024, 256, EpiStoreBf16<0>{p.KV, 1024}, 140); __syncthreads(); phase_gla_a(p, lds); }
    else if constexpr (PH == 4) { phase_post_qkv(p); phase_gla_b(p); }
    else if constexpr (PH == 5) {
        for (;;) { const int u = wq_next(p.ctl + CW_Q5, slot); if (u >= NU_SA) break; sattn_unit(p, lds, u); }
        for (;;) { const int u = wq_next(p.ctl + CW_Q5 + 64, slot); if (u >= NU_PA) break; pattn_unit(p, lds, u); }
        for (;;) { const int u = wq_next(p.ctl + CW_Q5 + 128, slot); if (u >= NGU) break; gla_c_unit(p, lds, u); } }
    else if constexpr (PH == 6) phase_sattn_combine(p, lds);
    else if constexpr (PH == 7) run_gemm(lds, p.OMIX, p.wt_out, T, DM, DM, EpiResF32{p.X1, p.xp, p.xs, TP}, 0);
    else if constexpr (PH == 8) phase_norm_rows(p, p.X1, p.g_x);
    else if constexpr (PH == 9) run_gemm(lds, p.H, p.wt_xq, T, 512, DM, EpiStoreBf16<0>{p.XQ, 512}, 0);
    else if constexpr (PH == 10) { for (;;) { const int u = wq_next(p.ctl + CW_QX, slot); if (u >= NU_XS + NU_XP) break; xattn_unit(p, lds, u < NU_XS ? NU_XP + u : u - NU_XS); } }
    else if constexpr (PH == 11) run_gemm(lds, p.XO, p.wt_xo, T, DM, 512, EpiResF32{p.X2, p.X1, p.X1, T}, 0);
    else if constexpr (PH == 12) phase_norm_rows(p, p.X2, p.g_ff);
    else if constexpr (PH == 13) run_gemm(lds, p.H, p.wt_ff1, T, DFF, DM, EpiStoreBf16<1>{p.U, DFF}, 0);
    else if constexpr (PH == 14) run_gemm(lds, p.U, p.wt_ff2, T, DM, DFF, EpiResF32{p.y, p.X2, p.X2, T}, 0);
}
#ifdef EMU
#define GET_LDS() ((LDS unsigned char*)EMU_SMEM())
#define GRID_BAR() emu_grid_barrier()
#else
#define GET_LDS() ((LDS unsigned char*)lds_raw)
#define GRID_BAR() xcd_barrier(bar)
#endif
template <int PH> __global__ void __launch_bounds__(NTHREADS, 2) k_phase(Params p) {
#ifndef EMU
    extern __shared__ __attribute__((aligned(16))) unsigned char lds_raw[];
#endif
    run_phase<PH>(p, GET_LDS());
}
#if N_LAUNCH_MODE == 1
__global__ void __launch_bounds__(NTHREADS, 2) k_mega(Params p) {
#ifndef EMU
    extern __shared__ __attribute__((aligned(16))) unsigned char lds_raw[];
    LDS unsigned char* lds = GET_LDS();
    if (threadIdx.x < 64) ((LDS unsigned*)(lds + LDS_CTL))[threadIdx.x] = 0u;
    __syncthreads();
    XcdBarrier bar = xcd_barrier_post(p.ctl + CW_BAR, (volatile LDS unsigned*)(lds + LDS_CTL));
#else
    LDS unsigned char* lds = GET_LDS();
#endif
    run_phase<0>(p, lds); GRID_BAR();
    run_phase<1>(p, lds); GRID_BAR();
    run_phase<2>(p, lds); GRID_BAR();
    run_phase<3>(p, lds); GRID_BAR();
    run_phase<4>(p, lds); GRID_BAR();
    run_phase<5>(p, lds); GRID_BAR();
    run_phase<6>(p, lds); GRID_BAR();
    run_phase<7>(p, lds); GRID_BAR();
    run_phase<8>(p, lds); GRID_BAR();
    run_phase<9>(p, lds); GRID_BAR();
    run_phase<10>(p, lds); GRID_BAR();
    run_phase<11>(p, lds); GRID_BAR();
    run_phase<12>(p, lds); GRID_BAR();
    run_phase<13>(p, lds); GRID_BAR();
    run_phase<14>(p, lds);
}
#endif

static size_t ws_take(size_t& off, size_t bytes) { const size_t o = off; off = (off + bytes + 255) & ~(size_t)255; return o; }
template <int PH> static void launch_phase(const Params& p, int grid, hipStream_t stream) {
#ifndef EMU
    static bool attr = false; if (!attr) { (void)hipFuncSetAttribute((const void*)k_phase<PH>, hipFuncAttributeMaxDynamicSharedMemorySize, LDS_BYTES); attr = true; }
#endif
    LAUNCH(k_phase<PH>, dim3(grid), dim3(NTHREADS), LDS_BYTES, stream, p);
}
extern "C" void kernel_launch(void* const* d_in, const int* in_sizes, int n_in, void* d_out, int out_size, void* d_ws, size_t ws_size, hipStream_t stream) {
    Params p{};
    const float* const* in = (const float* const*)d_in;
    p.xp = in[0]; p.xs = in[1]; p.memp = in[2]; p.cckv = in[3]; p.ckpe = in[4]; p.cmk = in[5]; p.cmv = in[6]; p.sgla = in[7]; p.ptab = (const int*)d_in[8];
    p.g_mix = in[9]; p.w_a2 = in[11]; p.b_a = in[12]; p.g_gla_o = in[13]; p.g_qa = in[14]; p.g_kva = in[16]; p.g_qn = in[18]; p.g_kn = in[19]; p.g_qr = in[20]; p.g_kr = in[21];
    p.g_x = in[23]; p.g_mem = in[24]; p.g_xq = in[28]; p.g_xk = in[29]; p.g_ff = in[31];
    float* out = (float*)d_out; size_t oo = 0;
    p.y = out; oo += (size_t)T * DM; p.o_ckvp = out + oo; oo += (size_t)TP * 256; p.o_kpep = out + oo; oo += (size_t)TP * 32; p.o_mkp = out + oo; oo += (size_t)MROWS * 512; p.o_mvp = out + oo; oo += (size_t)MROWS * 512;
    p.o_glap = out + oo; oo += (size_t)BATCH * 4 * 8192; p.o_ckvs = out + oo; oo += (size_t)TS * 256; p.o_kpes = out + oo; oo += (size_t)TS * 32; p.o_glas = out + oo; oo += (size_t)DECB * 4 * 8192;
    if ((size_t)out_size != oo || n_in != 34) { fprintf(stderr, "kernel_launch: unexpected sizes (out %d vs %zu, n_in %d)\n", out_size, oo, n_in); }
    unsigned char* ws = (unsigned char*)d_ws; size_t off = 0;
    p.ctl = (unsigned*)(ws + ws_take(off, 1 << 20));
#define WSB(name, elems) p.name = (bf16*)(ws + ws_take(off, (size_t)(elems) * 2))
#define WSF(name, elems) p.name = (float*)(ws + ws_take(off, (size_t)(elems) * 4))
    WSB(wt_in, (size_t)DINP * DM); WSB(wt_qb, 768 * 384); WSB(wt_kvb, 1024 * 256); WSB(wt_out, DM * DM); WSB(wt_xq, 512 * DM); WSB(wt_xkv, 1024 * DM); WSB(wt_xo, DM * 512); WSB(wt_ff1, (size_t)DFF * DM); WSB(wt_ff2, (size_t)DM * DFF);
    WSB(H, (size_t)T * DM); WSB(MEMN, (size_t)MROWS * DM); WSB(Z, (size_t)T * DINP); WSB(QAN, (size_t)T * 384); WSB(CKVB, (size_t)T * 256); WSB(KPB, (size_t)T * 32); WSB(MKB, (size_t)MROWS * 512); WSB(MVB, (size_t)MROWS * 512);
    WSB(QF, (size_t)T * 768); WSB(KV, (size_t)T * 1024); WSB(QN, (size_t)T * 768); WSB(KN, (size_t)T * 512); WSB(OMIX, (size_t)T * DM); WSB(XQ, (size_t)T * 512); WSB(XO, (size_t)T * 512); WSB(U, (size_t)T * DFF);
    WSF(MKV, (size_t)MROWS * 1024); WSF(LOGA, (size_t)T * 256); WSF(DS, (size_t)NGU * 8192); WSF(DDEC, (size_t)NGU * 64); WSF(X1, (size_t)T * DM); WSF(X2, (size_t)T * DM); WSF(PACC, (size_t)NU_SA * 64 * 256); WSF(PML, (size_t)NU_SA * 128);
    if (off > ws_size) { fprintf(stderr, "kernel_launch: workspace too small (%zu > %zu)\n", off, ws_size); return; }
    p.w_in = in[10]; p.w_qb = in[15]; p.w_kvb = in[17]; p.w_out = in[22]; p.w_xq = in[25]; p.w_xk = in[26]; p.w_xv = in[27]; p.w_xo = in[30]; p.w_ff1 = in[32]; p.w_ff2 = in[33];
    (void)hipMemsetAsync(p.ctl, 0, 1 << 20, stream);
#ifdef EMU
    const int grid = EMU_GRID;
#else
    static int grid = 0;
    if (!grid) { int dev = 0, cus = 0; (void)hipGetDevice(&dev); (void)hipDeviceGetAttribute(&cus, hipDeviceAttributeMultiprocessorCount, dev); grid = cus > 0 ? cus : 256;
#if N_LAUNCH_MODE == 1
        (void)hipFuncSetAttribute((const void*)k_mega, hipFuncAttributeMaxDynamicSharedMemorySize, LDS_BYTES);
        int per_cu = 0; if (hipOccupancyMaxActiveBlocksPerMultiprocessor(&per_cu, (const void*)k_mega, NTHREADS, LDS_BYTES) != hipSuccess || per_cu < 1) fprintf(stderr, "kernel_launch: occupancy query reports %d workgroups per CU\n", per_cu);
#endif
    }
#endif
#if N_LAUNCH_MODE == 1
    LAUNCH(k_mega, dim3(grid), dim3(NTHREADS), LDS_BYTES, stream, p);
#else
    launch_phase<0>(p, grid, stream); launch_phase<1>(p, grid, stream); launch_phase<2>(p, grid, stream); launch_phase<3>(p, grid, stream); launch_phase<4>(p, grid, stream);
    launch_phase<5>(p, grid, stream); launch_phase<6>(p, grid, stream); launch_phase<7>(p, grid, stream); launch_phase<8>(p, grid, stream); launch_phase<9>(p, grid, stream);
    launch_phase<10>(p, grid, stream); launch_phase<11>(p, grid, stream); launch_phase<12>(p, grid, stream); launch_phase<13>(p, grid, stream); launch_phase<14>(p, grid, stream);
#endif
}
```

```cpp
#ifdef EMU
#include "emu.h"
#define LDS
#else
#include <hip/hip_runtime.h>
#define LDS __attribute__((address_space(3)))
#define LAUNCH(kern, grid, block, smem, stream, ...) kern<<<grid, block, smem, stream>>>(__VA_ARGS__)
#endif
#include <cstdio>
#include <cstdint>
#include <cmath>
#define DI __device__ __forceinline__

#ifndef CFG_BATCH
#define CFG_BATCH 16
#define CFG_SEQ 2048
#define CFG_DECB 128
#define CFG_PAST 8192
#endif
#ifndef DUPM
#define DUPM 0
#endif
#ifndef N_LAUNCH_MODE
#define N_LAUNCH_MODE 1
#endif

typedef unsigned short bf16;
typedef short bf16x8 __attribute__((ext_vector_type(8)));
typedef short s16x4 __attribute__((ext_vector_type(4)));
typedef float f32x4 __attribute__((ext_vector_type(4)));
typedef float f32x16 __attribute__((ext_vector_type(16)));
typedef unsigned u32x4 __attribute__((ext_vector_type(4)));
typedef unsigned u32x2 __attribute__((ext_vector_type(2)));

constexpr int DM = 1024, BATCH = CFG_BATCH, SEQ = CFG_SEQ, DECB = CFG_DECB, DECS = 8, PAST = CFG_PAST, PAGE = 128, NPAGES = PAST / PAGE;
constexpr int NMEM = 256, TP = BATCH * SEQ, TS = DECB * DECS, T = TP + TS, MROWS = BATCH * NMEM;
constexpr int DIN = 2224, DINP = 2304, DFF = 4096;
constexpr int ZQ = 0, ZK = 256, ZV = 512, ZR = 1024, ZA = 1536, ZQA = 1552, ZKVA = 1936, ZKPE = 2192;
constexpr float EPS = 1e-6f, MLA_SCALE = 0.10206207261596577f  , X_SCALE = 0.08838834764831845f  ;
constexpr int NC = SEQ / 64;
constexpr int NGP = BATCH * 4 * NC, NGS = DECB * 4, NGU = NGP + NGS;
constexpr int NSPLIT = NPAGES >= 8 ? 8 : NPAGES, PPS = NPAGES / NSPLIT;
constexpr int NU_SA = DECB * NSPLIT, NQB = SEQ / 256, NU_PA = BATCH * 8 * NQB;
constexpr int NU_XP = BATCH * 4 * NQB, NU_XS = DECB * 4;
static_assert(T % 256 == 0 && MROWS % 256 == 0 && SEQ % 256 == 0 && NPAGES % NSPLIT == 0, "shape assumptions");
constexpr int NTHREADS = 512, LDS_BYTES = 147456, LDS_CTL = LDS_BYTES - 256;

DI int tid_opaque() {
    int t = threadIdx.x;
#ifndef EMU
    asm volatile("" : "+v"(t));
#endif
    return t;
}
DI float bf2f(bf16 b) { return __uint_as_float(((unsigned)b) << 16); }
DI bf16 f2bf(float x) {
#ifdef EMU
    unsigned u = __float_as_uint(x); u += 0x7fffu + ((u >> 16) & 1u); return (bf16)(u >> 16);
#else
    return __builtin_bit_cast(unsigned short, (__bf16)x);
#endif
}
DI unsigned pk2(float a, float b) { return (unsigned)f2bf(a) | ((unsigned)f2bf(b) << 16); }
DI f32x16 zero16() { f32x16 z; for (int i = 0; i < 16; ++i) z[i] = 0.f; return z; }
DI f32x16 mfma32(bf16x8 a, bf16x8 b, f32x16 c) { return __builtin_amdgcn_mfma_f32_32x32x16_bf16(a, b, c, 0, 0, 0); }
DI int crow(int i, int h) { return (i & 3) + 8 * (i >> 2) + 4 * h; }
DI bf16x8 ld8(const LDS bf16* p) { return *(const LDS bf16x8*)p; }
DI bf16x8 ld8g(const bf16* p) { return *(const bf16x8*)p; }
DI bf16x8 ldperm(const LDS bf16* p16, int h) {
    const s16x4 lo = *(const LDS s16x4*)(p16 + 4 * h), hi = *(const LDS s16x4*)(p16 + 8 + 4 * h);
    return __builtin_shufflevector(lo, hi, 0, 1, 2, 3, 4, 5, 6, 7);
}
DI bf16x8 ldpermg(const bf16* p16, int h) {
    const s16x4 lo = *(const s16x4*)(p16 + 4 * h), hi = *(const s16x4*)(p16 + 8 + 4 * h);
    return __builtin_shufflevector(lo, hi, 0, 1, 2, 3, 4, 5, 6, 7);
}
DI bf16x8 pack8(float a0, float a1, float a2, float a3, float a4, float a5, float a6, float a7) {
    u32x4 p; p[0] = pk2(a0, a1); p[1] = pk2(a2, a3); p[2] = pk2(a4, a5); p[3] = pk2(a6, a7); return __builtin_bit_cast(bf16x8, p);
}
#define PACK(x, s) pack8((x)[8 * (s)], (x)[8 * (s) + 1], (x)[8 * (s) + 2], (x)[8 * (s) + 3], (x)[8 * (s) + 4], (x)[8 * (s) + 5], (x)[8 * (s) + 6], (x)[8 * (s) + 7])
DI float wsum(float v) { for (int o = 32; o >= 1; o >>= 1) v += __shfl_xor(v, o); return v; }
DI bf16x8 zero8() { bf16x8 z; for (int i = 0; i < 8; ++i) z[i] = 0; return z; }

DI unsigned imgb(unsigned row, unsigned ch) { return 256u * row + 16u * (ch ^ (((row & 3u) << 2) | ((row >> 2) & 3u))); }
DI bf16x8 img_row(const LDS unsigned char* img, unsigned row, unsigned s, unsigned hh) { return *(const LDS bf16x8*)(img + imgb(row, 2 * s + hh)); }
DI s16x4 tr16(const LDS unsigned char* a) {
#ifdef EMU
    return emu_tr16_b64(a);
#else
    return __builtin_amdgcn_ds_read_tr16_b64_v4i16((LDS s16x4*)a);
#endif
}
template <bool PERM> DI bf16x8 img_tr(const LDS unsigned char* img, unsigned lane, unsigned c, unsigned k16) {
    const unsigned hh = lane >> 5, blk = (lane >> 4) & 1, q = (lane & 15) >> 2, pp = lane & 3;
    const unsigned r0 = k16 + (PERM ? 4 * hh : 8 * hh) + q, r1 = r0 + (PERM ? 8 : 4), ch = 4 * c + 2 * blk + (pp >> 1);
    const LDS unsigned char* a0 = img + imgb(r0, ch) + 8 * (pp & 1); const LDS unsigned char* a1 = img + imgb(r1, ch) + 8 * (pp & 1);
#ifdef EMU
    const s16x4 lo = emu_tr16_b64(a0), hi = emu_tr16_b64(a1);
#else
    s16x4 lo, hi;
    asm volatile("ds_read_b64_tr_b16 %0, %2\n\tds_read_b64_tr_b16 %1, %3\n\ts_waitcnt lgkmcnt(0)" : "=&v"(lo), "=&v"(hi) : "v"((unsigned)(size_t)a0), "v"((unsigned)(size_t)a1) : "memory");
#endif
    return __builtin_shufflevector(lo, hi, 0, 1, 2, 3, 4, 5, 6, 7);
}
DI void dma16(const void* g, LDS unsigned char* l) {
#ifdef EMU
    emu_dma16(g, l);
#else
    __builtin_amdgcn_global_load_lds((const unsigned*)g, (LDS unsigned*)l, 16, 0, 0);
#endif
}
#ifdef EMU
#define SCHED_FENCE() do {} while (0)
#else
#define SCHED_FENCE() __builtin_amdgcn_sched_barrier(0)
#endif
DI int rdlane(int v, int l) {
#ifdef EMU
    return __shfl(v, l);
#else
    return __builtin_amdgcn_readlane(v, l);
#endif
}
DI void wait_vm0() {
#ifndef EMU
    asm volatile("s_waitcnt vmcnt(0)" ::: "memory");
#endif
}
DI void bar_lds() {
#ifdef EMU
    __syncthreads();
#else
    asm volatile("s_waitcnt lgkmcnt(0)" ::: "memory"); __builtin_amdgcn_s_barrier(); asm volatile("" ::: "memory");
#endif
}

namespace pg8 {
#define PG8_LAS LDS
typedef unsigned short bf16_t;
constexpr int BM = 256, BK = 64, HALF = 128, HTB = HALF * BK * 2  , STAGE_BYTES = 8 * HTB, NXCD = 8, WGM = 8;
__host__ __device__ __forceinline__ int lds_byte(int r, int c) { const int st = (r >> 4) * 2 + (c >> 5), rr = r & 15, cc = c & 31, ob = rr * 64 + cc * 2; return st * 1024 + (ob ^ (((ob >> 9) & 1) << 5)); }
__host__ __device__ __forceinline__ void stage_rc(int b, int& R, int& C) { const int st = b / 1024, sb = b % 1024, swz = sb ^ (((sb >> 9) & 1) << 5); R = (st >> 1) * 16 + swz / 64; C = (st & 1) * 32 + (swz % 64) / 2; }
__host__ __device__ __forceinline__ int perm32(int rho) { const int n = rho >> 4, i = rho & 15; return 8 * (i >> 2) + 4 * n + (i & 3); }
struct Unit { int pm, pn; };
struct Gemm { const bf16_t* A; const bf16_t* Bt; int M, N, K; };
struct StaticOrder {
    int nM, nN, nwg, G, c;
    __host__ __device__ void init(int M, int N, int G_, int c_) { nM = M / BM; nN = N / BM; nwg = nM * nN; G = G_; c = c_; }
    __host__ __device__ bool next(int i, Unit& u) const {
        const long L = (long)i * G + c; if (L >= nwg) return false;
        int wgid = (int)L; { const int q = nwg / NXCD, r = nwg % NXCD, xcd = wgid % NXCD, off = wgid / NXCD; wgid = (xcd < r ? xcd * (q + 1) : r * (q + 1) + (xcd - r) * q) + off; }
        const int nig = WGM * nN, gid = wgid / nig, fm = gid * WGM, gsz = (nM - fm) < WGM ? (nM - fm) : WGM;
        u.pm = fm + ((wgid % nig) % gsz); u.pn = (wgid % nig) / gsz; return true;
    }
    __device__ __forceinline__ void a_ready(const Unit&) const {}
    __device__ __forceinline__ void done(const Unit&) const {}
};
#ifdef EMU
template <class Epi, class Sched>
__device__ __forceinline__ void gemm_phase(PG8_LAS unsigned char* lds, const Gemm g, const Sched& S, const Epi& E) {
    const int tid = tid_opaque(), wid = __builtin_amdgcn_readfirstlane(tid >> 6), lane = tid & 63, wr = wid >> 2, wc = wid & 3, fr = lane & 15, fq = lane >> 4;
    Unit cur;
    for (int ui = 0; S.next(ui, cur); ++ui) {
        f32x4 acc[2][2][4][2];
        for (int ai = 0; ai < 2; ++ai) for (int bj = 0; bj < 2; ++bj) for (int m = 0; m < 4; ++m) for (int n = 0; n < 2; ++n) for (int j = 0; j < 4; ++j) {
            const int row = 256 * cur.pm + 128 * ai + 64 * wr + 16 * m + fr;
            const int col = Epi::PERM ? 256 * cur.pn + 128 * bj + 32 * wc + 8 * fq + 4 * n + j : 256 * cur.pn + 128 * bj + 32 * wc + 16 * n + 4 * fq + j;
            const bf16_t* a = g.A + (size_t)row * g.K; const bf16_t* b = g.Bt + (size_t)col * g.K; float s = 0.f;
            for (int k = 0; k < g.K; ++k) s += bf2f(a[k]) * bf2f(b[k]);
            acc[ai][bj][m][n][j] = s;
        }
        E(acc, cur, wr, wc, fr, fq);
    }
}
#else
template <class Epi, class Sched>
__device__ __forceinline__ void gemm_phase(PG8_LAS unsigned char* lds, const Gemm g, const Sched& S, const Epi& E) {
    const int tid = tid_opaque(), wid = __builtin_amdgcn_readfirstlane(tid >> 6), lane = tid & 63, wr = wid >> 2, wc = wid & 3, fr = lane & 15, fq = lane >> 4;
    const int K = g.K, nt = K / BK;
    unsigned voffA[2], voffB[2];
#pragma unroll
    for (int i = 0; i < 2; ++i) { int R, C; stage_rc(tid * 16 + i * 8192, R, C); const int Rb = Epi::PERM ? ((R & ~31) + perm32(R & 31)) : R;
        voffA[i] = (unsigned)(R * K + C) * 2u; voffB[i] = (unsigned)(Rb * K + C) * 2u; }
    const size_t kstep = (size_t)(BK * 2);
    const size_t hstep = (size_t)HALF * K * 2;
    const size_t tstep = 2 * hstep;
    const unsigned ldsw = (unsigned)wid * 1024u;
    const int aoff = lds_byte(wr * 64 + fr, fq * 8), boff = lds_byte(wc * 32 + fr, fq * 8);
#define PG8_SA(b, h) (((b) * 2 + (h)) * HTB)
#define PG8_SB(b, h) ((4 + (b) * 2 + (h)) * HTB)
#define PG8_STAGE(bufoff, gbase, voff) do { _Pragma("unroll") for (int _i = 0; _i < 2; ++_i) \
        __builtin_amdgcn_global_load_lds((const unsigned*)((const char*)(gbase) + (voff)[_i]), (PG8_LAS unsigned*)(lds + (bufoff) + ldsw + _i * 8192), 16, 0, 0); } while (0)
#define PG8_LDA(dst, b, h) do { _Pragma("unroll") for (int m = 0; m < 4; ++m) _Pragma("unroll") for (int k = 0; k < 2; ++k) dst[m][k] = *(const PG8_LAS bf16x8*)(lds + PG8_SA(b, h) + aoff + m * 2048 + k * 1024); } while (0)
#define PG8_LDB(dst, b, h) do { _Pragma("unroll") for (int n = 0; n < 2; ++n) _Pragma("unroll") for (int k = 0; k < 2; ++k) dst[n][k] = *(const PG8_LAS bf16x8*)(lds + PG8_SB(b, h) + boff + n * 2048 + k * 1024); } while (0)
#define PG8_MMA(ai, bj, At, Bt) do { __builtin_amdgcn_s_setprio(1); _Pragma("unroll") for (int m = 0; m < 4; ++m) _Pragma("unroll") for (int n = 0; n < 2; ++n) _Pragma("unroll") for (int k = 0; k < 2; ++k) \
        acc[ai][bj][m][n] = __builtin_amdgcn_mfma_f32_16x16x32_bf16(Bt[n][k], At[m][k], acc[ai][bj][m][n], 0, 0, 0); __builtin_amdgcn_s_setprio(0); } while (0)
#define PG8_WAIT_V(n) asm volatile("s_waitcnt vmcnt(" #n ")" ::: "memory")
#define PG8_WAIT_L(n) asm volatile("s_waitcnt lgkmcnt(" #n ")" ::: "memory")
#define PG8_BAR __builtin_amdgcn_s_barrier()
#define PG8_SCHED __builtin_amdgcn_sched_barrier(0)
    Unit cur, nxt; int ui = 0;
    if (!S.next(0, cur)) return;
    f32x4 acc[2][2][4][2];
#pragma unroll
    for (int a = 0; a < 2; ++a)
#pragma unroll
        for (int b = 0; b < 2; ++b)
#pragma unroll
            for (int m = 0; m < 4; ++m)
#pragma unroll
                for (int n = 0; n < 2; ++n) acc[a][b][m][n] = (f32x4){0.f, 0.f, 0.f, 0.f};
    bf16x8 At[4][2], B0[2][2], B1[2][2];
    const char* cA = (const char*)g.A + (size_t)cur.pm * tstep; const char* cB = (const char*)g.Bt + (size_t)cur.pn * tstep;
    S.a_ready(cur);
    PG8_STAGE(PG8_SB(0, 0), cB, voffB); PG8_STAGE(PG8_SA(0, 0), cA, voffA); PG8_STAGE(PG8_SB(0, 1), cB + hstep, voffB); PG8_STAGE(PG8_SA(0, 1), cA + hstep, voffA);
    if (wr == 1) PG8_BAR;
    PG8_WAIT_V(4); PG8_BAR;
    PG8_STAGE(PG8_SB(1, 0), cB + kstep, voffB); PG8_STAGE(PG8_SA(1, 0), cA + kstep, voffA); PG8_STAGE(PG8_SB(1, 1), cB + hstep + kstep, voffB);
    PG8_WAIT_V(6); PG8_BAR;
    for (;;) {
        const bool has_next = S.next(ui + 1, nxt);
        const char* nA = has_next ? (const char*)g.A + (size_t)nxt.pm * tstep : cA; const char* nB = has_next ? (const char*)g.Bt + (size_t)nxt.pn * tstep : cB;
        for (int t = 0; t < nt; t += 2) {
            const bool last = (t == nt - 2);
            const char* a1 = cA + (size_t)(t + 1) * kstep;
            const char* a2 = last ? nA : cA + (size_t)(t + 2) * kstep; const char* b2 = last ? nB : cB + (size_t)(t + 2) * kstep;
            const char* a3 = a2 + kstep; const char* b3 = b2 + kstep;
            if (last && has_next) S.a_ready(nxt);
            PG8_LDB(B0, 0, 0); PG8_SCHED; PG8_LDA(At, 0, 0); PG8_STAGE(PG8_SA(1, 1), a1 + hstep, voffA);
            PG8_WAIT_L(8); PG8_BAR; PG8_WAIT_L(0); PG8_MMA(0, 0, At, B0); PG8_BAR; PG8_SCHED;
            PG8_LDB(B1, 0, 1); PG8_STAGE(PG8_SB(0, 0), b2, voffB);
            PG8_BAR; PG8_WAIT_L(0); PG8_MMA(0, 1, At, B1); PG8_BAR;
            PG8_LDA(At, 0, 1); PG8_STAGE(PG8_SA(0, 0), a2, voffA);
            PG8_BAR; PG8_WAIT_L(0); PG8_MMA(1, 0, At, B0); PG8_BAR; PG8_SCHED;
            PG8_STAGE(PG8_SB(0, 1), b2 + hstep, voffB);
            PG8_WAIT_V(6); PG8_BAR; PG8_MMA(1, 1, At, B1); PG8_BAR;
            PG8_LDB(B0, 1, 0); PG8_SCHED; PG8_LDA(At, 1, 0); PG8_STAGE(PG8_SA(0, 1), a2 + hstep, voffA);
            PG8_WAIT_L(8); PG8_BAR; PG8_WAIT_L(0); PG8_MMA(0, 0, At, B0); PG8_BAR; PG8_SCHED;
            PG8_LDB(B1, 1, 1); PG8_STAGE(PG8_SB(1, 0), b3, voffB);
            PG8_BAR; PG8_WAIT_L(0); PG8_MMA(0, 1, At, B1); PG8_BAR;
            PG8_LDA(At, 1, 1); PG8_STAGE(PG8_SA(1, 0), a3, voffA);
            PG8_BAR; PG8_WAIT_L(0); PG8_MMA(1, 0, At, B0); PG8_BAR; PG8_SCHED;
            PG8_STAGE(PG8_SB(1, 1), b3 + hstep, voffB);
            PG8_WAIT_V(6); PG8_BAR; PG8_MMA(1, 1, At, B1); PG8_BAR;
        }
        if constexpr (!Epi::AFTER_DRAIN) { E(acc, cur, wr, wc, fr, fq); S.done(cur); }
        if (!has_next) break;
#pragma unroll
        for (int a = 0; a < 2; ++a)
#pragma unroll
            for (int b = 0; b < 2; ++b)
#pragma unroll
                for (int m = 0; m < 4; ++m)
#pragma unroll
                    for (int n = 0; n < 2; ++n) acc[a][b][m][n] = (f32x4){0.f, 0.f, 0.f, 0.f};
        cur = nxt; cA = nA; cB = nB; ++ui;
    }
    PG8_WAIT_V(0);
    if (wr == 0) PG8_BAR;
    PG8_BAR;
    if constexpr (Epi::AFTER_DRAIN) { E.fused(acc, cur, wr, wc, fr, fq, lds, wid, lane); S.done(cur); }
#undef PG8_SA
#undef PG8_SB
#undef PG8_STAGE
#undef PG8_LDA
#undef PG8_LDB
#undef PG8_MMA
#undef PG8_WAIT_V
#undef PG8_WAIT_L
#undef PG8_BAR
#undef PG8_SCHED
}
#endif
}

struct Params {
    const float *xp, *xs, *memp, *cckv, *ckpe, *cmk, *cmv, *sgla; const int* ptab;
    const float *g_mix, *w_a2, *b_a, *g_gla_o, *g_qa, *g_kva, *g_qn, *g_kn, *g_qr, *g_kr, *g_x, *g_mem, *g_xq, *g_xk, *g_ff;
    float *y, *o_ckvp, *o_kpep, *o_mkp, *o_mvp, *o_glap, *o_ckvs, *o_kpes, *o_glas;
    unsigned* ctl;
    bf16 *wt_in, *wt_qb, *wt_kvb, *wt_out, *wt_xq, *wt_xkv, *wt_xo, *wt_ff1, *wt_ff2;
    bf16 *H, *MEMN, *Z, *QAN, *CKVB, *KPB, *MKB, *MVB, *QF, *KV, *QN, *KN, *OMIX, *XQ, *XO, *U;
    float *MKV, *LOGA, *DS, *DDEC, *X1, *X2, *PACC, *PML;
    const float *w_in, *w_qb, *w_kvb, *w_out, *w_xq, *w_xk, *w_xv, *w_xo, *w_ff1, *w_ff2;
};
constexpr int CW_Q5 = 0, CW_QX = 512, CW_BAR = 4096;

template <int ACT  > struct EpiStoreBf16 {
    static constexpr bool PERM = true, AFTER_DRAIN = false;
    bf16* O; int ldc;
    DI void operator()(const f32x4 (&acc)[2][2][4][2], const pg8::Unit& u, int wr, int wc, int fr, int fq) const {
        const int row0 = u.pm * 256 + wr * 64 + fr, col0 = u.pn * 256 + wc * 32 + 8 * fq;
#pragma unroll
        for (int ai = 0; ai < 2; ++ai)
#pragma unroll
            for (int m = 0; m < 4; ++m) { bf16* rowp = O + (size_t)(row0 + ai * 128 + m * 16) * ldc + col0;
#pragma unroll
                for (int bj = 0; bj < 2; ++bj) { f32x4 v0 = acc[ai][bj][m][0], v1 = acc[ai][bj][m][1];
                    if (ACT == 1) {
#pragma unroll
                        for (int j = 0; j < 4; ++j) { const float a = fmaxf(v0[j], 0.f), b = fmaxf(v1[j], 0.f); v0[j] = a * a; v1[j] = b * b; } }
                    u32x4 w; w[0] = pk2(v0[0], v0[1]); w[1] = pk2(v0[2], v0[3]); w[2] = pk2(v1[0], v1[1]); w[3] = pk2(v1[2], v1[3]);
                    *(u32x4*)(rowp + bj * 128) = w; } }
    }
};
struct EpiStoreF32 {
    static constexpr bool PERM = false, AFTER_DRAIN = false;
    float* C; const float* R; int ldc;
    DI void operator()(const f32x4 (&acc)[2][2][4][2], const pg8::Unit& u, int wr, int wc, int fr, int fq) const {
        const int row0 = u.pm * 256 + wr * 64 + fr, col0 = u.pn * 256 + wc * 32 + 4 * fq;
#pragma unroll
        for (int ai = 0; ai < 2; ++ai)
#pragma unroll
            for (int m = 0; m < 4; ++m) { const size_t off = (size_t)(row0 + ai * 128 + m * 16) * ldc + col0;
#pragma unroll
                for (int bj = 0; bj < 2; ++bj)
#pragma unroll
                    for (int n = 0; n < 2; ++n) { f32x4 v = acc[ai][bj][m][n]; if (R) v += *(const f32x4*)(R + off + bj * 128 + n * 16); *(f32x4*)(C + off + bj * 128 + n * 16) = v; } }
    }
};
template <class Epi> DI void run_gemm(LDS unsigned char* lds, const bf16* A, const bf16* Bt, int M, int N, int K, const Epi& E, int rot) {
    pg8::Gemm g{A, Bt, M, N, K}; pg8::StaticOrder S; S.init(M, N, (int)gridDim.x, (int)((blockIdx.x + rot) % gridDim.x));
    pg8::gemm_phase<Epi, pg8::StaticOrder>(lds, g, S, E);
}

DI const float* xrow(const Params& p, int t) { return t < TP ? p.xp + (size_t)t * DM : p.xs + (size_t)(t - TP) * DM; }
DI void rmsnorm_row_1024(const float* src, const float* g, bf16* dst, int lane) {
    f32x4 v[4]; float ss = 0.f;
#pragma unroll
    for (int i = 0; i < 4; ++i) { v[i] = *(const f32x4*)(src + 4 * (lane + 64 * i)); ss += v[i][0] * v[i][0] + v[i][1] * v[i][1] + v[i][2] * v[i][2] + v[i][3] * v[i][3]; }
    ss = wsum(ss); const float rs = rsqrtf(ss * (1.0f / 1024.0f) + EPS);
#pragma unroll
    for (int i = 0; i < 4; ++i) { const f32x4 gg = *(const f32x4*)(g + 4 * (lane + 64 * i)); u32x2 w; w[0] = pk2(v[i][0] * rs * gg[0], v[i][1] * rs * gg[1]); w[1] = pk2(v[i][2] * rs * gg[2], v[i][3] * rs * gg[3]);
        *(u32x2*)(dst + 4 * (lane + 64 * i)) = w; }
}
template <int K, int N, int NPAD> DI void prep_job(const float* W, bf16* Wt, LDS float* tl, int rot) {
    const int tid = tid_opaque(); constexpr int nkt = K / 64, ntiles = (NPAD / 64) * nkt;
    for (int tile = (int)((blockIdx.x + rot) % gridDim.x); tile < ntiles; tile += gridDim.x) {
        const int tn = tile / nkt, tk = tile % nkt;
        { const int kk = tid >> 3, n8 = (tid & 7) * 8; const int n = tn * 64 + n8; const float* s = W + (size_t)(tk * 64 + kk) * N + n;
            f32x4 a = {0.f, 0.f, 0.f, 0.f}, b = a; if (n < N) { a = *(const f32x4*)s; b = *(const f32x4*)(s + 4); }
#pragma unroll
            for (int q = 0; q < 4; ++q) { tl[kk * 65 + n8 + q] = a[q]; tl[kk * 65 + n8 + 4 + q] = b[q]; } }
        __syncthreads();
        { const int nn = tid >> 3, k8 = (tid & 7) * 8; u32x4 w;
#pragma unroll
            for (int q = 0; q < 4; ++q) w[q] = pk2(tl[(k8 + 2 * q) * 65 + nn], tl[(k8 + 2 * q + 1) * 65 + nn]);
            *(u32x4*)(Wt + (size_t)(tn * 64 + nn) * K + tk * 64 + k8) = w; }
        __syncthreads();
    }
}
DI void phase_prep(const Params& p, LDS unsigned char* lds) {
    const int tid = tid_opaque(), wid = __builtin_amdgcn_readfirstlane(tid >> 6), lane = tid & 63;
    LDS float* tl = (LDS float*)lds;
    prep_job<DM, DIN, DINP>(p.w_in, p.wt_in, tl, 0); prep_job<384, 768, 768>(p.w_qb, p.wt_qb, tl, 64); prep_job<256, 1024, 1024>(p.w_kvb, p.wt_kvb, tl, 136); prep_job<DM, DM, DM>(p.w_out, p.wt_out, tl, 200);
    prep_job<DM, 512, 512>(p.w_xq, p.wt_xq, tl, 0); prep_job<DM, 512, 512>(p.w_xk, p.wt_xkv, tl, 128); prep_job<DM, 512, 512>(p.w_xv, p.wt_xkv + (size_t)512 * DM, tl, 0); prep_job<512, DM, DM>(p.w_xo, p.wt_xo, tl, 128);
    prep_job<DM, DFF, DFF>(p.w_ff1, p.wt_ff1, tl, 0); prep_job<DFF, DM, DM>(p.w_ff2, p.wt_ff2, tl, 0);
    for (int row = blockIdx.x * 8 + wid; row < T + MROWS; row += gridDim.x * 8) {
        if (row < T) rmsnorm_row_1024(xrow(p, row), p.g_mix, p.H + (size_t)row * DM, lane);
        else rmsnorm_row_1024(p.memp + (size_t)(row - T) * DM, p.g_mem, p.MEMN + (size_t)(row - T) * DM, lane);
    }
}

DI float rope32(float xn, int lane, int pos) {
    const float partner = __shfl_xor(xn, 16);
    const int i = lane & 15; const float inv = expf(-(float)i * (9.210340371976184f / 16.0f)); const float ang = (float)pos * inv;
    const float c = cosf(ang), s = sinf(ang);
    return (lane & 16) ? xn * c + partner * s : xn * c - partner * s;
}
DI int row_pos(int t) { return t < TP ? (t % SEQ) : PAST + ((t - TP) % DECS); }

DI void phase_post_in(const Params& p) {
    const int tid = tid_opaque(), wid = __builtin_amdgcn_readfirstlane(tid >> 6), lane = tid & 63;
    for (int row = blockIdx.x * 8 + wid; row < T + MROWS; row += gridDim.x * 8) {
        if (row < T) {
            const int t = row; const bf16* z = p.Z + (size_t)t * DINP;
            float a[16];
#pragma unroll
            for (int i = 0; i < 16; ++i) a[i] = bf2f(z[ZA + i]);
#pragma unroll
            for (int q = 0; q < 4; ++q) { const int c = lane + 64 * q; float gp = p.b_a[c];
#pragma unroll
                for (int i = 0; i < 16; ++i) gp += a[i] * p.w_a2[i * 256 + c];
                const float ls = fminf(gp, 0.f) - log1pf(expf(-fabsf(gp)));
                p.LOGA[(size_t)t * 256 + c] = ls * (1.0f / 16.0f); }
            { float v[6]; float ss = 0.f;
#pragma unroll
                for (int q = 0; q < 6; ++q) { v[q] = bf2f(z[ZQA + lane + 64 * q]); ss += v[q] * v[q]; }
                ss = wsum(ss); const float rs = rsqrtf(ss * (1.0f / 384.0f) + EPS);
#pragma unroll
                for (int q = 0; q < 6; ++q) p.QAN[(size_t)t * 384 + lane + 64 * q] = f2bf(v[q] * rs * p.g_qa[lane + 64 * q]); }
            { float v[4]; float ss = 0.f;
#pragma unroll
                for (int q = 0; q < 4; ++q) { v[q] = bf2f(z[ZKVA + lane + 64 * q]); ss += v[q] * v[q]; }
                ss = wsum(ss); const float rs = rsqrtf(ss * (1.0f / 256.0f) + EPS);
                float* oc = t < TP ? p.o_ckvp + (size_t)t * 256 : p.o_ckvs + (size_t)(t - TP) * 256;
#pragma unroll
                for (int q = 0; q < 4; ++q) { const float c = v[q] * rs * p.g_kva[lane + 64 * q]; oc[lane + 64 * q] = c; p.CKVB[(size_t)t * 256 + lane + 64 * q] = f2bf(c); } }
            { const float v = lane < 32 ? bf2f(z[ZKPE + lane]) : 0.f; const float ss = wsum(v * v); const float rs = rsqrtf(ss * (1.0f / 32.0f) + EPS);
                const float xn = v * rs * p.g_kr[lane & 31]; const float o = rope32(xn, lane, row_pos(t));
                if (lane < 32) { float* ok = t < TP ? p.o_kpep + (size_t)t * 32 : p.o_kpes + (size_t)(t - TP) * 32; ok[lane] = o; p.KPB[(size_t)t * 32 + lane] = f2bf(o); } }
        } else {
            const int r = row - T; const float* s = p.MKV + (size_t)r * 1024;
            float v[8]; float ss = 0.f;
#pragma unroll
            for (int q = 0; q < 8; ++q) { v[q] = s[lane * 8 + q]; ss += v[q] * v[q]; }
            ss += __shfl_xor(ss, 1); ss += __shfl_xor(ss, 2); ss += __shfl_xor(ss, 4); ss += __shfl_xor(ss, 8);
            const float rs = rsqrtf(ss * (1.0f / 128.0f) + EPS);
#pragma unroll
            for (int q = 0; q < 8; ++q) { const int c = lane * 8 + q; const float k = v[q] * rs * p.g_xk[c & 127]; p.o_mkp[(size_t)r * 512 + c] = k; p.MKB[(size_t)r * 512 + c] = f2bf(k);
                const float vv = s[512 + c]; p.o_mvp[(size_t)r * 512 + c] = vv; p.MVB[(size_t)r * 512 + c] = f2bf(vv); }
        }
    }
}

DI void phase_post_qkv(const Params& p) {
    const int tid = tid_opaque(), wid = __builtin_amdgcn_readfirstlane(tid >> 6), lane = tid & 63;
    for (int t = blockIdx.x * 8 + wid; t < T; t += gridDim.x * 8) {
        const bf16* qf = p.QF + (size_t)t * 768; const bf16* kv = p.KV + (size_t)t * 1024; const int pos = row_pos(t);
        for (int h = 0; h < 8; ++h) {
            const float v = bf2f(qf[h * 96 + lane]); const float ss = wsum(v * v); const float rs = rsqrtf(ss * (1.0f / 64.0f) + EPS);
            p.QN[((size_t)t * 8 + h) * 96 + lane] = f2bf(v * rs * p.g_qn[lane] * MLA_SCALE);
            const float vr = lane < 32 ? bf2f(qf[h * 96 + 64 + lane]) : 0.f; const float ssr = wsum(vr * vr); const float rsr = rsqrtf(ssr * (1.0f / 32.0f) + EPS);
            const float xr = vr * rsr * p.g_qr[lane & 31]; const float o = rope32(xr, lane, pos);
            if (lane < 32) p.QN[((size_t)t * 8 + h) * 96 + 64 + lane] = f2bf(o * MLA_SCALE);
            const float k = bf2f(kv[h * 128 + lane]); const float sk = wsum(k * k); const float rk = rsqrtf(sk * (1.0f / 64.0f) + EPS);
            p.KN[((size_t)t * 8 + h) * 64 + lane] = f2bf(k * rk * p.g_kn[lane]);
        }
    }
}
struct GlaUnit { int t0, h, nv; };
DI GlaUnit gla_unit(int u) { GlaUnit g; if (u < NGP) { const int b = u / (4 * NC), h = (u / NC) % 4, c = u % NC; g.t0 = b * SEQ + c * 64; g.h = h; g.nv = 64; } else { const int us = u - NGP; g.t0 = TP + (us >> 2) * DECS; g.h = us & 3; g.nv = DECS; } return g; }
DI void gla_cumsum(const Params& p, const GlaUnit& g, LDS float* LA, int tid) {
    for (int i = tid; i < 64 * 64; i += NTHREADS) { const int s = i >> 6, kd = i & 63; LA[s * 65 + kd] = s < g.nv ? p.LOGA[(size_t)(g.t0 + s) * 256 + g.h * 64 + kd] : 0.f; }
    __syncthreads();
    if (tid < 64) { float a = 0.f; for (int s = 0; s < 64; ++s) { a += LA[s * 65 + tid]; LA[s * 65 + tid] = a; } }
    __syncthreads();
}
constexpr int GL_LA = 0, GL_KH = 16640  , GL_VT = GL_KH + 64 * 72 * 2, GL_QT = GL_VT + 128 * 72 * 2, GL_ST = GL_QT + 64 * 72 * 2, GL_ATT = GL_ST + 128 * 72 * 2, GL_OB = GL_ATT + 64 * 72 * 2, GL_END = GL_OB + 64 * 129 * 4;
static_assert(GL_END <= LDS_CTL && GL_KH % 16 == 0 && GL_OB % 16 == 0, "GLA LDS map");
DI void phase_gla_a(const Params& p, LDS unsigned char* lds) {
    const int tid = tid_opaque(), wid = __builtin_amdgcn_readfirstlane(tid >> 6), lane = tid & 63, r = lane & 31, hh = lane >> 5;
    LDS float* LA = (LDS float*)(lds + GL_LA); LDS bf16* KH = (LDS bf16*)(lds + GL_KH); LDS bf16* VT = (LDS bf16*)(lds + GL_VT);
    for (int u = blockIdx.x; u < NGU; u += gridDim.x) {
        const GlaUnit g = gla_unit(u);
        gla_cumsum(p, g, LA, tid);
        for (int i = tid; i < 64 * 64; i += NTHREADS) { const int s = i >> 6, kd = i & 63;
            float v = 0.f; if (s < g.nv) v = bf2f(p.Z[(size_t)(g.t0 + s) * DINP + ZK + g.h * 64 + kd]) * expf(LA[63 * 65 + kd] - LA[s * 65 + kd]);
            KH[kd * 72 + s] = f2bf(v); }
        for (int i = tid; i < 64 * 128; i += NTHREADS) { const int s = i >> 7, dv = i & 127;
            VT[dv * 72 + s] = s < g.nv ? p.Z[(size_t)(g.t0 + s) * DINP + ZV + g.h * 128 + dv] : (bf16)0; }
        if (tid < 64) p.DDEC[(size_t)u * 64 + tid] = expf(LA[63 * 65 + tid]);
        __syncthreads();
        { const int mt = wid & 1, nt = wid >> 1; f32x16 acc = zero16();
#pragma unroll
            for (int ks = 0; ks < 4; ++ks) acc = mfma32(ld8(KH + (32 * mt + r) * 72 + 16 * ks + 8 * hh), ld8(VT + (32 * nt + r) * 72 + 16 * ks + 8 * hh), acc);
            float* d = p.DS + (size_t)u * 8192;
#pragma unroll
            for (int i = 0; i < 16; ++i) d[(32 * mt + crow(i, hh)) * 128 + 32 * nt + r] = acc[i]; }
        __syncthreads();
    }
}
DI void phase_gla_b(const Params& p) {
    const int gid = blockIdx.x * NTHREADS + tid_opaque(), gsz = gridDim.x * NTHREADS;
    for (int e = gid; e < BATCH * 4 * 8192; e += gsz) { const int bh = e >> 13, idx = e & 8191, kd = idx >> 7; float S = 0.f;
        for (int c = 0; c < NC; ++c) { const size_t u = (size_t)bh * NC + c; const float d = p.DS[u * 8192 + idx]; p.DS[u * 8192 + idx] = S; S = S * p.DDEC[u * 64 + kd] + d; }
        p.o_glap[e] = S; }
    for (int e = gid; e < DECB * 4 * 8192; e += gsz) { const int bh = e >> 13, idx = e & 8191, kd = idx >> 7; const size_t u = (size_t)NGP + bh;
        p.o_glas[e] = p.sgla[e] * p.DDEC[u * 64 + kd] + p.DS[u * 8192 + idx]; }
}
DI void gla_c_unit(const Params& p, LDS unsigned char* lds, int u) {
    const int tid = tid_opaque(), wid = __builtin_amdgcn_readfirstlane(tid >> 6), lane = tid & 63, r = lane & 31, hh = lane >> 5;
    LDS float* LA = (LDS float*)(lds + GL_LA); LDS bf16* KT = (LDS bf16*)(lds + GL_KH); LDS bf16* VT = (LDS bf16*)(lds + GL_VT); LDS bf16* QT = (LDS bf16*)(lds + GL_QT);
    LDS bf16* ST = (LDS bf16*)(lds + GL_ST); LDS bf16* ATT = (LDS bf16*)(lds + GL_ATT); LDS float* OB = (LDS float*)(lds + GL_OB);
    const GlaUnit g = gla_unit(u);
    gla_cumsum(p, g, LA, tid);
    for (int i = tid; i < 64 * 64; i += NTHREADS) { const int s = i >> 6, kd = i & 63; float q = 0.f, k = 0.f;
        if (s < g.nv) { const bf16* z = p.Z + (size_t)(g.t0 + s) * DINP; const float b = LA[s * 65 + kd]; q = bf2f(z[ZQ + g.h * 64 + kd]) * expf(b) * 0.125f; k = bf2f(z[ZK + g.h * 64 + kd]) * expf(-b); }
        QT[s * 72 + kd] = f2bf(q); KT[s * 72 + kd] = f2bf(k); }
    for (int i = tid; i < 64 * 128; i += NTHREADS) { const int s = i >> 7, dv = i & 127;
        VT[dv * 72 + s] = s < g.nv ? p.Z[(size_t)(g.t0 + s) * DINP + ZV + g.h * 128 + dv] : (bf16)0; }
    { const float* sp = u < NGP ? p.DS + (size_t)u * 8192 : p.sgla + (size_t)(u - NGP) * 8192;
        for (int i = tid; i < 8192; i += NTHREADS) { const int kd = i >> 7, dv = i & 127; ST[dv * 72 + kd] = f2bf(sp[i]); } }
    __syncthreads();
    if (wid < 4) { const int mt = wid & 1, nt = wid >> 1; f32x16 acc = zero16();
#pragma unroll
        for (int ks = 0; ks < 4; ++ks) acc = mfma32(ld8(QT + (32 * mt + r) * 72 + 16 * ks + 8 * hh), ld8(KT + (32 * nt + r) * 72 + 16 * ks + 8 * hh), acc);
#pragma unroll
        for (int i = 0; i < 16; ++i) { const int t = 32 * mt + crow(i, hh), s = 32 * nt + r; ATT[t * 72 + s] = f2bf(s <= t ? acc[i] : 0.f); } }
    __syncthreads();
    { const int mt = wid & 1, nt = wid >> 1; f32x16 acc = zero16();
#pragma unroll
        for (int ks = 0; ks < 4; ++ks) acc = mfma32(ld8(QT + (32 * mt + r) * 72 + 16 * ks + 8 * hh), ld8(ST + (32 * nt + r) * 72 + 16 * ks + 8 * hh), acc);
#pragma unroll
        for (int ks = 0; ks < 4; ++ks) acc = mfma32(ld8(ATT + (32 * mt + r) * 72 + 16 * ks + 8 * hh), ld8(VT + (32 * nt + r) * 72 + 16 * ks + 8 * hh), acc);
#pragma unroll
        for (int i = 0; i < 16; ++i) OB[(32 * mt + crow(i, hh)) * 129 + 32 * nt + r] = acc[i]; }
    __syncthreads();
    for (int t = wid; t < g.nv; t += 8) { const float o0 = OB[t * 129 + lane], o1 = OB[t * 129 + 64 + lane]; const float ss = wsum(o0 * o0 + o1 * o1); const float rs = rsqrtf(ss * (1.0f / 128.0f) + EPS);
        const bf16* z = p.Z + (size_t)(g.t0 + t) * DINP + ZR + g.h * 128; bf16* o = p.OMIX + (size_t)(g.t0 + t) * DM + g.h * 128;
        const float r0 = bf2f(z[lane]), r1 = bf2f(z[64 + lane]);
        o[lane] = f2bf(o0 * rs * p.g_gla_o[lane] * (r0 / (1.0f + expf(-r0)))); o[64 + lane] = f2bf(o1 * rs * p.g_gla_o[64 + lane] * (r1 / (1.0f + expf(-r1)))); }
}
constexpr int PA_KT = 0, PA_VT = 64 * 104 * 2, PA_END = PA_VT + 64 * 72 * 2;
DI void pattn_unit(const Params& p, LDS unsigned char* lds, int u) {
    const int tid = tid_opaque(), wid = __builtin_amdgcn_readfirstlane(tid >> 6), lane = tid & 63, r = lane & 31, hh = lane >> 5;
    LDS bf16* KT = (LDS bf16*)(lds + PA_KT); LDS bf16* VT = (LDS bf16*)(lds + PA_VT);
    const int qb = NQB - 1 - u / (BATCH * 8), bh = u % (BATCH * 8), b = bh >> 3, h = bh & 7;
    const int qw0 = qb * 256 + 32 * wid, qpos = qw0 + r; const size_t trow = (size_t)b * SEQ + qpos;
    bf16x8 qf[6];
#pragma unroll
    for (int ks = 0; ks < 6; ++ks) qf[ks] = ld8g(p.QN + (trow * 8 + h) * 96 + 16 * ks + 8 * hh);
    f32x16 o0 = zero16(), o1 = zero16(); float m = -INFINITY, l = 0.f;
    const int nkt = 4 * (qb + 1);
    for (int kt = 0; kt < nkt; ++kt) {
        const int k0 = kt * 64; const size_t kr0 = (size_t)b * SEQ + k0;
        for (int i = tid; i < 64 * 12; i += NTHREADS) { const int key = i / 12, c = i % 12;
            const bf16x8 v = c < 8 ? ld8g(p.KN + ((kr0 + key) * 8 + h) * 64 + c * 8) : ld8g(p.KPB + (kr0 + key) * 32 + (c - 8) * 8);
            *(LDS bf16x8*)(KT + key * 104 + c * 8) = v; }
        { const int key = tid >> 3, c8 = (tid & 7) * 8; const bf16x8 v = ld8g(p.KV + (kr0 + key) * 1024 + h * 128 + 64 + c8);
#pragma unroll
            for (int j = 0; j < 8; ++j) VT[(c8 + j) * 72 + key] = (bf16)v[j]; }
        __syncthreads();
        if (k0 <= qw0 + 31) {
            f32x16 s0 = zero16(), s1 = zero16();
#pragma unroll
            for (int ks = 0; ks < 6; ++ks) { s0 = mfma32(ld8(KT + r * 104 + 16 * ks + 8 * hh), qf[ks], s0); s1 = mfma32(ld8(KT + (32 + r) * 104 + 16 * ks + 8 * hh), qf[ks], s1); }
            float tmax = -INFINITY;
#pragma unroll
            for (int i = 0; i < 16; ++i) { const int key = k0 + crow(i, hh); if (key > qpos) s0[i] = -INFINITY; if (key + 32 > qpos) s1[i] = -INFINITY; tmax = fmaxf(tmax, fmaxf(s0[i], s1[i])); }
            tmax = fmaxf(tmax, __shfl_xor(tmax, 32));
            const float mn = fmaxf(m, tmax), corr = expf(m - mn); m = mn; float ps = 0.f;
#pragma unroll
            for (int i = 0; i < 16; ++i) { s0[i] = expf(s0[i] - mn); s1[i] = expf(s1[i] - mn); ps += s0[i] + s1[i]; }
            l = l * corr + ps;
#pragma unroll
            for (int i = 0; i < 16; ++i) { o0[i] *= corr; o1[i] *= corr; }
#pragma unroll
            for (int s = 0; s < 2; ++s) { const bf16x8 pa = PACK(s0, s), pb = PACK(s1, s);
                o0 = mfma32(ldperm(VT + r * 72 + 16 * s, hh), pa, o0); o1 = mfma32(ldperm(VT + (32 + r) * 72 + 16 * s, hh), pa, o1);
                o0 = mfma32(ldperm(VT + r * 72 + 32 + 16 * s, hh), pb, o0); o1 = mfma32(ldperm(VT + (32 + r) * 72 + 32 + 16 * s, hh), pb, o1); }
        }
        __syncthreads();
    }
    l += __shfl_xor(l, 32); const float il = 1.0f / l;
    bf16* o = p.OMIX + trow * DM + 512 + h * 64;
#pragma unroll
    for (int g = 0; g < 4; ++g) { u32x2 w0, w1; w0[0] = pk2(o0[4 * g] * il, o0[4 * g + 1] * il); w0[1] = pk2(o0[4 * g + 2] * il, o0[4 * g + 3] * il); w1[0] = pk2(o1[4 * g] * il, o1[4 * g + 1] * il); w1[1] = pk2(o1[4 * g + 2] * il, o1[4 * g + 3] * il);
        *(u32x2*)(o + 8 * g + 4 * hh) = w0; *(u32x2*)(o + 32 + 8 * g + 4 * hh) = w1; }
}

constexpr int XA_K = 0, XA_V = 256 * 136 * 2, XA_END = XA_V + 128 * 264 * 2;
static_assert(XA_END <= LDS_CTL && XA_V % 16 == 0, "cross-attention LDS map");
DI void xattn_unit(const Params& p, LDS unsigned char* lds, int u) {
    const int tid = tid_opaque(), wid = __builtin_amdgcn_readfirstlane(tid >> 6), lane = tid & 63, r = lane & 31, hh = lane >> 5;
    LDS bf16* KX = (LDS bf16*)(lds + XA_K); LDS bf16* VX = (LDS bf16*)(lds + XA_V);
    int b, h, nrows; size_t tbase;
    if (u < NU_XP) { b = u / (4 * NQB); h = (u / NQB) & 3; const int qc = u % NQB; nrows = 256; tbase = (size_t)b * SEQ + qc * 256;
        for (int i = tid; i < 256 * 16; i += NTHREADS) { const int key = i >> 4, c8 = (i & 15) * 8; const size_t src = ((size_t)b * 256 + key) * 512 + h * 128 + c8;
            *(LDS bf16x8*)(KX + key * 136 + c8) = ld8g(p.MKB + src); const bf16x8 v = ld8g(p.MVB + src);
#pragma unroll
            for (int j = 0; j < 8; ++j) VX[(c8 + j) * 264 + key] = (bf16)v[j]; }
    } else { const int us = u - NU_XP; b = us >> 2; h = us & 3; nrows = DECS; tbase = (size_t)TP + b * DECS;
        for (int i = tid; i < 256 * 32; i += NTHREADS) { const int key = i >> 5, c4 = (i & 31) * 4; const size_t src = (((size_t)b * 256 + key) * 4 + h) * 128 + c4;
            const f32x4 k = *(const f32x4*)(p.cmk + src), v = *(const f32x4*)(p.cmv + src); u32x2 w; w[0] = pk2(k[0], k[1]); w[1] = pk2(k[2], k[3]); *(LDS u32x2*)(KX + key * 136 + c4) = w;
#pragma unroll
            for (int j = 0; j < 4; ++j) VX[(c4 + j) * 264 + key] = f2bf(v[j]); }
    }
    __syncthreads();
    if (32 * wid < nrows) {
        const bool valid = 32 * wid + r < nrows; const size_t trow = tbase + 32 * wid + (valid ? r : 0);
        bf16x8 qf[8]; float ss = 0.f;
#pragma unroll
        for (int ks = 0; ks < 8; ++ks) { qf[ks] = ld8g(p.XQ + trow * 512 + h * 128 + 16 * ks + 8 * hh);
#pragma unroll
            for (int j = 0; j < 8; ++j) { const float v = bf2f((bf16)qf[ks][j]); ss += v * v; } }
        ss += __shfl_xor(ss, 32); const float rs = valid ? rsqrtf(ss * (1.0f / 128.0f) + EPS) * X_SCALE : 0.f;
#pragma unroll
        for (int ks = 0; ks < 8; ++ks) { float q[8];
#pragma unroll
            for (int j = 0; j < 8; ++j) q[j] = bf2f((bf16)qf[ks][j]) * rs * p.g_xq[16 * ks + 8 * hh + j];
            qf[ks] = pack8(q[0], q[1], q[2], q[3], q[4], q[5], q[6], q[7]); }
        f32x16 o[4];
#pragma unroll
        for (int d = 0; d < 4; ++d) o[d] = zero16();
        float m = -INFINITY, l = 0.f;
        for (int kt = 0; kt < 4; ++kt) {
            f32x16 s0 = zero16(), s1 = zero16();
#pragma unroll
            for (int ks = 0; ks < 8; ++ks) { s0 = mfma32(ld8(KX + (64 * kt + r) * 136 + 16 * ks + 8 * hh), qf[ks], s0); s1 = mfma32(ld8(KX + (64 * kt + 32 + r) * 136 + 16 * ks + 8 * hh), qf[ks], s1); }
            float tmax = -INFINITY;
#pragma unroll
            for (int i = 0; i < 16; ++i) tmax = fmaxf(tmax, fmaxf(s0[i], s1[i]));
            tmax = fmaxf(tmax, __shfl_xor(tmax, 32));
            const float mn = fmaxf(m, tmax), corr = expf(m - mn); m = mn; float ps = 0.f;
#pragma unroll
            for (int i = 0; i < 16; ++i) { s0[i] = expf(s0[i] - mn); s1[i] = expf(s1[i] - mn); ps += s0[i] + s1[i]; }
            l = l * corr + ps;
#pragma unroll
            for (int d = 0; d < 4; ++d)
#pragma unroll
                for (int i = 0; i < 16; ++i) o[d][i] *= corr;
#pragma unroll
            for (int s = 0; s < 2; ++s) { const bf16x8 pa = PACK(s0, s), pb = PACK(s1, s);
#pragma unroll
                for (int d = 0; d < 4; ++d) { o[d] = mfma32(ldperm(VX + (32 * d + r) * 264 + 64 * kt + 16 * s, hh), pa, o[d]); o[d] = mfma32(ldperm(VX + (32 * d + r) * 264 + 64 * kt + 32 + 16 * s, hh), pb, o[d]); } }
        }
        l += __shfl_xor(l, 32); const float il = 1.0f / l;
        if (valid) { bf16* op = p.XO + trow * 512 + h * 128;
#pragma unroll
            for (int d = 0; d < 4; ++d)
#pragma unroll
                for (int g = 0; g < 4; ++g) { u32x2 w; w[0] = pk2(o[d][4 * g] * il, o[d][4 * g + 1] * il); w[1] = pk2(o[d][4 * g + 2] * il, o[d][4 * g + 3] * il); *(u32x2*)(op + 32 * d + 8 * g + 4 * hh) = w; } }
    }
}
constexpr int SA_F32 = 0, SA_KPF = 65536, SA_CK = SA_KPF + 8192, SA_KP = SA_CK + 32768, SA_P = SA_KP + 64 * 40 * 2, SA_QS = SA_P + 64 * 72 * 2, SA_CORR = SA_QS + 65 * 104 * 2, SA_END = SA_CORR + 1024;
static_assert(SA_END <= LDS_CTL && SA_KP % 16 == 0 && SA_P % 16 == 0 && SA_QS % 16 == 0 && SA_CORR % 16 == 0, "sample attention LDS map");
DI void sattn_issue(const Params& p, LDS unsigned char* lds, int pid, int half, int wid, int lane) {
    const size_t key0 = (size_t)pid * PAGE + half * 64;
#pragma unroll
    for (int i = 0; i < 8; ++i) { const int key = wid * 8 + i; dma16(p.cckv + (key0 + key) * 256 + lane * 4, lds + SA_F32 + key * 1024); }
    dma16(p.ckpe + (key0 + wid * 8 + (lane >> 3)) * 32 + (lane & 7) * 4, lds + SA_KPF + wid * 1024);
}
DI void sattn_convert(LDS unsigned char* lds) {
    const int tid = tid_opaque();
#pragma unroll
    for (int j = 0; j < 4; ++j) { const int i = tid + NTHREADS * j, key = i >> 5, c32 = i & 31;
        const f32x4 a = *(const LDS f32x4*)(lds + SA_F32 + key * 1024 + c32 * 32), bq = *(const LDS f32x4*)(lds + SA_F32 + key * 1024 + c32 * 32 + 16);
        u32x4 w; w[0] = pk2(a[0], a[1]); w[1] = pk2(a[2], a[3]); w[2] = pk2(bq[0], bq[1]); w[3] = pk2(bq[2], bq[3]);
        *(LDS u32x4*)(lds + SA_CK + (c32 >> 4) * 16384 + imgb(key, c32 & 15)) = w; }
    { const int key = tid >> 3, c4 = (tid & 7) * 4; const f32x4 v = *(const LDS f32x4*)(lds + SA_KPF + key * 128 + c4 * 4); u32x2 w; w[0] = pk2(v[0], v[1]); w[1] = pk2(v[2], v[3]);
        *(LDS u32x2*)(lds + SA_KP + (key * 40 + c4) * 2) = w; }
}
DI void sattn_unit(const Params& p, LDS unsigned char* lds, int u) {
    const int tid = tid_opaque(), wid = __builtin_amdgcn_readfirstlane(tid >> 6), lane = tid & 63, r = lane & 31, hh = lane >> 5;
    LDS unsigned char* CK = lds + SA_CK; LDS bf16* KP = (LDS bf16*)(lds + SA_KP); LDS bf16* PA = (LDS bf16*)(lds + SA_P);
    LDS bf16* QS = (LDS bf16*)(lds + SA_QS); LDS float* CORR = (LDS float*)(lds + SA_CORR);
    const int b = u / NSPLIT, sp = u % NSPLIT; const int h = wid;
    const int pidv = p.ptab[b * NPAGES + sp * PPS + (lane % PPS)];
    sattn_issue(p, lds, rdlane(pidv, 0), 0, wid, lane);
    for (int i = tid; i < 65 * 96; i += NTHREADS) { const int row = i / 96, d = i % 96; float v = 0.f;
        if (row < 64) { const int hq = row >> 3, q = row & 7; v = bf2f(p.QN[(((size_t)TP + b * DECS + q) * 8 + hq) * 96 + d]); if (d < 64) v *= p.g_kn[d]; }
        QS[row * 104 + d] = f2bf(v); }
    const int l15 = lane & 15, quad = lane >> 4;
    bf16x8 wk[4][8];
    { const bf16* wkp = p.wt_kvb + (size_t)(h * 128 + l15) * 256 + 8 * quad;
#pragma unroll
        for (int dt = 0; dt < 4; ++dt)
#pragma unroll
            for (int ks = 0; ks < 8; ++ks) wk[dt][ks] = ld8g(wkp + dt * 16 * 256 + 32 * ks); }
#ifndef EMU
#pragma unroll
    for (int dt = 0; dt < 4; ++dt)
#pragma unroll
        for (int ks = 0; ks < 8; ++ks) asm volatile("" : "+v"(wk[dt][ks]));
#endif
    const int qrow = l15 < 8 ? h * 8 + l15 : 64;
    f32x16 acc0 = zero16(), acc1 = zero16(); float m = -INFINITY, l = 0.f;
    const int npt = PPS * 2, ntile = npt + (sp == NSPLIT - 1 ? 1 : 0);
    wait_vm0(); bar_lds(); sattn_convert(lds); bar_lds();
    for (int tile = 0; tile < ntile; ++tile) {
        const bool newt = tile == npt;
        unsigned lo_ = lane;
#ifndef EMU
        asm volatile("" : "+v"(lo_));
#endif
        const unsigned l15o = lo_ & 15, quado = lo_ >> 4;
        if (tile + 1 < npt) sattn_issue(p, lds, rdlane(pidv, (tile + 1) >> 1), (tile + 1) & 1, wid, lane);
#pragma unroll 1
        for (int kg = 0; kg < 4; ++kg) {
            f32x4 x[4];
#pragma unroll
            for (int dt = 0; dt < 4; ++dt) x[dt] = (f32x4){0.f, 0.f, 0.f, 0.f};
#pragma unroll
            for (int ks = 0; ks < 8; ++ks) { const bf16x8 cb = *(const LDS bf16x8*)(CK + (ks >> 2) * 16384 + imgb(16 * kg + l15o, 4 * (ks & 3) + quado));
#pragma unroll
                for (int dt = 0; dt < 4; ++dt) x[dt] = __builtin_amdgcn_mfma_f32_16x16x32_bf16(wk[dt][ks], cb, x[dt], 0, 0, 0); }
            float ss = 0.f;
#pragma unroll
            for (int dt = 0; dt < 4; ++dt) ss += x[dt][0] * x[dt][0] + x[dt][1] * x[dt][1] + x[dt][2] * x[dt][2] + x[dt][3] * x[dt][3];
            ss += __shfl_xor(ss, 16); ss += __shfl_xor(ss, 32); const float inv = rsqrtf(ss * (1.0f / 64.0f) + EPS);
            f32x4 z = {0.f, 0.f, 0.f, 0.f};
#pragma unroll
            for (int pp = 0; pp < 2; ++pp) {
                const bf16x8 a = pack8(x[2 * pp][0] * inv, x[2 * pp][1] * inv, x[2 * pp][2] * inv, x[2 * pp][3] * inv, x[2 * pp + 1][0] * inv, x[2 * pp + 1][1] * inv, x[2 * pp + 1][2] * inv, x[2 * pp + 1][3] * inv);
                const s16x4 q0 = *(const LDS s16x4*)(QS + qrow * 104 + 32 * pp + 4 * quad), q1 = *(const LDS s16x4*)(QS + qrow * 104 + 32 * pp + 16 + 4 * quad);
                z = __builtin_amdgcn_mfma_f32_16x16x32_bf16(a, __builtin_shufflevector(q0, q1, 0, 1, 2, 3, 4, 5, 6, 7), z, 0, 0, 0); }
            z = __builtin_amdgcn_mfma_f32_16x16x32_bf16(ld8(KP + (16 * kg + l15) * 40 + 8 * quad), ld8(QS + qrow * 104 + 64 + 8 * quad), z, 0, 0, 0);
            float tmax = -INFINITY;
#pragma unroll
            for (int j = 0; j < 4; ++j) { const int key = 16 * kg + 4 * quad + j; if (newt && (key > l15 || key >= DECS)) z[j] = -INFINITY; tmax = fmaxf(tmax, z[j]); }
            tmax = fmaxf(tmax, __shfl_xor(tmax, 16)); tmax = fmaxf(tmax, __shfl_xor(tmax, 32));
            if (l15 >= 8 || (newt && kg > 0)) tmax = fmaxf(tmax, -1e30f);
            const float mn = fmaxf(m, tmax), corr = expf(m - mn); m = mn;
#pragma unroll
            for (int j = 0; j < 4; ++j) z[j] = expf(z[j] - mn);
            l = l * corr + (z[0] + z[1]) + (z[2] + z[3]);
            if (l15 < 8) { u32x2 w; w[0] = pk2(z[0], z[1]); w[1] = pk2(z[2], z[3]); *(LDS u32x2*)(PA + (h * 8 + l15) * 72 + 16 * kg + 4 * quad) = w;
                if (quad == 0) CORR[kg * 64 + h * 8 + l15] = corr; }
        }
        bar_lds();
#pragma unroll
        for (int ks = 0; ks < 4; ++ks) { const float c0 = CORR[ks * 64 + r], c1 = CORR[ks * 64 + 32 + r];
#pragma unroll
            for (int i = 0; i < 16; ++i) { acc0[i] *= c0; acc1[i] *= c1; }
            const bf16x8 a = img_tr<false>(CK + (wid >> 2) * 16384, lo_, wid & 3, 16 * ks);
            acc0 = mfma32(a, ld8(PA + r * 72 + 16 * ks + 8 * hh), acc0); acc1 = mfma32(a, ld8(PA + (32 + r) * 72 + 16 * ks + 8 * hh), acc1); }
        if (tile + 1 < ntile) {
            if (tile + 1 < npt) { wait_vm0(); bar_lds(); sattn_convert(lds); }
            else { bar_lds(); const size_t t0 = (size_t)TP + b * DECS;
                for (int i = tid; i < 64 * 32; i += NTHREADS) { const int key = i >> 5, c32 = i & 31; bf16x8 v = zero8(); if (key < DECS) v = ld8g(p.CKVB + (t0 + key) * 256 + c32 * 8);
                    *(LDS bf16x8*)(CK + (c32 >> 4) * 16384 + imgb(key, c32 & 15)) = v; }
                for (int i = tid; i < 64 * 32; i += NTHREADS) { const int key = i >> 5, c = i & 31; KP[key * 40 + c] = key < DECS ? p.KPB[(t0 + key) * 32 + c] : (bf16)0; } }
            bar_lds();
        }
    }
    { const int t2 = tid_opaque(), w2 = __builtin_amdgcn_readfirstlane(t2 >> 6), l2 = t2 & 63, r2 = l2 & 31, h2 = l2 >> 5;
        float* pa = p.PACC + (size_t)u * 64 * 256;
#pragma unroll
        for (int g = 0; g < 4; ++g) { f32x4 v0 = {acc0[4 * g], acc0[4 * g + 1], acc0[4 * g + 2], acc0[4 * g + 3]}, v1 = {acc1[4 * g], acc1[4 * g + 1], acc1[4 * g + 2], acc1[4 * g + 3]};
            *(f32x4*)(pa + (size_t)r2 * 256 + 32 * w2 + 8 * g + 4 * h2) = v0; *(f32x4*)(pa + (size_t)(32 + r2) * 256 + 32 * w2 + 8 * g + 4 * h2) = v1; }
        l += __shfl_xor(l, 16); l += __shfl_xor(l, 32);
        if (l2 < 8) { p.PML[((size_t)u * 64 + w2 * 8 + r2) * 2] = m; p.PML[((size_t)u * 64 + w2 * 8 + r2) * 2 + 1] = l; } }
}
constexpr int SC_ACC = 0, SC_W = 64 * 257 * 4, SC_END = SC_W + 64 * NSPLIT * 4 + 256;
DI void phase_sattn_combine(const Params& p, LDS unsigned char* lds) {
    const int tid = tid_opaque();
    LDS float* AC = (LDS float*)(lds + SC_ACC); LDS float* WS = (LDS float*)(lds + SC_W);
    for (int b = blockIdx.x; b < DECB; b += gridDim.x) {
        if (tid < 64) { float M = -INFINITY; for (int j = 0; j < NSPLIT; ++j) M = fmaxf(M, p.PML[((size_t)(b * NSPLIT + j) * 64 + tid) * 2]);
            float L = 0.f; for (int j = 0; j < NSPLIT; ++j) { const float w = expf(p.PML[((size_t)(b * NSPLIT + j) * 64 + tid) * 2] - M); WS[tid * NSPLIT + j] = w; L += w * p.PML[((size_t)(b * NSPLIT + j) * 64 + tid) * 2 + 1]; }
            const float iL = 1.0f / L; for (int j = 0; j < NSPLIT; ++j) WS[tid * NSPLIT + j] *= iL; }
        __syncthreads();
        for (int i = tid; i < 64 * 256; i += NTHREADS) { const int hq = i >> 8, lat = i & 255; float s = 0.f;
            for (int j = 0; j < NSPLIT; ++j) s += WS[hq * NSPLIT + j] * p.PACC[((size_t)(b * NSPLIT + j) * 64 + hq) * 256 + lat];
            AC[hq * 257 + lat] = s; }
        __syncthreads();
        for (int i = tid; i < 64 * 64; i += NTHREADS) { const int hq = i >> 6, dv = i & 63, h = hq >> 3, q = hq & 7; const bf16* w = p.wt_kvb + (size_t)(h * 128 + 64 + dv) * 256; float s = 0.f;
            for (int lat = 0; lat < 256; ++lat) s += AC[hq * 257 + lat] * bf2f(w[lat]);
            p.OMIX[((size_t)TP + b * DECS + q) * DM + 512 + h * 64 + dv] = f2bf(s); }
        __syncthreads();
    }
}
#ifndef EMU
#define XB_TMO      128
#define XB_XCNT(j)  (256  + 64 * (j))
#define XB_XSUB(j)  (1280 + 64 * (j))
#define XB_XGEN(j)  (2304 + 64 * (j))
#define XB_TOP      3328
#define XB_TOPGEN   3392
#define XCD_BAR_WORDS 3456
#define XB_SPIN_CAP (1u << 18)
#define LAS __attribute__((address_space(3)))
__device__ __forceinline__ unsigned xb_ld(unsigned* p)              { return __hip_atomic_load(p, __ATOMIC_RELAXED, __HIP_MEMORY_SCOPE_AGENT); }
__device__ __forceinline__ unsigned xb_add(unsigned* p, unsigned v) { return __hip_atomic_fetch_add(p, v, __ATOMIC_RELAXED, __HIP_MEMORY_SCOPE_AGENT); }
__device__ __forceinline__ unsigned xb_xcc_id() { return (unsigned)__builtin_amdgcn_s_getreg((3 << 11) | 20) & 0xFu; }
#define XB_SPIN(cond, bar) do { unsigned _sp = 0; while (cond) { __builtin_amdgcn_s_sleep(1); \
    if ((++_sp & 255u) == 0u) { if (xb_ld(&(bar)[XB_TMO])) break; if (_sp > XB_SPIN_CAP) { atomicAdd(&(bar)[XB_TMO], 1u); break; } } } } while (0)
struct XcdBarrier { unsigned* bar; unsigned x; volatile LAS unsigned* st; };
__device__ __forceinline__ XcdBarrier xcd_barrier_post(unsigned* bar, volatile LAS unsigned* st) {
    XcdBarrier b; b.bar = bar; b.x = xb_xcc_id(); b.st = st;
    if (threadIdx.x == 0) (void)xb_add(&bar[XB_XCNT(b.x)], 1u);
    return b;
}
__device__ __forceinline__ void xcd_barrier_complete(unsigned* bar, unsigned x, unsigned& nloc, unsigned& nx) {
    const unsigned G = gridDim.x * gridDim.y * gridDim.z;
    unsigned sum, cnt, mine, sp = 0u;
    for (;;) {
        sum = 0u; cnt = 0u; mine = 0u;
#pragma unroll
        for (unsigned j = 0; j < 16; ++j) { const unsigned c = xb_ld(&bar[XB_XCNT(j)]); sum += c; cnt += (c > 0u) ? 1u : 0u; mine = (j == x) ? c : mine; }
        if (sum == G) break;
        __builtin_amdgcn_s_sleep(1);
        if ((++sp & 255u) == 0u) { if (xb_ld(&bar[XB_TMO])) break; if (sp > XB_SPIN_CAP) { atomicAdd(&bar[XB_TMO], 1u); break; } }
    }
    nloc = mine > 0u ? mine : 1u; nx = cnt > 0u ? cnt : 1u;
}
__device__ __forceinline__ void xcd_barrier(const XcdBarrier& b) {
    asm volatile("s_waitcnt vmcnt(0)" ::: "memory");
    __syncthreads();
    if (threadIdx.x == 0) {
        unsigned* bar = b.bar;
        __builtin_amdgcn_s_waitcnt(0);
        unsigned nloc = b.st[0], nx = b.st[1];
        if (nloc == 0u) { xcd_barrier_complete(bar, b.x, nloc, nx); b.st[0] = nloc; b.st[1] = nx; }
        const unsigned old = xb_add(&bar[XB_XSUB(b.x)], 1u);
        const unsigned gen = old / nloc;
        if (old + 1u == (gen + 1u) * nloc) {
            __builtin_amdgcn_fence(__ATOMIC_RELEASE, "agent");
            asm volatile("s_waitcnt vmcnt(0)" ::: "memory");
            const unsigned og = xb_add(&bar[XB_TOP], 1u);
            const unsigned tg = og / nx;
            if (og + 1u == (tg + 1u) * nx) xb_add(&bar[XB_TOPGEN], 1u);
            else XB_SPIN(xb_ld(&bar[XB_TOPGEN]) == tg, bar);
            __builtin_amdgcn_fence(__ATOMIC_ACQUIRE, "agent");
            xb_add(&bar[XB_XGEN(b.x)], 1u);
            asm volatile("s_waitcnt vmcnt(0)" ::: "memory");
        } else {
            XB_SPIN(xb_ld(&bar[XB_XGEN(b.x)]) == gen, bar);
            __builtin_amdgcn_fence(__ATOMIC_ACQUIRE, "agent");
            asm volatile("s_waitcnt vmcnt(0)" ::: "memory");
        }
    }
    __syncthreads();
}
#endif

DI int wq_next(unsigned* ctr, LDS unsigned* slot) {
    __syncthreads();
    if (threadIdx.x == 0) *slot = atomicAdd(ctr, 1u);
    __syncthreads();
    return __builtin_amdgcn_readfirstlane((int)*slot);
}
struct EpiResF32 {
    static constexpr bool PERM = false, AFTER_DRAIN = false;
    float* C; const float* R0; const float* R1; int split;
    DI void operator()(const f32x4 (&acc)[2][2][4][2], const pg8::Unit& u, int wr, int wc, int fr, int fq) const {
        const int row0 = u.pm * 256 + wr * 64 + fr, col0 = u.pn * 256 + wc * 32 + 4 * fq;
        const float* R = row0 < split ? R0 : R1 - (size_t)split * DM;
#pragma unroll
        for (int ai = 0; ai < 2; ++ai)
#pragma unroll
            for (int m = 0; m < 4; ++m) { const size_t off = (size_t)(row0 + ai * 128 + m * 16) * DM + col0;
#pragma unroll
                for (int bj = 0; bj < 2; ++bj)
#pragma unroll
                    for (int n = 0; n < 2; ++n) { const f32x4 v = acc[ai][bj][m][n] + *(const f32x4*)(R + off + bj * 128 + n * 16); *(f32x4*)(C + off + bj * 128 + n * 16) = v; } }
    }
};
DI void phase_norm_rows(const Params& p, const float* X, const float* g) {
    const int tid = tid_opaque(), wid = __builtin_amdgcn_readfirstlane(tid >> 6), lane = tid & 63;
    for (int row = blockIdx.x * 8 + wid; row < T; row += gridDim.x * 8) rmsnorm_row_1024(X + (size_t)row * DM, g, p.H + (size_t)row * DM, lane);
}
constexpr int NPHASE = 15;
template <int PH> DI void run_phase(const Params& p, LDS unsigned char* lds) {
    LDS unsigned* slot = (LDS unsigned*)(lds + LDS_CTL + 64);
    if constexpr (PH == 0) phase_prep(p, lds);
    else if constexpr (PH == 1) { run_gemm(lds, p.H, p.wt_in, T, DINP, DM, EpiStoreBf16<0>{p.Z, DINP}, 0); run_gemm(lds, p.MEMN, p.wt_xkv, MROWS, 1024, DM, EpiStoreF32{p.MKV, nullptr, 1024}, 100); }
    else if constexpr (PH == 2) { phase_post_in(p); if (DUPM & 8) phase_post_in(p); }
    else if constexpr (PH == 3) { run_gemm(lds, p.QAN, p.wt_qb, T, 768, 384, EpiStoreBf16<0>{p.QF, 768}, 0); run_gemm(lds, p.CKVB, p.wt_kvb, T, 1024, 256, EpiStoreBf16<0>{p.KV, 1024}, 140); __syncthreads(); phase_gla_a(p, lds); }
    else if constexpr (PH == 4) { phase_post_qkv(p); if (DUPM & 16) phase_post_qkv(p); phase_gla_b(p); }
    else if constexpr (PH == 5) {
        for (int rep = 0; rep < ((DUPM & 1) ? 2 : 1); ++rep) for (;;) { const int u = wq_next(p.ctl + CW_Q5 + 192 * rep, slot); if (u >= NU_SA) break; sattn_unit(p, lds, u); }
        for (int rep = 0; rep < ((DUPM & 2) ? 2 : 1); ++rep) for (;;) { const int u = wq_next(p.ctl + CW_Q5 + 64 + 192 * rep, slot); if (u >= NU_PA) break; pattn_unit(p, lds, u); }
        for (int rep = 0; rep < ((DUPM & 4) ? 2 : 1); ++rep) for (;;) { const int u = wq_next(p.ctl + CW_Q5 + 128 + 192 * rep, slot); if (u >= NGU) break; gla_c_unit(p, lds, u); } }
    else if constexpr (PH == 6) phase_sattn_combine(p, lds);
    else if constexpr (PH == 7) run_gemm(lds, p.OMIX, p.wt_out, T, DM, DM, EpiResF32{p.X1, p.xp, p.xs, TP}, 0);
    else if constexpr (PH == 8) phase_norm_rows(p, p.X1, p.g_x);
    else if constexpr (PH == 9) run_gemm(lds, p.H, p.wt_xq, T, 512, DM, EpiStoreBf16<0>{p.XQ, 512}, 0);
    else if constexpr (PH == 10) { for (;;) { const int u = wq_next(p.ctl + CW_QX, slot); if (u >= NU_XS + NU_XP) break; xattn_unit(p, lds, u < NU_XS ? NU_XP + u : u - NU_XS); } }
    else if constexpr (PH == 11) run_gemm(lds, p.XO, p.wt_xo, T, DM, 512, EpiResF32{p.X2, p.X1, p.X1, T}, 0);
    else if constexpr (PH == 12) phase_norm_rows(p, p.X2, p.g_ff);
    else if constexpr (PH == 13) run_gemm(lds, p.H, p.wt_ff1, T, DFF, DM, EpiStoreBf16<1>{p.U, DFF}, 0);
    else if constexpr (PH == 14) run_gemm(lds, p.U, p.wt_ff2, T, DM, DFF, EpiResF32{p.y, p.X2, p.X2, T}, 0);
}
#ifdef EMU
#define GET_LDS() ((LDS unsigned char*)EMU_SMEM())
#define GRID_BAR() emu_grid_barrier()
#else
#define GET_LDS() ((LDS unsigned char*)lds_raw)
#define GRID_BAR() xcd_barrier(bar)
#endif
template <int PH> __global__ void __launch_bounds__(NTHREADS, 2) k_phase(Params p) {
#ifndef EMU
    extern __shared__ __attribute__((aligned(16))) unsigned char lds_raw[];
#endif
    run_phase<PH>(p, GET_LDS());
}
#if N_LAUNCH_MODE == 1
__global__ void __launch_bounds__(NTHREADS, 2) k_mega(Params p) {
#ifndef EMU
    extern __shared__ __attribute__((aligned(16))) unsigned char lds_raw[];
    LDS unsigned char* lds = GET_LDS();
    if (threadIdx.x < 64) ((LDS unsigned*)(lds + LDS_CTL))[threadIdx.x] = 0u;
    __syncthreads();
    XcdBarrier bar = xcd_barrier_post(p.ctl + CW_BAR, (volatile LDS unsigned*)(lds + LDS_CTL));
#else
    LDS unsigned char* lds = GET_LDS();
#endif
    run_phase<0>(p, lds); GRID_BAR();
    run_phase<1>(p, lds); GRID_BAR();
    run_phase<2>(p, lds); GRID_BAR();
    run_phase<3>(p, lds); GRID_BAR();
    run_phase<4>(p, lds); GRID_BAR();
    run_phase<5>(p, lds); GRID_BAR();
    run_phase<6>(p, lds); GRID_BAR();
    run_phase<7>(p, lds); GRID_BAR();
    run_phase<8>(p, lds); GRID_BAR();
    run_phase<9>(p, lds); GRID_BAR();
    run_phase<10>(p, lds); GRID_BAR();
    run_phase<11>(p, lds); GRID_BAR();
    run_phase<12>(p, lds); GRID_BAR();
    run_phase<13>(p, lds); GRID_BAR();
    run_phase<14>(p, lds);
}
#endif

static size_t ws_take(size_t& off, size_t bytes) { const size_t o = off; off = (off + bytes + 255) & ~(size_t)255; return o; }
template <int PH> static void launch_phase(const Params& p, int grid, hipStream_t stream) {
#ifndef EMU
    static bool attr = false; if (!attr) { (void)hipFuncSetAttribute((const void*)k_phase<PH>, hipFuncAttributeMaxDynamicSharedMemorySize, LDS_BYTES); attr = true; }
#endif
    LAUNCH(k_phase<PH>, dim3(grid), dim3(NTHREADS), LDS_BYTES, stream, p);
}
extern "C" void kernel_launch(void* const* d_in, const int* in_sizes, int n_in, void* d_out, int out_size, void* d_ws, size_t ws_size, hipStream_t stream) {
    Params p{};
    const float* const* in = (const float* const*)d_in;
    p.xp = in[0]; p.xs = in[1]; p.memp = in[2]; p.cckv = in[3]; p.ckpe = in[4]; p.cmk = in[5]; p.cmv = in[6]; p.sgla = in[7]; p.ptab = (const int*)d_in[8];
    p.g_mix = in[9]; p.w_a2 = in[11]; p.b_a = in[12]; p.g_gla_o = in[13]; p.g_qa = in[14]; p.g_kva = in[16]; p.g_qn = in[18]; p.g_kn = in[19]; p.g_qr = in[20]; p.g_kr = in[21];
    p.g_x = in[23]; p.g_mem = in[24]; p.g_xq = in[28]; p.g_xk = in[29]; p.g_ff = in[31];
    float* out = (float*)d_out; size_t oo = 0;
    p.y = out; oo += (size_t)T * DM; p.o_ckvp = out + oo; oo += (size_t)TP * 256; p.o_kpep = out + oo; oo += (size_t)TP * 32; p.o_mkp = out + oo; oo += (size_t)MROWS * 512; p.o_mvp = out + oo; oo += (size_t)MROWS * 512;
    p.o_glap = out + oo; oo += (size_t)BATCH * 4 * 8192; p.o_ckvs = out + oo; oo += (size_t)TS * 256; p.o_kpes = out + oo; oo += (size_t)TS * 32; p.o_glas = out + oo; oo += (size_t)DECB * 4 * 8192;
    if ((size_t)out_size != oo || n_in != 34) { fprintf(stderr, "kernel_launch: unexpected sizes (out %d vs %zu, n_in %d)\n", out_size, oo, n_in); }
    unsigned char* ws = (unsigned char*)d_ws; size_t off = 0;
    p.ctl = (unsigned*)(ws + ws_take(off, 1 << 20));
#define WSB(name, elems) p.name = (bf16*)(ws + ws_take(off, (size_t)(elems) * 2))
#define WSF(name, elems) p.name = (float*)(ws + ws_take(off, (size_t)(elems) * 4))
    WSB(wt_in, (size_t)DINP * DM); WSB(wt_qb, 768 * 384); WSB(wt_kvb, 1024 * 256); WSB(wt_out, DM * DM); WSB(wt_xq, 512 * DM); WSB(wt_xkv, 1024 * DM); WSB(wt_xo, DM * 512); WSB(wt_ff1, (size_t)DFF * DM); WSB(wt_ff2, (size_t)DM * DFF);
    WSB(H, (size_t)T * DM); WSB(MEMN, (size_t)MROWS * DM); WSB(Z, (size_t)T * DINP); WSB(QAN, (size_t)T * 384); WSB(CKVB, (size_t)T * 256); WSB(KPB, (size_t)T * 32); WSB(MKB, (size_t)MROWS * 512); WSB(MVB, (size_t)MROWS * 512);
    WSB(QF, (size_t)T * 768); WSB(KV, (size_t)T * 1024); WSB(QN, (size_t)T * 768); WSB(KN, (size_t)T * 512); WSB(OMIX, (size_t)T * DM); WSB(XQ, (size_t)T * 512); WSB(XO, (size_t)T * 512); WSB(U, (size_t)T * DFF);
    WSF(MKV, (size_t)MROWS * 1024); WSF(LOGA, (size_t)T * 256); WSF(DS, (size_t)NGU * 8192); WSF(DDEC, (size_t)NGU * 64); WSF(X1, (size_t)T * DM); WSF(X2, (size_t)T * DM); WSF(PACC, (size_t)NU_SA * 64 * 256); WSF(PML, (size_t)NU_SA * 128);
    if (off > ws_size) { fprintf(stderr, "kernel_launch: workspace too small (%zu > %zu)\n", off, ws_size); return; }
    p.w_in = in[10]; p.w_qb = in[15]; p.w_kvb = in[17]; p.w_out = in[22]; p.w_xq = in[25]; p.w_xk = in[26]; p.w_xv = in[27]; p.w_xo = in[30]; p.w_ff1 = in[32]; p.w_ff2 = in[33];
    (void)hipMemsetAsync(p.ctl, 0, 1 << 20, stream);
#ifdef EMU
    const int grid = EMU_GRID;
#else
    static int grid = 0;
    if (!grid) { int dev = 0, cus = 0; (void)hipGetDevice(&dev); (void)hipDeviceGetAttribute(&cus, hipDeviceAttributeMultiprocessorCount, dev); grid = cus > 0 ? cus : 256;
#if N_LAUNCH_MODE == 1
        (void)hipFuncSetAttribute((const void*)k_mega, hipFuncAttributeMaxDynamicSharedMemorySize, LDS_BYTES);
        int per_cu = 0; if (hipOccupancyMaxActiveBlocksPerMultiprocessor(&per_cu, (const void*)k_mega, NTHREADS, LDS_BYTES) != hipSuccess || per_cu < 1) fprintf(stderr, "kernel_launch: occupancy query reports %d workgroups per CU\n", per_cu);
#endif
    }
#endif
#if N_LAUNCH_MODE == 1
    LAUNCH(k_mega, dim3(grid), dim3(NTHREADS), LDS_BYTES, stream, p);
#else
    launch_phase<0>(p, grid, stream); launch_phase<1>(p, grid, stream); launch_phase<2>(p, grid, stream); launch_phase<3>(p, grid, stream); launch_phase<4>(p, grid, stream);
    launch_phase<5>(p, grid, stream); launch_phase<6>(p, grid, stream); launch_phase<7>(p, grid, stream); launch_phase<8>(p, grid, stream); launch_phase<9>(p, grid, stream);
    launch_phase<10>(p, grid, stream); launch_phase<11>(p, grid, stream); launch_phase<12>(p, grid, stream); launch_phase<13>(p, grid, stream); launch_phase<14>(p, grid, stream);
#endif
}
```

```cpp
#ifdef EMU
#include "emu.h"
#define LDS
#else
#include <hip/hip_runtime.h>
#define LDS __attribute__((address_space(3)))
#define LAUNCH(kern, grid, block, smem, stream, ...) kern<<<grid, block, smem, stream>>>(__VA_ARGS__)
#endif
#include <cstdio>
#include <cstdint>
#include <cmath>
#define DI __device__ __forceinline__

#ifndef CFG_BATCH
#define CFG_BATCH 16
#define CFG_SEQ 2048
#define CFG_DECB 128
#define CFG_PAST 8192
#endif
#ifndef DUPP
#define DUPP 0
#endif
#ifndef DUPM
#define DUPM 0
#endif
#ifndef N_LAUNCH_MODE
#define N_LAUNCH_MODE 1
#endif

typedef unsigned short bf16;
typedef short bf16x8 __attribute__((ext_vector_type(8)));
typedef short s16x4 __attribute__((ext_vector_type(4)));
typedef float f32x4 __attribute__((ext_vector_type(4)));
typedef float f32x16 __attribute__((ext_vector_type(16)));
typedef unsigned u32x4 __attribute__((ext_vector_type(4)));
typedef unsigned u32x2 __attribute__((ext_vector_type(2)));

constexpr int DM = 1024, BATCH = CFG_BATCH, SEQ = CFG_SEQ, DECB = CFG_DECB, DECS = 8, PAST = CFG_PAST, PAGE = 128, NPAGES = PAST / PAGE;
constexpr int NMEM = 256, TP = BATCH * SEQ, TS = DECB * DECS, T = TP + TS, MROWS = BATCH * NMEM;
constexpr int DIN = 2224, DINP = 2304, DFF = 4096;
constexpr int ZQ = 0, ZK = 256, ZV = 512, ZR = 1024, ZA = 1536, ZQA = 1552, ZKVA = 1936, ZKPE = 2192;
constexpr float EPS = 1e-6f, MLA_SCALE = 0.10206207261596577f  , X_SCALE = 0.08838834764831845f  ;
constexpr int NC = SEQ / 64;
constexpr int NGP = BATCH * 4 * NC, NGS = DECB * 4, NGU = NGP + NGS;
constexpr int NSPLIT = NPAGES >= 8 ? 8 : NPAGES, PPS = NPAGES / NSPLIT;
constexpr int NU_SA = DECB * NSPLIT, NQB = SEQ / 256, NU_PA = BATCH * 8 * NQB;
constexpr int NU_XP = BATCH * 4 * NQB, NU_XS = DECB * 4;
static_assert(T % 256 == 0 && MROWS % 256 == 0 && SEQ % 256 == 0 && NPAGES % NSPLIT == 0, "shape assumptions");
constexpr int NTHREADS = 512, LDS_BYTES = 147456, LDS_CTL = LDS_BYTES - 256;

DI int tid_opaque() {
    int t = threadIdx.x;
#ifndef EMU
    asm volatile("" : "+v"(t));
#endif
    return t;
}
DI float bf2f(bf16 b) { return __uint_as_float(((unsigned)b) << 16); }
DI bf16 f2bf(float x) {
#ifdef EMU
    unsigned u = __float_as_uint(x); u += 0x7fffu + ((u >> 16) & 1u); return (bf16)(u >> 16);
#else
    return __builtin_bit_cast(unsigned short, (__bf16)x);
#endif
}
DI unsigned pk2(float a, float b) { return (unsigned)f2bf(a) | ((unsigned)f2bf(b) << 16); }
DI f32x16 zero16() { f32x16 z; for (int i = 0; i < 16; ++i) z[i] = 0.f; return z; }
DI f32x16 mfma32(bf16x8 a, bf16x8 b, f32x16 c) { return __builtin_amdgcn_mfma_f32_32x32x16_bf16(a, b, c, 0, 0, 0); }
DI int crow(int i, int h) { return (i & 3) + 8 * (i >> 2) + 4 * h; }
DI bf16x8 ld8(const LDS bf16* p) { return *(const LDS bf16x8*)p; }
DI bf16x8 ld8g(const bf16* p) { return *(const bf16x8*)p; }
DI bf16x8 ldperm(const LDS bf16* p16, int h) {
    const s16x4 lo = *(const LDS s16x4*)(p16 + 4 * h), hi = *(const LDS s16x4*)(p16 + 8 + 4 * h);
    return __builtin_shufflevector(lo, hi, 0, 1, 2, 3, 4, 5, 6, 7);
}
DI bf16x8 ldpermg(const bf16* p16, int h) {
    const s16x4 lo = *(const s16x4*)(p16 + 4 * h), hi = *(const s16x4*)(p16 + 8 + 4 * h);
    return __builtin_shufflevector(lo, hi, 0, 1, 2, 3, 4, 5, 6, 7);
}
DI bf16x8 pack8(float a0, float a1, float a2, float a3, float a4, float a5, float a6, float a7) {
    u32x4 p; p[0] = pk2(a0, a1); p[1] = pk2(a2, a3); p[2] = pk2(a4, a5); p[3] = pk2(a6, a7); return __builtin_bit_cast(bf16x8, p);
}
#define PACK(x, s) pack8((x)[8 * (s)], (x)[8 * (s) + 1], (x)[8 * (s) + 2], (x)[8 * (s) + 3], (x)[8 * (s) + 4], (x)[8 * (s) + 5], (x)[8 * (s) + 6], (x)[8 * (s) + 7])
DI float wsum(float v) { for (int o = 32; o >= 1; o >>= 1) v += __shfl_xor(v, o); return v; }
DI bf16x8 zero8() { bf16x8 z; for (int i = 0; i < 8; ++i) z[i] = 0; return z; }

DI unsigned imgb(unsigned row, unsigned ch) { return 256u * row + 16u * (ch ^ (((row & 3u) << 2) | ((row >> 2) & 3u))); }
DI bf16x8 img_row(const LDS unsigned char* img, unsigned row, unsigned s, unsigned hh) { return *(const LDS bf16x8*)(img + imgb(row, 2 * s + hh)); }
DI s16x4 tr16(const LDS unsigned char* a) {
#ifdef EMU
    return emu_tr16_b64(a);
#else
    return __builtin_amdgcn_ds_read_tr16_b64_v4i16((LDS s16x4*)a);
#endif
}
template <bool PERM> DI bf16x8 img_tr(const LDS unsigned char* img, unsigned lane, unsigned c, unsigned k16) {
    const unsigned hh = lane >> 5, blk = (lane >> 4) & 1, q = (lane & 15) >> 2, pp = lane & 3;
    const unsigned r0 = k16 + (PERM ? 4 * hh : 8 * hh) + q, r1 = r0 + (PERM ? 8 : 4), ch = 4 * c + 2 * blk + (pp >> 1);
    const LDS unsigned char* a0 = img + imgb(r0, ch) + 8 * (pp & 1); const LDS unsigned char* a1 = img + imgb(r1, ch) + 8 * (pp & 1);
#ifdef EMU
    const s16x4 lo = emu_tr16_b64(a0), hi = emu_tr16_b64(a1);
#else
    s16x4 lo, hi;
    asm volatile("ds_read_b64_tr_b16 %0, %2\n\tds_read_b64_tr_b16 %1, %3\n\ts_waitcnt lgkmcnt(0)" : "=&v"(lo), "=&v"(hi) : "v"((unsigned)(size_t)a0), "v"((unsigned)(size_t)a1) : "memory");
#endif
    return __builtin_shufflevector(lo, hi, 0, 1, 2, 3, 4, 5, 6, 7);
}
DI void dma16(const void* g, LDS unsigned char* l) {
#ifdef EMU
    emu_dma16(g, l);
#else
    __builtin_amdgcn_global_load_lds((const unsigned*)g, (LDS unsigned*)l, 16, 0, 0);
#endif
}
#ifdef EMU
#define SCHED_FENCE() do {} while (0)
#else
#define SCHED_FENCE() __builtin_amdgcn_sched_barrier(0)
#endif
DI int rdlane(int v, int l) {
#ifdef EMU
    return __shfl(v, l);
#else
    return __builtin_amdgcn_readlane(v, l);
#endif
}
DI void wait_vm0() {
#ifndef EMU
    asm volatile("s_waitcnt vmcnt(0)" ::: "memory");
#endif
}
DI void bar_lds() {
#ifdef EMU
    __syncthreads();
#else
    asm volatile("s_waitcnt lgkmcnt(0)" ::: "memory"); __builtin_amdgcn_s_barrier(); asm volatile("" ::: "memory");
#endif
}

namespace pg8 {
#define PG8_LAS LDS
typedef unsigned short bf16_t;
constexpr int BM = 256, BK = 64, HALF = 128, HTB = HALF * BK * 2  , STAGE_BYTES = 8 * HTB, NXCD = 8, WGM = 8;
__host__ __device__ __forceinline__ int lds_byte(int r, int c) { const int st = (r >> 4) * 2 + (c >> 5), rr = r & 15, cc = c & 31, ob = rr * 64 + cc * 2; return st * 1024 + (ob ^ (((ob >> 9) & 1) << 5)); }
__host__ __device__ __forceinline__ void stage_rc(int b, int& R, int& C) { const int st = b / 1024, sb = b % 1024, swz = sb ^ (((sb >> 9) & 1) << 5); R = (st >> 1) * 16 + swz / 64; C = (st & 1) * 32 + (swz % 64) / 2; }
__host__ __device__ __forceinline__ int perm32(int rho) { const int n = rho >> 4, i = rho & 15; return 8 * (i >> 2) + 4 * n + (i & 3); }
struct Unit { int pm, pn; };
struct Gemm { const bf16_t* A; const bf16_t* Bt; int M, N, K; };
struct StaticOrder {
    int nM, nN, nwg, G, c;
    __host__ __device__ void init(int M, int N, int G_, int c_) { nM = M / BM; nN = N / BM; nwg = nM * nN; G = G_; c = c_; }
    __host__ __device__ bool next(int i, Unit& u) const {
        const long L = (long)i * G + c; if (L >= nwg) return false;
        int wgid = (int)L; { const int q = nwg / NXCD, r = nwg % NXCD, xcd = wgid % NXCD, off = wgid / NXCD; wgid = (xcd < r ? xcd * (q + 1) : r * (q + 1) + (xcd - r) * q) + off; }
        const int nig = WGM * nN, gid = wgid / nig, fm = gid * WGM, gsz = (nM - fm) < WGM ? (nM - fm) : WGM;
        u.pm = fm + ((wgid % nig) % gsz); u.pn = (wgid % nig) / gsz; return true;
    }
    __device__ __forceinline__ void a_ready(const Unit&) const {}
    __device__ __forceinline__ void done(const Unit&) const {}
};
#ifdef EMU
template <class Epi, class Sched>
__device__ __forceinline__ void gemm_phase(PG8_LAS unsigned char* lds, const Gemm g, const Sched& S, const Epi& E) {
    const int tid = tid_opaque(), wid = __builtin_amdgcn_readfirstlane(tid >> 6), lane = tid & 63, wr = wid >> 2, wc = wid & 3, fr = lane & 15, fq = lane >> 4;
    Unit cur;
    for (int ui = 0; S.next(ui, cur); ++ui) {
        f32x4 acc[2][2][4][2];
        for (int ai = 0; ai < 2; ++ai) for (int bj = 0; bj < 2; ++bj) for (int m = 0; m < 4; ++m) for (int n = 0; n < 2; ++n) for (int j = 0; j < 4; ++j) {
            const int row = 256 * cur.pm + 128 * ai + 64 * wr + 16 * m + fr;
            const int col = Epi::PERM ? 256 * cur.pn + 128 * bj + 32 * wc + 8 * fq + 4 * n + j : 256 * cur.pn + 128 * bj + 32 * wc + 16 * n + 4 * fq + j;
            const bf16_t* a = g.A + (size_t)row * g.K; const bf16_t* b = g.Bt + (size_t)col * g.K; float s = 0.f;
            for (int k = 0; k < g.K; ++k) s += bf2f(a[k]) * bf2f(b[k]);
            acc[ai][bj][m][n][j] = s;
        }
        E(acc, cur, wr, wc, fr, fq);
    }
}
#else
template <class Epi, class Sched>
__device__ __forceinline__ void gemm_phase(PG8_LAS unsigned char* lds, const Gemm g, const Sched& S, const Epi& E) {
    const int tid = tid_opaque(), wid = __builtin_amdgcn_readfirstlane(tid >> 6), lane = tid & 63, wr = wid >> 2, wc = wid & 3, fr = lane & 15, fq = lane >> 4;
    const int K = g.K, nt = K / BK;
    unsigned voffA[2], voffB[2];
#pragma unroll
    for (int i = 0; i < 2; ++i) { int R, C; stage_rc(tid * 16 + i * 8192, R, C); const int Rb = Epi::PERM ? ((R & ~31) + perm32(R & 31)) : R;
        voffA[i] = (unsigned)(R * K + C) * 2u; voffB[i] = (unsigned)(Rb * K + C) * 2u; }
    const size_t kstep = (size_t)(BK * 2);
    const size_t hstep = (size_t)HALF * K * 2;
    const size_t tstep = 2 * hstep;
    const unsigned ldsw = (unsigned)wid * 1024u;
    const int aoff = lds_byte(wr * 64 + fr, fq * 8), boff = lds_byte(wc * 32 + fr, fq * 8);
#define PG8_SA(b, h) (((b) * 2 + (h)) * HTB)
#define PG8_SB(b, h) ((4 + (b) * 2 + (h)) * HTB)
#define PG8_STAGE(bufoff, gbase, voff) do { _Pragma("unroll") for (int _i = 0; _i < 2; ++_i) \
        __builtin_amdgcn_global_load_lds((const unsigned*)((const char*)(gbase) + (voff)[_i]), (PG8_LAS unsigned*)(lds + (bufoff) + ldsw + _i * 8192), 16, 0, 0); } while (0)
#define PG8_LDA(dst, b, h) do { _Pragma("unroll") for (int m = 0; m < 4; ++m) _Pragma("unroll") for (int k = 0; k < 2; ++k) dst[m][k] = *(const PG8_LAS bf16x8*)(lds + PG8_SA(b, h) + aoff + m * 2048 + k * 1024); } while (0)
#define PG8_LDB(dst, b, h) do { _Pragma("unroll") for (int n = 0; n < 2; ++n) _Pragma("unroll") for (int k = 0; k < 2; ++k) dst[n][k] = *(const PG8_LAS bf16x8*)(lds + PG8_SB(b, h) + boff + n * 2048 + k * 1024); } while (0)
#define PG8_MMA(ai, bj, At, Bt) do { __builtin_amdgcn_s_setprio(1); _Pragma("unroll") for (int m = 0; m < 4; ++m) _Pragma("unroll") for (int n = 0; n < 2; ++n) _Pragma("unroll") for (int k = 0; k < 2; ++k) \
        acc[ai][bj][m][n] = __builtin_amdgcn_mfma_f32_16x16x32_bf16(Bt[n][k], At[m][k], acc[ai][bj][m][n], 0, 0, 0); __builtin_amdgcn_s_setprio(0); } while (0)
#define PG8_WAIT_V(n) asm volatile("s_waitcnt vmcnt(" #n ")" ::: "memory")
#define PG8_WAIT_L(n) asm volatile("s_waitcnt lgkmcnt(" #n ")" ::: "memory")
#define PG8_BAR __builtin_amdgcn_s_barrier()
#define PG8_SCHED __builtin_amdgcn_sched_barrier(0)
    Unit cur, nxt; int ui = 0;
    if (!S.next(0, cur)) return;
    f32x4 acc[2][2][4][2];
#pragma unroll
    for (int a = 0; a < 2; ++a)
#pragma unroll
        for (int b = 0; b < 2; ++b)
#pragma unroll
            for (int m = 0; m < 4; ++m)
#pragma unroll
                for (int n = 0; n < 2; ++n) acc[a][b][m][n] = (f32x4){0.f, 0.f, 0.f, 0.f};
    bf16x8 At[4][2], B0[2][2], B1[2][2];
    const char* cA = (const char*)g.A + (size_t)cur.pm * tstep; const char* cB = (const char*)g.Bt + (size_t)cur.pn * tstep;
    S.a_ready(cur);
    PG8_STAGE(PG8_SB(0, 0), cB, voffB); PG8_STAGE(PG8_SA(0, 0), cA, voffA); PG8_STAGE(PG8_SB(0, 1), cB + hstep, voffB); PG8_STAGE(PG8_SA(0, 1), cA + hstep, voffA);
    if (wr == 1) PG8_BAR;
    PG8_WAIT_V(4); PG8_BAR;
    PG8_STAGE(PG8_SB(1, 0), cB + kstep, voffB); PG8_STAGE(PG8_SA(1, 0), cA + kstep, voffA); PG8_STAGE(PG8_SB(1, 1), cB + hstep + kstep, voffB);
    PG8_WAIT_V(6); PG8_BAR;
    for (;;) {
        const bool has_next = S.next(ui + 1, nxt);
        const char* nA = has_next ? (const char*)g.A + (size_t)nxt.pm * tstep : cA; const char* nB = has_next ? (const char*)g.Bt + (size_t)nxt.pn * tstep : cB;
        for (int t = 0; t < nt; t += 2) {
            const bool last = (t == nt - 2);
            const char* a1 = cA + (size_t)(t + 1) * kstep;
            const char* a2 = last ? nA : cA + (size_t)(t + 2) * kstep; const char* b2 = last ? nB : cB + (size_t)(t + 2) * kstep;
            const char* a3 = a2 + kstep; const char* b3 = b2 + kstep;
            if (last && has_next) S.a_ready(nxt);
            PG8_LDB(B0, 0, 0); PG8_SCHED; PG8_LDA(At, 0, 0); PG8_STAGE(PG8_SA(1, 1), a1 + hstep, voffA);
            PG8_WAIT_L(8); PG8_BAR; PG8_WAIT_L(0); PG8_MMA(0, 0, At, B0); PG8_BAR; PG8_SCHED;
            PG8_LDB(B1, 0, 1); PG8_STAGE(PG8_SB(0, 0), b2, voffB);
            PG8_BAR; PG8_WAIT_L(0); PG8_MMA(0, 1, At, B1); PG8_BAR;
            PG8_LDA(At, 0, 1); PG8_STAGE(PG8_SA(0, 0), a2, voffA);
            PG8_BAR; PG8_WAIT_L(0); PG8_MMA(1, 0, At, B0); PG8_BAR; PG8_SCHED;
            PG8_STAGE(PG8_SB(0, 1), b2 + hstep, voffB);
            PG8_WAIT_V(6); PG8_BAR; PG8_MMA(1, 1, At, B1); PG8_BAR;
            PG8_LDB(B0, 1, 0); PG8_SCHED; PG8_LDA(At, 1, 0); PG8_STAGE(PG8_SA(0, 1), a2 + hstep, voffA);
            PG8_WAIT_L(8); PG8_BAR; PG8_WAIT_L(0); PG8_MMA(0, 0, At, B0); PG8_BAR; PG8_SCHED;
            PG8_LDB(B1, 1, 1); PG8_STAGE(PG8_SB(1, 0), b3, voffB);
            PG8_BAR; PG8_WAIT_L(0); PG8_MMA(0, 1, At, B1); PG8_BAR;
            PG8_LDA(At, 1, 1); PG8_STAGE(PG8_SA(1, 0), a3, voffA);
            PG8_BAR; PG8_WAIT_L(0); PG8_MMA(1, 0, At, B0); PG8_BAR; PG8_SCHED;
            PG8_STAGE(PG8_SB(1, 1), b3 + hstep, voffB);
            PG8_WAIT_V(6); PG8_BAR; PG8_MMA(1, 1, At, B1); PG8_BAR;
        }
        if constexpr (!Epi::AFTER_DRAIN) { E(acc, cur, wr, wc, fr, fq); S.done(cur); }
        if (!has_next) break;
#pragma unroll
        for (int a = 0; a < 2; ++a)
#pragma unroll
            for (int b = 0; b < 2; ++b)
#pragma unroll
                for (int m = 0; m < 4; ++m)
#pragma unroll
                    for (int n = 0; n < 2; ++n) acc[a][b][m][n] = (f32x4){0.f, 0.f, 0.f, 0.f};
        cur = nxt; cA = nA; cB = nB; ++ui;
    }
    PG8_WAIT_V(0);
    if (wr == 0) PG8_BAR;
    PG8_BAR;
    if constexpr (Epi::AFTER_DRAIN) { E.fused(acc, cur, wr, wc, fr, fq, lds, wid, lane); S.done(cur); }
#undef PG8_SA
#undef PG8_SB
#undef PG8_STAGE
#undef PG8_LDA
#undef PG8_LDB
#undef PG8_MMA
#undef PG8_WAIT_V
#undef PG8_WAIT_L
#undef PG8_BAR
#undef PG8_SCHED
}
#endif
}

struct Params {
    const float *xp, *xs, *memp, *cckv, *ckpe, *cmk, *cmv, *sgla; const int* ptab;
    const float *g_mix, *w_a2, *b_a, *g_gla_o, *g_qa, *g_kva, *g_qn, *g_kn, *g_qr, *g_kr, *g_x, *g_mem, *g_xq, *g_xk, *g_ff;
    float *y, *o_ckvp, *o_kpep, *o_mkp, *o_mvp, *o_glap, *o_ckvs, *o_kpes, *o_glas;
    unsigned* ctl;
    bf16 *wt_in, *wt_qb, *wt_kvb, *wt_out, *wt_xq, *wt_xkv, *wt_xo, *wt_ff1, *wt_ff2;
    bf16 *H, *MEMN, *Z, *QAN, *CKVB, *KPB, *MKB, *MVB, *QF, *KV, *QN, *KN, *OMIX, *XQ, *XO, *U;
    float *MKV, *LOGA, *DS, *DDEC, *X1, *X2, *PACC, *PML;
    const float *w_in, *w_qb, *w_kvb, *w_out, *w_xq, *w_xk, *w_xv, *w_xo, *w_ff1, *w_ff2;
};
constexpr int CW_Q5 = 0, CW_QX = 512, CW_BAR = 4096;

template <int ACT  > struct EpiStoreBf16 {
    static constexpr bool PERM = true, AFTER_DRAIN = false;
    bf16* O; int ldc;
    DI void operator()(const f32x4 (&acc)[2][2][4][2], const pg8::Unit& u, int wr, int wc, int fr, int fq) const {
        const int row0 = u.pm * 256 + wr * 64 + fr, col0 = u.pn * 256 + wc * 32 + 8 * fq;
#pragma unroll
        for (int ai = 0; ai < 2; ++ai)
#pragma unroll
            for (int m = 0; m < 4; ++m) { bf16* rowp = O + (size_t)(row0 + ai * 128 + m * 16) * ldc + col0;
#pragma unroll
                for (int bj = 0; bj < 2; ++bj) { f32x4 v0 = acc[ai][bj][m][0], v1 = acc[ai][bj][m][1];
                    if (ACT == 1) {
#pragma unroll
                        for (int j = 0; j < 4; ++j) { const float a = fmaxf(v0[j], 0.f), b = fmaxf(v1[j], 0.f); v0[j] = a * a; v1[j] = b * b; } }
                    u32x4 w; w[0] = pk2(v0[0], v0[1]); w[1] = pk2(v0[2], v0[3]); w[2] = pk2(v1[0], v1[1]); w[3] = pk2(v1[2], v1[3]);
                    *(u32x4*)(rowp + bj * 128) = w; } }
    }
};
struct EpiStoreF32 {
    static constexpr bool PERM = false, AFTER_DRAIN = false;
    float* C; const float* R; int ldc;
    DI void operator()(const f32x4 (&acc)[2][2][4][2], const pg8::Unit& u, int wr, int wc, int fr, int fq) const {
        const int row0 = u.pm * 256 + wr * 64 + fr, col0 = u.pn * 256 + wc * 32 + 4 * fq;
#pragma unroll
        for (int ai = 0; ai < 2; ++ai)
#pragma unroll
            for (int m = 0; m < 4; ++m) { const size_t off = (size_t)(row0 + ai * 128 + m * 16) * ldc + col0;
#pragma unroll
                for (int bj = 0; bj < 2; ++bj)
#pragma unroll
                    for (int n = 0; n < 2; ++n) { f32x4 v = acc[ai][bj][m][n]; if (R) v += *(const f32x4*)(R + off + bj * 128 + n * 16); *(f32x4*)(C + off + bj * 128 + n * 16) = v; } }
    }
};
template <class Epi> DI void run_gemm(LDS unsigned char* lds, const bf16* A, const bf16* Bt, int M, int N, int K, const Epi& E, int rot) {
    pg8::Gemm g{A, Bt, M, N, K}; pg8::StaticOrder S; S.init(M, N, (int)gridDim.x, (int)((blockIdx.x + rot) % gridDim.x));
    pg8::gemm_phase<Epi, pg8::StaticOrder>(lds, g, S, E);
}

DI const float* xrow(const Params& p, int t) { return t < TP ? p.xp + (size_t)t * DM : p.xs + (size_t)(t - TP) * DM; }
DI void rmsnorm_row_1024(const float* src, const float* g, bf16* dst, int lane) {
    f32x4 v[4]; float ss = 0.f;
#pragma unroll
    for (int i = 0; i < 4; ++i) { v[i] = *(const f32x4*)(src + 4 * (lane + 64 * i)); ss += v[i][0] * v[i][0] + v[i][1] * v[i][1] + v[i][2] * v[i][2] + v[i][3] * v[i][3]; }
    ss = wsum(ss); const float rs = rsqrtf(ss * (1.0f / 1024.0f) + EPS);
#pragma unroll
    for (int i = 0; i < 4; ++i) { const f32x4 gg = *(const f32x4*)(g + 4 * (lane + 64 * i)); u32x2 w; w[0] = pk2(v[i][0] * rs * gg[0], v[i][1] * rs * gg[1]); w[1] = pk2(v[i][2] * rs * gg[2], v[i][3] * rs * gg[3]);
        *(u32x2*)(dst + 4 * (lane + 64 * i)) = w; }
}
template <int K, int N, int NPAD> DI void prep_job(const float* W, bf16* Wt, LDS float* tl, int rot) {
    const int tid = tid_opaque(); constexpr int nkt = K / 64, ntiles = (NPAD / 64) * nkt;
    for (int tile = (int)((blockIdx.x + rot) % gridDim.x); tile < ntiles; tile += gridDim.x) {
        const int tn = tile / nkt, tk = tile % nkt;
        { const int kk = tid >> 3, n8 = (tid & 7) * 8; const int n = tn * 64 + n8; const float* s = W + (size_t)(tk * 64 + kk) * N + n;
            f32x4 a = {0.f, 0.f, 0.f, 0.f}, b = a; if (n < N) { a = *(const f32x4*)s; b = *(const f32x4*)(s + 4); }
#pragma unroll
            for (int q = 0; q < 4; ++q) { tl[kk * 65 + n8 + q] = a[q]; tl[kk * 65 + n8 + 4 + q] = b[q]; } }
        __syncthreads();
        { const int nn = tid >> 3, k8 = (tid & 7) * 8; u32x4 w;
#pragma unroll
            for (int q = 0; q < 4; ++q) w[q] = pk2(tl[(k8 + 2 * q) * 65 + nn], tl[(k8 + 2 * q + 1) * 65 + nn]);
            *(u32x4*)(Wt + (size_t)(tn * 64 + nn) * K + tk * 64 + k8) = w; }
        __syncthreads();
    }
}
DI void phase_prep(const Params& p, LDS unsigned char* lds) {
    const int tid = tid_opaque(), wid = __builtin_amdgcn_readfirstlane(tid >> 6), lane = tid & 63;
    LDS float* tl = (LDS float*)lds;
    prep_job<DM, DIN, DINP>(p.w_in, p.wt_in, tl, 0); prep_job<384, 768, 768>(p.w_qb, p.wt_qb, tl, 64); prep_job<256, 1024, 1024>(p.w_kvb, p.wt_kvb, tl, 136); prep_job<DM, DM, DM>(p.w_out, p.wt_out, tl, 200);
    prep_job<DM, 512, 512>(p.w_xq, p.wt_xq, tl, 0); prep_job<DM, 512, 512>(p.w_xk, p.wt_xkv, tl, 128); prep_job<DM, 512, 512>(p.w_xv, p.wt_xkv + (size_t)512 * DM, tl, 0); prep_job<512, DM, DM>(p.w_xo, p.wt_xo, tl, 128);
    prep_job<DM, DFF, DFF>(p.w_ff1, p.wt_ff1, tl, 0); prep_job<DFF, DM, DM>(p.w_ff2, p.wt_ff2, tl, 0);
    for (int row = blockIdx.x * 8 + wid; row < T + MROWS; row += gridDim.x * 8) {
        if (row < T) rmsnorm_row_1024(xrow(p, row), p.g_mix, p.H + (size_t)row * DM, lane);
        else rmsnorm_row_1024(p.memp + (size_t)(row - T) * DM, p.g_mem, p.MEMN + (size_t)(row - T) * DM, lane);
    }
}

DI float rope32(float xn, int lane, int pos) {
    const float partner = __shfl_xor(xn, 16);
    const int i = lane & 15; const float inv = expf(-(float)i * (9.210340371976184f / 16.0f)); const float ang = (float)pos * inv;
    const float c = cosf(ang), s = sinf(ang);
    return (lane & 16) ? xn * c + partner * s : xn * c - partner * s;
}
DI int row_pos(int t) { return t < TP ? (t % SEQ) : PAST + ((t - TP) % DECS); }

DI void phase_post_in(const Params& p) {
    const int tid = tid_opaque(), wid = __builtin_amdgcn_readfirstlane(tid >> 6), lane = tid & 63;
    for (int row = blockIdx.x * 8 + wid; row < T + MROWS; row += gridDim.x * 8) {
        if (row < T) {
            const int t = row; const bf16* z = p.Z + (size_t)t * DINP;
            float a[16];
#pragma unroll
            for (int i = 0; i < 16; ++i) a[i] = bf2f(z[ZA + i]);
#pragma unroll
            for (int q = 0; q < 4; ++q) { const int c = lane + 64 * q; float gp = p.b_a[c];
#pragma unroll
                for (int i = 0; i < 16; ++i) gp += a[i] * p.w_a2[i * 256 + c];
                const float ls = fminf(gp, 0.f) - log1pf(expf(-fabsf(gp)));
                p.LOGA[(size_t)t * 256 + c] = ls * (1.0f / 16.0f); }
            { float v[6]; float ss = 0.f;
#pragma unroll
                for (int q = 0; q < 6; ++q) { v[q] = bf2f(z[ZQA + lane + 64 * q]); ss += v[q] * v[q]; }
                ss = wsum(ss); const float rs = rsqrtf(ss * (1.0f / 384.0f) + EPS);
#pragma unroll
                for (int q = 0; q < 6; ++q) p.QAN[(size_t)t * 384 + lane + 64 * q] = f2bf(v[q] * rs * p.g_qa[lane + 64 * q]); }
            { float v[4]; float ss = 0.f;
#pragma unroll
                for (int q = 0; q < 4; ++q) { v[q] = bf2f(z[ZKVA + lane + 64 * q]); ss += v[q] * v[q]; }
                ss = wsum(ss); const float rs = rsqrtf(ss * (1.0f / 256.0f) + EPS);
                float* oc = t < TP ? p.o_ckvp + (size_t)t * 256 : p.o_ckvs + (size_t)(t - TP) * 256;
#pragma unroll
                for (int q = 0; q < 4; ++q) { const float c = v[q] * rs * p.g_kva[lane + 64 * q]; oc[lane + 64 * q] = c; p.CKVB[(size_t)t * 256 + lane + 64 * q] = f2bf(c); } }
            { const float v = lane < 32 ? bf2f(z[ZKPE + lane]) : 0.f; const float ss = wsum(v * v); const float rs = rsqrtf(ss * (1.0f / 32.0f) + EPS);
                const float xn = v * rs * p.g_kr[lane & 31]; const float o = rope32(xn, lane, row_pos(t));
                if (lane < 32) { float* ok = t < TP ? p.o_kpep + (size_t)t * 32 : p.o_kpes + (size_t)(t - TP) * 32; ok[lane] = o; p.KPB[(size_t)t * 32 + lane] = f2bf(o); } }
        } else {
            const int r = row - T; const float* s = p.MKV + (size_t)r * 1024;
            float v[8]; float ss = 0.f;
#pragma unroll
            for (int q = 0; q < 8; ++q) { v[q] = s[lane * 8 + q]; ss += v[q] * v[q]; }
            ss += __shfl_xor(ss, 1); ss += __shfl_xor(ss, 2); ss += __shfl_xor(ss, 4); ss += __shfl_xor(ss, 8);
            const float rs = rsqrtf(ss * (1.0f / 128.0f) + EPS);
#pragma unroll
            for (int q = 0; q < 8; ++q) { const int c = lane * 8 + q; const float k = v[q] * rs * p.g_xk[c & 127]; p.o_mkp[(size_t)r * 512 + c] = k; p.MKB[(size_t)r * 512 + c] = f2bf(k);
                const float vv = s[512 + c]; p.o_mvp[(size_t)r * 512 + c] = vv; p.MVB[(size_t)r * 512 + c] = f2bf(vv); }
        }
    }
}

DI void phase_post_qkv(const Params& p) {
    const int tid = tid_opaque(), wid = __builtin_amdgcn_readfirstlane(tid >> 6), lane = tid & 63;
    for (int t = TP + blockIdx.x * 8 + wid; t < T; t += gridDim.x * 8) {
        const bf16* qf = p.QF + (size_t)t * 768; const int pos = row_pos(t);
        for (int h = 0; h < 8; ++h) {
            const float v = bf2f(qf[h * 96 + lane]); const float ss = wsum(v * v); const float rs = rsqrtf(ss * (1.0f / 64.0f) + EPS);
            p.QN[((size_t)t * 8 + h) * 96 + lane] = f2bf(v * rs * p.g_qn[lane] * MLA_SCALE);
            const float vr = lane < 32 ? bf2f(qf[h * 96 + 64 + lane]) : 0.f; const float ssr = wsum(vr * vr); const float rsr = rsqrtf(ssr * (1.0f / 32.0f) + EPS);
            const float xr = vr * rsr * p.g_qr[lane & 31]; const float o = rope32(xr, lane, pos);
            if (lane < 32) p.QN[((size_t)t * 8 + h) * 96 + 64 + lane] = f2bf(o * MLA_SCALE);
        }
    }
}
struct GlaUnit { int t0, h, nv; };
DI GlaUnit gla_unit(int u) { GlaUnit g; if (u < NGP) { const int b = u / (4 * NC), h = (u / NC) % 4, c = u % NC; g.t0 = b * SEQ + c * 64; g.h = h; g.nv = 64; } else { const int us = u - NGP; g.t0 = TP + (us >> 2) * DECS; g.h = us & 3; g.nv = DECS; } return g; }
DI void gla_cumsum(const Params& p, const GlaUnit& g, LDS float* LA, int tid) {
    for (int i = tid; i < 64 * 64; i += NTHREADS) { const int s = i >> 6, kd = i & 63; LA[s * 65 + kd] = s < g.nv ? p.LOGA[(size_t)(g.t0 + s) * 256 + g.h * 64 + kd] : 0.f; }
    __syncthreads();
    if (tid < 64) { float a = 0.f; for (int s = 0; s < 64; ++s) { a += LA[s * 65 + tid]; LA[s * 65 + tid] = a; } }
    __syncthreads();
}
constexpr int GL_LA = 0, GL_KH = 16640  , GL_VT = GL_KH + 64 * 72 * 2, GL_QT = GL_VT + 128 * 72 * 2, GL_ST = GL_QT + 64 * 72 * 2, GL_ATT = GL_ST + 128 * 72 * 2, GL_OB = GL_ATT + 64 * 72 * 2, GL_END = GL_OB + 64 * 129 * 4;
static_assert(GL_END <= LDS_CTL && GL_KH % 16 == 0 && GL_OB % 16 == 0, "GLA LDS map");
DI void phase_gla_a(const Params& p, LDS unsigned char* lds) {
    const int tid = tid_opaque(), wid = __builtin_amdgcn_readfirstlane(tid >> 6), lane = tid & 63, r = lane & 31, hh = lane >> 5;
    LDS float* LA = (LDS float*)(lds + GL_LA); LDS bf16* KH = (LDS bf16*)(lds + GL_KH); LDS bf16* VT = (LDS bf16*)(lds + GL_VT);
    for (int u = blockIdx.x; u < NGU; u += gridDim.x) {
        const GlaUnit g = gla_unit(u);
        gla_cumsum(p, g, LA, tid);
        for (int i = tid; i < 64 * 64; i += NTHREADS) { const int s = i >> 6, kd = i & 63;
            float v = 0.f; if (s < g.nv) v = bf2f(p.Z[(size_t)(g.t0 + s) * DINP + ZK + g.h * 64 + kd]) * expf(LA[63 * 65 + kd] - LA[s * 65 + kd]);
            KH[kd * 72 + s] = f2bf(v); }
        for (int i = tid; i < 64 * 128; i += NTHREADS) { const int s = i >> 7, dv = i & 127;
            VT[dv * 72 + s] = s < g.nv ? p.Z[(size_t)(g.t0 + s) * DINP + ZV + g.h * 128 + dv] : (bf16)0; }
        if (tid < 64) p.DDEC[(size_t)u * 64 + tid] = expf(LA[63 * 65 + tid]);
        __syncthreads();
        { const int mt = wid & 1, nt = wid >> 1; f32x16 acc = zero16();
#pragma unroll
            for (int ks = 0; ks < 4; ++ks) acc = mfma32(ld8(KH + (32 * mt + r) * 72 + 16 * ks + 8 * hh), ld8(VT + (32 * nt + r) * 72 + 16 * ks + 8 * hh), acc);
            float* d = p.DS + (size_t)u * 8192;
#pragma unroll
            for (int i = 0; i < 16; ++i) d[(32 * mt + crow(i, hh)) * 128 + 32 * nt + r] = acc[i]; }
        __syncthreads();
    }
}
DI void phase_gla_b(const Params& p) {
    const int gid = blockIdx.x * NTHREADS + tid_opaque(), gsz = gridDim.x * NTHREADS;
    for (int e = gid; e < BATCH * 4 * 8192; e += gsz) { const int bh = e >> 13, idx = e & 8191, kd = idx >> 7; float S = 0.f;
        for (int c = 0; c < NC; ++c) { const size_t u = (size_t)bh * NC + c; const float d = p.DS[u * 8192 + idx]; p.DS[u * 8192 + idx] = S; S = S * p.DDEC[u * 64 + kd] + d; }
        p.o_glap[e] = S; }
    for (int e = gid; e < DECB * 4 * 8192; e += gsz) { const int bh = e >> 13, idx = e & 8191, kd = idx >> 7; const size_t u = (size_t)NGP + bh;
        p.o_glas[e] = p.sgla[e] * p.DDEC[u * 64 + kd] + p.DS[u * 8192 + idx]; }
}
DI void gla_c_unit(const Params& p, LDS unsigned char* lds, int u) {
    const int tid = tid_opaque(), wid = __builtin_amdgcn_readfirstlane(tid >> 6), lane = tid & 63, r = lane & 31, hh = lane >> 5;
    LDS float* LA = (LDS float*)(lds + GL_LA); LDS bf16* KT = (LDS bf16*)(lds + GL_KH); LDS bf16* VT = (LDS bf16*)(lds + GL_VT); LDS bf16* QT = (LDS bf16*)(lds + GL_QT);
    LDS bf16* ST = (LDS bf16*)(lds + GL_ST); LDS bf16* ATT = (LDS bf16*)(lds + GL_ATT); LDS float* OB = (LDS float*)(lds + GL_OB);
    const GlaUnit g = gla_unit(u);
    gla_cumsum(p, g, LA, tid);
    for (int i = tid; i < 64 * 64; i += NTHREADS) { const int s = i >> 6, kd = i & 63; float q = 0.f, k = 0.f;
        if (s < g.nv) { const bf16* z = p.Z + (size_t)(g.t0 + s) * DINP; const float b = LA[s * 65 + kd]; q = bf2f(z[ZQ + g.h * 64 + kd]) * expf(b) * 0.125f; k = bf2f(z[ZK + g.h * 64 + kd]) * expf(-b); }
        QT[s * 72 + kd] = f2bf(q); KT[s * 72 + kd] = f2bf(k); }
    for (int i = tid; i < 64 * 128; i += NTHREADS) { const int s = i >> 7, dv = i & 127;
        VT[dv * 72 + s] = s < g.nv ? p.Z[(size_t)(g.t0 + s) * DINP + ZV + g.h * 128 + dv] : (bf16)0; }
    { const float* sp = u < NGP ? p.DS + (size_t)u * 8192 : p.sgla + (size_t)(u - NGP) * 8192;
        for (int i = tid; i < 8192; i += NTHREADS) { const int kd = i >> 7, dv = i & 127; ST[dv * 72 + kd] = f2bf(sp[i]); } }
    __syncthreads();
    if (wid < 4) { const int mt = wid & 1, nt = wid >> 1; f32x16 acc = zero16();
#pragma unroll
        for (int ks = 0; ks < 4; ++ks) acc = mfma32(ld8(QT + (32 * mt + r) * 72 + 16 * ks + 8 * hh), ld8(KT + (32 * nt + r) * 72 + 16 * ks + 8 * hh), acc);
#pragma unroll
        for (int i = 0; i < 16; ++i) { const int t = 32 * mt + crow(i, hh), s = 32 * nt + r; ATT[t * 72 + s] = f2bf(s <= t ? acc[i] : 0.f); } }
    __syncthreads();
    { const int mt = wid & 1, nt = wid >> 1; f32x16 acc = zero16();
#pragma unroll
        for (int ks = 0; ks < 4; ++ks) acc = mfma32(ld8(QT + (32 * mt + r) * 72 + 16 * ks + 8 * hh), ld8(ST + (32 * nt + r) * 72 + 16 * ks + 8 * hh), acc);
#pragma unroll
        for (int ks = 0; ks < 4; ++ks) acc = mfma32(ld8(ATT + (32 * mt + r) * 72 + 16 * ks + 8 * hh), ld8(VT + (32 * nt + r) * 72 + 16 * ks + 8 * hh), acc);
#pragma unroll
        for (int i = 0; i < 16; ++i) OB[(32 * mt + crow(i, hh)) * 129 + 32 * nt + r] = acc[i]; }
    __syncthreads();
    for (int t = wid; t < g.nv; t += 8) { const float o0 = OB[t * 129 + lane], o1 = OB[t * 129 + 64 + lane]; const float ss = wsum(o0 * o0 + o1 * o1); const float rs = rsqrtf(ss * (1.0f / 128.0f) + EPS);
        const bf16* z = p.Z + (size_t)(g.t0 + t) * DINP + ZR + g.h * 128; bf16* o = p.OMIX + (size_t)(g.t0 + t) * DM + g.h * 128;
        const float r0 = bf2f(z[lane]), r1 = bf2f(z[64 + lane]);
        o[lane] = f2bf(o0 * rs * p.g_gla_o[lane] * (r0 / (1.0f + expf(-r0)))); o[64 + lane] = f2bf(o1 * rs * p.g_gla_o[64 + lane] * (r1 / (1.0f + expf(-r1)))); }
}
constexpr int PA_IMG = 0, PA_KP = 2 * 32768, PA_END = PA_KP + 2 * 128 * 40 * 2;
static_assert(PA_END <= LDS_CTL, "prompt attention LDS map");
DI void pattn_stage_load(const Params& p, size_t kr0, int h, int tid, bf16x8 (&kv)[4], bf16x8& kp) {
#pragma unroll
    for (int j = 0; j < 4; ++j) { const int c = tid + NTHREADS * j, key = c >> 4, ch = c & 15; kv[j] = ld8g(p.KV + (kr0 + key) * 1024 + h * 128 + ch * 8); }
    kp = ld8g(p.KPB + (kr0 + (tid >> 2)) * 32 + (tid & 3) * 8);
}
DI void pattn_stage_store(const Params& p, LDS unsigned char* img, LDS bf16* kpl, int tid, const bf16x8 (&kv)[4], const bf16x8& kp) {
    const int ch = tid & 15;
    f32x4 g0 = {1.f, 1.f, 1.f, 1.f}, g1 = g0; if (ch < 8) { g0 = *(const f32x4*)(p.g_kn + ch * 8); g1 = *(const f32x4*)(p.g_kn + ch * 8 + 4); }
#pragma unroll
    for (int j = 0; j < 4; ++j) { const int key = (tid + NTHREADS * j) >> 4; float f[8]; float ss = 0.f;
#pragma unroll
        for (int q = 0; q < 8; ++q) { f[q] = bf2f((bf16)kv[j][q]); ss += f[q] * f[q]; }
        ss += __shfl_xor(ss, 1); ss += __shfl_xor(ss, 2); ss += __shfl_xor(ss, 4);
        const float rs = ch < 8 ? rsqrtf(ss * (1.0f / 64.0f) + EPS) : 1.0f;
        *(LDS bf16x8*)(img + imgb(key, ch)) = pack8(f[0] * rs * g0[0], f[1] * rs * g0[1], f[2] * rs * g0[2], f[3] * rs * g0[3], f[4] * rs * g1[0], f[5] * rs * g1[1], f[6] * rs * g1[2], f[7] * rs * g1[3]); }
    *(LDS bf16x8*)(kpl + (tid >> 2) * 40 + (tid & 3) * 8) = kp;
}
DI void pattn_unit(const Params& p, LDS unsigned char* lds, int u) {
    const int tid = tid_opaque(), wid = __builtin_amdgcn_readfirstlane(tid >> 6), lane = tid & 63, r = lane & 31, hh = lane >> 5;
    const int qb = NQB - 1 - u / (BATCH * 8), bh = u % (BATCH * 8), b = bh >> 3, h = bh & 7;
    const int qw0 = qb * 256 + 32 * wid, qpos = qw0 + r; const size_t trow = (size_t)b * SEQ + qpos;
    bf16x8 kvr[4], kpr;
    pattn_stage_load(p, (size_t)b * SEQ, h, tid, kvr, kpr);
    bf16x8 qf[6];
    { float ss = 0.f, sr = 0.f; float f[6][8];
#pragma unroll
        for (int ks = 0; ks < 6; ++ks) { const bf16x8 raw = ld8g(p.QF + trow * 768 + h * 96 + 16 * ks + 8 * hh);
#pragma unroll
            for (int j = 0; j < 8; ++j) { f[ks][j] = bf2f((bf16)raw[j]); if (ks < 4) ss += f[ks][j] * f[ks][j]; else sr += f[ks][j] * f[ks][j]; } }
        ss += __shfl_xor(ss, 32); sr += __shfl_xor(sr, 32);
        const float rs = rsqrtf(ss * (1.0f / 64.0f) + EPS) * MLA_SCALE, rr = rsqrtf(sr * (1.0f / 32.0f) + EPS) * MLA_SCALE;
#pragma unroll
        for (int ks = 0; ks < 4; ++ks) { const f32x4 g0 = *(const f32x4*)(p.g_qn + 16 * ks + 8 * hh), g1 = *(const f32x4*)(p.g_qn + 16 * ks + 8 * hh + 4);
            qf[ks] = pack8(f[ks][0] * rs * g0[0], f[ks][1] * rs * g0[1], f[ks][2] * rs * g0[2], f[ks][3] * rs * g0[3], f[ks][4] * rs * g1[0], f[ks][5] * rs * g1[1], f[ks][6] * rs * g1[2], f[ks][7] * rs * g1[3]); }
        float o1[8], o2[8];
#pragma unroll
        for (int j = 0; j < 8; ++j) { const int i = 8 * hh + j; const float x1 = f[4][j] * rr * p.g_qr[i], x2 = f[5][j] * rr * p.g_qr[16 + i];
            const float ang = (float)qpos * expf(-(float)i * (9.210340371976184f / 16.0f)); const float c = cosf(ang), s = sinf(ang);
            o1[j] = x1 * c - x2 * s; o2[j] = x2 * c + x1 * s; }
        qf[4] = pack8(o1[0], o1[1], o1[2], o1[3], o1[4], o1[5], o1[6], o1[7]); qf[5] = pack8(o2[0], o2[1], o2[2], o2[3], o2[4], o2[5], o2[6], o2[7]); }
    f32x16 o0 = zero16(), o1 = zero16(); float m = -INFINITY, l = 0.f;
    const int nkt = 2 * (qb + 1);
    pattn_stage_store(p, lds + PA_IMG, (LDS bf16*)(lds + PA_KP), tid, kvr, kpr);
    __syncthreads();
    for (int kt = 0; kt < nkt; ++kt) {
        const int k0 = kt * 128; LDS unsigned char* img = lds + PA_IMG + (kt & 1) * 32768; const LDS bf16* kpl = (const LDS bf16*)(lds + PA_KP) + (kt & 1) * 128 * 40;
        if (kt + 1 < nkt) pattn_stage_load(p, (size_t)b * SEQ + k0 + 128, h, tid, kvr, kpr);
#pragma unroll 1
        for (int half = 0; half < 2; ++half) { const int kb = 64 * half;
            if (k0 + kb <= qw0 + 31) {
                f32x16 s0 = zero16(), s1 = zero16();
#pragma unroll
                for (int ks = 0; ks < 4; ++ks) { s0 = mfma32(img_row(img, kb + r, ks, hh), qf[ks], s0); s1 = mfma32(img_row(img, kb + 32 + r, ks, hh), qf[ks], s1); }
#pragma unroll
                for (int ks = 0; ks < 2; ++ks) { s0 = mfma32(ld8(kpl + (kb + r) * 40 + 16 * ks + 8 * hh), qf[4 + ks], s0); s1 = mfma32(ld8(kpl + (kb + 32 + r) * 40 + 16 * ks + 8 * hh), qf[4 + ks], s1); }
                float tmax = -INFINITY;
                if (k0 + kb + 63 > qw0) {
#pragma unroll
                    for (int i = 0; i < 16; ++i) { const int key = k0 + kb + crow(i, hh); if (key > qpos) s0[i] = -INFINITY; if (key + 32 > qpos) s1[i] = -INFINITY; } }
#pragma unroll
                for (int i = 0; i < 16; ++i) tmax = fmaxf(tmax, fmaxf(s0[i], s1[i]));
                tmax = fmaxf(tmax, __shfl_xor(tmax, 32));
                const float mn = fmaxf(m, tmax), corr = expf(m - mn); m = mn; float ps = 0.f;
#pragma unroll
                for (int i = 0; i < 16; ++i) { s0[i] = expf(s0[i] - mn); s1[i] = expf(s1[i] - mn); ps += s0[i] + s1[i]; }
                l = l * corr + ps;
#pragma unroll
                for (int i = 0; i < 16; ++i) { o0[i] *= corr; o1[i] *= corr; }
#pragma unroll
                for (int s = 0; s < 2; ++s) { const bf16x8 pa = PACK(s0, s), pb = PACK(s1, s);
                    o0 = mfma32(img_tr<true>(img, lane, 2, kb + 16 * s), pa, o0); o1 = mfma32(img_tr<true>(img, lane, 3, kb + 16 * s), pa, o1);
                    o0 = mfma32(img_tr<true>(img, lane, 2, kb + 32 + 16 * s), pb, o0); o1 = mfma32(img_tr<true>(img, lane, 3, kb + 32 + 16 * s), pb, o1); }
            }
        }
        if (kt + 1 < nkt) pattn_stage_store(p, lds + PA_IMG + ((kt + 1) & 1) * 32768, (LDS bf16*)(lds + PA_KP) + ((kt + 1) & 1) * 128 * 40, tid, kvr, kpr);
        __syncthreads();
    }
    l += __shfl_xor(l, 32); const float il = 1.0f / l;
    bf16* o = p.OMIX + trow * DM + 512 + h * 64;
#pragma unroll
    for (int g = 0; g < 4; ++g) { u32x2 w0, w1; w0[0] = pk2(o0[4 * g] * il, o0[4 * g + 1] * il); w0[1] = pk2(o0[4 * g + 2] * il, o0[4 * g + 3] * il); w1[0] = pk2(o1[4 * g] * il, o1[4 * g + 1] * il); w1[1] = pk2(o1[4 * g + 2] * il, o1[4 * g + 3] * il);
        *(u32x2*)(o + 8 * g + 4 * hh) = w0; *(u32x2*)(o + 32 + 8 * g + 4 * hh) = w1; }
}

constexpr int XA_K = 0, XA_V = 256 * 136 * 2, XA_END = XA_V + 128 * 264 * 2;
static_assert(XA_END <= LDS_CTL && XA_V % 16 == 0, "cross-attention LDS map");
DI void xattn_unit(const Params& p, LDS unsigned char* lds, int u) {
    const int tid = tid_opaque(), wid = __builtin_amdgcn_readfirstlane(tid >> 6), lane = tid & 63, r = lane & 31, hh = lane >> 5;
    LDS bf16* KX = (LDS bf16*)(lds + XA_K); LDS bf16* VX = (LDS bf16*)(lds + XA_V);
    int b, h, nrows; size_t tbase;
    if (u < NU_XP) { b = u / (4 * NQB); h = (u / NQB) & 3; const int qc = u % NQB; nrows = 256; tbase = (size_t)b * SEQ + qc * 256;
        for (int i = tid; i < 256 * 16; i += NTHREADS) { const int key = i >> 4, c8 = (i & 15) * 8; const size_t src = ((size_t)b * 256 + key) * 512 + h * 128 + c8;
            *(LDS bf16x8*)(KX + key * 136 + c8) = ld8g(p.MKB + src); const bf16x8 v = ld8g(p.MVB + src);
#pragma unroll
            for (int j = 0; j < 8; ++j) VX[(c8 + j) * 264 + key] = (bf16)v[j]; }
    } else { const int us = u - NU_XP; b = us >> 2; h = us & 3; nrows = DECS; tbase = (size_t)TP + b * DECS;
        for (int i = tid; i < 256 * 32; i += NTHREADS) { const int key = i >> 5, c4 = (i & 31) * 4; const size_t src = (((size_t)b * 256 + key) * 4 + h) * 128 + c4;
            const f32x4 k = *(const f32x4*)(p.cmk + src), v = *(const f32x4*)(p.cmv + src); u32x2 w; w[0] = pk2(k[0], k[1]); w[1] = pk2(k[2], k[3]); *(LDS u32x2*)(KX + key * 136 + c4) = w;
#pragma unroll
            for (int j = 0; j < 4; ++j) VX[(c4 + j) * 264 + key] = f2bf(v[j]); }
    }
    __syncthreads();
    if (32 * wid < nrows) {
        const bool valid = 32 * wid + r < nrows; const size_t trow = tbase + 32 * wid + (valid ? r : 0);
        bf16x8 qf[8]; float ss = 0.f;
#pragma unroll
        for (int ks = 0; ks < 8; ++ks) { qf[ks] = ld8g(p.XQ + trow * 512 + h * 128 + 16 * ks + 8 * hh);
#pragma unroll
            for (int j = 0; j < 8; ++j) { const float v = bf2f((bf16)qf[ks][j]); ss += v * v; } }
        ss += __shfl_xor(ss, 32); const float rs = valid ? rsqrtf(ss * (1.0f / 128.0f) + EPS) * X_SCALE : 0.f;
#pragma unroll
        for (int ks = 0; ks < 8; ++ks) { float q[8];
#pragma unroll
            for (int j = 0; j < 8; ++j) q[j] = bf2f((bf16)qf[ks][j]) * rs * p.g_xq[16 * ks + 8 * hh + j];
            qf[ks] = pack8(q[0], q[1], q[2], q[3], q[4], q[5], q[6], q[7]); }
        f32x16 o[4];
#pragma unroll
        for (int d = 0; d < 4; ++d) o[d] = zero16();
        float m = -INFINITY, l = 0.f;
        for (int kt = 0; kt < 4; ++kt) {
            f32x16 s0 = zero16(), s1 = zero16();
#pragma unroll
            for (int ks = 0; ks < 8; ++ks) { s0 = mfma32(ld8(KX + (64 * kt + r) * 136 + 16 * ks + 8 * hh), qf[ks], s0); s1 = mfma32(ld8(KX + (64 * kt + 32 + r) * 136 + 16 * ks + 8 * hh), qf[ks], s1); }
            float tmax = -INFINITY;
#pragma unroll
            for (int i = 0; i < 16; ++i) tmax = fmaxf(tmax, fmaxf(s0[i], s1[i]));
            tmax = fmaxf(tmax, __shfl_xor(tmax, 32));
            const float mn = fmaxf(m, tmax), corr = expf(m - mn); m = mn; float ps = 0.f;
#pragma unroll
            for (int i = 0; i < 16; ++i) { s0[i] = expf(s0[i] - mn); s1[i] = expf(s1[i] - mn); ps += s0[i] + s1[i]; }
            l = l * corr + ps;
#pragma unroll
            for (int d = 0; d < 4; ++d)
#pragma unroll
                for (int i = 0; i < 16; ++i) o[d][i] *= corr;
#pragma unroll
            for (int s = 0; s < 2; ++s) { const bf16x8 pa = PACK(s0, s), pb = PACK(s1, s);
#pragma unroll
                for (int d = 0; d < 4; ++d) { o[d] = mfma32(ldperm(VX + (32 * d + r) * 264 + 64 * kt + 16 * s, hh), pa, o[d]); o[d] = mfma32(ldperm(VX + (32 * d + r) * 264 + 64 * kt + 32 + 16 * s, hh), pb, o[d]); } }
        }
        l += __shfl_xor(l, 32); const float il = 1.0f / l;
        if (valid) { bf16* op = p.XO + trow * 512 + h * 128;
#pragma unroll
            for (int d = 0; d < 4; ++d)
#pragma unroll
                for (int g = 0; g < 4; ++g) { u32x2 w; w[0] = pk2(o[d][4 * g] * il, o[d][4 * g + 1] * il); w[1] = pk2(o[d][4 * g + 2] * il, o[d][4 * g + 3] * il); *(u32x2*)(op + 32 * d + 8 * g + 4 * hh) = w; } }
    }
}
constexpr int SA_F32 = 0, SA_KPF = 65536, SA_CK = SA_KPF + 8192, SA_KP = SA_CK + 32768, SA_P = SA_KP + 64 * 40 * 2, SA_QS = SA_P + 64 * 72 * 2, SA_CORR = SA_QS + 65 * 104 * 2, SA_END = SA_CORR + 1024;
static_assert(SA_END <= LDS_CTL && SA_KP % 16 == 0 && SA_P % 16 == 0 && SA_QS % 16 == 0 && SA_CORR % 16 == 0, "sample attention LDS map");
DI void sattn_issue(const Params& p, LDS unsigned char* lds, int pid, int half, int wid, int lane) {
    const size_t key0 = (size_t)pid * PAGE + half * 64;
#pragma unroll
    for (int i = 0; i < 8; ++i) { const int key = wid * 8 + i; dma16(p.cckv + (key0 + key) * 256 + lane * 4, lds + SA_F32 + key * 1024); }
    dma16(p.ckpe + (key0 + wid * 8 + (lane >> 3)) * 32 + (lane & 7) * 4, lds + SA_KPF + wid * 1024);
}
DI void sattn_convert(LDS unsigned char* lds) {
    const int tid = tid_opaque();
#pragma unroll
    for (int j = 0; j < 4; ++j) { const int i = tid + NTHREADS * j, key = i >> 5, c32 = i & 31;
        const f32x4 a = *(const LDS f32x4*)(lds + SA_F32 + key * 1024 + c32 * 32), bq = *(const LDS f32x4*)(lds + SA_F32 + key * 1024 + c32 * 32 + 16);
        u32x4 w; w[0] = pk2(a[0], a[1]); w[1] = pk2(a[2], a[3]); w[2] = pk2(bq[0], bq[1]); w[3] = pk2(bq[2], bq[3]);
        *(LDS u32x4*)(lds + SA_CK + (c32 >> 4) * 16384 + imgb(key, c32 & 15)) = w; }
    { const int key = tid >> 3, c4 = (tid & 7) * 4; const f32x4 v = *(const LDS f32x4*)(lds + SA_KPF + key * 128 + c4 * 4); u32x2 w; w[0] = pk2(v[0], v[1]); w[1] = pk2(v[2], v[3]);
        *(LDS u32x2*)(lds + SA_KP + (key * 40 + c4) * 2) = w; }
}
DI void sattn_unit(const Params& p, LDS unsigned char* lds, int u) {
    const int tid = tid_opaque(), wid = __builtin_amdgcn_readfirstlane(tid >> 6), lane = tid & 63, r = lane & 31, hh = lane >> 5;
    LDS unsigned char* CK = lds + SA_CK; LDS bf16* KP = (LDS bf16*)(lds + SA_KP); LDS bf16* PA = (LDS bf16*)(lds + SA_P);
    LDS bf16* QS = (LDS bf16*)(lds + SA_QS); LDS float* CORR = (LDS float*)(lds + SA_CORR);
    const int b = u / NSPLIT, sp = u % NSPLIT; const int h = wid;
    const int pidv = p.ptab[b * NPAGES + sp * PPS + (lane % PPS)];
    sattn_issue(p, lds, rdlane(pidv, 0), 0, wid, lane);
    for (int i = tid; i < 65 * 96; i += NTHREADS) { const int row = i / 96, d = i % 96; float v = 0.f;
        if (row < 64) { const int hq = row >> 3, q = row & 7; v = bf2f(p.QN[(((size_t)TP + b * DECS + q) * 8 + hq) * 96 + d]); if (d < 64) v *= p.g_kn[d]; }
        QS[row * 104 + d] = f2bf(v); }
    const int l15 = lane & 15, quad = lane >> 4;
    bf16x8 wk[4][8];
    { const bf16* wkp = p.wt_kvb + (size_t)(h * 128 + l15) * 256 + 8 * quad;
#pragma unroll
        for (int dt = 0; dt < 4; ++dt)
#pragma unroll
            for (int ks = 0; ks < 8; ++ks) wk[dt][ks] = ld8g(wkp + dt * 16 * 256 + 32 * ks); }
#ifndef EMU
#pragma unroll
    for (int dt = 0; dt < 4; ++dt)
#pragma unroll
        for (int ks = 0; ks < 8; ++ks) asm volatile("" : "+v"(wk[dt][ks]));
#endif
    const int qrow = l15 < 8 ? h * 8 + l15 : 64;
    f32x16 acc0 = zero16(), acc1 = zero16(); float m = -INFINITY, l = 0.f;
    const int npt = PPS * 2, ntile = npt + (sp == NSPLIT - 1 ? 1 : 0);
    wait_vm0(); bar_lds(); sattn_convert(lds); bar_lds();
    for (int tile = 0; tile < ntile; ++tile) {
        const bool newt = tile == npt;
        unsigned lo_ = lane;
#ifndef EMU
        asm volatile("" : "+v"(lo_));
#endif
        const unsigned l15o = lo_ & 15, quado = lo_ >> 4;
        if (tile + 1 < npt) sattn_issue(p, lds, rdlane(pidv, (tile + 1) >> 1), (tile + 1) & 1, wid, lane);
#pragma unroll 1
        for (int kg = 0; kg < 4; ++kg) {
            f32x4 x[4];
#pragma unroll
            for (int dt = 0; dt < 4; ++dt) x[dt] = (f32x4){0.f, 0.f, 0.f, 0.f};
#pragma unroll
            for (int ks = 0; ks < 8; ++ks) { const bf16x8 cb = *(const LDS bf16x8*)(CK + (ks >> 2) * 16384 + imgb(16 * kg + l15o, 4 * (ks & 3) + quado));
#pragma unroll
                for (int dt = 0; dt < 4; ++dt) x[dt] = __builtin_amdgcn_mfma_f32_16x16x32_bf16(wk[dt][ks], cb, x[dt], 0, 0, 0); }
            float ss = 0.f;
#pragma unroll
            for (int dt = 0; dt < 4; ++dt) ss += x[dt][0] * x[dt][0] + x[dt][1] * x[dt][1] + x[dt][2] * x[dt][2] + x[dt][3] * x[dt][3];
            ss += __shfl_xor(ss, 16); ss += __shfl_xor(ss, 32); const float inv = rsqrtf(ss * (1.0f / 64.0f) + EPS);
            f32x4 z = {0.f, 0.f, 0.f, 0.f};
#pragma unroll
            for (int pp = 0; pp < 2; ++pp) {
                const bf16x8 a = pack8(x[2 * pp][0] * inv, x[2 * pp][1] * inv, x[2 * pp][2] * inv, x[2 * pp][3] * inv, x[2 * pp + 1][0] * inv, x[2 * pp + 1][1] * inv, x[2 * pp + 1][2] * inv, x[2 * pp + 1][3] * inv);
                const s16x4 q0 = *(const LDS s16x4*)(QS + qrow * 104 + 32 * pp + 4 * quad), q1 = *(const LDS s16x4*)(QS + qrow * 104 + 32 * pp + 16 + 4 * quad);
                z = __builtin_amdgcn_mfma_f32_16x16x32_bf16(a, __builtin_shufflevector(q0, q1, 0, 1, 2, 3, 4, 5, 6, 7), z, 0, 0, 0); }
            z = __builtin_amdgcn_mfma_f32_16x16x32_bf16(ld8(KP + (16 * kg + l15) * 40 + 8 * quad), ld8(QS + qrow * 104 + 64 + 8 * quad), z, 0, 0, 0);
            float tmax = -INFINITY;
#pragma unroll
            for (int j = 0; j < 4; ++j) { const int key = 16 * kg + 4 * quad + j; if (newt && (key > l15 || key >= DECS)) z[j] = -INFINITY; tmax = fmaxf(tmax, z[j]); }
            tmax = fmaxf(tmax, __shfl_xor(tmax, 16)); tmax = fmaxf(tmax, __shfl_xor(tmax, 32));
            if (l15 >= 8 || (newt && kg > 0)) tmax = fmaxf(tmax, -1e30f);
            const float mn = fmaxf(m, tmax), corr = expf(m - mn); m = mn;
#pragma unroll
            for (int j = 0; j < 4; ++j) z[j] = expf(z[j] - mn);
            l = l * corr + (z[0] + z[1]) + (z[2] + z[3]);
            if (l15 < 8) { u32x2 w; w[0] = pk2(z[0], z[1]); w[1] = pk2(z[2], z[3]); *(LDS u32x2*)(PA + (h * 8 + l15) * 72 + 16 * kg + 4 * quad) = w;
                if (quad == 0) CORR[kg * 64 + h * 8 + l15] = corr; }
        }
        bar_lds();
#pragma unroll
        for (int ks = 0; ks < 4; ++ks) { const float c0 = CORR[ks * 64 + r], c1 = CORR[ks * 64 + 32 + r];
#pragma unroll
            for (int i = 0; i < 16; ++i) { acc0[i] *= c0; acc1[i] *= c1; }
            const bf16x8 a = img_tr<false>(CK + (wid >> 2) * 16384, lo_, wid & 3, 16 * ks);
            acc0 = mfma32(a, ld8(PA + r * 72 + 16 * ks + 8 * hh), acc0); acc1 = mfma32(a, ld8(PA + (32 + r) * 72 + 16 * ks + 8 * hh), acc1); }
        if (tile + 1 < ntile) {
            if (tile + 1 < npt) { wait_vm0(); bar_lds(); sattn_convert(lds); }
            else { bar_lds(); const size_t t0 = (size_t)TP + b * DECS;
                for (int i = tid; i < 64 * 32; i += NTHREADS) { const int key = i >> 5, c32 = i & 31; bf16x8 v = zero8(); if (key < DECS) v = ld8g(p.CKVB + (t0 + key) * 256 + c32 * 8);
                    *(LDS bf16x8*)(CK + (c32 >> 4) * 16384 + imgb(key, c32 & 15)) = v; }
                for (int i = tid; i < 64 * 32; i += NTHREADS) { const int key = i >> 5, c = i & 31; KP[key * 40 + c] = key < DECS ? p.KPB[(t0 + key) * 32 + c] : (bf16)0; } }
            bar_lds();
        }
    }
    { const int t2 = tid_opaque(), w2 = __builtin_amdgcn_readfirstlane(t2 >> 6), l2 = t2 & 63, r2 = l2 & 31, h2 = l2 >> 5;
        float* pa = p.PACC + (size_t)u * 64 * 256;
#pragma unroll
        for (int g = 0; g < 4; ++g) { f32x4 v0 = {acc0[4 * g], acc0[4 * g + 1], acc0[4 * g + 2], acc0[4 * g + 3]}, v1 = {acc1[4 * g], acc1[4 * g + 1], acc1[4 * g + 2], acc1[4 * g + 3]};
            *(f32x4*)(pa + (size_t)r2 * 256 + 32 * w2 + 8 * g + 4 * h2) = v0; *(f32x4*)(pa + (size_t)(32 + r2) * 256 + 32 * w2 + 8 * g + 4 * h2) = v1; }
        l += __shfl_xor(l, 16); l += __shfl_xor(l, 32);
        if (l2 < 8) { p.PML[((size_t)u * 64 + w2 * 8 + r2) * 2] = m; p.PML[((size_t)u * 64 + w2 * 8 + r2) * 2 + 1] = l; } }
}
DI void phase_sattn_combine(const Params& p, LDS unsigned char* lds) {
    const int tid = tid_opaque();
    LDS float* AC = (LDS float*)lds; LDS float* WS = (LDS float*)(lds + 8 * 256 * 4);
    for (int u = blockIdx.x; u < DECB * 8; u += gridDim.x) { const int b = u >> 3, h = u & 7;
        if (tid < 8) { const int hq = h * 8 + tid; float M = -INFINITY; for (int j = 0; j < NSPLIT; ++j) M = fmaxf(M, p.PML[((size_t)(b * NSPLIT + j) * 64 + hq) * 2]);
            float L = 0.f; for (int j = 0; j < NSPLIT; ++j) { const float w = expf(p.PML[((size_t)(b * NSPLIT + j) * 64 + hq) * 2] - M); WS[tid * NSPLIT + j] = w; L += w * p.PML[((size_t)(b * NSPLIT + j) * 64 + hq) * 2 + 1]; }
            const float iL = 1.0f / L; for (int j = 0; j < NSPLIT; ++j) WS[tid * NSPLIT + j] *= iL; }
        __syncthreads();
        { const int q = tid >> 6, l4 = (tid & 63) * 4; f32x4 s = {0.f, 0.f, 0.f, 0.f};
#pragma unroll
            for (int j = 0; j < NSPLIT; ++j) s += WS[q * NSPLIT + j] * *(const f32x4*)(p.PACC + ((size_t)(b * NSPLIT + j) * 64 + h * 8 + q) * 256 + l4);
            *(LDS f32x4*)(AC + q * 256 + l4) = s; }
        __syncthreads();
        { const int q = tid >> 6, dv = tid & 63; const bf16* w = p.wt_kvb + (size_t)(h * 128 + 64 + dv) * 256; float s = 0.f;
#pragma unroll 4
            for (int c = 0; c < 32; ++c) { const bf16x8 wv = ld8g(w + 8 * c); const f32x4 a0 = *(const LDS f32x4*)(AC + q * 256 + 8 * c), a1 = *(const LDS f32x4*)(AC + q * 256 + 8 * c + 4);
                s += a0[0] * bf2f((bf16)wv[0]) + a0[1] * bf2f((bf16)wv[1]) + a0[2] * bf2f((bf16)wv[2]) + a0[3] * bf2f((bf16)wv[3]) + a1[0] * bf2f((bf16)wv[4]) + a1[1] * bf2f((bf16)wv[5]) + a1[2] * bf2f((bf16)wv[6]) + a1[3] * bf2f((bf16)wv[7]); }
            p.OMIX[((size_t)TP + b * DECS + q) * DM + 512 + h * 64 + dv] = f2bf(s); }
        __syncthreads();
    }
}
#ifndef EMU
#define XB_TMO      128
#define XB_XCNT(j)  (256  + 64 * (j))
#define XB_XSUB(j)  (1280 + 64 * (j))
#define XB_XGEN(j)  (2304 + 64 * (j))
#define XB_TOP      3328
#define XB_TOPGEN   3392
#define XCD_BAR_WORDS 3456
#define XB_SPIN_CAP (1u << 18)
#define LAS __attribute__((address_space(3)))
__device__ __forceinline__ unsigned xb_ld(unsigned* p)              { return __hip_atomic_load(p, __ATOMIC_RELAXED, __HIP_MEMORY_SCOPE_AGENT); }
__device__ __forceinline__ unsigned xb_add(unsigned* p, unsigned v) { return __hip_atomic_fetch_add(p, v, __ATOMIC_RELAXED, __HIP_MEMORY_SCOPE_AGENT); }
__device__ __forceinline__ unsigned xb_xcc_id() { return (unsigned)__builtin_amdgcn_s_getreg((3 << 11) | 20) & 0xFu; }
#define XB_SPIN(cond, bar) do { unsigned _sp = 0; while (cond) { __builtin_amdgcn_s_sleep(1); \
    if ((++_sp & 255u) == 0u) { if (xb_ld(&(bar)[XB_TMO])) break; if (_sp > XB_SPIN_CAP) { atomicAdd(&(bar)[XB_TMO], 1u); break; } } } } while (0)
struct XcdBarrier { unsigned* bar; unsigned x; volatile LAS unsigned* st; };
__device__ __forceinline__ XcdBarrier xcd_barrier_post(unsigned* bar, volatile LAS unsigned* st) {
    XcdBarrier b; b.bar = bar; b.x = xb_xcc_id(); b.st = st;
    if (threadIdx.x == 0) (void)xb_add(&bar[XB_XCNT(b.x)], 1u);
    return b;
}
__device__ __forceinline__ void xcd_barrier_complete(unsigned* bar, unsigned x, unsigned& nloc, unsigned& nx) {
    const unsigned G = gridDim.x * gridDim.y * gridDim.z;
    unsigned sum, cnt, mine, sp = 0u;
    for (;;) {
        sum = 0u; cnt = 0u; mine = 0u;
#pragma unroll
        for (unsigned j = 0; j < 16; ++j) { const unsigned c = xb_ld(&bar[XB_XCNT(j)]); sum += c; cnt += (c > 0u) ? 1u : 0u; mine = (j == x) ? c : mine; }
        if (sum == G) break;
        __builtin_amdgcn_s_sleep(1);
        if ((++sp & 255u) == 0u) { if (xb_ld(&bar[XB_TMO])) break; if (sp > XB_SPIN_CAP) { atomicAdd(&bar[XB_TMO], 1u); break; } }
    }
    nloc = mine > 0u ? mine : 1u; nx = cnt > 0u ? cnt : 1u;
}
__device__ __forceinline__ void xcd_barrier(const XcdBarrier& b) {
    asm volatile("s_waitcnt vmcnt(0)" ::: "memory");
    __syncthreads();
    if (threadIdx.x == 0) {
        unsigned* bar = b.bar;
        __builtin_amdgcn_s_waitcnt(0);
        unsigned nloc = b.st[0], nx = b.st[1];
        if (nloc == 0u) { xcd_barrier_complete(bar, b.x, nloc, nx); b.st[0] = nloc; b.st[1] = nx; }
        const unsigned old = xb_add(&bar[XB_XSUB(b.x)], 1u);
        const unsigned gen = old / nloc;
        if (old + 1u == (gen + 1u) * nloc) {
            __builtin_amdgcn_fence(__ATOMIC_RELEASE, "agent");
            asm volatile("s_waitcnt vmcnt(0)" ::: "memory");
            const unsigned og = xb_add(&bar[XB_TOP], 1u);
            const unsigned tg = og / nx;
            if (og + 1u == (tg + 1u) * nx) xb_add(&bar[XB_TOPGEN], 1u);
            else XB_SPIN(xb_ld(&bar[XB_TOPGEN]) == tg, bar);
            __builtin_amdgcn_fence(__ATOMIC_ACQUIRE, "agent");
            xb_add(&bar[XB_XGEN(b.x)], 1u);
            asm volatile("s_waitcnt vmcnt(0)" ::: "memory");
        } else {
            XB_SPIN(xb_ld(&bar[XB_XGEN(b.x)]) == gen, bar);
            __builtin_amdgcn_fence(__ATOMIC_ACQUIRE, "agent");
            asm volatile("s_waitcnt vmcnt(0)" ::: "memory");
        }
    }
    __syncthreads();
}
#endif

DI int wq_next(unsigned* ctr, LDS unsigned* slot) {
    __syncthreads();
    if (threadIdx.x == 0) *slot = atomicAdd(ctr, 1u);
    __syncthreads();
    return __builtin_amdgcn_readfirstlane((int)*slot);
}
struct EpiResF32 {
    static constexpr bool PERM = false, AFTER_DRAIN = false;
    float* C; const float* R0; const float* R1; int split;
    DI void operator()(const f32x4 (&acc)[2][2][4][2], const pg8::Unit& u, int wr, int wc, int fr, int fq) const {
        const int row0 = u.pm * 256 + wr * 64 + fr, col0 = u.pn * 256 + wc * 32 + 4 * fq;
        const float* R = row0 < split ? R0 : R1 - (size_t)split * DM;
#pragma unroll
        for (int ai = 0; ai < 2; ++ai)
#pragma unroll
            for (int mp = 0; mp < 2; ++mp) { f32x4 rr[2][2][2];
#pragma unroll
                for (int mm = 0; mm < 2; ++mm) { const size_t off = (size_t)(row0 + ai * 128 + (2 * mp + mm) * 16) * DM + col0;
#pragma unroll
                    for (int bj = 0; bj < 2; ++bj)
#pragma unroll
                        for (int n = 0; n < 2; ++n) rr[mm][bj][n] = *(const f32x4*)(R + off + bj * 128 + n * 16); }
#pragma unroll
                for (int mm = 0; mm < 2; ++mm) { const size_t off = (size_t)(row0 + ai * 128 + (2 * mp + mm) * 16) * DM + col0;
#pragma unroll
                    for (int bj = 0; bj < 2; ++bj)
#pragma unroll
                        for (int n = 0; n < 2; ++n) *(f32x4*)(C + off + bj * 128 + n * 16) = acc[ai][bj][2 * mp + mm][n] + rr[mm][bj][n]; }
#ifndef EMU
                asm volatile("" ::: "memory");
#endif
            }
    }
};
DI void phase_norm_rows(const Params& p, const float* X, const float* g) {
    const int tid = tid_opaque(), wid = __builtin_amdgcn_readfirstlane(tid >> 6), lane = tid & 63;
    for (int row = blockIdx.x * 8 + wid; row < T; row += gridDim.x * 8) rmsnorm_row_1024(X + (size_t)row * DM, g, p.H + (size_t)row * DM, lane);
}
constexpr int NPHASE = 15;
template <int PH> DI void run_phase(const Params& p, LDS unsigned char* lds) {
    LDS unsigned* slot = (LDS unsigned*)(lds + LDS_CTL + 64);
    if constexpr (PH == 0) phase_prep(p, lds);
    else if constexpr (PH == 1) { run_gemm(lds, p.H, p.wt_in, T, DINP, DM, EpiStoreBf16<0>{p.Z, DINP}, 0); run_gemm(lds, p.MEMN, p.wt_xkv, MROWS, 1024, DM, EpiStoreF32{p.MKV, nullptr, 1024}, 100); }
    else if constexpr (PH == 2) { phase_post_in(p); if (DUPM & 8) phase_post_in(p); }
    else if constexpr (PH == 3) { run_gemm(lds, p.QAN, p.wt_qb, T, 768, 384, EpiStoreBf16<0>{p.QF, 768}, 0); run_gemm(lds, p.CKVB, p.wt_kvb, T, 1024, 256, EpiStoreBf16<0>{p.KV, 1024}, 140); __syncthreads(); phase_gla_a(p, lds); }
    else if constexpr (PH == 4) { phase_post_qkv(p); if (DUPM & 16) phase_post_qkv(p); phase_gla_b(p); }
    else if constexpr (PH == 5) {
        for (int rep = 0; rep < ((DUPM & 1) ? 2 : 1); ++rep) for (;;) { const int u = wq_next(p.ctl + CW_Q5 + 192 * rep, slot); if (u >= NU_SA) break; sattn_unit(p, lds, u); }
        for (int rep = 0; rep < ((DUPM & 2) ? 2 : 1); ++rep) for (;;) { const int u = wq_next(p.ctl + CW_Q5 + 64 + 192 * rep, slot); if (u >= NU_PA) break; pattn_unit(p, lds, u); }
        for (int rep = 0; rep < ((DUPM & 4) ? 2 : 1); ++rep) for (;;) { const int u = wq_next(p.ctl + CW_Q5 + 128 + 192 * rep, slot); if (u >= NGU) break; gla_c_unit(p, lds, u); } }
    else if constexpr (PH == 6) phase_sattn_combine(p, lds);
    else if constexpr (PH == 7) run_gemm(lds, p.OMIX, p.wt_out, T, DM, DM, EpiResF32{p.X1, p.xp, p.xs, TP}, 0);
    else if constexpr (PH == 8) phase_norm_rows(p, p.X1, p.g_x);
    else if constexpr (PH == 9) run_gemm(lds, p.H, p.wt_xq, T, 512, DM, EpiStoreBf16<0>{p.XQ, 512}, 0);
    else if constexpr (PH == 10) { unsigned* ctr = p.ctl + CW_QX; if (DUPP & (1 << 10)) { __syncthreads(); if (*(volatile unsigned*)ctr >= (unsigned)(NU_XS + NU_XP) ) ctr += 64; }
        for (;;) { const int u = wq_next(ctr, slot); if (u >= NU_XS + NU_XP) break; xattn_unit(p, lds, u < NU_XS ? NU_XP + u : u - NU_XS); } }
    else if constexpr (PH == 11) run_gemm(lds, p.XO, p.wt_xo, T, DM, 512, EpiResF32{p.X2, p.X1, p.X1, T}, 0);
    else if constexpr (PH == 12) phase_norm_rows(p, p.X2, p.g_ff);
    else if constexpr (PH == 13) run_gemm(lds, p.H, p.wt_ff1, T, DFF, DM, EpiStoreBf16<1>{p.U, DFF}, 0);
    else if constexpr (PH == 14) run_gemm(lds, p.U, p.wt_ff2, T, DM, DFF, EpiResF32{p.y, p.X2, p.X2, T}, 0);
}
#ifdef EMU
#define GET_LDS() ((LDS unsigned char*)EMU_SMEM())
#define GRID_BAR() emu_grid_barrier()
#else
#define GET_LDS() ((LDS unsigned char*)lds_raw)
#define GRID_BAR() xcd_barrier(bar)
#endif
template <int PH> __global__ void __launch_bounds__(NTHREADS, 2) k_phase(Params p) {
#ifndef EMU
    extern __shared__ __attribute__((aligned(16))) unsigned char lds_raw[];
#endif
    run_phase<PH>(p, GET_LDS());
}
#if N_LAUNCH_MODE == 1
__global__ void __launch_bounds__(NTHREADS, 2) k_mega(Params p) {
#ifndef EMU
    extern __shared__ __attribute__((aligned(16))) unsigned char lds_raw[];
    LDS unsigned char* lds = GET_LDS();
    if (threadIdx.x < 64) ((LDS unsigned*)(lds + LDS_CTL))[threadIdx.x] = 0u;
    __syncthreads();
    XcdBarrier bar = xcd_barrier_post(p.ctl + CW_BAR, (volatile LDS unsigned*)(lds + LDS_CTL));
#else
    LDS unsigned char* lds = GET_LDS();
#endif
    run_phase<0>(p, lds); if (DUPP & (1 << 0)) run_phase<0>(p, lds); GRID_BAR();
    run_phase<1>(p, lds); if (DUPP & (1 << 1)) run_phase<1>(p, lds); GRID_BAR();
    run_phase<2>(p, lds); if (DUPP & (1 << 2)) run_phase<2>(p, lds); GRID_BAR();
    run_phase<3>(p, lds); if (DUPP & (1 << 3)) run_phase<3>(p, lds); GRID_BAR();
    run_phase<4>(p, lds); GRID_BAR();
    run_phase<5>(p, lds); GRID_BAR();
    run_phase<6>(p, lds); if (DUPP & (1 << 6)) run_phase<6>(p, lds); GRID_BAR();
    run_phase<7>(p, lds); if (DUPP & (1 << 7)) run_phase<7>(p, lds); GRID_BAR();
    run_phase<8>(p, lds); if (DUPP & (1 << 8)) run_phase<8>(p, lds); GRID_BAR();
    run_phase<9>(p, lds); if (DUPP & (1 << 9)) run_phase<9>(p, lds); GRID_BAR();
    run_phase<10>(p, lds); if (DUPP & (1 << 10)) run_phase<10>(p, lds); GRID_BAR();
    run_phase<11>(p, lds); if (DUPP & (1 << 11)) run_phase<11>(p, lds); GRID_BAR();
    run_phase<12>(p, lds); if (DUPP & (1 << 12)) run_phase<12>(p, lds); GRID_BAR();
    run_phase<13>(p, lds); if (DUPP & (1 << 13)) run_phase<13>(p, lds); GRID_BAR();
    run_phase<14>(p, lds); if (DUPP & (1 << 14)) run_phase<14>(p, lds);
}
#endif

static size_t ws_take(size_t& off, size_t bytes) { const size_t o = off; off = (off + bytes + 255) & ~(size_t)255; return o; }
template <int PH> static void launch_phase(const Params& p, int grid, hipStream_t stream) {
#ifndef EMU
    static bool attr = false; if (!attr) { (void)hipFuncSetAttribute((const void*)k_phase<PH>, hipFuncAttributeMaxDynamicSharedMemorySize, LDS_BYTES); attr = true; }
#endif
    LAUNCH(k_phase<PH>, dim3(grid), dim3(NTHREADS), LDS_BYTES, stream, p);
}
extern "C" void kernel_launch(void* const* d_in, const int* in_sizes, int n_in, void* d_out, int out_size, void* d_ws, size_t ws_size, hipStream_t stream) {
    Params p{};
    const float* const* in = (const float* const*)d_in;
    p.xp = in[0]; p.xs = in[1]; p.memp = in[2]; p.cckv = in[3]; p.ckpe = in[4]; p.cmk = in[5]; p.cmv = in[6]; p.sgla = in[7]; p.ptab = (const int*)d_in[8];
    p.g_mix = in[9]; p.w_a2 = in[11]; p.b_a = in[12]; p.g_gla_o = in[13]; p.g_qa = in[14]; p.g_kva = in[16]; p.g_qn = in[18]; p.g_kn = in[19]; p.g_qr = in[20]; p.g_kr = in[21];
    p.g_x = in[23]; p.g_mem = in[24]; p.g_xq = in[28]; p.g_xk = in[29]; p.g_ff = in[31];
    float* out = (float*)d_out; size_t oo = 0;
    p.y = out; oo += (size_t)T * DM; p.o_ckvp = out + oo; oo += (size_t)TP * 256; p.o_kpep = out + oo; oo += (size_t)TP * 32; p.o_mkp = out + oo; oo += (size_t)MROWS * 512; p.o_mvp = out + oo; oo += (size_t)MROWS * 512;
    p.o_glap = out + oo; oo += (size_t)BATCH * 4 * 8192; p.o_ckvs = out + oo; oo += (size_t)TS * 256; p.o_kpes = out + oo; oo += (size_t)TS * 32; p.o_glas = out + oo; oo += (size_t)DECB * 4 * 8192;
    if ((size_t)out_size != oo || n_in != 34) { fprintf(stderr, "kernel_launch: unexpected sizes (out %d vs %zu, n_in %d)\n", out_size, oo, n_in); }
    unsigned char* ws = (unsigned char*)d_ws; size_t off = 0;
    p.ctl = (unsigned*)(ws + ws_take(off, 1 << 20));
#define WSB(name, elems) p.name = (bf16*)(ws + ws_take(off, (size_t)(elems) * 2))
#define WSF(name, elems) p.name = (float*)(ws + ws_take(off, (size_t)(elems) * 4))
    WSB(wt_in, (size_t)DINP * DM); WSB(wt_qb, 768 * 384); WSB(wt_kvb, 1024 * 256); WSB(wt_out, DM * DM); WSB(wt_xq, 512 * DM); WSB(wt_xkv, 1024 * DM); WSB(wt_xo, DM * 512); WSB(wt_ff1, (size_t)DFF * DM); WSB(wt_ff2, (size_t)DM * DFF);
    WSB(H, (size_t)T * DM); WSB(MEMN, (size_t)MROWS * DM); WSB(Z, (size_t)T * DINP); WSB(QAN, (size_t)T * 384); WSB(CKVB, (size_t)T * 256); WSB(KPB, (size_t)T * 32); WSB(MKB, (size_t)MROWS * 512); WSB(MVB, (size_t)MROWS * 512);
    WSB(QF, (size_t)T * 768); WSB(KV, (size_t)T * 1024); WSB(QN, (size_t)T * 768); WSB(KN, (size_t)T * 512); WSB(OMIX, (size_t)T * DM); WSB(XQ, (size_t)T * 512); WSB(XO, (size_t)T * 512); WSB(U, (size_t)T * DFF);
    WSF(MKV, (size_t)MROWS * 1024); WSF(LOGA, (size_t)T * 256); WSF(DS, (size_t)NGU * 8192); WSF(DDEC, (size_t)NGU * 64); WSF(X1, (size_t)T * DM); WSF(X2, (size_t)T * DM); WSF(PACC, (size_t)NU_SA * 64 * 256); WSF(PML, (size_t)NU_SA * 128);
    if (off > ws_size) { fprintf(stderr, "kernel_launch: workspace too small (%zu > %zu)\n", off, ws_size); return; }
    p.w_in = in[10]; p.w_qb = in[15]; p.w_kvb = in[17]; p.w_out = in[22]; p.w_xq = in[25]; p.w_xk = in[26]; p.w_xv = in[27]; p.w_xo = in[30]; p.w_ff1 = in[32]; p.w_ff2 = in[33];
    (void)hipMemsetAsync(p.ctl, 0, 1 << 20, stream);
#ifdef EMU
    const int grid = EMU_GRID;
#else
    static int grid = 0;
    if (!grid) { int dev = 0, cus = 0; (void)hipGetDevice(&dev); (void)hipDeviceGetAttribute(&cus, hipDeviceAttributeMultiprocessorCount, dev); grid = cus > 0 ? cus : 256;
#if N_LAUNCH_MODE == 1
        (void)hipFuncSetAttribute((const void*)k_mega, hipFuncAttributeMaxDynamicSharedMemorySize, LDS_BYTES);
        int per_cu = 0; if (hipOccupancyMaxActiveBlocksPerMultiprocessor(&per_cu, (const void*)k_mega, NTHREADS, LDS_BYTES) != hipSuccess || per_cu < 1) fprintf(stderr, "kernel_launch: occupancy query reports %d workgroups per CU\n", per_cu);
#endif
    }
#endif
#if N_LAUNCH_MODE == 1
    LAUNCH(k_mega, dim3(grid), dim3(NTHREADS), LDS_BYTES, stream, p);
#else
    launch_phase<0>(p, grid, stream); launch_phase<1>(p, grid, stream); launch_phase<2>(p, grid, stream); launch_phase<3>(p, grid, stream); launch_phase<4>(p, grid, stream);
    launch_phase<5>(p, grid, stream); launch_phase<6>(p, grid, stream); launch_phase<7>(p, grid, stream); launch_phase<8>(p, grid, stream); launch_phase<9>(p, grid, stream);
    launch_phase<10>(p, grid, stream); launch_phase<11>(p, grid, stream); launch_phase<12>(p, grid, stream); launch_phase<13>(p, grid, stream); launch_phase<14>(p, grid, stream);
#endif
}
```

```cpp
#ifdef EMU
#include "emu.h"
#define LDS
#else
#include <hip/hip_runtime.h>
#define LDS __attribute__((address_space(3)))
#define LAUNCH(kern, grid, block, smem, stream, ...) kern<<<grid, block, smem, stream>>>(__VA_ARGS__)
#endif
#include <cstdio>
#include <cstdint>
#include <cmath>
#define DI __device__ __forceinline__

#ifndef CFG_BATCH
#define CFG_BATCH 16
#define CFG_SEQ 2048
#define CFG_DECB 128
#define CFG_PAST 8192
#endif
#ifndef DUPP
#define DUPP 0
#endif
#ifndef DUPM
#define DUPM 0
#endif
#ifndef N_LAUNCH_MODE
#define N_LAUNCH_MODE 1
#endif

typedef unsigned short bf16;
typedef short bf16x8 __attribute__((ext_vector_type(8)));
typedef short s16x4 __attribute__((ext_vector_type(4)));
typedef float f32x4 __attribute__((ext_vector_type(4)));
typedef float f32x16 __attribute__((ext_vector_type(16)));
typedef unsigned u32x4 __attribute__((ext_vector_type(4)));
typedef unsigned u32x2 __attribute__((ext_vector_type(2)));

constexpr int DM = 1024, BATCH = CFG_BATCH, SEQ = CFG_SEQ, DECB = CFG_DECB, DECS = 8, PAST = CFG_PAST, PAGE = 128, NPAGES = PAST / PAGE;
constexpr int NMEM = 256, TP = BATCH * SEQ, TS = DECB * DECS, T = TP + TS, MROWS = BATCH * NMEM;
constexpr int DIN = 2224, DINP = 2304, DFF = 4096;
constexpr int ZQ = 0, ZK = 256, ZV = 512, ZR = 1024, ZA = 1536, ZQA = 1552, ZKVA = 1936, ZKPE = 2192;
constexpr float EPS = 1e-6f, MLA_SCALE = 0.10206207261596577f  , X_SCALE = 0.08838834764831845f  ;
constexpr int NC = SEQ / 64;
constexpr int NGP = BATCH * 4 * NC, NGS = DECB * 4, NGU = NGP + NGS;
constexpr int NSPLIT = NPAGES >= 8 ? 8 : NPAGES, PPS = NPAGES / NSPLIT;
constexpr int NU_SA = DECB * NSPLIT, NQB = SEQ / 256, NU_PA = BATCH * 8 * NQB;
constexpr int NU_XP = BATCH * 4 * NQB, NU_XS = DECB * 4;
static_assert(T % 256 == 0 && MROWS % 256 == 0 && SEQ % 256 == 0 && NPAGES % NSPLIT == 0, "shape assumptions");
constexpr int NTHREADS = 512, LDS_BYTES = 147456, LDS_CTL = LDS_BYTES - 256;

DI int tid_opaque() {
    int t = threadIdx.x;
#ifndef EMU
    asm volatile("" : "+v"(t));
#endif
    return t;
}
DI float bf2f(bf16 b) { return __uint_as_float(((unsigned)b) << 16); }
DI bf16 f2bf(float x) {
#ifdef EMU
    unsigned u = __float_as_uint(x); u += 0x7fffu + ((u >> 16) & 1u); return (bf16)(u >> 16);
#else
    return __builtin_bit_cast(unsigned short, (__bf16)x);
#endif
}
DI float fexp(float x) {
#ifdef EMU
    return exp2f(x * 1.4426950408889634f);
#else
    return __builtin_amdgcn_exp2f(x * 1.4426950408889634f);
#endif
}
DI unsigned pk2(float a, float b) { return (unsigned)f2bf(a) | ((unsigned)f2bf(b) << 16); }
DI f32x16 zero16() { f32x16 z; for (int i = 0; i < 16; ++i) z[i] = 0.f; return z; }
DI f32x16 mfma32(bf16x8 a, bf16x8 b, f32x16 c) { return __builtin_amdgcn_mfma_f32_32x32x16_bf16(a, b, c, 0, 0, 0); }
DI int crow(int i, int h) { return (i & 3) + 8 * (i >> 2) + 4 * h; }
DI bf16x8 ld8(const LDS bf16* p) { return *(const LDS bf16x8*)p; }
DI bf16x8 ld8g(const bf16* p) { return *(const bf16x8*)p; }
DI bf16x8 ldperm(const LDS bf16* p16, int h) {
    const s16x4 lo = *(const LDS s16x4*)(p16 + 4 * h), hi = *(const LDS s16x4*)(p16 + 8 + 4 * h);
    return __builtin_shufflevector(lo, hi, 0, 1, 2, 3, 4, 5, 6, 7);
}
DI bf16x8 ldpermg(const bf16* p16, int h) {
    const s16x4 lo = *(const s16x4*)(p16 + 4 * h), hi = *(const s16x4*)(p16 + 8 + 4 * h);
    return __builtin_shufflevector(lo, hi, 0, 1, 2, 3, 4, 5, 6, 7);
}
DI bf16x8 pack8(float a0, float a1, float a2, float a3, float a4, float a5, float a6, float a7) {
    u32x4 p; p[0] = pk2(a0, a1); p[1] = pk2(a2, a3); p[2] = pk2(a4, a5); p[3] = pk2(a6, a7); return __builtin_bit_cast(bf16x8, p);
}
#define PACK(x, s) pack8((x)[8 * (s)], (x)[8 * (s) + 1], (x)[8 * (s) + 2], (x)[8 * (s) + 3], (x)[8 * (s) + 4], (x)[8 * (s) + 5], (x)[8 * (s) + 6], (x)[8 * (s) + 7])
DI float wsum(float v) { for (int o = 32; o >= 1; o >>= 1) v += __shfl_xor(v, o); return v; }
DI bf16x8 zero8() { bf16x8 z; for (int i = 0; i < 8; ++i) z[i] = 0; return z; }

DI unsigned imgb(unsigned row, unsigned ch) { return 256u * row + 16u * (ch ^ (((row & 3u) << 2) | ((row >> 2) & 3u))); }
DI bf16x8 img_row(const LDS unsigned char* img, unsigned row, unsigned s, unsigned hh) { return *(const LDS bf16x8*)(img + imgb(row, 2 * s + hh)); }
DI s16x4 tr16(const LDS unsigned char* a) {
#ifdef EMU
    return emu_tr16_b64(a);
#else
    return __builtin_amdgcn_ds_read_tr16_b64_v4i16((LDS s16x4*)a);
#endif
}
template <bool PERM> DI bf16x8 img_tr(const LDS unsigned char* img, unsigned lane, unsigned c, unsigned k16) {
    const unsigned hh = lane >> 5, blk = (lane >> 4) & 1, q = (lane & 15) >> 2, pp = lane & 3;
    const unsigned r0 = k16 + (PERM ? 4 * hh : 8 * hh) + q, r1 = r0 + (PERM ? 8 : 4), ch = 4 * c + 2 * blk + (pp >> 1);
    const LDS unsigned char* a0 = img + imgb(r0, ch) + 8 * (pp & 1); const LDS unsigned char* a1 = img + imgb(r1, ch) + 8 * (pp & 1);
#ifdef EMU
    const s16x4 lo = emu_tr16_b64(a0), hi = emu_tr16_b64(a1);
#else
    s16x4 lo, hi;
    asm volatile("ds_read_b64_tr_b16 %0, %2\n\tds_read_b64_tr_b16 %1, %3\n\ts_waitcnt lgkmcnt(0)" : "=&v"(lo), "=&v"(hi) : "v"((unsigned)(size_t)a0), "v"((unsigned)(size_t)a1) : "memory");
#endif
    return __builtin_shufflevector(lo, hi, 0, 1, 2, 3, 4, 5, 6, 7);
}
DI void dma16(const void* g, LDS unsigned char* l) {
#ifdef EMU
    emu_dma16(g, l);
#else
    __builtin_amdgcn_global_load_lds((const unsigned*)g, (LDS unsigned*)l, 16, 0, 0);
#endif
}
#ifdef EMU
#define SCHED_FENCE() do {} while (0)
#else
#define SCHED_FENCE() __builtin_amdgcn_sched_barrier(0)
#endif
DI int rdlane(int v, int l) {
#ifdef EMU
    return __shfl(v, l);
#else
    return __builtin_amdgcn_readlane(v, l);
#endif
}
DI void wait_vm0() {
#ifndef EMU
    asm volatile("s_waitcnt vmcnt(0)" ::: "memory");
#endif
}
DI void bar_lds() {
#ifdef EMU
    __syncthreads();
#else
    asm volatile("s_waitcnt lgkmcnt(0)" ::: "memory"); __builtin_amdgcn_s_barrier(); asm volatile("" ::: "memory");
#endif
}

namespace pg8 {
#define PG8_LAS LDS
typedef unsigned short bf16_t;
constexpr int BM = 256, BK = 64, HALF = 128, HTB = HALF * BK * 2  , STAGE_BYTES = 8 * HTB, NXCD = 8, WGM = 8;
__host__ __device__ __forceinline__ int lds_byte(int r, int c) { const int st = (r >> 4) * 2 + (c >> 5), rr = r & 15, cc = c & 31, ob = rr * 64 + cc * 2; return st * 1024 + (ob ^ (((ob >> 9) & 1) << 5)); }
__host__ __device__ __forceinline__ void stage_rc(int b, int& R, int& C) { const int st = b / 1024, sb = b % 1024, swz = sb ^ (((sb >> 9) & 1) << 5); R = (st >> 1) * 16 + swz / 64; C = (st & 1) * 32 + (swz % 64) / 2; }
__host__ __device__ __forceinline__ int perm32(int rho) { const int n = rho >> 4, i = rho & 15; return 8 * (i >> 2) + 4 * n + (i & 3); }
struct Unit { int pm, pn; };
struct Gemm { const bf16_t* A; const bf16_t* Bt; int M, N, K; };
struct StaticOrder {
    int nM, nN, nwg, G, c;
    __host__ __device__ void init(int M, int N, int G_, int c_) { nM = M / BM; nN = N / BM; nwg = nM * nN; G = G_; c = c_; }
    __host__ __device__ bool next(int i, Unit& u) const {
        const long L = (long)i * G + c; if (L >= nwg) return false;
        int wgid = (int)L; { const int q = nwg / NXCD, r = nwg % NXCD, xcd = wgid % NXCD, off = wgid / NXCD; wgid = (xcd < r ? xcd * (q + 1) : r * (q + 1) + (xcd - r) * q) + off; }
        const int nig = WGM * nN, gid = wgid / nig, fm = gid * WGM, gsz = (nM - fm) < WGM ? (nM - fm) : WGM;
        u.pm = fm + ((wgid % nig) % gsz); u.pn = (wgid % nig) / gsz; return true;
    }
    __device__ __forceinline__ void a_ready(const Unit&) const {}
    __device__ __forceinline__ void done(const Unit&) const {}
};
#ifdef EMU
template <class Epi, class Sched>
__device__ __forceinline__ void gemm_phase(PG8_LAS unsigned char* lds, const Gemm g, const Sched& S, const Epi& E) {
    const int tid = tid_opaque(), wid = __builtin_amdgcn_readfirstlane(tid >> 6), lane = tid & 63, wr = wid >> 2, wc = wid & 3, fr = lane & 15, fq = lane >> 4;
    Unit cur;
    for (int ui = 0; S.next(ui, cur); ++ui) {
        f32x4 acc[2][2][4][2];
        for (int ai = 0; ai < 2; ++ai) for (int bj = 0; bj < 2; ++bj) for (int m = 0; m < 4; ++m) for (int n = 0; n < 2; ++n) for (int j = 0; j < 4; ++j) {
            const int row = 256 * cur.pm + 128 * ai + 64 * wr + 16 * m + fr;
            const int col = Epi::PERM ? 256 * cur.pn + 128 * bj + 32 * wc + 8 * fq + 4 * n + j : 256 * cur.pn + 128 * bj + 32 * wc + 16 * n + 4 * fq + j;
            const bf16_t* a = g.A + (size_t)row * g.K; const bf16_t* b = g.Bt + (size_t)col * g.K; float s = 0.f;
            for (int k = 0; k < g.K; ++k) s += bf2f(a[k]) * bf2f(b[k]);
            acc[ai][bj][m][n][j] = s;
        }
        E(acc, cur, wr, wc, fr, fq);
    }
}
#else
template <class Epi, class Sched>
__device__ __forceinline__ void gemm_phase(PG8_LAS unsigned char* lds, const Gemm g, const Sched& S, const Epi& E) {
    const int tid = tid_opaque(), wid = __builtin_amdgcn_readfirstlane(tid >> 6), lane = tid & 63, wr = wid >> 2, wc = wid & 3, fr = lane & 15, fq = lane >> 4;
    const int K = g.K, nt = K / BK;
    unsigned voffA[2], voffB[2];
#pragma unroll
    for (int i = 0; i < 2; ++i) { int R, C; stage_rc(tid * 16 + i * 8192, R, C); const int Rb = Epi::PERM ? ((R & ~31) + perm32(R & 31)) : R;
        voffA[i] = (unsigned)(R * K + C) * 2u; voffB[i] = (unsigned)(Rb * K + C) * 2u; }
    const size_t kstep = (size_t)(BK * 2);
    const size_t hstep = (size_t)HALF * K * 2;
    const size_t tstep = 2 * hstep;
    const unsigned ldsw = (unsigned)wid * 1024u;
    const int aoff = lds_byte(wr * 64 + fr, fq * 8), boff = lds_byte(wc * 32 + fr, fq * 8);
#define PG8_SA(b, h) (((b) * 2 + (h)) * HTB)
#define PG8_SB(b, h) ((4 + (b) * 2 + (h)) * HTB)
#define PG8_STAGE(bufoff, gbase, voff) do { _Pragma("unroll") for (int _i = 0; _i < 2; ++_i) \
        __builtin_amdgcn_global_load_lds((const unsigned*)((const char*)(gbase) + (voff)[_i]), (PG8_LAS unsigned*)(lds + (bufoff) + ldsw + _i * 8192), 16, 0, 0); } while (0)
#define PG8_LDA(dst, b, h) do { _Pragma("unroll") for (int m = 0; m < 4; ++m) _Pragma("unroll") for (int k = 0; k < 2; ++k) dst[m][k] = *(const PG8_LAS bf16x8*)(lds + PG8_SA(b, h) + aoff + m * 2048 + k * 1024); } while (0)
#define PG8_LDB(dst, b, h) do { _Pragma("unroll") for (int n = 0; n < 2; ++n) _Pragma("unroll") for (int k = 0; k < 2; ++k) dst[n][k] = *(const PG8_LAS bf16x8*)(lds + PG8_SB(b, h) + boff + n * 2048 + k * 1024); } while (0)
#define PG8_MMA(ai, bj, At, Bt) do { __builtin_amdgcn_s_setprio(1); _Pragma("unroll") for (int m = 0; m < 4; ++m) _Pragma("unroll") for (int n = 0; n < 2; ++n) _Pragma("unroll") for (int k = 0; k < 2; ++k) \
        acc[ai][bj][m][n] = __builtin_amdgcn_mfma_f32_16x16x32_bf16(Bt[n][k], At[m][k], acc[ai][bj][m][n], 0, 0, 0); __builtin_amdgcn_s_setprio(0); } while (0)
#define PG8_WAIT_V(n) asm volatile("s_waitcnt vmcnt(" #n ")" ::: "memory")
#define PG8_WAIT_L(n) asm volatile("s_waitcnt lgkmcnt(" #n ")" ::: "memory")
#define PG8_BAR __builtin_amdgcn_s_barrier()
#define PG8_SCHED __builtin_amdgcn_sched_barrier(0)
    Unit cur, nxt; int ui = 0;
    if (!S.next(0, cur)) return;
    f32x4 acc[2][2][4][2];
#pragma unroll
    for (int a = 0; a < 2; ++a)
#pragma unroll
        for (int b = 0; b < 2; ++b)
#pragma unroll
            for (int m = 0; m < 4; ++m)
#pragma unroll
                for (int n = 0; n < 2; ++n) acc[a][b][m][n] = (f32x4){0.f, 0.f, 0.f, 0.f};
    bf16x8 At[4][2], B0[2][2], B1[2][2];
    const char* cA = (const char*)g.A + (size_t)cur.pm * tstep; const char* cB = (const char*)g.Bt + (size_t)cur.pn * tstep;
    S.a_ready(cur);
    PG8_STAGE(PG8_SB(0, 0), cB, voffB); PG8_STAGE(PG8_SA(0, 0), cA, voffA); PG8_STAGE(PG8_SB(0, 1), cB + hstep, voffB); PG8_STAGE(PG8_SA(0, 1), cA + hstep, voffA);
    if (wr == 1) PG8_BAR;
    PG8_WAIT_V(4); PG8_BAR;
    PG8_STAGE(PG8_SB(1, 0), cB + kstep, voffB); PG8_STAGE(PG8_SA(1, 0), cA + kstep, voffA); PG8_STAGE(PG8_SB(1, 1), cB + hstep + kstep, voffB);
    PG8_WAIT_V(6); PG8_BAR;
    for (;;) {
        const bool has_next = S.next(ui + 1, nxt);
        const char* nA = has_next ? (const char*)g.A + (size_t)nxt.pm * tstep : cA; const char* nB = has_next ? (const char*)g.Bt + (size_t)nxt.pn * tstep : cB;
        for (int t = 0; t < nt; t += 2) {
            const bool last = (t == nt - 2);
            const char* a1 = cA + (size_t)(t + 1) * kstep;
            const char* a2 = last ? nA : cA + (size_t)(t + 2) * kstep; const char* b2 = last ? nB : cB + (size_t)(t + 2) * kstep;
            const char* a3 = a2 + kstep; const char* b3 = b2 + kstep;
            if (last && has_next) S.a_ready(nxt);
            PG8_LDB(B0, 0, 0); PG8_SCHED; PG8_LDA(At, 0, 0); PG8_STAGE(PG8_SA(1, 1), a1 + hstep, voffA);
            PG8_WAIT_L(8); PG8_BAR; PG8_WAIT_L(0); PG8_MMA(0, 0, At, B0); PG8_BAR; PG8_SCHED;
            PG8_LDB(B1, 0, 1); PG8_STAGE(PG8_SB(0, 0), b2, voffB);
            PG8_BAR; PG8_WAIT_L(0); PG8_MMA(0, 1, At, B1); PG8_BAR;
            PG8_LDA(At, 0, 1); PG8_STAGE(PG8_SA(0, 0), a2, voffA);
            PG8_BAR; PG8_WAIT_L(0); PG8_MMA(1, 0, At, B0); PG8_BAR; PG8_SCHED;
            PG8_STAGE(PG8_SB(0, 1), b2 + hstep, voffB);
            PG8_WAIT_V(6); PG8_BAR; PG8_MMA(1, 1, At, B1); PG8_BAR;
            PG8_LDB(B0, 1, 0); PG8_SCHED; PG8_LDA(At, 1, 0); PG8_STAGE(PG8_SA(0, 1), a2 + hstep, voffA);
            PG8_WAIT_L(8); PG8_BAR; PG8_WAIT_L(0); PG8_MMA(0, 0, At, B0); PG8_BAR; PG8_SCHED;
            PG8_LDB(B1, 1, 1); PG8_STAGE(PG8_SB(1, 0), b3, voffB);
            PG8_BAR; PG8_WAIT_L(0); PG8_MMA(0, 1, At, B1); PG8_BAR;
            PG8_LDA(At, 1, 1); PG8_STAGE(PG8_SA(1, 0), a3, voffA);
            PG8_BAR; PG8_WAIT_L(0); PG8_MMA(1, 0, At, B0); PG8_BAR; PG8_SCHED;
            PG8_STAGE(PG8_SB(1, 1), b3 + hstep, voffB);
            PG8_WAIT_V(6); PG8_BAR; PG8_MMA(1, 1, At, B1); PG8_BAR;
        }
        if constexpr (!Epi::AFTER_DRAIN) { E(acc, cur, wr, wc, fr, fq); S.done(cur); }
        if (!has_next) break;
#pragma unroll
        for (int a = 0; a < 2; ++a)
#pragma unroll
            for (int b = 0; b < 2; ++b)
#pragma unroll
                for (int m = 0; m < 4; ++m)
#pragma unroll
                    for (int n = 0; n < 2; ++n) acc[a][b][m][n] = (f32x4){0.f, 0.f, 0.f, 0.f};
        cur = nxt; cA = nA; cB = nB; ++ui;
    }
    PG8_WAIT_V(0);
    if (wr == 0) PG8_BAR;
    PG8_BAR;
    if constexpr (Epi::AFTER_DRAIN) { E.fused(acc, cur, wr, wc, fr, fq, lds, wid, lane); S.done(cur); }
#undef PG8_SA
#undef PG8_SB
#undef PG8_STAGE
#undef PG8_LDA
#undef PG8_LDB
#undef PG8_MMA
#undef PG8_WAIT_V
#undef PG8_WAIT_L
#undef PG8_BAR
#undef PG8_SCHED
}
#endif
}

struct Params {
    const float *xp, *xs, *memp, *cckv, *ckpe, *cmk, *cmv, *sgla; const int* ptab;
    const float *g_mix, *w_a2, *b_a, *g_gla_o, *g_qa, *g_kva, *g_qn, *g_kn, *g_qr, *g_kr, *g_x, *g_mem, *g_xq, *g_xk, *g_ff;
    float *y, *o_ckvp, *o_kpep, *o_mkp, *o_mvp, *o_glap, *o_ckvs, *o_kpes, *o_glas;
    unsigned* ctl;
    bf16 *wt_in, *wt_qb, *wt_kvb, *wt_out, *wt_xq, *wt_xkv, *wt_xo, *wt_ff1, *wt_ff2;
    bf16 *H, *MEMN, *Z, *QAN, *CKVB, *KPB, *MKB, *MVB, *QF, *KV, *QN, *KN, *OMIX, *XQ, *XO, *U;
    float *MKV, *LOGA, *DS, *DDEC, *X1, *X2, *PACC, *PML;
    const float *w_in, *w_qb, *w_kvb, *w_out, *w_xq, *w_xk, *w_xv, *w_xo, *w_ff1, *w_ff2;
};
constexpr int CW_Q5 = 0, CW_QX = 512, CW_BAR = 4096;

template <int ACT  > struct EpiStoreBf16 {
    static constexpr bool PERM = true, AFTER_DRAIN = false;
    bf16* O; int ldc;
    DI void operator()(const f32x4 (&acc)[2][2][4][2], const pg8::Unit& u, int wr, int wc, int fr, int fq) const {
        const int row0 = u.pm * 256 + wr * 64 + fr, col0 = u.pn * 256 + wc * 32 + 8 * fq;
#pragma unroll
        for (int ai = 0; ai < 2; ++ai)
#pragma unroll
            for (int m = 0; m < 4; ++m) { bf16* rowp = O + (size_t)(row0 + ai * 128 + m * 16) * ldc + col0;
#pragma unroll
                for (int bj = 0; bj < 2; ++bj) { f32x4 v0 = acc[ai][bj][m][0], v1 = acc[ai][bj][m][1];
                    if (ACT == 1) {
#pragma unroll
                        for (int j = 0; j < 4; ++j) { const float a = fmaxf(v0[j], 0.f), b = fmaxf(v1[j], 0.f); v0[j] = a * a; v1[j] = b * b; } }
                    u32x4 w; w[0] = pk2(v0[0], v0[1]); w[1] = pk2(v0[2], v0[3]); w[2] = pk2(v1[0], v1[1]); w[3] = pk2(v1[2], v1[3]);
                    *(u32x4*)(rowp + bj * 128) = w; } }
    }
};
struct EpiStoreF32 {
    static constexpr bool PERM = false, AFTER_DRAIN = false;
    float* C; const float* R; int ldc;
    DI void operator()(const f32x4 (&acc)[2][2][4][2], const pg8::Unit& u, int wr, int wc, int fr, int fq) const {
        const int row0 = u.pm * 256 + wr * 64 + fr, col0 = u.pn * 256 + wc * 32 + 4 * fq;
#pragma unroll
        for (int ai = 0; ai < 2; ++ai)
#pragma unroll
            for (int m = 0; m < 4; ++m) { const size_t off = (size_t)(row0 + ai * 128 + m * 16) * ldc + col0;
#pragma unroll
                for (int bj = 0; bj < 2; ++bj)
#pragma unroll
                    for (int n = 0; n < 2; ++n) { f32x4 v = acc[ai][bj][m][n]; if (R) v += *(const f32x4*)(R + off + bj * 128 + n * 16); *(f32x4*)(C + off + bj * 128 + n * 16) = v; } }
    }
};
template <class Epi> DI void run_gemm(LDS unsigned char* lds, const bf16* A, const bf16* Bt, int M, int N, int K, const Epi& E, int rot) {
    pg8::Gemm g{A, Bt, M, N, K}; pg8::StaticOrder S; S.init(M, N, (int)gridDim.x, (int)((blockIdx.x + rot) % gridDim.x));
    pg8::gemm_phase<Epi, pg8::StaticOrder>(lds, g, S, E);
}

DI const float* xrow(const Params& p, int t) { return t < TP ? p.xp + (size_t)t * DM : p.xs + (size_t)(t - TP) * DM; }
DI void rmsnorm_row_1024(const float* src, const float* g, bf16* dst, int lane) {
    f32x4 v[4]; float ss = 0.f;
#pragma unroll
    for (int i = 0; i < 4; ++i) { v[i] = *(const f32x4*)(src + 4 * (lane + 64 * i)); ss += v[i][0] * v[i][0] + v[i][1] * v[i][1] + v[i][2] * v[i][2] + v[i][3] * v[i][3]; }
    ss = wsum(ss); const float rs = rsqrtf(ss * (1.0f / 1024.0f) + EPS);
#pragma unroll
    for (int i = 0; i < 4; ++i) { const f32x4 gg = *(const f32x4*)(g + 4 * (lane + 64 * i)); u32x2 w; w[0] = pk2(v[i][0] * rs * gg[0], v[i][1] * rs * gg[1]); w[1] = pk2(v[i][2] * rs * gg[2], v[i][3] * rs * gg[3]);
        *(u32x2*)(dst + 4 * (lane + 64 * i)) = w; }
}
template <int K, int N, int NPAD> DI void prep_job(const float* W, bf16* Wt, LDS float* tl, int rot) {
    const int tid = tid_opaque(); constexpr int nkt = K / 64, ntiles = (NPAD / 64) * nkt;
    for (int tile = (int)((blockIdx.x + rot) % gridDim.x); tile < ntiles; tile += gridDim.x) {
        const int tn = tile / nkt, tk = tile % nkt;
        { const int kk = tid >> 3, n8 = (tid & 7) * 8; const int n = tn * 64 + n8; const float* s = W + (size_t)(tk * 64 + kk) * N + n;
            f32x4 a = {0.f, 0.f, 0.f, 0.f}, b = a; if (n < N) { a = *(const f32x4*)s; b = *(const f32x4*)(s + 4); }
#pragma unroll
            for (int q = 0; q < 4; ++q) { tl[kk * 65 + n8 + q] = a[q]; tl[kk * 65 + n8 + 4 + q] = b[q]; } }
        __syncthreads();
        { const int nn = tid >> 3, k8 = (tid & 7) * 8; u32x4 w;
#pragma unroll
            for (int q = 0; q < 4; ++q) w[q] = pk2(tl[(k8 + 2 * q) * 65 + nn], tl[(k8 + 2 * q + 1) * 65 + nn]);
            *(u32x4*)(Wt + (size_t)(tn * 64 + nn) * K + tk * 64 + k8) = w; }
        __syncthreads();
    }
}
DI void phase_prep(const Params& p, LDS unsigned char* lds) {
    const int tid = tid_opaque(), wid = __builtin_amdgcn_readfirstlane(tid >> 6), lane = tid & 63;
    LDS float* tl = (LDS float*)lds;
    prep_job<DM, DIN, DINP>(p.w_in, p.wt_in, tl, 0); prep_job<384, 768, 768>(p.w_qb, p.wt_qb, tl, 64); prep_job<256, 1024, 1024>(p.w_kvb, p.wt_kvb, tl, 136); prep_job<DM, DM, DM>(p.w_out, p.wt_out, tl, 200);
    prep_job<DM, 512, 512>(p.w_xq, p.wt_xq, tl, 0); prep_job<DM, 512, 512>(p.w_xk, p.wt_xkv, tl, 128); prep_job<DM, 512, 512>(p.w_xv, p.wt_xkv + (size_t)512 * DM, tl, 0); prep_job<512, DM, DM>(p.w_xo, p.wt_xo, tl, 128);
    prep_job<DM, DFF, DFF>(p.w_ff1, p.wt_ff1, tl, 0); prep_job<DFF, DM, DM>(p.w_ff2, p.wt_ff2, tl, 0);
    for (int row = blockIdx.x * 8 + wid; row < T + MROWS; row += gridDim.x * 8) {
        if (row < T) rmsnorm_row_1024(xrow(p, row), p.g_mix, p.H + (size_t)row * DM, lane);
        else rmsnorm_row_1024(p.memp + (size_t)(row - T) * DM, p.g_mem, p.MEMN + (size_t)(row - T) * DM, lane);
    }
}

DI float rope32(float xn, int lane, int pos) {
    const float partner = __shfl_xor(xn, 16);
    const int i = lane & 15; const float inv = expf(-(float)i * (9.210340371976184f / 16.0f)); const float ang = (float)pos * inv;
    const float c = cosf(ang), s = sinf(ang);
    return (lane & 16) ? xn * c + partner * s : xn * c - partner * s;
}
DI int row_pos(int t) { return t < TP ? (t % SEQ) : PAST + ((t - TP) % DECS); }

DI void phase_post_in(const Params& p) {
    const int tid = tid_opaque(), wid = __builtin_amdgcn_readfirstlane(tid >> 6), lane = tid & 63;
    for (int row = blockIdx.x * 8 + wid; row < T + MROWS; row += gridDim.x * 8) {
        if (row < T) {
            const int t = row; const bf16* z = p.Z + (size_t)t * DINP;
            float a[16];
#pragma unroll
            for (int i = 0; i < 16; ++i) a[i] = bf2f(z[ZA + i]);
#pragma unroll
            for (int q = 0; q < 4; ++q) { const int c = lane + 64 * q; float gp = p.b_a[c];
#pragma unroll
                for (int i = 0; i < 16; ++i) gp += a[i] * p.w_a2[i * 256 + c];
                const float ls = fminf(gp, 0.f) - log1pf(expf(-fabsf(gp)));
                p.LOGA[(size_t)t * 256 + c] = ls * (1.0f / 16.0f); }
            { float v[6]; float ss = 0.f;
#pragma unroll
                for (int q = 0; q < 6; ++q) { v[q] = bf2f(z[ZQA + lane + 64 * q]); ss += v[q] * v[q]; }
                ss = wsum(ss); const float rs = rsqrtf(ss * (1.0f / 384.0f) + EPS);
#pragma unroll
                for (int q = 0; q < 6; ++q) p.QAN[(size_t)t * 384 + lane + 64 * q] = f2bf(v[q] * rs * p.g_qa[lane + 64 * q]); }
            { float v[4]; float ss = 0.f;
#pragma unroll
                for (int q = 0; q < 4; ++q) { v[q] = bf2f(z[ZKVA + lane + 64 * q]); ss += v[q] * v[q]; }
                ss = wsum(ss); const float rs = rsqrtf(ss * (1.0f / 256.0f) + EPS);
                float* oc = t < TP ? p.o_ckvp + (size_t)t * 256 : p.o_ckvs + (size_t)(t - TP) * 256;
#pragma unroll
                for (int q = 0; q < 4; ++q) { const float c = v[q] * rs * p.g_kva[lane + 64 * q]; oc[lane + 64 * q] = c; p.CKVB[(size_t)t * 256 + lane + 64 * q] = f2bf(c); } }
            { const float v = lane < 32 ? bf2f(z[ZKPE + lane]) : 0.f; const float ss = wsum(v * v); const float rs = rsqrtf(ss * (1.0f / 32.0f) + EPS);
                const float xn = v * rs * p.g_kr[lane & 31]; const float o = rope32(xn, lane, row_pos(t));
                if (lane < 32) { float* ok = t < TP ? p.o_kpep + (size_t)t * 32 : p.o_kpes + (size_t)(t - TP) * 32; ok[lane] = o; p.KPB[(size_t)t * 32 + lane] = f2bf(o); } }
        } else {
            const int r = row - T; const float* s = p.MKV + (size_t)r * 1024;
            float v[8]; float ss = 0.f;
#pragma unroll
            for (int q = 0; q < 8; ++q) { v[q] = s[lane * 8 + q]; ss += v[q] * v[q]; }
            ss += __shfl_xor(ss, 1); ss += __shfl_xor(ss, 2); ss += __shfl_xor(ss, 4); ss += __shfl_xor(ss, 8);
            const float rs = rsqrtf(ss * (1.0f / 128.0f) + EPS);
#pragma unroll
            for (int q = 0; q < 8; ++q) { const int c = lane * 8 + q; const float k = v[q] * rs * p.g_xk[c & 127]; p.o_mkp[(size_t)r * 512 + c] = k; p.MKB[(size_t)r * 512 + c] = f2bf(k);
                const float vv = s[512 + c]; p.o_mvp[(size_t)r * 512 + c] = vv; p.MVB[(size_t)r * 512 + c] = f2bf(vv); }
        }
    }
}

DI void phase_post_qkv(const Params& p) {
    const int tid = tid_opaque(), wid = __builtin_amdgcn_readfirstlane(tid >> 6), lane = tid & 63;
    for (int t = TP + blockIdx.x * 8 + wid; t < T; t += gridDim.x * 8) {
        const bf16* qf = p.QF + (size_t)t * 768; const int pos = row_pos(t);
        for (int h = 0; h < 8; ++h) {
            const float v = bf2f(qf[h * 96 + lane]); const float ss = wsum(v * v); const float rs = rsqrtf(ss * (1.0f / 64.0f) + EPS);
            p.QN[((size_t)t * 8 + h) * 96 + lane] = f2bf(v * rs * p.g_qn[lane] * MLA_SCALE);
            const float vr = lane < 32 ? bf2f(qf[h * 96 + 64 + lane]) : 0.f; const float ssr = wsum(vr * vr); const float rsr = rsqrtf(ssr * (1.0f / 32.0f) + EPS);
            const float xr = vr * rsr * p.g_qr[lane & 31]; const float o = rope32(xr, lane, pos);
            if (lane < 32) p.QN[((size_t)t * 8 + h) * 96 + 64 + lane] = f2bf(o * MLA_SCALE);
        }
    }
}
struct GlaUnit { int t0, h, nv; };
DI GlaUnit gla_unit(int u) { GlaUnit g; if (u < NGP) { const int b = u / (4 * NC), h = (u / NC) % 4, c = u % NC; g.t0 = b * SEQ + c * 64; g.h = h; g.nv = 64; } else { const int us = u - NGP; g.t0 = TP + (us >> 2) * DECS; g.h = us & 3; g.nv = DECS; } return g; }
constexpr int GL_QK = 0, GL_V = 16384, GL_S = 32768, GL_TOT = 49152, GL_SS = GL_TOT + 2048, GL_END = GL_SS + 1024;
static_assert(GL_END <= LDS_CTL, "GLA LDS map");
DI float gla_scan(const Params& p, const GlaUnit& g, LDS unsigned char* lds, int c, int sb, float (&b)[8]) {
    LDS float* TOT = (LDS float*)(lds + GL_TOT); float a = 0.f;
#pragma unroll
    for (int i = 0; i < 8; ++i) { const int s = 8 * sb + i; a += s < g.nv ? p.LOGA[(size_t)(g.t0 + s) * 256 + g.h * 64 + c] : 0.f; b[i] = a; }
    TOT[sb * 64 + c] = a;
    __syncthreads();
    float pre = 0.f, tot = 0.f;
#pragma unroll
    for (int q = 0; q < 8; ++q) { const float v = TOT[q * 64 + c]; tot += v; if (q < sb) pre += v; }
#pragma unroll
    for (int i = 0; i < 8; ++i) b[i] += pre;
    return tot;
}
DI void gla_put(LDS unsigned char* img, int row, int col, float v) { *(LDS bf16*)(img + imgb(row, col >> 3) + 2 * (col & 7)) = f2bf(v); }
DI void gla_stage_v(const Params& p, const GlaUnit& g, LDS unsigned char* lds, int tid) {
#pragma unroll
    for (int j = 0; j < 2; ++j) { const int cidx = tid + NTHREADS * j, s = cidx >> 4, ch = cidx & 15; bf16x8 v = zero8(); if (s < g.nv) v = ld8g(p.Z + (size_t)(g.t0 + s) * DINP + ZV + g.h * 128 + ch * 8);
        *(LDS bf16x8*)(lds + GL_V + imgb(s, ch)) = v; }
}
DI void phase_gla_a(const Params& p, LDS unsigned char* lds) {
    const int tid = tid_opaque(), wid = __builtin_amdgcn_readfirstlane(tid >> 6), lane = tid & 63, r = lane & 31, hh = lane >> 5;
    for (int u = blockIdx.x; u < NGU; u += gridDim.x) {
        const GlaUnit g = gla_unit(u); const int c = tid & 63, sb = tid >> 6;
        float b[8]; const float bl = gla_scan(p, g, lds, c, sb, b);
#pragma unroll
        for (int i = 0; i < 8; ++i) { const int s = 8 * sb + i; float v = 0.f; if (s < g.nv) v = bf2f(p.Z[(size_t)(g.t0 + s) * DINP + ZK + g.h * 64 + c]) * fexp(bl - b[i]); gla_put(lds + GL_QK, s, c, v); }
        gla_stage_v(p, g, lds, tid);
        if (tid < 64) p.DDEC[(size_t)u * 64 + tid] = fexp(bl);
        __syncthreads();
        { const int mt = wid & 1, nt = wid >> 1; f32x16 acc = zero16();
#pragma unroll
            for (int ks = 0; ks < 4; ++ks) acc = mfma32(img_tr<false>(lds + GL_QK, lane, mt, 16 * ks), img_tr<false>(lds + GL_V, lane, nt, 16 * ks), acc);
            float* d = p.DS + (size_t)u * 8192;
#pragma unroll
            for (int i = 0; i < 16; ++i) d[(32 * mt + crow(i, hh)) * 128 + 32 * nt + r] = acc[i]; }
        __syncthreads();
    }
}
DI void phase_gla_b(const Params& p) {
    const int gid = blockIdx.x * NTHREADS + tid_opaque(), gsz = gridDim.x * NTHREADS;
    for (int e = gid; e < BATCH * 4 * 8192; e += gsz) { const int bh = e >> 13, idx = e & 8191, kd = idx >> 7; float S = 0.f;
        for (int c = 0; c < NC; ++c) { const size_t u = (size_t)bh * NC + c; const float d = p.DS[u * 8192 + idx]; p.DS[u * 8192 + idx] = S; S = S * p.DDEC[u * 64 + kd] + d; }
        p.o_glap[e] = S; }
    for (int e = gid; e < DECB * 4 * 8192; e += gsz) { const int bh = e >> 13, idx = e & 8191, kd = idx >> 7; const size_t u = (size_t)NGP + bh;
        p.o_glas[e] = p.sgla[e] * p.DDEC[u * 64 + kd] + p.DS[u * 8192 + idx]; }
}
DI void gla_c_unit(const Params& p, LDS unsigned char* lds, int u) {
    const int tid = tid_opaque(), wid = __builtin_amdgcn_readfirstlane(tid >> 6), lane = tid & 63, r = lane & 31, hh = lane >> 5;
    const GlaUnit g = gla_unit(u); const int c = tid & 63, sb = tid >> 6;
    { float b[8]; gla_scan(p, g, lds, c, sb, b);
#pragma unroll
        for (int i = 0; i < 8; ++i) { const int s = 8 * sb + i; float q = 0.f, k = 0.f;
            if (s < g.nv) { const bf16* z = p.Z + (size_t)(g.t0 + s) * DINP; q = bf2f(z[ZQ + g.h * 64 + c]) * fexp(b[i]) * 0.125f; k = bf2f(z[ZK + g.h * 64 + c]) * fexp(-b[i]); }
            gla_put(lds + GL_QK, s, c, q); gla_put(lds + GL_QK, s, 64 + c, k); } }
    gla_stage_v(p, g, lds, tid);
    { const float* sp = u < NGP ? p.DS + (size_t)u * 8192 : p.sgla + (size_t)(u - NGP) * 8192;
#pragma unroll
        for (int j = 0; j < 2; ++j) { const int cidx = tid + NTHREADS * j, kd = cidx >> 4, ch = cidx & 15; const f32x4 a = *(const f32x4*)(sp + kd * 128 + ch * 8), bq = *(const f32x4*)(sp + kd * 128 + ch * 8 + 4);
            *(LDS bf16x8*)(lds + GL_S + imgb(kd, ch)) = pack8(a[0], a[1], a[2], a[3], bq[0], bq[1], bq[2], bq[3]); } }
    __syncthreads();
    const int dvt = wid & 3, tt = wid >> 2;
    f32x16 o = zero16();
#pragma unroll
    for (int ks = 0; ks < 4; ++ks) o = mfma32(img_tr<false>(lds + GL_S, lane, dvt, 16 * ks), img_row(lds + GL_QK, 32 * tt + r, ks, hh), o);
#pragma unroll
    for (int st = 0; st < 2; ++st) if (st <= tt) {
        f32x16 x = zero16();
#pragma unroll
        for (int ks = 0; ks < 4; ++ks) x = mfma32(img_row(lds + GL_QK, 32 * st + r, 4 + ks, hh), img_row(lds + GL_QK, 32 * tt + r, ks, hh), x);
        if (st == tt) {
#pragma unroll
            for (int i = 0; i < 16; ++i) if (crow(i, hh) > r) x[i] = 0.f; }
#pragma unroll
        for (int s2 = 0; s2 < 2; ++s2) o = mfma32(img_tr<true>(lds + GL_V, lane, dvt, 32 * st + 16 * s2), PACK(x, s2), o);
    }
    LDS float* SS = (LDS float*)(lds + GL_SS); float ss = 0.f;
#pragma unroll
    for (int i = 0; i < 16; ++i) ss += o[i] * o[i];
    ss += __shfl_xor(ss, 32); if (hh == 0) SS[dvt * 64 + 32 * tt + r] = ss;
    __syncthreads();
    const int t = 32 * tt + r;
    if (t < g.nv) { const float rs = rsqrtf((SS[t] + SS[64 + t] + SS[128 + t] + SS[192 + t]) * (1.0f / 128.0f) + EPS);
        const bf16* z = p.Z + (size_t)(g.t0 + t) * DINP + ZR + g.h * 128 + 32 * dvt + 4 * hh; bf16* op = p.OMIX + (size_t)(g.t0 + t) * DM + g.h * 128 + 32 * dvt + 4 * hh; const float* gg = p.g_gla_o + 32 * dvt + 4 * hh;
#pragma unroll
        for (int q = 0; q < 4; ++q) { const s16x4 rg = *(const s16x4*)(z + 8 * q); const f32x4 g4 = *(const f32x4*)(gg + 8 * q); float w[4];
#pragma unroll
            for (int j = 0; j < 4; ++j) { const float rr = bf2f((bf16)rg[j]); w[j] = o[4 * q + j] * rs * g4[j] * (rr / (1.0f + fexp(-rr))); }
            u32x2 pk; pk[0] = pk2(w[0], w[1]); pk[1] = pk2(w[2], w[3]); *(u32x2*)(op + 8 * q) = pk; } }
}
constexpr int PA_IMG = 0, PA_KP = 2 * 32768, PA_END = PA_KP + 2 * 128 * 40 * 2;
static_assert(PA_END <= LDS_CTL, "prompt attention LDS map");
DI void pattn_stage_load(const Params& p, size_t kr0, int h, int tid, bf16x8 (&kv)[4], bf16x8& kp) {
#pragma unroll
    for (int j = 0; j < 4; ++j) { const int c = tid + NTHREADS * j, key = c >> 4, ch = c & 15; kv[j] = ld8g(p.KV + (kr0 + key) * 1024 + h * 128 + ch * 8); }
    kp = ld8g(p.KPB + (kr0 + (tid >> 2)) * 32 + (tid & 3) * 8);
}
DI void pattn_stage_store(const Params& p, LDS unsigned char* img, LDS bf16* kpl, int tid, const bf16x8 (&kv)[4], const bf16x8& kp) {
    const int ch = tid & 15;
    f32x4 g0 = {1.f, 1.f, 1.f, 1.f}, g1 = g0; if (ch < 8) { g0 = *(const f32x4*)(p.g_kn + ch * 8); g1 = *(const f32x4*)(p.g_kn + ch * 8 + 4); }
#pragma unroll
    for (int j = 0; j < 4; ++j) { const int key = (tid + NTHREADS * j) >> 4; float f[8]; float ss = 0.f;
#pragma unroll
        for (int q = 0; q < 8; ++q) { f[q] = bf2f((bf16)kv[j][q]); ss += f[q] * f[q]; }
        ss += __shfl_xor(ss, 1); ss += __shfl_xor(ss, 2); ss += __shfl_xor(ss, 4);
        const float rs = ch < 8 ? rsqrtf(ss * (1.0f / 64.0f) + EPS) : 1.0f;
        *(LDS bf16x8*)(img + imgb(key, ch)) = pack8(f[0] * rs * g0[0], f[1] * rs * g0[1], f[2] * rs * g0[2], f[3] * rs * g0[3], f[4] * rs * g1[0], f[5] * rs * g1[1], f[6] * rs * g1[2], f[7] * rs * g1[3]); }
    *(LDS bf16x8*)(kpl + (tid >> 2) * 40 + (tid & 3) * 8) = kp;
}
DI void pattn_unit(const Params& p, LDS unsigned char* lds, int u) {
    const int tid = tid_opaque(), wid = __builtin_amdgcn_readfirstlane(tid >> 6), lane = tid & 63, r = lane & 31, hh = lane >> 5;
    const int qb = NQB - 1 - u / (BATCH * 8), bh = u % (BATCH * 8), b = bh >> 3, h = bh & 7;
    const int qw0 = qb * 256 + 32 * wid, qpos = qw0 + r; const size_t trow = (size_t)b * SEQ + qpos;
    bf16x8 kvr[4], kpr;
    pattn_stage_load(p, (size_t)b * SEQ, h, tid, kvr, kpr);
    bf16x8 qf[6];
    { float ss = 0.f, sr = 0.f; float f[6][8];
#pragma unroll
        for (int ks = 0; ks < 6; ++ks) { const bf16x8 raw = ld8g(p.QF + trow * 768 + h * 96 + 16 * ks + 8 * hh);
#pragma unroll
            for (int j = 0; j < 8; ++j) { f[ks][j] = bf2f((bf16)raw[j]); if (ks < 4) ss += f[ks][j] * f[ks][j]; else sr += f[ks][j] * f[ks][j]; } }
        ss += __shfl_xor(ss, 32); sr += __shfl_xor(sr, 32);
        const float rs = rsqrtf(ss * (1.0f / 64.0f) + EPS) * MLA_SCALE, rr = rsqrtf(sr * (1.0f / 32.0f) + EPS) * MLA_SCALE;
#pragma unroll
        for (int ks = 0; ks < 4; ++ks) { const f32x4 g0 = *(const f32x4*)(p.g_qn + 16 * ks + 8 * hh), g1 = *(const f32x4*)(p.g_qn + 16 * ks + 8 * hh + 4);
            qf[ks] = pack8(f[ks][0] * rs * g0[0], f[ks][1] * rs * g0[1], f[ks][2] * rs * g0[2], f[ks][3] * rs * g0[3], f[ks][4] * rs * g1[0], f[ks][5] * rs * g1[1], f[ks][6] * rs * g1[2], f[ks][7] * rs * g1[3]); }
        float o1[8], o2[8];
#pragma unroll
        for (int j = 0; j < 8; ++j) { const int i = 8 * hh + j; const float x1 = f[4][j] * rr * p.g_qr[i], x2 = f[5][j] * rr * p.g_qr[16 + i];
            const float ang = (float)qpos * expf(-(float)i * (9.210340371976184f / 16.0f)); const float c = cosf(ang), s = sinf(ang);
            o1[j] = x1 * c - x2 * s; o2[j] = x2 * c + x1 * s; }
        qf[4] = pack8(o1[0], o1[1], o1[2], o1[3], o1[4], o1[5], o1[6], o1[7]); qf[5] = pack8(o2[0], o2[1], o2[2], o2[3], o2[4], o2[5], o2[6], o2[7]); }
    f32x16 o0 = zero16(), o1 = zero16(); float m = -INFINITY, l = 0.f;
    const int nkt = 2 * (qb + 1);
    pattn_stage_store(p, lds + PA_IMG, (LDS bf16*)(lds + PA_KP), tid, kvr, kpr);
    __syncthreads();
    for (int kt = 0; kt < nkt; ++kt) {
        const int k0 = kt * 128; LDS unsigned char* img = lds + PA_IMG + (kt & 1) * 32768; const LDS bf16* kpl = (const LDS bf16*)(lds + PA_KP) + (kt & 1) * 128 * 40;
        if (kt + 1 < nkt) pattn_stage_load(p, (size_t)b * SEQ + k0 + 128, h, tid, kvr, kpr);
#pragma unroll 1
        for (int half = 0; half < 2; ++half) { const int kb = 64 * half;
            if (k0 + kb <= qw0 + 31) {
                f32x16 s0 = zero16(), s1 = zero16();
#pragma unroll
                for (int ks = 0; ks < 4; ++ks) { s0 = mfma32(img_row(img, kb + r, ks, hh), qf[ks], s0); s1 = mfma32(img_row(img, kb + 32 + r, ks, hh), qf[ks], s1); }
#pragma unroll
                for (int ks = 0; ks < 2; ++ks) { s0 = mfma32(ld8(kpl + (kb + r) * 40 + 16 * ks + 8 * hh), qf[4 + ks], s0); s1 = mfma32(ld8(kpl + (kb + 32 + r) * 40 + 16 * ks + 8 * hh), qf[4 + ks], s1); }
                float tmax = -INFINITY;
                if (k0 + kb + 63 > qw0) {
#pragma unroll
                    for (int i = 0; i < 16; ++i) { const int key = k0 + kb + crow(i, hh); if (key > qpos) s0[i] = -INFINITY; if (key + 32 > qpos) s1[i] = -INFINITY; } }
#pragma unroll
                for (int i = 0; i < 16; ++i) tmax = fmaxf(tmax, fmaxf(s0[i], s1[i]));
                tmax = fmaxf(tmax, __shfl_xor(tmax, 32));
                const float mn = fmaxf(m, tmax), corr = fexp(m - mn); m = mn; float ps = 0.f;
#pragma unroll
                for (int i = 0; i < 16; ++i) { s0[i] = fexp(s0[i] - mn); s1[i] = fexp(s1[i] - mn); ps += s0[i] + s1[i]; }
                l = l * corr + ps;
#pragma unroll
                for (int i = 0; i < 16; ++i) { o0[i] *= corr; o1[i] *= corr; }
#pragma unroll
                for (int s = 0; s < 2; ++s) { const bf16x8 pa = PACK(s0, s), pb = PACK(s1, s);
                    o0 = mfma32(img_tr<true>(img, lane, 2, kb + 16 * s), pa, o0); o1 = mfma32(img_tr<true>(img, lane, 3, kb + 16 * s), pa, o1);
                    o0 = mfma32(img_tr<true>(img, lane, 2, kb + 32 + 16 * s), pb, o0); o1 = mfma32(img_tr<true>(img, lane, 3, kb + 32 + 16 * s), pb, o1); }
            }
        }
        if (kt + 1 < nkt) pattn_stage_store(p, lds + PA_IMG + ((kt + 1) & 1) * 32768, (LDS bf16*)(lds + PA_KP) + ((kt + 1) & 1) * 128 * 40, tid, kvr, kpr);
        __syncthreads();
    }
    l += __shfl_xor(l, 32); const float il = 1.0f / l;
    bf16* o = p.OMIX + trow * DM + 512 + h * 64;
#pragma unroll
    for (int g = 0; g < 4; ++g) { u32x2 w0, w1; w0[0] = pk2(o0[4 * g] * il, o0[4 * g + 1] * il); w0[1] = pk2(o0[4 * g + 2] * il, o0[4 * g + 3] * il); w1[0] = pk2(o1[4 * g] * il, o1[4 * g + 1] * il); w1[1] = pk2(o1[4 * g + 2] * il, o1[4 * g + 3] * il);
        *(u32x2*)(o + 8 * g + 4 * hh) = w0; *(u32x2*)(o + 32 + 8 * g + 4 * hh) = w1; }
}

constexpr int XA_K = 0, XA_V = 256 * 136 * 2, XA_END = XA_V + 128 * 264 * 2;
static_assert(XA_END <= LDS_CTL && XA_V % 16 == 0, "cross-attention LDS map");
DI void xattn_unit(const Params& p, LDS unsigned char* lds, int u) {
    const int tid = tid_opaque(), wid = __builtin_amdgcn_readfirstlane(tid >> 6), lane = tid & 63, r = lane & 31, hh = lane >> 5;
    LDS bf16* KX = (LDS bf16*)(lds + XA_K); LDS bf16* VX = (LDS bf16*)(lds + XA_V);
    int b, h, nrows; size_t tbase;
    if (u < NU_XP) { b = u / (4 * NQB); h = (u / NQB) & 3; const int qc = u % NQB; nrows = 256; tbase = (size_t)b * SEQ + qc * 256;
        for (int i = tid; i < 256 * 16; i += NTHREADS) { const int key = i >> 4, c8 = (i & 15) * 8; const size_t src = ((size_t)b * 256 + key) * 512 + h * 128 + c8;
            *(LDS bf16x8*)(KX + key * 136 + c8) = ld8g(p.MKB + src); const bf16x8 v = ld8g(p.MVB + src);
#pragma unroll
            for (int j = 0; j < 8; ++j) VX[(c8 + j) * 264 + key] = (bf16)v[j]; }
    } else { const int us = u - NU_XP; b = us >> 2; h = us & 3; nrows = DECS; tbase = (size_t)TP + b * DECS;
        for (int i = tid; i < 256 * 32; i += NTHREADS) { const int key = i >> 5, c4 = (i & 31) * 4; const size_t src = (((size_t)b * 256 + key) * 4 + h) * 128 + c4;
            const f32x4 k = *(const f32x4*)(p.cmk + src), v = *(const f32x4*)(p.cmv + src); u32x2 w; w[0] = pk2(k[0], k[1]); w[1] = pk2(k[2], k[3]); *(LDS u32x2*)(KX + key * 136 + c4) = w;
#pragma unroll
            for (int j = 0; j < 4; ++j) VX[(c4 + j) * 264 + key] = f2bf(v[j]); }
    }
    __syncthreads();
    if (32 * wid < nrows) {
        const bool valid = 32 * wid + r < nrows; const size_t trow = tbase + 32 * wid + (valid ? r : 0);
        bf16x8 qf[8]; float ss = 0.f;
#pragma unroll
        for (int ks = 0; ks < 8; ++ks) { qf[ks] = ld8g(p.XQ + trow * 512 + h * 128 + 16 * ks + 8 * hh);
#pragma unroll
            for (int j = 0; j < 8; ++j) { const float v = bf2f((bf16)qf[ks][j]); ss += v * v; } }
        ss += __shfl_xor(ss, 32); const float rs = valid ? rsqrtf(ss * (1.0f / 128.0f) + EPS) * X_SCALE : 0.f;
#pragma unroll
        for (int ks = 0; ks < 8; ++ks) { float q[8];
#pragma unroll
            for (int j = 0; j < 8; ++j) q[j] = bf2f((bf16)qf[ks][j]) * rs * p.g_xq[16 * ks + 8 * hh + j];
            qf[ks] = pack8(q[0], q[1], q[2], q[3], q[4], q[5], q[6], q[7]); }
        f32x16 o[4];
#pragma unroll
        for (int d = 0; d < 4; ++d) o[d] = zero16();
        float m = -INFINITY, l = 0.f;
        for (int kt = 0; kt < 4; ++kt) {
            f32x16 s0 = zero16(), s1 = zero16();
#pragma unroll
            for (int ks = 0; ks < 8; ++ks) { s0 = mfma32(ld8(KX + (64 * kt + r) * 136 + 16 * ks + 8 * hh), qf[ks], s0); s1 = mfma32(ld8(KX + (64 * kt + 32 + r) * 136 + 16 * ks + 8 * hh), qf[ks], s1); }
            float tmax = -INFINITY;
#pragma unroll
            for (int i = 0; i < 16; ++i) tmax = fmaxf(tmax, fmaxf(s0[i], s1[i]));
            tmax = fmaxf(tmax, __shfl_xor(tmax, 32));
            const float mn = fmaxf(m, tmax), corr = fexp(m - mn); m = mn; float ps = 0.f;
#pragma unroll
            for (int i = 0; i < 16; ++i) { s0[i] = fexp(s0[i] - mn); s1[i] = fexp(s1[i] - mn); ps += s0[i] + s1[i]; }
            l = l * corr + ps;
#pragma unroll
            for (int d = 0; d < 4; ++d)
#pragma unroll
                for (int i = 0; i < 16; ++i) o[d][i] *= corr;
#pragma unroll
            for (int s = 0; s < 2; ++s) { const bf16x8 pa = PACK(s0, s), pb = PACK(s1, s);
#pragma unroll
                for (int d = 0; d < 4; ++d) { o[d] = mfma32(ldperm(VX + (32 * d + r) * 264 + 64 * kt + 16 * s, hh), pa, o[d]); o[d] = mfma32(ldperm(VX + (32 * d + r) * 264 + 64 * kt + 32 + 16 * s, hh), pb, o[d]); } }
        }
        l += __shfl_xor(l, 32); const float il = 1.0f / l;
        if (valid) { bf16* op = p.XO + trow * 512 + h * 128;
#pragma unroll
            for (int d = 0; d < 4; ++d)
#pragma unroll
                for (int g = 0; g < 4; ++g) { u32x2 w; w[0] = pk2(o[d][4 * g] * il, o[d][4 * g + 1] * il); w[1] = pk2(o[d][4 * g + 2] * il, o[d][4 * g + 3] * il); *(u32x2*)(op + 32 * d + 8 * g + 4 * hh) = w; } }
    }
}
constexpr int SA_F32 = 0, SA_KPF = 65536, SA_CK = SA_KPF + 8192, SA_KP = SA_CK + 32768, SA_P = SA_KP + 64 * 40 * 2, SA_QS = SA_P + 64 * 72 * 2, SA_CORR = SA_QS + 65 * 104 * 2, SA_END = SA_CORR + 1024;
static_assert(SA_END <= LDS_CTL && SA_KP % 16 == 0 && SA_P % 16 == 0 && SA_QS % 16 == 0 && SA_CORR % 16 == 0, "sample attention LDS map");
DI void sattn_issue(const Params& p, LDS unsigned char* lds, int pid, int half, int wid, int lane) {
    const size_t key0 = (size_t)pid * PAGE + half * 64;
#pragma unroll
    for (int i = 0; i < 8; ++i) { const int key = wid * 8 + i; dma16(p.cckv + (key0 + key) * 256 + lane * 4, lds + SA_F32 + key * 1024); }
    dma16(p.ckpe + (key0 + wid * 8 + (lane >> 3)) * 32 + (lane & 7) * 4, lds + SA_KPF + wid * 1024);
}
DI void sattn_convert(LDS unsigned char* lds) {
    const int tid = tid_opaque();
#pragma unroll
    for (int j = 0; j < 4; ++j) { const int i = tid + NTHREADS * j, key = i >> 5, c32 = i & 31;
        const f32x4 a = *(const LDS f32x4*)(lds + SA_F32 + key * 1024 + c32 * 32), bq = *(const LDS f32x4*)(lds + SA_F32 + key * 1024 + c32 * 32 + 16);
        u32x4 w; w[0] = pk2(a[0], a[1]); w[1] = pk2(a[2], a[3]); w[2] = pk2(bq[0], bq[1]); w[3] = pk2(bq[2], bq[3]);
        *(LDS u32x4*)(lds + SA_CK + (c32 >> 4) * 16384 + imgb(key, c32 & 15)) = w; }
    { const int key = tid >> 3, c4 = (tid & 7) * 4; const f32x4 v = *(const LDS f32x4*)(lds + SA_KPF + key * 128 + c4 * 4); u32x2 w; w[0] = pk2(v[0], v[1]); w[1] = pk2(v[2], v[3]);
        *(LDS u32x2*)(lds + SA_KP + (key * 40 + c4) * 2) = w; }
}
DI void sattn_unit(const Params& p, LDS unsigned char* lds, int u) {
    const int tid = tid_opaque(), wid = __builtin_amdgcn_readfirstlane(tid >> 6), lane = tid & 63, r = lane & 31, hh = lane >> 5;
    LDS unsigned char* CK = lds + SA_CK; LDS bf16* KP = (LDS bf16*)(lds + SA_KP); LDS bf16* PA = (LDS bf16*)(lds + SA_P);
    LDS bf16* QS = (LDS bf16*)(lds + SA_QS); LDS float* CORR = (LDS float*)(lds + SA_CORR);
    const int b = u / NSPLIT, sp = u % NSPLIT; const int h = wid;
    const int pidv = p.ptab[b * NPAGES + sp * PPS + (lane % PPS)];
    sattn_issue(p, lds, rdlane(pidv, 0), 0, wid, lane);
    for (int i = tid; i < 65 * 96; i += NTHREADS) { const int row = i / 96, d = i % 96; float v = 0.f;
        if (row < 64) { const int hq = row >> 3, q = row & 7; v = bf2f(p.QN[(((size_t)TP + b * DECS + q) * 8 + hq) * 96 + d]); if (d < 64) v *= p.g_kn[d]; }
        QS[row * 104 + d] = f2bf(v); }
    const int l15 = lane & 15, quad = lane >> 4;
    bf16x8 wk[4][8];
    { const bf16* wkp = p.wt_kvb + (size_t)(h * 128 + l15) * 256 + 8 * quad;
#pragma unroll
        for (int dt = 0; dt < 4; ++dt)
#pragma unroll
            for (int ks = 0; ks < 8; ++ks) wk[dt][ks] = ld8g(wkp + dt * 16 * 256 + 32 * ks); }
#ifndef EMU
#pragma unroll
    for (int dt = 0; dt < 4; ++dt)
#pragma unroll
        for (int ks = 0; ks < 8; ++ks) asm volatile("" : "+v"(wk[dt][ks]));
#endif
    const int qrow = l15 < 8 ? h * 8 + l15 : 64;
    f32x16 acc0 = zero16(), acc1 = zero16(); float m = -INFINITY, l = 0.f;
    const int npt = PPS * 2, ntile = npt + (sp == NSPLIT - 1 ? 1 : 0);
    wait_vm0(); bar_lds(); sattn_convert(lds); bar_lds();
    for (int tile = 0; tile < ntile; ++tile) {
        const bool newt = tile == npt;
        unsigned lo_ = lane;
#ifndef EMU
        asm volatile("" : "+v"(lo_));
#endif
        const unsigned l15o = lo_ & 15, quado = lo_ >> 4;
        if (tile + 1 < npt) sattn_issue(p, lds, rdlane(pidv, (tile + 1) >> 1), (tile + 1) & 1, wid, lane);
#pragma unroll 1
        for (int kg = 0; kg < 4; ++kg) {
            f32x4 x[4];
#pragma unroll
            for (int dt = 0; dt < 4; ++dt) x[dt] = (f32x4){0.f, 0.f, 0.f, 0.f};
#pragma unroll
            for (int ks = 0; ks < 8; ++ks) { const bf16x8 cb = *(const LDS bf16x8*)(CK + (ks >> 2) * 16384 + imgb(16 * kg + l15o, 4 * (ks & 3) + quado));
#pragma unroll
                for (int dt = 0; dt < 4; ++dt) x[dt] = __builtin_amdgcn_mfma_f32_16x16x32_bf16(wk[dt][ks], cb, x[dt], 0, 0, 0); }
            float ss = 0.f;
#pragma unroll
            for (int dt = 0; dt < 4; ++dt) ss += x[dt][0] * x[dt][0] + x[dt][1] * x[dt][1] + x[dt][2] * x[dt][2] + x[dt][3] * x[dt][3];
            ss += __shfl_xor(ss, 16); ss += __shfl_xor(ss, 32); const float inv = rsqrtf(ss * (1.0f / 64.0f) + EPS);
            f32x4 z = {0.f, 0.f, 0.f, 0.f};
#pragma unroll
            for (int pp = 0; pp < 2; ++pp) {
                const bf16x8 a = pack8(x[2 * pp][0] * inv, x[2 * pp][1] * inv, x[2 * pp][2] * inv, x[2 * pp][3] * inv, x[2 * pp + 1][0] * inv, x[2 * pp + 1][1] * inv, x[2 * pp + 1][2] * inv, x[2 * pp + 1][3] * inv);
                const s16x4 q0 = *(const LDS s16x4*)(QS + qrow * 104 + 32 * pp + 4 * quad), q1 = *(const LDS s16x4*)(QS + qrow * 104 + 32 * pp + 16 + 4 * quad);
                z = __builtin_amdgcn_mfma_f32_16x16x32_bf16(a, __builtin_shufflevector(q0, q1, 0, 1, 2, 3, 4, 5, 6, 7), z, 0, 0, 0); }
            z = __builtin_amdgcn_mfma_f32_16x16x32_bf16(ld8(KP + (16 * kg + l15) * 40 + 8 * quad), ld8(QS + qrow * 104 + 64 + 8 * quad), z, 0, 0, 0);
            float tmax = -INFINITY;
#pragma unroll
            for (int j = 0; j < 4; ++j) { const int key = 16 * kg + 4 * quad + j; if (newt && (key > l15 || key >= DECS)) z[j] = -INFINITY; tmax = fmaxf(tmax, z[j]); }
            tmax = fmaxf(tmax, __shfl_xor(tmax, 16)); tmax = fmaxf(tmax, __shfl_xor(tmax, 32));
            if (l15 >= 8 || (newt && kg > 0)) tmax = fmaxf(tmax, -1e30f);
            const float mn = fmaxf(m, tmax), corr = fexp(m - mn); m = mn;
#pragma unroll
            for (int j = 0; j < 4; ++j) z[j] = fexp(z[j] - mn);
            l = l * corr + (z[0] + z[1]) + (z[2] + z[3]);
            if (l15 < 8) { u32x2 w; w[0] = pk2(z[0], z[1]); w[1] = pk2(z[2], z[3]); *(LDS u32x2*)(PA + (h * 8 + l15) * 72 + 16 * kg + 4 * quad) = w;
                if (quad == 0) CORR[kg * 64 + h * 8 + l15] = corr; }
        }
        bar_lds();
#pragma unroll
        for (int ks = 0; ks < 4; ++ks) { const float c0 = CORR[ks * 64 + r], c1 = CORR[ks * 64 + 32 + r];
#pragma unroll
            for (int i = 0; i < 16; ++i) { acc0[i] *= c0; acc1[i] *= c1; }
            const bf16x8 a = img_tr<false>(CK + (wid >> 2) * 16384, lo_, wid & 3, 16 * ks);
            acc0 = mfma32(a, ld8(PA + r * 72 + 16 * ks + 8 * hh), acc0); acc1 = mfma32(a, ld8(PA + (32 + r) * 72 + 16 * ks + 8 * hh), acc1); }
        if (tile + 1 < ntile) {
            if (tile + 1 < npt) { wait_vm0(); bar_lds(); sattn_convert(lds); }
            else { bar_lds(); const size_t t0 = (size_t)TP + b * DECS;
                for (int i = tid; i < 64 * 32; i += NTHREADS) { const int key = i >> 5, c32 = i & 31; bf16x8 v = zero8(); if (key < DECS) v = ld8g(p.CKVB + (t0 + key) * 256 + c32 * 8);
                    *(LDS bf16x8*)(CK + (c32 >> 4) * 16384 + imgb(key, c32 & 15)) = v; }
                for (int i = tid; i < 64 * 32; i += NTHREADS) { const int key = i >> 5, c = i & 31; KP[key * 40 + c] = key < DECS ? p.KPB[(t0 + key) * 32 + c] : (bf16)0; } }
            bar_lds();
        }
    }
    { const int t2 = tid_opaque(), w2 = __builtin_amdgcn_readfirstlane(t2 >> 6), l2 = t2 & 63, r2 = l2 & 31, h2 = l2 >> 5;
        float* pa = p.PACC + (size_t)u * 64 * 256;
#pragma unroll
        for (int g = 0; g < 4; ++g) { f32x4 v0 = {acc0[4 * g], acc0[4 * g + 1], acc0[4 * g + 2], acc0[4 * g + 3]}, v1 = {acc1[4 * g], acc1[4 * g + 1], acc1[4 * g + 2], acc1[4 * g + 3]};
            *(f32x4*)(pa + (size_t)r2 * 256 + 32 * w2 + 8 * g + 4 * h2) = v0; *(f32x4*)(pa + (size_t)(32 + r2) * 256 + 32 * w2 + 8 * g + 4 * h2) = v1; }
        l += __shfl_xor(l, 16); l += __shfl_xor(l, 32);
        if (l2 < 8) { p.PML[((size_t)u * 64 + w2 * 8 + r2) * 2] = m; p.PML[((size_t)u * 64 + w2 * 8 + r2) * 2 + 1] = l; } }
}
DI void phase_sattn_combine(const Params& p, LDS unsigned char* lds) {
    const int tid = tid_opaque();
    LDS float* AC = (LDS float*)lds; LDS float* WS = (LDS float*)(lds + 8 * 256 * 4);
    for (int u = blockIdx.x; u < DECB * 8; u += gridDim.x) { const int b = u >> 3, h = u & 7;
        if (tid < 8) { const int hq = h * 8 + tid; float M = -INFINITY; for (int j = 0; j < NSPLIT; ++j) M = fmaxf(M, p.PML[((size_t)(b * NSPLIT + j) * 64 + hq) * 2]);
            float L = 0.f; for (int j = 0; j < NSPLIT; ++j) { const float w = expf(p.PML[((size_t)(b * NSPLIT + j) * 64 + hq) * 2] - M); WS[tid * NSPLIT + j] = w; L += w * p.PML[((size_t)(b * NSPLIT + j) * 64 + hq) * 2 + 1]; }
            const float iL = 1.0f / L; for (int j = 0; j < NSPLIT; ++j) WS[tid * NSPLIT + j] *= iL; }
        __syncthreads();
        { const int q = tid >> 6, l4 = (tid & 63) * 4; f32x4 s = {0.f, 0.f, 0.f, 0.f};
#pragma unroll
            for (int j = 0; j < NSPLIT; ++j) s += WS[q * NSPLIT + j] * *(const f32x4*)(p.PACC + ((size_t)(b * NSPLIT + j) * 64 + h * 8 + q) * 256 + l4);
            *(LDS f32x4*)(AC + q * 256 + l4) = s; }
        __syncthreads();
        { const int q = tid >> 6, dv = tid & 63; const bf16* w = p.wt_kvb + (size_t)(h * 128 + 64 + dv) * 256; float s = 0.f;
#pragma unroll 4
            for (int c = 0; c < 32; ++c) { const bf16x8 wv = ld8g(w + 8 * c); const f32x4 a0 = *(const LDS f32x4*)(AC + q * 256 + 8 * c), a1 = *(const LDS f32x4*)(AC + q * 256 + 8 * c + 4);
                s += a0[0] * bf2f((bf16)wv[0]) + a0[1] * bf2f((bf16)wv[1]) + a0[2] * bf2f((bf16)wv[2]) + a0[3] * bf2f((bf16)wv[3]) + a1[0] * bf2f((bf16)wv[4]) + a1[1] * bf2f((bf16)wv[5]) + a1[2] * bf2f((bf16)wv[6]) + a1[3] * bf2f((bf16)wv[7]); }
            p.OMIX[((size_t)TP + b * DECS + q) * DM + 512 + h * 64 + dv] = f2bf(s); }
        __syncthreads();
    }
}
#ifndef EMU
#define XB_TMO      128
#define XB_XCNT(j)  (256  + 64 * (j))
#define XB_XSUB(j)  (1280 + 64 * (j))
#define XB_XGEN(j)  (2304 + 64 * (j))
#define XB_TOP      3328
#define XB_TOPGEN   3392
#define XCD_BAR_WORDS 3456
#define XB_SPIN_CAP (1u << 18)
#define LAS __attribute__((address_space(3)))
__device__ __forceinline__ unsigned xb_ld(unsigned* p)              { return __hip_atomic_load(p, __ATOMIC_RELAXED, __HIP_MEMORY_SCOPE_AGENT); }
__device__ __forceinline__ unsigned xb_add(unsigned* p, unsigned v) { return __hip_atomic_fetch_add(p, v, __ATOMIC_RELAXED, __HIP_MEMORY_SCOPE_AGENT); }
__device__ __forceinline__ unsigned xb_xcc_id() { return (unsigned)__builtin_amdgcn_s_getreg((3 << 11) | 20) & 0xFu; }
#define XB_SPIN(cond, bar) do { unsigned _sp = 0; while (cond) { __builtin_amdgcn_s_sleep(1); \
    if ((++_sp & 255u) == 0u) { if (xb_ld(&(bar)[XB_TMO])) break; if (_sp > XB_SPIN_CAP) { atomicAdd(&(bar)[XB_TMO], 1u); break; } } } } while (0)
struct XcdBarrier { unsigned* bar; unsigned x; volatile LAS unsigned* st; };
__device__ __forceinline__ XcdBarrier xcd_barrier_post(unsigned* bar, volatile LAS unsigned* st) {
    XcdBarrier b; b.bar = bar; b.x = xb_xcc_id(); b.st = st;
    if (threadIdx.x == 0) (void)xb_add(&bar[XB_XCNT(b.x)], 1u);
    return b;
}
__device__ __forceinline__ void xcd_barrier_complete(unsigned* bar, unsigned x, unsigned& nloc, unsigned& nx) {
    const unsigned G = gridDim.x * gridDim.y * gridDim.z;
    unsigned sum, cnt, mine, sp = 0u;
    for (;;) {
        sum = 0u; cnt = 0u; mine = 0u;
#pragma unroll
        for (unsigned j = 0; j < 16; ++j) { const unsigned c = xb_ld(&bar[XB_XCNT(j)]); sum += c; cnt += (c > 0u) ? 1u : 0u; mine = (j == x) ? c : mine; }
        if (sum == G) break;
        __builtin_amdgcn_s_sleep(1);
        if ((++sp & 255u) == 0u) { if (xb_ld(&bar[XB_TMO])) break; if (sp > XB_SPIN_CAP) { atomicAdd(&bar[XB_TMO], 1u); break; } }
    }
    nloc = mine > 0u ? mine : 1u; nx = cnt > 0u ? cnt : 1u;
}
__device__ __forceinline__ void xcd_barrier(const XcdBarrier& b) {
    asm volatile("s_waitcnt vmcnt(0)" ::: "memory");
    __syncthreads();
    if (threadIdx.x == 0) {
        unsigned* bar = b.bar;
        __builtin_amdgcn_s_waitcnt(0);
        unsigned nloc = b.st[0], nx = b.st[1];
        if (nloc == 0u) { xcd_barrier_complete(bar, b.x, nloc, nx); b.st[0] = nloc; b.st[1] = nx; }
        const unsigned old = xb_add(&bar[XB_XSUB(b.x)], 1u);
        const unsigned gen = old / nloc;
        if (old + 1u == (gen + 1u) * nloc) {
            __builtin_amdgcn_fence(__ATOMIC_RELEASE, "agent");
            asm volatile("s_waitcnt vmcnt(0)" ::: "memory");
            const unsigned og = xb_add(&bar[XB_TOP], 1u);
            const unsigned tg = og / nx;
            if (og + 1u == (tg + 1u) * nx) xb_add(&bar[XB_TOPGEN], 1u);
            else XB_SPIN(xb_ld(&bar[XB_TOPGEN]) == tg, bar);
            __builtin_amdgcn_fence(__ATOMIC_ACQUIRE, "agent");
            xb_add(&bar[XB_XGEN(b.x)], 1u);
            asm volatile("s_waitcnt vmcnt(0)" ::: "memory");
        } else {
            XB_SPIN(xb_ld(&bar[XB_XGEN(b.x)]) == gen, bar);
            __builtin_amdgcn_fence(__ATOMIC_ACQUIRE, "agent");
            asm volatile("s_waitcnt vmcnt(0)" ::: "memory");
        }
    }
    __syncthreads();
}
#endif

DI int wq_next(unsigned* ctr, LDS unsigned* slot) {
    __syncthreads();
    if (threadIdx.x == 0) *slot = atomicAdd(ctr, 1u);
    __syncthreads();
    return __builtin_amdgcn_readfirstlane((int)*slot);
}
struct EpiResF32 {
    static constexpr bool PERM = false, AFTER_DRAIN = false;
    float* C; const float* R0; const float* R1; int split;
    DI void operator()(const f32x4 (&acc)[2][2][4][2], const pg8::Unit& u, int wr, int wc, int fr, int fq) const {
        const int row0 = u.pm * 256 + wr * 64 + fr, col0 = u.pn * 256 + wc * 32 + 4 * fq;
        const float* R = row0 < split ? R0 : R1 - (size_t)split * DM;
#pragma unroll
        for (int ai = 0; ai < 2; ++ai)
#pragma unroll
            for (int mp = 0; mp < 2; ++mp) { f32x4 rr[2][2][2];
#pragma unroll
                for (int mm = 0; mm < 2; ++mm) { const size_t off = (size_t)(row0 + ai * 128 + (2 * mp + mm) * 16) * DM + col0;
#pragma unroll
                    for (int bj = 0; bj < 2; ++bj)
#pragma unroll
                        for (int n = 0; n < 2; ++n) rr[mm][bj][n] = *(const f32x4*)(R + off + bj * 128 + n * 16); }
#pragma unroll
                for (int mm = 0; mm < 2; ++mm) { const size_t off = (size_t)(row0 + ai * 128 + (2 * mp + mm) * 16) * DM + col0;
#pragma unroll
                    for (int bj = 0; bj < 2; ++bj)
#pragma unroll
                        for (int n = 0; n < 2; ++n) *(f32x4*)(C + off + bj * 128 + n * 16) = acc[ai][bj][2 * mp + mm][n] + rr[mm][bj][n]; }
#ifndef EMU
                asm volatile("" ::: "memory");
#endif
            }
    }
};
DI void phase_norm_rows(const Params& p, const float* X, const float* g) {
    const int tid = tid_opaque(), wid = __builtin_amdgcn_readfirstlane(tid >> 6), lane = tid & 63;
    for (int row = blockIdx.x * 8 + wid; row < T; row += gridDim.x * 8) rmsnorm_row_1024(X + (size_t)row * DM, g, p.H + (size_t)row * DM, lane);
}
constexpr int NPHASE = 15;
template <int PH> DI void run_phase(const Params& p, LDS unsigned char* lds) {
    LDS unsigned* slot = (LDS unsigned*)(lds + LDS_CTL + 64);
    if constexpr (PH == 0) phase_prep(p, lds);
    else if constexpr (PH == 1) { run_gemm(lds, p.H, p.wt_in, T, DINP, DM, EpiStoreBf16<0>{p.Z, DINP}, 0); run_gemm(lds, p.MEMN, p.wt_xkv, MROWS, 1024, DM, EpiStoreF32{p.MKV, nullptr, 1024}, 100); }
    else if constexpr (PH == 2) { phase_post_in(p); if (DUPM & 8) phase_post_in(p); }
    else if constexpr (PH == 3) { run_gemm(lds, p.QAN, p.wt_qb, T, 768, 384, EpiStoreBf16<0>{p.QF, 768}, 0); run_gemm(lds, p.CKVB, p.wt_kvb, T, 1024, 256, EpiStoreBf16<0>{p.KV, 1024}, 140); __syncthreads(); phase_gla_a(p, lds); }
    else if constexpr (PH == 4) { phase_post_qkv(p); if (DUPM & 16) phase_post_qkv(p); phase_gla_b(p); }
    else if constexpr (PH == 5) {
        for (int rep = 0; rep < ((DUPM & 1) ? 2 : 1); ++rep) for (;;) { const int u = wq_next(p.ctl + CW_Q5 + 192 * rep, slot); if (u >= NU_SA) break; sattn_unit(p, lds, u); }
        for (int rep = 0; rep < ((DUPM & 2) ? 2 : 1); ++rep) for (;;) { const int u = wq_next(p.ctl + CW_Q5 + 64 + 192 * rep, slot); if (u >= NU_PA) break; pattn_unit(p, lds, u); }
        for (int rep = 0; rep < ((DUPM & 4) ? 2 : 1); ++rep) for (;;) { const int u = wq_next(p.ctl + CW_Q5 + 128 + 192 * rep, slot); if (u >= NGU) break; gla_c_unit(p, lds, u); } }
    else if constexpr (PH == 6) phase_sattn_combine(p, lds);
    else if constexpr (PH == 7) run_gemm(lds, p.OMIX, p.wt_out, T, DM, DM, EpiResF32{p.X1, p.xp, p.xs, TP}, 0);
    else if constexpr (PH == 8) phase_norm_rows(p, p.X1, p.g_x);
    else if constexpr (PH == 9) run_gemm(lds, p.H, p.wt_xq, T, 512, DM, EpiStoreBf16<0>{p.XQ, 512}, 0);
    else if constexpr (PH == 10) { unsigned* ctr = p.ctl + CW_QX; if (DUPP & (1 << 10)) { __syncthreads(); if (*(volatile unsigned*)ctr >= (unsigned)(NU_XS + NU_XP) ) ctr += 64; }
        for (;;) { const int u = wq_next(ctr, slot); if (u >= NU_XS + NU_XP) break; xattn_unit(p, lds, u < NU_XS ? NU_XP + u : u - NU_XS); } }
    else if constexpr (PH == 11) run_gemm(lds, p.XO, p.wt_xo, T, DM, 512, EpiResF32{p.X2, p.X1, p.X1, T}, 0);
    else if constexpr (PH == 12) phase_norm_rows(p, p.X2, p.g_ff);
    else if constexpr (PH == 13) run_gemm(lds, p.H, p.wt_ff1, T, DFF, DM, EpiStoreBf16<1>{p.U, DFF}, 0);
    else if constexpr (PH == 14) run_gemm(lds, p.U, p.wt_ff2, T, DM, DFF, EpiResF32{p.y, p.X2, p.X2, T}, 0);
}
#ifdef EMU
#define GET_LDS() ((LDS unsigned char*)EMU_SMEM())
#define GRID_BAR() emu_grid_barrier()
#else
#define GET_LDS() ((LDS unsigned char*)lds_raw)
#define GRID_BAR() xcd_barrier(bar)
#endif
template <int PH> __global__ void __launch_bounds__(NTHREADS, 2) k_phase(Params p) {
#ifndef EMU
    extern __shared__ __attribute__((aligned(16))) unsigned char lds_raw[];
#endif
    run_phase<PH>(p, GET_LDS());
}
#if N_LAUNCH_MODE == 1
__global__ void __launch_bounds__(NTHREADS, 2) k_mega(Params p) {
#ifndef EMU
    extern __shared__ __attribute__((aligned(16))) unsigned char lds_raw[];
    LDS unsigned char* lds = GET_LDS();
    if (threadIdx.x < 64) ((LDS unsigned*)(lds + LDS_CTL))[threadIdx.x] = 0u;
    __syncthreads();
    XcdBarrier bar = xcd_barrier_post(p.ctl + CW_BAR, (volatile LDS unsigned*)(lds + LDS_CTL));
#else
    LDS unsigned char* lds = GET_LDS();
#endif
    run_phase<0>(p, lds); if (DUPP & (1 << 0)) run_phase<0>(p, lds); GRID_BAR();
    run_phase<1>(p, lds); if (DUPP & (1 << 1)) run_phase<1>(p, lds); GRID_BAR();
    run_phase<2>(p, lds); if (DUPP & (1 << 2)) run_phase<2>(p, lds); GRID_BAR();
    run_phase<3>(p, lds); if (DUPP & (1 << 3)) run_phase<3>(p, lds); GRID_BAR();
    run_phase<4>(p, lds); GRID_BAR();
    run_phase<5>(p, lds); GRID_BAR();
    run_phase<6>(p, lds); if (DUPP & (1 << 6)) run_phase<6>(p, lds); GRID_BAR();
    run_phase<7>(p, lds); if (DUPP & (1 << 7)) run_phase<7>(p, lds); GRID_BAR();
    run_phase<8>(p, lds); if (DUPP & (1 << 8)) run_phase<8>(p, lds); GRID_BAR();
    run_phase<9>(p, lds); if (DUPP & (1 << 9)) run_phase<9>(p, lds); GRID_BAR();
    run_phase<10>(p, lds); if (DUPP & (1 << 10)) run_phase<10>(p, lds); GRID_BAR();
    run_phase<11>(p, lds); if (DUPP & (1 << 11)) run_phase<11>(p, lds); GRID_BAR();
    run_phase<12>(p, lds); if (DUPP & (1 << 12)) run_phase<12>(p, lds); GRID_BAR();
    run_phase<13>(p, lds); if (DUPP & (1 << 13)) run_phase<13>(p, lds); GRID_BAR();
    run_phase<14>(p, lds); if (DUPP & (1 << 14)) run_phase<14>(p, lds);
}
#endif

static size_t ws_take(size_t& off, size_t bytes) { const size_t o = off; off = (off + bytes + 255) & ~(size_t)255; return o; }
template <int PH> static void launch_phase(const Params& p, int grid, hipStream_t stream) {
#ifndef EMU
    static bool attr = false; if (!attr) { (void)hipFuncSetAttribute((const void*)k_phase<PH>, hipFuncAttributeMaxDynamicSharedMemorySize, LDS_BYTES); attr = true; }
#endif
    LAUNCH(k_phase<PH>, dim3(grid), dim3(NTHREADS), LDS_BYTES, stream, p);
}
extern "C" void kernel_launch(void* const* d_in, const int* in_sizes, int n_in, void* d_out, int out_size, void* d_ws, size_t ws_size, hipStream_t stream) {
    Params p{};
    const float* const* in = (const float* const*)d_in;
    p.xp = in[0]; p.xs = in[1]; p.memp = in[2]; p.cckv = in[3]; p.ckpe = in[4]; p.cmk = in[5]; p.cmv = in[6]; p.sgla = in[7]; p.ptab = (const int*)d_in[8];
    p.g_mix = in[9]; p.w_a2 = in[11]; p.b_a = in[12]; p.g_gla_o = in[13]; p.g_qa = in[14]; p.g_kva = in[16]; p.g_qn = in[18]; p.g_kn = in[19]; p.g_qr = in[20]; p.g_kr = in[21];
    p.g_x = in[23]; p.g_mem = in[24]; p.g_xq = in[28]; p.g_xk = in[29]; p.g_ff = in[31];
    float* out = (float*)d_out; size_t oo = 0;
    p.y = out; oo += (size_t)T * DM; p.o_ckvp = out + oo; oo += (size_t)TP * 256; p.o_kpep = out + oo; oo += (size_t)TP * 32; p.o_mkp = out + oo; oo += (size_t)MROWS * 512; p.o_mvp = out + oo; oo += (size_t)MROWS * 512;
    p.o_glap = out + oo; oo += (size_t)BATCH * 4 * 8192; p.o_ckvs = out + oo; oo += (size_t)TS * 256; p.o_kpes = out + oo; oo += (size_t)TS * 32; p.o_glas = out + oo; oo += (size_t)DECB * 4 * 8192;
    if ((size_t)out_size != oo || n_in != 34) { fprintf(stderr, "kernel_launch: unexpected sizes (out %d vs %zu, n_in %d)\n", out_size, oo, n_in); }
    unsigned char* ws = (unsigned char*)d_ws; size_t off = 0;
    p.ctl = (unsigned*)(ws + ws_take(off, 1 << 20));
#define WSB(name, elems) p.name = (bf16*)(ws + ws_take(off, (size_t)(elems) * 2))
#define WSF(name, elems) p.name = (float*)(ws + ws_take(off, (size_t)(elems) * 4))
    WSB(wt_in, (size_t)DINP * DM); WSB(wt_qb, 768 * 384); WSB(wt_kvb, 1024 * 256); WSB(wt_out, DM * DM); WSB(wt_xq, 512 * DM); WSB(wt_xkv, 1024 * DM); WSB(wt_xo, DM * 512); WSB(wt_ff1, (size_t)DFF * DM); WSB(wt_ff2, (size_t)DM * DFF);
    WSB(H, (size_t)T * DM); WSB(MEMN, (size_t)MROWS * DM); WSB(Z, (size_t)T * DINP); WSB(QAN, (size_t)T * 384); WSB(CKVB, (size_t)T * 256); WSB(KPB, (size_t)T * 32); WSB(MKB, (size_t)MROWS * 512); WSB(MVB, (size_t)MROWS * 512);
    WSB(QF, (size_t)T * 768); WSB(KV, (size_t)T * 1024); WSB(QN, (size_t)T * 768); WSB(KN, (size_t)T * 512); WSB(OMIX, (size_t)T * DM); WSB(XQ, (size_t)T * 512); WSB(XO, (size_t)T * 512); WSB(U, (size_t)T * DFF);
    WSF(MKV, (size_t)MROWS * 1024); WSF(LOGA, (size_t)T * 256); WSF(DS, (size_t)NGU * 8192); WSF(DDEC, (size_t)NGU * 64); WSF(X1, (size_t)T * DM); WSF(X2, (size_t)T * DM); WSF(PACC, (size_t)NU_SA * 64 * 256); WSF(PML, (size_t)NU_SA * 128);
    if (off > ws_size) { fprintf(stderr, "kernel_launch: workspace too small (%zu > %zu)\n", off, ws_size); return; }
    p.w_in = in[10]; p.w_qb = in[15]; p.w_kvb = in[17]; p.w_out = in[22]; p.w_xq = in[25]; p.w_xk = in[26]; p.w_xv = in[27]; p.w_xo = in[30]; p.w_ff1 = in[32]; p.w_ff2 = in[33];
    (void)hipMemsetAsync(p.ctl, 0, 1 << 20, stream);
#ifdef EMU
    const int grid = EMU_GRID;
#else
    static int grid = 0;
    if (!grid) { int dev = 0, cus = 0; (void)hipGetDevice(&dev); (void)hipDeviceGetAttribute(&cus, hipDeviceAttributeMultiprocessorCount, dev); grid = cus > 0 ? cus : 256;
#if N_LAUNCH_MODE == 1
        (void)hipFuncSetAttribute((const void*)k_mega, hipFuncAttributeMaxDynamicSharedMemorySize, LDS_BYTES);
        int per_cu = 0; if (hipOccupancyMaxActiveBlocksPerMultiprocessor(&per_cu, (const void*)k_mega, NTHREADS, LDS_BYTES) != hipSuccess || per_cu < 1) fprintf(stderr, "kernel_launch: occupancy query reports %d workgroups per CU\n", per_cu);
#endif
    }
#endif
#if N_LAUNCH_MODE == 1
    LAUNCH(k_mega, dim3(grid), dim3(NTHREADS), LDS_BYTES, stream, p);
#else
    launch_phase<0>(p, grid, stream); launch_phase<1>(p, grid, stream); launch_phase<2>(p, grid, stream); launch_phase<3>(p, grid, stream); launch_phase<4>(p, grid, stream);
    launch_phase<5>(p, grid, stream); launch_phase<6>(p, grid, stream); launch_phase<7>(p, grid, stream); launch_phase<8>(p, grid, stream); launch_phase<9>(p, grid, stream);
    launch_phase<10>(p, grid, stream); launch_phase<11>(p, grid, stream); launch_phase<12>(p, grid, stream); launch_phase<13>(p, grid, stream); launch_phase<14>(p, grid, stream);
#endif
}
```

```cpp
#ifdef EMU
#include "emu.h"
#define LDS
#else
#include <hip/hip_runtime.h>
#define LDS __attribute__((address_space(3)))
#define LAUNCH(kern, grid, block, smem, stream, ...) kern<<<grid, block, smem, stream>>>(__VA_ARGS__)
#endif
#include <cstdio>
#include <cstdint>
#include <cmath>
#define DI __device__ __forceinline__

#ifndef CFG_BATCH
#define CFG_BATCH 16
#define CFG_SEQ 2048
#define CFG_DECB 128
#define CFG_PAST 8192
#endif
#ifndef DUPP
#define DUPP 0
#endif
#ifndef DUPM
#define DUPM 0
#endif
#ifndef N_LAUNCH_MODE
#define N_LAUNCH_MODE 1
#endif

typedef unsigned short bf16;
typedef short bf16x8 __attribute__((ext_vector_type(8)));
typedef short s16x4 __attribute__((ext_vector_type(4)));
typedef float f32x4 __attribute__((ext_vector_type(4)));
typedef float f32x16 __attribute__((ext_vector_type(16)));
typedef unsigned u32x4 __attribute__((ext_vector_type(4)));
typedef unsigned u32x2 __attribute__((ext_vector_type(2)));

constexpr int DM = 1024, BATCH = CFG_BATCH, SEQ = CFG_SEQ, DECB = CFG_DECB, DECS = 8, PAST = CFG_PAST, PAGE = 128, NPAGES = PAST / PAGE;
constexpr int NMEM = 256, TP = BATCH * SEQ, TS = DECB * DECS, T = TP + TS, MROWS = BATCH * NMEM;
constexpr int DIN = 2224, DINP = 2304, DFF = 4096;
constexpr int ZQ = 0, ZK = 256, ZV = 512, ZR = 1024, ZA = 1536, ZQA = 1552, ZKVA = 1936, ZKPE = 2192;
constexpr float EPS = 1e-6f, MLA_SCALE = 0.10206207261596577f  , X_SCALE = 0.08838834764831845f  ;
constexpr int NC = SEQ / 64;
constexpr int NGP = BATCH * 4 * NC, NGS = DECB * 4, NGU = NGP + NGS;
constexpr int NSPLIT = NPAGES >= 8 ? 8 : NPAGES, PPS = NPAGES / NSPLIT;
constexpr int NU_SA = DECB * NSPLIT, NQB = SEQ / 256, NU_PA = BATCH * 8 * NQB;
constexpr int NU_XP = BATCH * 4 * NQB, NU_XS = DECB * 4;
static_assert(T % 256 == 0 && MROWS % 256 == 0 && SEQ % 256 == 0 && NPAGES % NSPLIT == 0, "shape assumptions");
constexpr int NTHREADS = 512, LDS_BYTES = 147456, LDS_CTL = LDS_BYTES - 256;

DI int tid_opaque() {
    int t = threadIdx.x;
#ifndef EMU
    asm volatile("" : "+v"(t));
#endif
    return t;
}
DI float bf2f(bf16 b) { return __uint_as_float(((unsigned)b) << 16); }
DI bf16 f2bf(float x) {
#ifdef EMU
    unsigned u = __float_as_uint(x); u += 0x7fffu + ((u >> 16) & 1u); return (bf16)(u >> 16);
#else
    return __builtin_bit_cast(unsigned short, (__bf16)x);
#endif
}
DI float fexp(float x) {
#ifdef EMU
    return exp2f(x * 1.4426950408889634f);
#else
    return __builtin_amdgcn_exp2f(x * 1.4426950408889634f);
#endif
}
DI unsigned pk2(float a, float b) { return (unsigned)f2bf(a) | ((unsigned)f2bf(b) << 16); }
DI f32x16 zero16() { f32x16 z; for (int i = 0; i < 16; ++i) z[i] = 0.f; return z; }
DI f32x16 mfma32(bf16x8 a, bf16x8 b, f32x16 c) { return __builtin_amdgcn_mfma_f32_32x32x16_bf16(a, b, c, 0, 0, 0); }
DI int crow(int i, int h) { return (i & 3) + 8 * (i >> 2) + 4 * h; }
DI bf16x8 ld8(const LDS bf16* p) { return *(const LDS bf16x8*)p; }
DI bf16x8 ld8g(const bf16* p) { return *(const bf16x8*)p; }
DI bf16x8 ldperm(const LDS bf16* p16, int h) {
    const s16x4 lo = *(const LDS s16x4*)(p16 + 4 * h), hi = *(const LDS s16x4*)(p16 + 8 + 4 * h);
    return __builtin_shufflevector(lo, hi, 0, 1, 2, 3, 4, 5, 6, 7);
}
DI bf16x8 ldpermg(const bf16* p16, int h) {
    const s16x4 lo = *(const s16x4*)(p16 + 4 * h), hi = *(const s16x4*)(p16 + 8 + 4 * h);
    return __builtin_shufflevector(lo, hi, 0, 1, 2, 3, 4, 5, 6, 7);
}
DI bf16x8 pack8(float a0, float a1, float a2, float a3, float a4, float a5, float a6, float a7) {
    u32x4 p; p[0] = pk2(a0, a1); p[1] = pk2(a2, a3); p[2] = pk2(a4, a5); p[3] = pk2(a6, a7); return __builtin_bit_cast(bf16x8, p);
}
#define PACK(x, s) pack8((x)[8 * (s)], (x)[8 * (s) + 1], (x)[8 * (s) + 2], (x)[8 * (s) + 3], (x)[8 * (s) + 4], (x)[8 * (s) + 5], (x)[8 * (s) + 6], (x)[8 * (s) + 7])
DI float wsum(float v) { for (int o = 32; o >= 1; o >>= 1) v += __shfl_xor(v, o); return v; }
DI bf16x8 zero8() { bf16x8 z; for (int i = 0; i < 8; ++i) z[i] = 0; return z; }

DI unsigned imgb(unsigned row, unsigned ch) { return 256u * row + 16u * (ch ^ (((row & 3u) << 2) | ((row >> 2) & 3u))); }
DI bf16x8 img_row(const LDS unsigned char* img, unsigned row, unsigned s, unsigned hh) { return *(const LDS bf16x8*)(img + imgb(row, 2 * s + hh)); }
DI s16x4 tr16(const LDS unsigned char* a) {
#ifdef EMU
    return emu_tr16_b64(a);
#else
    return __builtin_amdgcn_ds_read_tr16_b64_v4i16((LDS s16x4*)a);
#endif
}
template <bool PERM> DI bf16x8 img_tr(const LDS unsigned char* img, unsigned lane, unsigned c, unsigned k16) {
    const unsigned hh = lane >> 5, blk = (lane >> 4) & 1, q = (lane & 15) >> 2, pp = lane & 3;
    const unsigned r0 = k16 + (PERM ? 4 * hh : 8 * hh) + q, r1 = r0 + (PERM ? 8 : 4), ch = 4 * c + 2 * blk + (pp >> 1);
    const LDS unsigned char* a0 = img + imgb(r0, ch) + 8 * (pp & 1); const LDS unsigned char* a1 = img + imgb(r1, ch) + 8 * (pp & 1);
#ifdef EMU
    const s16x4 lo = emu_tr16_b64(a0), hi = emu_tr16_b64(a1);
#else
    s16x4 lo, hi;
    asm volatile("ds_read_b64_tr_b16 %0, %2\n\tds_read_b64_tr_b16 %1, %3\n\ts_waitcnt lgkmcnt(0)" : "=&v"(lo), "=&v"(hi) : "v"((unsigned)(size_t)a0), "v"((unsigned)(size_t)a1) : "memory");
#endif
    return __builtin_shufflevector(lo, hi, 0, 1, 2, 3, 4, 5, 6, 7);
}
DI void dma16(const void* g, LDS unsigned char* l) {
#ifdef EMU
    emu_dma16(g, l);
#else
    __builtin_amdgcn_global_load_lds((const unsigned*)g, (LDS unsigned*)l, 16, 0, 0);
#endif
}
#ifdef EMU
#define SCHED_FENCE() do {} while (0)
#else
#define SCHED_FENCE() __builtin_amdgcn_sched_barrier(0)
#endif
DI int rdlane(int v, int l) {
#ifdef EMU
    return __shfl(v, l);
#else
    return __builtin_amdgcn_readlane(v, l);
#endif
}
DI void wait_vm0() {
#ifndef EMU
    asm volatile("s_waitcnt vmcnt(0)" ::: "memory");
#endif
}
DI void bar_lds() {
#ifdef EMU
    __syncthreads();
#else
    asm volatile("s_waitcnt lgkmcnt(0)" ::: "memory"); __builtin_amdgcn_s_barrier(); asm volatile("" ::: "memory");
#endif
}

namespace pg8 {
#define PG8_LAS LDS
typedef unsigned short bf16_t;
constexpr int BM = 256, BK = 64, HALF = 128, HTB = HALF * BK * 2  , STAGE_BYTES = 8 * HTB, NXCD = 8, WGM = 8;
__host__ __device__ __forceinline__ int lds_byte(int r, int c) { const int st = (r >> 4) * 2 + (c >> 5), rr = r & 15, cc = c & 31, ob = rr * 64 + cc * 2; return st * 1024 + (ob ^ (((ob >> 9) & 1) << 5)); }
__host__ __device__ __forceinline__ void stage_rc(int b, int& R, int& C) { const int st = b / 1024, sb = b % 1024, swz = sb ^ (((sb >> 9) & 1) << 5); R = (st >> 1) * 16 + swz / 64; C = (st & 1) * 32 + (swz % 64) / 2; }
__host__ __device__ __forceinline__ int perm32(int rho) { const int n = rho >> 4, i = rho & 15; return 8 * (i >> 2) + 4 * n + (i & 3); }
struct Unit { int pm, pn; };
struct Gemm { const bf16_t* A; const bf16_t* Bt; int M, N, K; };
struct StaticOrder {
    int nM, nN, nwg, G, c;
    __host__ __device__ void init(int M, int N, int G_, int c_) { nM = M / BM; nN = N / BM; nwg = nM * nN; G = G_; c = c_; }
    __host__ __device__ bool next(int i, Unit& u) const {
        const long L = (long)i * G + c; if (L >= nwg) return false;
        int wgid = (int)L; { const int q = nwg / NXCD, r = nwg % NXCD, xcd = wgid % NXCD, off = wgid / NXCD; wgid = (xcd < r ? xcd * (q + 1) : r * (q + 1) + (xcd - r) * q) + off; }
        const int nig = WGM * nN, gid = wgid / nig, fm = gid * WGM, gsz = (nM - fm) < WGM ? (nM - fm) : WGM;
        u.pm = fm + ((wgid % nig) % gsz); u.pn = (wgid % nig) / gsz; return true;
    }
    __device__ __forceinline__ void a_ready(const Unit&) const {}
    __device__ __forceinline__ void done(const Unit&) const {}
};
#ifdef EMU
template <class Epi, class Sched>
__device__ __forceinline__ void gemm_phase(PG8_LAS unsigned char* lds, const Gemm g, const Sched& S, const Epi& E) {
    const int tid = tid_opaque(), wid = __builtin_amdgcn_readfirstlane(tid >> 6), lane = tid & 63, wr = wid >> 2, wc = wid & 3, fr = lane & 15, fq = lane >> 4;
    Unit cur;
    for (int ui = 0; S.next(ui, cur); ++ui) {
        f32x4 acc[2][2][4][2];
        for (int ai = 0; ai < 2; ++ai) for (int bj = 0; bj < 2; ++bj) for (int m = 0; m < 4; ++m) for (int n = 0; n < 2; ++n) for (int j = 0; j < 4; ++j) {
            const int row = 256 * cur.pm + 128 * ai + 64 * wr + 16 * m + fr;
            const int col = Epi::PERM ? 256 * cur.pn + 128 * bj + 32 * wc + 8 * fq + 4 * n + j : 256 * cur.pn + 128 * bj + 32 * wc + 16 * n + 4 * fq + j;
            const bf16_t* a = g.A + (size_t)row * g.K; const bf16_t* b = g.Bt + (size_t)col * g.K; float s = 0.f;
            for (int k = 0; k < g.K; ++k) s += bf2f(a[k]) * bf2f(b[k]);
            acc[ai][bj][m][n][j] = s;
        }
        E(acc, cur, wr, wc, fr, fq);
    }
}
#else
template <class Epi, class Sched>
__device__ __forceinline__ void gemm_phase(PG8_LAS unsigned char* lds, const Gemm g, const Sched& S, const Epi& E) {
    const int tid = tid_opaque(), wid = __builtin_amdgcn_readfirstlane(tid >> 6), lane = tid & 63, wr = wid >> 2, wc = wid & 3, fr = lane & 15, fq = lane >> 4;
    const int K = g.K, nt = K / BK;
    unsigned voffA[2], voffB[2];
#pragma unroll
    for (int i = 0; i < 2; ++i) { int R, C; stage_rc(tid * 16 + i * 8192, R, C); const int Rb = Epi::PERM ? ((R & ~31) + perm32(R & 31)) : R;
        voffA[i] = (unsigned)(R * K + C) * 2u; voffB[i] = (unsigned)(Rb * K + C) * 2u; }
    const size_t kstep = (size_t)(BK * 2);
    const size_t hstep = (size_t)HALF * K * 2;
    const size_t tstep = 2 * hstep;
    const unsigned ldsw = (unsigned)wid * 1024u;
    const int aoff = lds_byte(wr * 64 + fr, fq * 8), boff = lds_byte(wc * 32 + fr, fq * 8);
#define PG8_SA(b, h) (((b) * 2 + (h)) * HTB)
#define PG8_SB(b, h) ((4 + (b) * 2 + (h)) * HTB)
#define PG8_STAGE(bufoff, gbase, voff) do { _Pragma("unroll") for (int _i = 0; _i < 2; ++_i) \
        __builtin_amdgcn_global_load_lds((const unsigned*)((const char*)(gbase) + (voff)[_i]), (PG8_LAS unsigned*)(lds + (bufoff) + ldsw + _i * 8192), 16, 0, 0); } while (0)
#define PG8_LDA(dst, b, h) do { _Pragma("unroll") for (int m = 0; m < 4; ++m) _Pragma("unroll") for (int k = 0; k < 2; ++k) dst[m][k] = *(const PG8_LAS bf16x8*)(lds + PG8_SA(b, h) + aoff + m * 2048 + k * 1024); } while (0)
#define PG8_LDB(dst, b, h) do { _Pragma("unroll") for (int n = 0; n < 2; ++n) _Pragma("unroll") for (int k = 0; k < 2; ++k) dst[n][k] = *(const PG8_LAS bf16x8*)(lds + PG8_SB(b, h) + boff + n * 2048 + k * 1024); } while (0)
#define PG8_MMA(ai, bj, At, Bt) do { __builtin_amdgcn_s_setprio(1); _Pragma("unroll") for (int m = 0; m < 4; ++m) _Pragma("unroll") for (int n = 0; n < 2; ++n) _Pragma("unroll") for (int k = 0; k < 2; ++k) \
        acc[ai][bj][m][n] = __builtin_amdgcn_mfma_f32_16x16x32_bf16(Bt[n][k], At[m][k], acc[ai][bj][m][n], 0, 0, 0); __builtin_amdgcn_s_setprio(0); } while (0)
#define PG8_WAIT_V(n) asm volatile("s_waitcnt vmcnt(" #n ")" ::: "memory")
#define PG8_WAIT_L(n) asm volatile("s_waitcnt lgkmcnt(" #n ")" ::: "memory")
#define PG8_BAR __builtin_amdgcn_s_barrier()
#define PG8_SCHED __builtin_amdgcn_sched_barrier(0)
    Unit cur, nxt; int ui = 0;
    if (!S.next(0, cur)) return;
    f32x4 acc[2][2][4][2];
#pragma unroll
    for (int a = 0; a < 2; ++a)
#pragma unroll
        for (int b = 0; b < 2; ++b)
#pragma unroll
            for (int m = 0; m < 4; ++m)
#pragma unroll
                for (int n = 0; n < 2; ++n) acc[a][b][m][n] = (f32x4){0.f, 0.f, 0.f, 0.f};
    bf16x8 At[4][2], B0[2][2], B1[2][2];
    const char* cA = (const char*)g.A + (size_t)cur.pm * tstep; const char* cB = (const char*)g.Bt + (size_t)cur.pn * tstep;
    S.a_ready(cur);
    PG8_STAGE(PG8_SB(0, 0), cB, voffB); PG8_STAGE(PG8_SA(0, 0), cA, voffA); PG8_STAGE(PG8_SB(0, 1), cB + hstep, voffB); PG8_STAGE(PG8_SA(0, 1), cA + hstep, voffA);
    if (wr == 1) PG8_BAR;
    PG8_WAIT_V(4); PG8_BAR;
    PG8_STAGE(PG8_SB(1, 0), cB + kstep, voffB); PG8_STAGE(PG8_SA(1, 0), cA + kstep, voffA); PG8_STAGE(PG8_SB(1, 1), cB + hstep + kstep, voffB);
    PG8_WAIT_V(6); PG8_BAR;
    for (;;) {
        const bool has_next = S.next(ui + 1, nxt);
        const char* nA = has_next ? (const char*)g.A + (size_t)nxt.pm * tstep : cA; const char* nB = has_next ? (const char*)g.Bt + (size_t)nxt.pn * tstep : cB;
        for (int t = 0; t < nt; t += 2) {
            const bool last = (t == nt - 2);
            const char* a1 = cA + (size_t)(t + 1) * kstep;
            const char* a2 = last ? nA : cA + (size_t)(t + 2) * kstep; const char* b2 = last ? nB : cB + (size_t)(t + 2) * kstep;
            const char* a3 = a2 + kstep; const char* b3 = b2 + kstep;
            if (last && has_next) S.a_ready(nxt);
            PG8_LDB(B0, 0, 0); PG8_SCHED; PG8_LDA(At, 0, 0); PG8_STAGE(PG8_SA(1, 1), a1 + hstep, voffA);
            PG8_WAIT_L(8); PG8_BAR; PG8_WAIT_L(0); PG8_MMA(0, 0, At, B0); PG8_BAR; PG8_SCHED;
            PG8_LDB(B1, 0, 1); PG8_STAGE(PG8_SB(0, 0), b2, voffB);
            PG8_BAR; PG8_WAIT_L(0); PG8_MMA(0, 1, At, B1); PG8_BAR;
            PG8_LDA(At, 0, 1); PG8_STAGE(PG8_SA(0, 0), a2, voffA);
            PG8_BAR; PG8_WAIT_L(0); PG8_MMA(1, 0, At, B0); PG8_BAR; PG8_SCHED;
            PG8_STAGE(PG8_SB(0, 1), b2 + hstep, voffB);
            PG8_WAIT_V(6); PG8_BAR; PG8_MMA(1, 1, At, B1); PG8_BAR;
            PG8_LDB(B0, 1, 0); PG8_SCHED; PG8_LDA(At, 1, 0); PG8_STAGE(PG8_SA(0, 1), a2 + hstep, voffA);
            PG8_WAIT_L(8); PG8_BAR; PG8_WAIT_L(0); PG8_MMA(0, 0, At, B0); PG8_BAR; PG8_SCHED;
            PG8_LDB(B1, 1, 1); PG8_STAGE(PG8_SB(1, 0), b3, voffB);
            PG8_BAR; PG8_WAIT_L(0); PG8_MMA(0, 1, At, B1); PG8_BAR;
            PG8_LDA(At, 1, 1); PG8_STAGE(PG8_SA(1, 0), a3, voffA);
            PG8_BAR; PG8_WAIT_L(0); PG8_MMA(1, 0, At, B0); PG8_BAR; PG8_SCHED;
            PG8_STAGE(PG8_SB(1, 1), b3 + hstep, voffB);
            PG8_WAIT_V(6); PG8_BAR; PG8_MMA(1, 1, At, B1); PG8_BAR;
        }
        if constexpr (!Epi::AFTER_DRAIN) { E(acc, cur, wr, wc, fr, fq); S.done(cur); }
        if (!has_next) break;
#pragma unroll
        for (int a = 0; a < 2; ++a)
#pragma unroll
            for (int b = 0; b < 2; ++b)
#pragma unroll
                for (int m = 0; m < 4; ++m)
#pragma unroll
                    for (int n = 0; n < 2; ++n) acc[a][b][m][n] = (f32x4){0.f, 0.f, 0.f, 0.f};
        cur = nxt; cA = nA; cB = nB; ++ui;
    }
    PG8_WAIT_V(0);
    if (wr == 0) PG8_BAR;
    PG8_BAR;
    if constexpr (Epi::AFTER_DRAIN) { E.fused(acc, cur, wr, wc, fr, fq, lds, wid, lane); S.done(cur); }
#undef PG8_SA
#undef PG8_SB
#undef PG8_STAGE
#undef PG8_LDA
#undef PG8_LDB
#undef PG8_MMA
#undef PG8_WAIT_V
#undef PG8_WAIT_L
#undef PG8_BAR
#undef PG8_SCHED
}
#endif
}

struct Params {
    const float *xp, *xs, *memp, *cckv, *ckpe, *cmk, *cmv, *sgla; const int* ptab;
    const float *g_mix, *w_a2, *b_a, *g_gla_o, *g_qa, *g_kva, *g_qn, *g_kn, *g_qr, *g_kr, *g_x, *g_mem, *g_xq, *g_xk, *g_ff;
    float *y, *o_ckvp, *o_kpep, *o_mkp, *o_mvp, *o_glap, *o_ckvs, *o_kpes, *o_glas;
    unsigned* ctl;
    bf16 *wt_in, *wt_qb, *wt_kvb, *wt_out, *wt_xq, *wt_xkv, *wt_xo, *wt_ff1, *wt_ff2;
    bf16 *H, *MEMN, *Z, *QAN, *CKVB, *KPB, *MKB, *MVB, *QF, *KV, *QN, *KN, *OMIX, *XQ, *XO, *U;
    float *MKV, *LOGA, *DS, *DDEC, *X1, *X2, *PACC, *PML;
    const float *w_in, *w_qb, *w_kvb, *w_out, *w_xq, *w_xk, *w_xv, *w_xo, *w_ff1, *w_ff2;
};
constexpr int CW_Q5 = 0, CW_QX = 512, CW_BAR = 4096;

template <int ACT  > struct EpiStoreBf16 {
    static constexpr bool PERM = true, AFTER_DRAIN = false;
    bf16* O; int ldc;
    DI void operator()(const f32x4 (&acc)[2][2][4][2], const pg8::Unit& u, int wr, int wc, int fr, int fq) const {
        const int row0 = u.pm * 256 + wr * 64 + fr, col0 = u.pn * 256 + wc * 32 + 8 * fq;
#pragma unroll
        for (int ai = 0; ai < 2; ++ai)
#pragma unroll
            for (int m = 0; m < 4; ++m) { bf16* rowp = O + (size_t)(row0 + ai * 128 + m * 16) * ldc + col0;
#pragma unroll
                for (int bj = 0; bj < 2; ++bj) { f32x4 v0 = acc[ai][bj][m][0], v1 = acc[ai][bj][m][1];
                    if (ACT == 1) {
#pragma unroll
                        for (int j = 0; j < 4; ++j) { const float a = fmaxf(v0[j], 0.f), b = fmaxf(v1[j], 0.f); v0[j] = a * a; v1[j] = b * b; } }
                    u32x4 w; w[0] = pk2(v0[0], v0[1]); w[1] = pk2(v0[2], v0[3]); w[2] = pk2(v1[0], v1[1]); w[3] = pk2(v1[2], v1[3]);
                    *(u32x4*)(rowp + bj * 128) = w; } }
    }
};
struct EpiStoreF32 {
    static constexpr bool PERM = false, AFTER_DRAIN = false;
    float* C; const float* R; int ldc;
    DI void operator()(const f32x4 (&acc)[2][2][4][2], const pg8::Unit& u, int wr, int wc, int fr, int fq) const {
        const int row0 = u.pm * 256 + wr * 64 + fr, col0 = u.pn * 256 + wc * 32 + 4 * fq;
#pragma unroll
        for (int ai = 0; ai < 2; ++ai)
#pragma unroll
            for (int m = 0; m < 4; ++m) { const size_t off = (size_t)(row0 + ai * 128 + m * 16) * ldc + col0;
#pragma unroll
                for (int bj = 0; bj < 2; ++bj)
#pragma unroll
                    for (int n = 0; n < 2; ++n) { f32x4 v = acc[ai][bj][m][n]; if (R) v += *(const f32x4*)(R + off + bj * 128 + n * 16); *(f32x4*)(C + off + bj * 128 + n * 16) = v; } }
    }
};
template <class Epi> DI void run_gemm(LDS unsigned char* lds, const bf16* A, const bf16* Bt, int M, int N, int K, const Epi& E, int rot) {
    pg8::Gemm g{A, Bt, M, N, K}; pg8::StaticOrder S; S.init(M, N, (int)gridDim.x, (int)((blockIdx.x + rot) % gridDim.x));
    pg8::gemm_phase<Epi, pg8::StaticOrder>(lds, g, S, E);
}


struct SEpiBf16 { bf16* O; int ld; int act;
    DI void put(int row, int col, f32x4 v) const { if (act) {
#pragma unroll
            for (int j = 0; j < 4; ++j) { const float a = fmaxf(v[j], 0.f); v[j] = a * a; } }
        u32x2 w; w[0] = pk2(v[0], v[1]); w[1] = pk2(v[2], v[3]); *(u32x2*)(O + (size_t)row * ld + col) = w; } };
struct SEpiRes { float* C; const float* R;
    DI void put(int row, int col, f32x4 v) const { *(f32x4*)(C + (size_t)row * DM + col) = v + *(const f32x4*)(R + (size_t)row * DM + col); } };
template <class SE> DI void small_gemm(LDS unsigned char* lds, const bf16* A, const bf16* Bt, int N, int K, const SE& E, int rot) {
    const int tid = tid_opaque(), wid = __builtin_amdgcn_readfirstlane(tid >> 6), lane = tid & 63, r = lane & 31, hh = lane >> 5;
    const int nN = N / 64, nunits = (TS / 64) * nN, kw = K / 8, nks = kw / 16;
    LDS float* RED = (LDS float*)lds;
    for (int u = (int)((blockIdx.x + rot) % gridDim.x); u < nunits; u += gridDim.x) {
        const int um = u / nN, un = u % nN;
        const bf16* ap = A + (size_t)(TP + um * 64 + r) * K + wid * kw + 8 * hh;
        const bf16* bp = Bt + (size_t)(un * 64 + r) * K + wid * kw + 8 * hh;
        f32x16 acc[2][2];
#pragma unroll
        for (int i = 0; i < 2; ++i)
#pragma unroll
            for (int j = 0; j < 2; ++j) acc[i][j] = zero16();
        for (int k0 = 0; k0 < nks; k0 += 4) {
            bf16x8 af[4][2], bfr[4][2];
#pragma unroll
            for (int q = 0; q < 4; ++q) if (k0 + q < nks) {
#pragma unroll
                for (int t = 0; t < 2; ++t) { af[q][t] = ld8g(ap + (size_t)t * 32 * K + 16 * (k0 + q)); bfr[q][t] = ld8g(bp + (size_t)t * 32 * K + 16 * (k0 + q)); } }
#pragma unroll
            for (int q = 0; q < 4; ++q) if (k0 + q < nks) {
#pragma unroll
                for (int mt = 0; mt < 2; ++mt)
#pragma unroll
                    for (int nt = 0; nt < 2; ++nt) acc[mt][nt] = mfma32(bfr[q][nt], af[q][mt], acc[mt][nt]); }
        }
#pragma unroll
        for (int mt = 0; mt < 2; ++mt)
#pragma unroll
            for (int nt = 0; nt < 2; ++nt)
#pragma unroll
                for (int g = 0; g < 4; ++g) *(LDS f32x4*)(RED + wid * 4096 + (32 * mt + r) * 64 + 32 * nt + 8 * g + 4 * hh) = (f32x4){acc[mt][nt][4 * g], acc[mt][nt][4 * g + 1], acc[mt][nt][4 * g + 2], acc[mt][nt][4 * g + 3]};
        __syncthreads();
#pragma unroll
        for (int j = 0; j < 2; ++j) { const int gidx = tid + NTHREADS * j, row = gidx >> 4, c4 = (gidx & 15) * 4; f32x4 s = *(const LDS f32x4*)(RED + row * 64 + c4);
#pragma unroll
            for (int w = 1; w < 8; ++w) s += *(const LDS f32x4*)(RED + w * 4096 + row * 64 + c4);
            E.put(TP + um * 64 + row, un * 64 + c4, s); }
        __syncthreads();
    }
}

DI const float* xrow(const Params& p, int t) { return t < TP ? p.xp + (size_t)t * DM : p.xs + (size_t)(t - TP) * DM; }
DI void rmsnorm_row_1024(const float* src, const float* g, bf16* dst, int lane) {
    f32x4 v[4]; float ss = 0.f;
#pragma unroll
    for (int i = 0; i < 4; ++i) { v[i] = *(const f32x4*)(src + 4 * (lane + 64 * i)); ss += v[i][0] * v[i][0] + v[i][1] * v[i][1] + v[i][2] * v[i][2] + v[i][3] * v[i][3]; }
    ss = wsum(ss); const float rs = rsqrtf(ss * (1.0f / 1024.0f) + EPS);
#pragma unroll
    for (int i = 0; i < 4; ++i) { const f32x4 gg = *(const f32x4*)(g + 4 * (lane + 64 * i)); u32x2 w; w[0] = pk2(v[i][0] * rs * gg[0], v[i][1] * rs * gg[1]); w[1] = pk2(v[i][2] * rs * gg[2], v[i][3] * rs * gg[3]);
        *(u32x2*)(dst + 4 * (lane + 64 * i)) = w; }
}
template <int K, int N, int NPAD> DI void prep_job(const float* W, bf16* Wt, LDS float* tl, int rot) {
    const int tid = tid_opaque(); constexpr int nkt = K / 64, ntiles = (NPAD / 64) * nkt;
    for (int tile = (int)((blockIdx.x + rot) % gridDim.x); tile < ntiles; tile += gridDim.x) {
        const int tn = tile / nkt, tk = tile % nkt;
        { const int kk = tid >> 3, n8 = (tid & 7) * 8; const int n = tn * 64 + n8; const float* s = W + (size_t)(tk * 64 + kk) * N + n;
            f32x4 a = {0.f, 0.f, 0.f, 0.f}, b = a; if (n < N) { a = *(const f32x4*)s; b = *(const f32x4*)(s + 4); }
#pragma unroll
            for (int q = 0; q < 4; ++q) { tl[kk * 65 + n8 + q] = a[q]; tl[kk * 65 + n8 + 4 + q] = b[q]; } }
        __syncthreads();
        { const int nn = tid >> 3, k8 = (tid & 7) * 8; u32x4 w;
#pragma unroll
            for (int q = 0; q < 4; ++q) w[q] = pk2(tl[(k8 + 2 * q) * 65 + nn], tl[(k8 + 2 * q + 1) * 65 + nn]);
            *(u32x4*)(Wt + (size_t)(tn * 64 + nn) * K + tk * 64 + k8) = w; }
        __syncthreads();
    }
}
DI void phase_prep(const Params& p, LDS unsigned char* lds) {
    const int tid = tid_opaque(), wid = __builtin_amdgcn_readfirstlane(tid >> 6), lane = tid & 63;
    LDS float* tl = (LDS float*)lds;
    prep_job<DM, DIN, DINP>(p.w_in, p.wt_in, tl, 0); prep_job<384, 768, 768>(p.w_qb, p.wt_qb, tl, 64); prep_job<256, 1024, 1024>(p.w_kvb, p.wt_kvb, tl, 136); prep_job<DM, DM, DM>(p.w_out, p.wt_out, tl, 200);
    prep_job<DM, 512, 512>(p.w_xq, p.wt_xq, tl, 0); prep_job<DM, 512, 512>(p.w_xk, p.wt_xkv, tl, 128); prep_job<DM, 512, 512>(p.w_xv, p.wt_xkv + (size_t)512 * DM, tl, 0); prep_job<512, DM, DM>(p.w_xo, p.wt_xo, tl, 128);
    prep_job<DM, DFF, DFF>(p.w_ff1, p.wt_ff1, tl, 0); prep_job<DFF, DM, DM>(p.w_ff2, p.wt_ff2, tl, 0);
    for (int row = blockIdx.x * 8 + wid; row < T + MROWS; row += gridDim.x * 8) {
        if (row < T) rmsnorm_row_1024(xrow(p, row), p.g_mix, p.H + (size_t)row * DM, lane);
        else rmsnorm_row_1024(p.memp + (size_t)(row - T) * DM, p.g_mem, p.MEMN + (size_t)(row - T) * DM, lane);
    }
}

DI float rope32(float xn, int lane, int pos) {
    const float partner = __shfl_xor(xn, 16);
    const int i = lane & 15; const float inv = expf(-(float)i * (9.210340371976184f / 16.0f)); const float ang = (float)pos * inv;
    const float c = cosf(ang), s = sinf(ang);
    return (lane & 16) ? xn * c + partner * s : xn * c - partner * s;
}
DI int row_pos(int t) { return t < TP ? (t % SEQ) : PAST + ((t - TP) % DECS); }

DI void phase_post_in(const Params& p) {
    const int tid = tid_opaque(), wid = __builtin_amdgcn_readfirstlane(tid >> 6), lane = tid & 63;
    for (int row = blockIdx.x * 8 + wid; row < T + MROWS; row += gridDim.x * 8) {
        if (row < T) {
            const int t = row; const bf16* z = p.Z + (size_t)t * DINP;
            float a[16];
#pragma unroll
            for (int i = 0; i < 16; ++i) a[i] = bf2f(z[ZA + i]);
#pragma unroll
            for (int q = 0; q < 4; ++q) { const int c = lane + 64 * q; float gp = p.b_a[c];
#pragma unroll
                for (int i = 0; i < 16; ++i) gp += a[i] * p.w_a2[i * 256 + c];
                const float ls = fminf(gp, 0.f) - log1pf(expf(-fabsf(gp)));
                p.LOGA[(size_t)t * 256 + c] = ls * (1.0f / 16.0f); }
            { float v[6]; float ss = 0.f;
#pragma unroll
                for (int q = 0; q < 6; ++q) { v[q] = bf2f(z[ZQA + lane + 64 * q]); ss += v[q] * v[q]; }
                ss = wsum(ss); const float rs = rsqrtf(ss * (1.0f / 384.0f) + EPS);
#pragma unroll
                for (int q = 0; q < 6; ++q) p.QAN[(size_t)t * 384 + lane + 64 * q] = f2bf(v[q] * rs * p.g_qa[lane + 64 * q]); }
            { float v[4]; float ss = 0.f;
#pragma unroll
                for (int q = 0; q < 4; ++q) { v[q] = bf2f(z[ZKVA + lane + 64 * q]); ss += v[q] * v[q]; }
                ss = wsum(ss); const float rs = rsqrtf(ss * (1.0f / 256.0f) + EPS);
                float* oc = t < TP ? p.o_ckvp + (size_t)t * 256 : p.o_ckvs + (size_t)(t - TP) * 256;
#pragma unroll
                for (int q = 0; q < 4; ++q) { const float c = v[q] * rs * p.g_kva[lane + 64 * q]; oc[lane + 64 * q] = c; p.CKVB[(size_t)t * 256 + lane + 64 * q] = f2bf(c); } }
            { const float v = lane < 32 ? bf2f(z[ZKPE + lane]) : 0.f; const float ss = wsum(v * v); const float rs = rsqrtf(ss * (1.0f / 32.0f) + EPS);
                const float xn = v * rs * p.g_kr[lane & 31]; const float o = rope32(xn, lane, row_pos(t));
                if (lane < 32) { float* ok = t < TP ? p.o_kpep + (size_t)t * 32 : p.o_kpes + (size_t)(t - TP) * 32; ok[lane] = o; p.KPB[(size_t)t * 32 + lane] = f2bf(o); } }
        } else {
            const int r = row - T; const float* s = p.MKV + (size_t)r * 1024;
            float v[8]; float ss = 0.f;
#pragma unroll
            for (int q = 0; q < 8; ++q) { v[q] = s[lane * 8 + q]; ss += v[q] * v[q]; }
            ss += __shfl_xor(ss, 1); ss += __shfl_xor(ss, 2); ss += __shfl_xor(ss, 4); ss += __shfl_xor(ss, 8);
            const float rs = rsqrtf(ss * (1.0f / 128.0f) + EPS);
#pragma unroll
            for (int q = 0; q < 8; ++q) { const int c = lane * 8 + q; const float k = v[q] * rs * p.g_xk[c & 127]; p.o_mkp[(size_t)r * 512 + c] = k; p.MKB[(size_t)r * 512 + c] = f2bf(k);
                const float vv = s[512 + c]; p.o_mvp[(size_t)r * 512 + c] = vv; p.MVB[(size_t)r * 512 + c] = f2bf(vv); }
        }
    }
}

DI void phase_post_qkv(const Params& p) {
    const int tid = tid_opaque(), wid = __builtin_amdgcn_readfirstlane(tid >> 6), lane = tid & 63;
    for (int t = TP + blockIdx.x * 8 + wid; t < T; t += gridDim.x * 8) {
        const bf16* qf = p.QF + (size_t)t * 768; const int pos = row_pos(t);
        for (int h = 0; h < 8; ++h) {
            const float v = bf2f(qf[h * 96 + lane]); const float ss = wsum(v * v); const float rs = rsqrtf(ss * (1.0f / 64.0f) + EPS);
            p.QN[((size_t)t * 8 + h) * 96 + lane] = f2bf(v * rs * p.g_qn[lane] * MLA_SCALE);
            const float vr = lane < 32 ? bf2f(qf[h * 96 + 64 + lane]) : 0.f; const float ssr = wsum(vr * vr); const float rsr = rsqrtf(ssr * (1.0f / 32.0f) + EPS);
            const float xr = vr * rsr * p.g_qr[lane & 31]; const float o = rope32(xr, lane, pos);
            if (lane < 32) p.QN[((size_t)t * 8 + h) * 96 + 64 + lane] = f2bf(o * MLA_SCALE);
        }
    }
}
struct GlaUnit { int t0, h, nv; };
DI GlaUnit gla_unit(int u) { GlaUnit g; if (u < NGP) { const int b = u / (4 * NC), h = (u / NC) % 4, c = u % NC; g.t0 = b * SEQ + c * 64; g.h = h; g.nv = 64; } else { const int us = u - NGP; g.t0 = TP + (us >> 2) * DECS; g.h = us & 3; g.nv = DECS; } return g; }
constexpr int GL_QK = 0, GL_V = 16384, GL_S = 32768, GL_TOT = 49152, GL_SS = GL_TOT + 2048, GL_END = GL_SS + 1024;
static_assert(GL_END <= LDS_CTL, "GLA LDS map");
DI float gla_scan(const Params& p, const GlaUnit& g, LDS unsigned char* lds, int c, int sb, float (&b)[8]) {
    LDS float* TOT = (LDS float*)(lds + GL_TOT); float a = 0.f;
#pragma unroll
    for (int i = 0; i < 8; ++i) { const int s = 8 * sb + i; a += s < g.nv ? p.LOGA[(size_t)(g.t0 + s) * 256 + g.h * 64 + c] : 0.f; b[i] = a; }
    TOT[sb * 64 + c] = a;
    __syncthreads();
    float pre = 0.f, tot = 0.f;
#pragma unroll
    for (int q = 0; q < 8; ++q) { const float v = TOT[q * 64 + c]; tot += v; if (q < sb) pre += v; }
#pragma unroll
    for (int i = 0; i < 8; ++i) b[i] += pre;
    return tot;
}
DI void gla_put(LDS unsigned char* img, int row, int col, float v) { *(LDS bf16*)(img + imgb(row, col >> 3) + 2 * (col & 7)) = f2bf(v); }
DI void gla_stage_v(const Params& p, const GlaUnit& g, LDS unsigned char* lds, int tid) {
#pragma unroll
    for (int j = 0; j < 2; ++j) { const int cidx = tid + NTHREADS * j, s = cidx >> 4, ch = cidx & 15; bf16x8 v = zero8(); if (s < g.nv) v = ld8g(p.Z + (size_t)(g.t0 + s) * DINP + ZV + g.h * 128 + ch * 8);
        *(LDS bf16x8*)(lds + GL_V + imgb(s, ch)) = v; }
}
DI void phase_gla_a(const Params& p, LDS unsigned char* lds) {
    const int tid = tid_opaque(), wid = __builtin_amdgcn_readfirstlane(tid >> 6), lane = tid & 63, r = lane & 31, hh = lane >> 5;
    for (int u = blockIdx.x; u < NGU; u += gridDim.x) {
        const GlaUnit g = gla_unit(u); const int c = tid & 63, sb = tid >> 6;
        float b[8]; const float bl = gla_scan(p, g, lds, c, sb, b);
#pragma unroll
        for (int i = 0; i < 8; ++i) { const int s = 8 * sb + i; float v = 0.f; if (s < g.nv) v = bf2f(p.Z[(size_t)(g.t0 + s) * DINP + ZK + g.h * 64 + c]) * fexp(bl - b[i]); gla_put(lds + GL_QK, s, c, v); }
        gla_stage_v(p, g, lds, tid);
        if (tid < 64) p.DDEC[(size_t)u * 64 + tid] = fexp(bl);
        __syncthreads();
        { const int mt = wid & 1, nt = wid >> 1; f32x16 acc = zero16();
#pragma unroll
            for (int ks = 0; ks < 4; ++ks) acc = mfma32(img_tr<false>(lds + GL_QK, lane, mt, 16 * ks), img_tr<false>(lds + GL_V, lane, nt, 16 * ks), acc);
            float* d = p.DS + (size_t)u * 8192;
#pragma unroll
            for (int i = 0; i < 16; ++i) d[(32 * mt + crow(i, hh)) * 128 + 32 * nt + r] = acc[i]; }
        __syncthreads();
    }
}
DI void phase_gla_b(const Params& p) {
    const int gid = blockIdx.x * NTHREADS + tid_opaque(), gsz = gridDim.x * NTHREADS;
    for (int e = gid; e < BATCH * 4 * 8192; e += gsz) { const int bh = e >> 13, idx = e & 8191, kd = idx >> 7; float S = 0.f;
        for (int c = 0; c < NC; ++c) { const size_t u = (size_t)bh * NC + c; const float d = p.DS[u * 8192 + idx]; p.DS[u * 8192 + idx] = S; S = S * p.DDEC[u * 64 + kd] + d; }
        p.o_glap[e] = S; }
    for (int e = gid; e < DECB * 4 * 8192; e += gsz) { const int bh = e >> 13, idx = e & 8191, kd = idx >> 7; const size_t u = (size_t)NGP + bh;
        p.o_glas[e] = p.sgla[e] * p.DDEC[u * 64 + kd] + p.DS[u * 8192 + idx]; }
}
DI void gla_c_unit(const Params& p, LDS unsigned char* lds, int u) {
    const int tid = tid_opaque(), wid = __builtin_amdgcn_readfirstlane(tid >> 6), lane = tid & 63, r = lane & 31, hh = lane >> 5;
    const GlaUnit g = gla_unit(u); const int c = tid & 63, sb = tid >> 6;
    { float b[8]; gla_scan(p, g, lds, c, sb, b);
#pragma unroll
        for (int i = 0; i < 8; ++i) { const int s = 8 * sb + i; float q = 0.f, k = 0.f;
            if (s < g.nv) { const bf16* z = p.Z + (size_t)(g.t0 + s) * DINP; q = bf2f(z[ZQ + g.h * 64 + c]) * fexp(b[i]) * 0.125f; k = bf2f(z[ZK + g.h * 64 + c]) * fexp(-b[i]); }
            gla_put(lds + GL_QK, s, c, q); gla_put(lds + GL_QK, s, 64 + c, k); } }
    gla_stage_v(p, g, lds, tid);
    { const float* sp = u < NGP ? p.DS + (size_t)u * 8192 : p.sgla + (size_t)(u - NGP) * 8192;
#pragma unroll
        for (int j = 0; j < 2; ++j) { const int cidx = tid + NTHREADS * j, kd = cidx >> 4, ch = cidx & 15; const f32x4 a = *(const f32x4*)(sp + kd * 128 + ch * 8), bq = *(const f32x4*)(sp + kd * 128 + ch * 8 + 4);
            *(LDS bf16x8*)(lds + GL_S + imgb(kd, ch)) = pack8(a[0], a[1], a[2], a[3], bq[0], bq[1], bq[2], bq[3]); } }
    __syncthreads();
    const int dvt = wid & 3, tt = wid >> 2;
    f32x16 o = zero16();
#pragma unroll
    for (int ks = 0; ks < 4; ++ks) o = mfma32(img_tr<false>(lds + GL_S, lane, dvt, 16 * ks), img_row(lds + GL_QK, 32 * tt + r, ks, hh), o);
#pragma unroll
    for (int st = 0; st < 2; ++st) if (st <= tt) {
        f32x16 x = zero16();
#pragma unroll
        for (int ks = 0; ks < 4; ++ks) x = mfma32(img_row(lds + GL_QK, 32 * st + r, 4 + ks, hh), img_row(lds + GL_QK, 32 * tt + r, ks, hh), x);
        if (st == tt) {
#pragma unroll
            for (int i = 0; i < 16; ++i) if (crow(i, hh) > r) x[i] = 0.f; }
#pragma unroll
        for (int s2 = 0; s2 < 2; ++s2) o = mfma32(img_tr<true>(lds + GL_V, lane, dvt, 32 * st + 16 * s2), PACK(x, s2), o);
    }
    LDS float* SS = (LDS float*)(lds + GL_SS); float ss = 0.f;
#pragma unroll
    for (int i = 0; i < 16; ++i) ss += o[i] * o[i];
    ss += __shfl_xor(ss, 32); if (hh == 0) SS[dvt * 64 + 32 * tt + r] = ss;
    __syncthreads();
    const int t = 32 * tt + r;
    if (t < g.nv) { const float rs = rsqrtf((SS[t] + SS[64 + t] + SS[128 + t] + SS[192 + t]) * (1.0f / 128.0f) + EPS);
        const bf16* z = p.Z + (size_t)(g.t0 + t) * DINP + ZR + g.h * 128 + 32 * dvt + 4 * hh; bf16* op = p.OMIX + (size_t)(g.t0 + t) * DM + g.h * 128 + 32 * dvt + 4 * hh; const float* gg = p.g_gla_o + 32 * dvt + 4 * hh;
#pragma unroll
        for (int q = 0; q < 4; ++q) { const s16x4 rg = *(const s16x4*)(z + 8 * q); const f32x4 g4 = *(const f32x4*)(gg + 8 * q); float w[4];
#pragma unroll
            for (int j = 0; j < 4; ++j) { const float rr = bf2f((bf16)rg[j]); w[j] = o[4 * q + j] * rs * g4[j] * (rr / (1.0f + fexp(-rr))); }
            u32x2 pk; pk[0] = pk2(w[0], w[1]); pk[1] = pk2(w[2], w[3]); *(u32x2*)(op + 8 * q) = pk; } }
}
constexpr int PA_IMG = 0, PA_KP = 2 * 32768, PA_END = PA_KP + 2 * 128 * 40 * 2;
static_assert(PA_END <= LDS_CTL, "prompt attention LDS map");
DI void pattn_stage_load(const Params& p, size_t kr0, int h, int tid, bf16x8 (&kv)[4], bf16x8& kp) {
#pragma unroll
    for (int j = 0; j < 4; ++j) { const int c = tid + NTHREADS * j, key = c >> 4, ch = c & 15; kv[j] = ld8g(p.KV + (kr0 + key) * 1024 + h * 128 + ch * 8); }
    kp = ld8g(p.KPB + (kr0 + (tid >> 2)) * 32 + (tid & 3) * 8);
}
DI void pattn_stage_store(const Params& p, LDS unsigned char* img, LDS bf16* kpl, int tid, const bf16x8 (&kv)[4], const bf16x8& kp) {
    const int ch = tid & 15;
    f32x4 g0 = {1.f, 1.f, 1.f, 1.f}, g1 = g0; if (ch < 8) { g0 = *(const f32x4*)(p.g_kn + ch * 8); g1 = *(const f32x4*)(p.g_kn + ch * 8 + 4); }
#pragma unroll
    for (int j = 0; j < 4; ++j) { const int key = (tid + NTHREADS * j) >> 4; float f[8]; float ss = 0.f;
#pragma unroll
        for (int q = 0; q < 8; ++q) { f[q] = bf2f((bf16)kv[j][q]); ss += f[q] * f[q]; }
        ss += __shfl_xor(ss, 1); ss += __shfl_xor(ss, 2); ss += __shfl_xor(ss, 4);
        const float rs = ch < 8 ? rsqrtf(ss * (1.0f / 64.0f) + EPS) : 1.0f;
        *(LDS bf16x8*)(img + imgb(key, ch)) = pack8(f[0] * rs * g0[0], f[1] * rs * g0[1], f[2] * rs * g0[2], f[3] * rs * g0[3], f[4] * rs * g1[0], f[5] * rs * g1[1], f[6] * rs * g1[2], f[7] * rs * g1[3]); }
    *(LDS bf16x8*)(kpl + (tid >> 2) * 40 + (tid & 3) * 8) = kp;
}
DI void pattn_unit(const Params& p, LDS unsigned char* lds, int u) {
    const int tid = tid_opaque(), wid = __builtin_amdgcn_readfirstlane(tid >> 6), lane = tid & 63, r = lane & 31, hh = lane >> 5;
    const int qb = NQB - 1 - u / (BATCH * 8), bh = u % (BATCH * 8), b = bh >> 3, h = bh & 7;
    const int qw0 = qb * 256 + 32 * wid, qpos = qw0 + r; const size_t trow = (size_t)b * SEQ + qpos;
    bf16x8 kvr[4], kpr;
    pattn_stage_load(p, (size_t)b * SEQ, h, tid, kvr, kpr);
    bf16x8 qf[6];
    { float ss = 0.f, sr = 0.f; float f[6][8];
#pragma unroll
        for (int ks = 0; ks < 6; ++ks) { const bf16x8 raw = ld8g(p.QF + trow * 768 + h * 96 + 16 * ks + 8 * hh);
#pragma unroll
            for (int j = 0; j < 8; ++j) { f[ks][j] = bf2f((bf16)raw[j]); if (ks < 4) ss += f[ks][j] * f[ks][j]; else sr += f[ks][j] * f[ks][j]; } }
        ss += __shfl_xor(ss, 32); sr += __shfl_xor(sr, 32);
        const float rs = rsqrtf(ss * (1.0f / 64.0f) + EPS) * MLA_SCALE, rr = rsqrtf(sr * (1.0f / 32.0f) + EPS) * MLA_SCALE;
#pragma unroll
        for (int ks = 0; ks < 4; ++ks) { const f32x4 g0 = *(const f32x4*)(p.g_qn + 16 * ks + 8 * hh), g1 = *(const f32x4*)(p.g_qn + 16 * ks + 8 * hh + 4);
            qf[ks] = pack8(f[ks][0] * rs * g0[0], f[ks][1] * rs * g0[1], f[ks][2] * rs * g0[2], f[ks][3] * rs * g0[3], f[ks][4] * rs * g1[0], f[ks][5] * rs * g1[1], f[ks][6] * rs * g1[2], f[ks][7] * rs * g1[3]); }
        float o1[8], o2[8];
#pragma unroll
        for (int j = 0; j < 8; ++j) { const int i = 8 * hh + j; const float x1 = f[4][j] * rr * p.g_qr[i], x2 = f[5][j] * rr * p.g_qr[16 + i];
            const float ang = (float)qpos * expf(-(float)i * (9.210340371976184f / 16.0f)); const float c = cosf(ang), s = sinf(ang);
            o1[j] = x1 * c - x2 * s; o2[j] = x2 * c + x1 * s; }
        qf[4] = pack8(o1[0], o1[1], o1[2], o1[3], o1[4], o1[5], o1[6], o1[7]); qf[5] = pack8(o2[0], o2[1], o2[2], o2[3], o2[4], o2[5], o2[6], o2[7]); }
    f32x16 o0 = zero16(), o1 = zero16(); float m = -INFINITY, l = 0.f;
    const int nkt = 2 * (qb + 1);
    pattn_stage_store(p, lds + PA_IMG, (LDS bf16*)(lds + PA_KP), tid, kvr, kpr);
    __syncthreads();
    for (int kt = 0; kt < nkt; ++kt) {
        const int k0 = kt * 128; LDS unsigned char* img = lds + PA_IMG + (kt & 1) * 32768; const LDS bf16* kpl = (const LDS bf16*)(lds + PA_KP) + (kt & 1) * 128 * 40;
        if (kt + 1 < nkt) pattn_stage_load(p, (size_t)b * SEQ + k0 + 128, h, tid, kvr, kpr);
#pragma unroll 1
        for (int half = 0; half < 2; ++half) { const int kb = 64 * half;
            if (k0 + kb <= qw0 + 31) {
                f32x16 s0 = zero16(), s1 = zero16();
#pragma unroll
                for (int ks = 0; ks < 4; ++ks) { s0 = mfma32(img_row(img, kb + r, ks, hh), qf[ks], s0); s1 = mfma32(img_row(img, kb + 32 + r, ks, hh), qf[ks], s1); }
#pragma unroll
                for (int ks = 0; ks < 2; ++ks) { s0 = mfma32(ld8(kpl + (kb + r) * 40 + 16 * ks + 8 * hh), qf[4 + ks], s0); s1 = mfma32(ld8(kpl + (kb + 32 + r) * 40 + 16 * ks + 8 * hh), qf[4 + ks], s1); }
                float tmax = -INFINITY;
                if (k0 + kb + 63 > qw0) {
#pragma unroll
                    for (int i = 0; i < 16; ++i) { const int key = k0 + kb + crow(i, hh); if (key > qpos) s0[i] = -INFINITY; if (key + 32 > qpos) s1[i] = -INFINITY; } }
#pragma unroll
                for (int i = 0; i < 16; ++i) tmax = fmaxf(tmax, fmaxf(s0[i], s1[i]));
                tmax = fmaxf(tmax, __shfl_xor(tmax, 32));
                const float mn = fmaxf(m, tmax), corr = fexp(m - mn); m = mn; float ps = 0.f;
#pragma unroll
                for (int i = 0; i < 16; ++i) { s0[i] = fexp(s0[i] - mn); s1[i] = fexp(s1[i] - mn); ps += s0[i] + s1[i]; }
                l = l * corr + ps;
#pragma unroll
                for (int i = 0; i < 16; ++i) { o0[i] *= corr; o1[i] *= corr; }
#pragma unroll
                for (int s = 0; s < 2; ++s) { const bf16x8 pa = PACK(s0, s), pb = PACK(s1, s);
                    o0 = mfma32(img_tr<true>(img, lane, 2, kb + 16 * s), pa, o0); o1 = mfma32(img_tr<true>(img, lane, 3, kb + 16 * s), pa, o1);
                    o0 = mfma32(img_tr<true>(img, lane, 2, kb + 32 + 16 * s), pb, o0); o1 = mfma32(img_tr<true>(img, lane, 3, kb + 32 + 16 * s), pb, o1); }
            }
        }
        if (kt + 1 < nkt) pattn_stage_store(p, lds + PA_IMG + ((kt + 1) & 1) * 32768, (LDS bf16*)(lds + PA_KP) + ((kt + 1) & 1) * 128 * 40, tid, kvr, kpr);
        __syncthreads();
    }
    l += __shfl_xor(l, 32); const float il = 1.0f / l;
    bf16* o = p.OMIX + trow * DM + 512 + h * 64;
#pragma unroll
    for (int g = 0; g < 4; ++g) { u32x2 w0, w1; w0[0] = pk2(o0[4 * g] * il, o0[4 * g + 1] * il); w0[1] = pk2(o0[4 * g + 2] * il, o0[4 * g + 3] * il); w1[0] = pk2(o1[4 * g] * il, o1[4 * g + 1] * il); w1[1] = pk2(o1[4 * g + 2] * il, o1[4 * g + 3] * il);
        *(u32x2*)(o + 8 * g + 4 * hh) = w0; *(u32x2*)(o + 32 + 8 * g + 4 * hh) = w1; }
}

constexpr int XA_K = 0, XA_V = 256 * 136 * 2, XA_END = XA_V + 128 * 264 * 2;
static_assert(XA_END <= LDS_CTL && XA_V % 16 == 0, "cross-attention LDS map");
DI void xattn_unit(const Params& p, LDS unsigned char* lds, int u) {
    const int tid = tid_opaque(), wid = __builtin_amdgcn_readfirstlane(tid >> 6), lane = tid & 63, r = lane & 31, hh = lane >> 5;
    LDS bf16* KX = (LDS bf16*)(lds + XA_K); LDS bf16* VX = (LDS bf16*)(lds + XA_V);
    int b, h, nrows; size_t tbase;
    if (u < NU_XP) { b = u / (4 * NQB); h = (u / NQB) & 3; const int qc = u % NQB; nrows = 256; tbase = (size_t)b * SEQ + qc * 256;
        for (int i = tid; i < 256 * 16; i += NTHREADS) { const int key = i >> 4, c8 = (i & 15) * 8; const size_t src = ((size_t)b * 256 + key) * 512 + h * 128 + c8;
            *(LDS bf16x8*)(KX + key * 136 + c8) = ld8g(p.MKB + src); const bf16x8 v = ld8g(p.MVB + src);
#pragma unroll
            for (int j = 0; j < 8; ++j) VX[(c8 + j) * 264 + key] = (bf16)v[j]; }
    } else { const int us = u - NU_XP; b = us >> 2; h = us & 3; nrows = DECS; tbase = (size_t)TP + b * DECS;
        for (int i = tid; i < 256 * 32; i += NTHREADS) { const int key = i >> 5, c4 = (i & 31) * 4; const size_t src = (((size_t)b * 256 + key) * 4 + h) * 128 + c4;
            const f32x4 k = *(const f32x4*)(p.cmk + src), v = *(const f32x4*)(p.cmv + src); u32x2 w; w[0] = pk2(k[0], k[1]); w[1] = pk2(k[2], k[3]); *(LDS u32x2*)(KX + key * 136 + c4) = w;
#pragma unroll
            for (int j = 0; j < 4; ++j) VX[(c4 + j) * 264 + key] = f2bf(v[j]); }
    }
    __syncthreads();
    if (32 * wid < nrows) {
        const bool valid = 32 * wid + r < nrows; const size_t trow = tbase + 32 * wid + (valid ? r : 0);
        bf16x8 qf[8]; float ss = 0.f;
#pragma unroll
        for (int ks = 0; ks < 8; ++ks) { qf[ks] = ld8g(p.XQ + trow * 512 + h * 128 + 16 * ks + 8 * hh);
#pragma unroll
            for (int j = 0; j < 8; ++j) { const float v = bf2f((bf16)qf[ks][j]); ss += v * v; } }
        ss += __shfl_xor(ss, 32); const float rs = valid ? rsqrtf(ss * (1.0f / 128.0f) + EPS) * X_SCALE : 0.f;
#pragma unroll
        for (int ks = 0; ks < 8; ++ks) { float q[8];
#pragma unroll
            for (int j = 0; j < 8; ++j) q[j] = bf2f((bf16)qf[ks][j]) * rs * p.g_xq[16 * ks + 8 * hh + j];
            qf[ks] = pack8(q[0], q[1], q[2], q[3], q[4], q[5], q[6], q[7]); }
        f32x16 o[4];
#pragma unroll
        for (int d = 0; d < 4; ++d) o[d] = zero16();
        float m = -INFINITY, l = 0.f;
        for (int kt = 0; kt < 4; ++kt) {
            f32x16 s0 = zero16(), s1 = zero16();
#pragma unroll
            for (int ks = 0; ks < 8; ++ks) { s0 = mfma32(ld8(KX + (64 * kt + r) * 136 + 16 * ks + 8 * hh), qf[ks], s0); s1 = mfma32(ld8(KX + (64 * kt + 32 + r) * 136 + 16 * ks + 8 * hh), qf[ks], s1); }
            float tmax = -INFINITY;
#pragma unroll
            for (int i = 0; i < 16; ++i) tmax = fmaxf(tmax, fmaxf(s0[i], s1[i]));
            tmax = fmaxf(tmax, __shfl_xor(tmax, 32));
            const float mn = fmaxf(m, tmax), corr = fexp(m - mn); m = mn; float ps = 0.f;
#pragma unroll
            for (int i = 0; i < 16; ++i) { s0[i] = fexp(s0[i] - mn); s1[i] = fexp(s1[i] - mn); ps += s0[i] + s1[i]; }
            l = l * corr + ps;
#pragma unroll
            for (int d = 0; d < 4; ++d)
#pragma unroll
                for (int i = 0; i < 16; ++i) o[d][i] *= corr;
#pragma unroll
            for (int s = 0; s < 2; ++s) { const bf16x8 pa = PACK(s0, s), pb = PACK(s1, s);
#pragma unroll
                for (int d = 0; d < 4; ++d) { o[d] = mfma32(ldperm(VX + (32 * d + r) * 264 + 64 * kt + 16 * s, hh), pa, o[d]); o[d] = mfma32(ldperm(VX + (32 * d + r) * 264 + 64 * kt + 32 + 16 * s, hh), pb, o[d]); } }
        }
        l += __shfl_xor(l, 32); const float il = 1.0f / l;
        if (valid) { bf16* op = p.XO + trow * 512 + h * 128;
#pragma unroll
            for (int d = 0; d < 4; ++d)
#pragma unroll
                for (int g = 0; g < 4; ++g) { u32x2 w; w[0] = pk2(o[d][4 * g] * il, o[d][4 * g + 1] * il); w[1] = pk2(o[d][4 * g + 2] * il, o[d][4 * g + 3] * il); *(u32x2*)(op + 32 * d + 8 * g + 4 * hh) = w; } }
    }
}
constexpr int SA_F32 = 0, SA_KPF = 65536, SA_CK = SA_KPF + 8192, SA_KP = SA_CK + 32768, SA_P = SA_KP + 64 * 40 * 2, SA_QS = SA_P + 64 * 72 * 2, SA_CORR = SA_QS + 65 * 104 * 2, SA_END = SA_CORR + 1024;
static_assert(SA_END <= LDS_CTL && SA_KP % 16 == 0 && SA_P % 16 == 0 && SA_QS % 16 == 0 && SA_CORR % 16 == 0, "sample attention LDS map");
DI void sattn_issue(const Params& p, LDS unsigned char* lds, int pid, int half, int wid, int lane) {
    const size_t key0 = (size_t)pid * PAGE + half * 64;
#pragma unroll
    for (int i = 0; i < 8; ++i) { const int key = wid * 8 + i; dma16(p.cckv + (key0 + key) * 256 + lane * 4, lds + SA_F32 + key * 1024); }
    dma16(p.ckpe + (key0 + wid * 8 + (lane >> 3)) * 32 + (lane & 7) * 4, lds + SA_KPF + wid * 1024);
}
DI void sattn_convert(LDS unsigned char* lds) {
    const int tid = tid_opaque();
#pragma unroll
    for (int j = 0; j < 4; ++j) { const int i = tid + NTHREADS * j, key = i >> 5, c32 = i & 31;
        const f32x4 a = *(const LDS f32x4*)(lds + SA_F32 + key * 1024 + c32 * 32), bq = *(const LDS f32x4*)(lds + SA_F32 + key * 1024 + c32 * 32 + 16);
        u32x4 w; w[0] = pk2(a[0], a[1]); w[1] = pk2(a[2], a[3]); w[2] = pk2(bq[0], bq[1]); w[3] = pk2(bq[2], bq[3]);
        *(LDS u32x4*)(lds + SA_CK + (c32 >> 4) * 16384 + imgb(key, c32 & 15)) = w; }
    { const int key = tid >> 3, c4 = (tid & 7) * 4; const f32x4 v = *(const LDS f32x4*)(lds + SA_KPF + key * 128 + c4 * 4); u32x2 w; w[0] = pk2(v[0], v[1]); w[1] = pk2(v[2], v[3]);
        *(LDS u32x2*)(lds + SA_KP + (key * 40 + c4) * 2) = w; }
}
DI void sattn_unit(const Params& p, LDS unsigned char* lds, int u) {
    const int tid = tid_opaque(), wid = __builtin_amdgcn_readfirstlane(tid >> 6), lane = tid & 63, r = lane & 31, hh = lane >> 5;
    LDS unsigned char* CK = lds + SA_CK; LDS bf16* KP = (LDS bf16*)(lds + SA_KP); LDS bf16* PA = (LDS bf16*)(lds + SA_P);
    LDS bf16* QS = (LDS bf16*)(lds + SA_QS); LDS float* CORR = (LDS float*)(lds + SA_CORR);
    const int b = u / NSPLIT, sp = u % NSPLIT; const int h = wid;
    const int pidv = p.ptab[b * NPAGES + sp * PPS + (lane % PPS)];
    sattn_issue(p, lds, rdlane(pidv, 0), 0, wid, lane);
    for (int i = tid; i < 65 * 96; i += NTHREADS) { const int row = i / 96, d = i % 96; float v = 0.f;
        if (row < 64) { const int hq = row >> 3, q = row & 7; v = bf2f(p.QN[(((size_t)TP + b * DECS + q) * 8 + hq) * 96 + d]); if (d < 64) v *= p.g_kn[d]; }
        QS[row * 104 + d] = f2bf(v); }
    const int l15 = lane & 15, quad = lane >> 4;
    bf16x8 wk[4][8];
    { const bf16* wkp = p.wt_kvb + (size_t)(h * 128 + l15) * 256 + 8 * quad;
#pragma unroll
        for (int dt = 0; dt < 4; ++dt)
#pragma unroll
            for (int ks = 0; ks < 8; ++ks) wk[dt][ks] = ld8g(wkp + dt * 16 * 256 + 32 * ks); }
#ifndef EMU
#pragma unroll
    for (int dt = 0; dt < 4; ++dt)
#pragma unroll
        for (int ks = 0; ks < 8; ++ks) asm volatile("" : "+v"(wk[dt][ks]));
#endif
    const int qrow = l15 < 8 ? h * 8 + l15 : 64;
    f32x16 acc0 = zero16(), acc1 = zero16(); float m = -INFINITY, l = 0.f;
    const int npt = PPS * 2, ntile = npt + (sp == NSPLIT - 1 ? 1 : 0);
    wait_vm0(); bar_lds(); sattn_convert(lds); bar_lds();
    for (int tile = 0; tile < ntile; ++tile) {
        const bool newt = tile == npt;
        unsigned lo_ = lane;
#ifndef EMU
        asm volatile("" : "+v"(lo_));
#endif
        const unsigned l15o = lo_ & 15, quado = lo_ >> 4;
        if (tile + 1 < npt) sattn_issue(p, lds, rdlane(pidv, (tile + 1) >> 1), (tile + 1) & 1, wid, lane);
#pragma unroll 1
        for (int kg = 0; kg < 4; ++kg) {
            f32x4 x[4];
#pragma unroll
            for (int dt = 0; dt < 4; ++dt) x[dt] = (f32x4){0.f, 0.f, 0.f, 0.f};
#define SA_CB(ks) (*(const LDS bf16x8*)(CK + ((ks) >> 2) * 16384 + imgb(16 * kg + l15o, 4 * ((ks) & 3) + quado)))
#define SA_MM(ks, cbv) do { _Pragma("unroll") for (int dt = 0; dt < 4; ++dt) x[dt] = __builtin_amdgcn_mfma_f32_16x16x32_bf16(wk[dt][ks], cbv, x[dt], 0, 0, 0); } while (0)
            bf16x8 ca0 = SA_CB(0), ca1 = SA_CB(1), cb0 = SA_CB(2), cb1 = SA_CB(3); SCHED_FENCE();
            SA_MM(0, ca0); SA_MM(1, ca1); ca0 = SA_CB(4); ca1 = SA_CB(5); SCHED_FENCE();
            SA_MM(2, cb0); SA_MM(3, cb1); cb0 = SA_CB(6); cb1 = SA_CB(7); SCHED_FENCE();
            const s16x4 qa0 = *(const LDS s16x4*)(QS + qrow * 104 + 4 * quad), qa1 = *(const LDS s16x4*)(QS + qrow * 104 + 16 + 4 * quad), qb0 = *(const LDS s16x4*)(QS + qrow * 104 + 32 + 4 * quad), qb1 = *(const LDS s16x4*)(QS + qrow * 104 + 48 + 4 * quad);
            const bf16x8 kpf = ld8(KP + (16 * kg + l15) * 40 + 8 * quad), qrf = ld8(QS + qrow * 104 + 64 + 8 * quad);
            SA_MM(4, ca0); SA_MM(5, ca1); SCHED_FENCE();
            SA_MM(6, cb0); SA_MM(7, cb1); SCHED_FENCE();
#undef SA_CB
#undef SA_MM
            float ss = 0.f;
#pragma unroll
            for (int dt = 0; dt < 4; ++dt) ss += x[dt][0] * x[dt][0] + x[dt][1] * x[dt][1] + x[dt][2] * x[dt][2] + x[dt][3] * x[dt][3];
            ss += __shfl_xor(ss, 16); ss += __shfl_xor(ss, 32); const float inv = rsqrtf(ss * (1.0f / 64.0f) + EPS);
            f32x4 z = {0.f, 0.f, 0.f, 0.f};
#pragma unroll
            for (int pp = 0; pp < 2; ++pp) {
                const bf16x8 a = pack8(x[2 * pp][0] * inv, x[2 * pp][1] * inv, x[2 * pp][2] * inv, x[2 * pp][3] * inv, x[2 * pp + 1][0] * inv, x[2 * pp + 1][1] * inv, x[2 * pp + 1][2] * inv, x[2 * pp + 1][3] * inv);
                z = __builtin_amdgcn_mfma_f32_16x16x32_bf16(a, pp == 0 ? __builtin_shufflevector(qa0, qa1, 0, 1, 2, 3, 4, 5, 6, 7) : __builtin_shufflevector(qb0, qb1, 0, 1, 2, 3, 4, 5, 6, 7), z, 0, 0, 0); }
            z = __builtin_amdgcn_mfma_f32_16x16x32_bf16(kpf, qrf, z, 0, 0, 0);
            float tmax = -INFINITY;
#pragma unroll
            for (int j = 0; j < 4; ++j) { const int key = 16 * kg + 4 * quad + j; if (newt && (key > l15 || key >= DECS)) z[j] = -INFINITY; tmax = fmaxf(tmax, z[j]); }
            tmax = fmaxf(tmax, __shfl_xor(tmax, 16)); tmax = fmaxf(tmax, __shfl_xor(tmax, 32));
            if (l15 >= 8 || (newt && kg > 0)) tmax = fmaxf(tmax, -1e30f);
            const float mn = fmaxf(m, tmax), corr = fexp(m - mn); m = mn;
#pragma unroll
            for (int j = 0; j < 4; ++j) z[j] = fexp(z[j] - mn);
            l = l * corr + (z[0] + z[1]) + (z[2] + z[3]);
            if (l15 < 8) { u32x2 w; w[0] = pk2(z[0], z[1]); w[1] = pk2(z[2], z[3]); *(LDS u32x2*)(PA + (h * 8 + l15) * 72 + 16 * kg + 4 * quad) = w;
                if (quad == 0) CORR[kg * 64 + h * 8 + l15] = corr; }
        }
        bar_lds();
#pragma unroll
        for (int ks = 0; ks < 4; ++ks) { const float c0 = CORR[ks * 64 + r], c1 = CORR[ks * 64 + 32 + r];
#pragma unroll
            for (int i = 0; i < 16; ++i) { acc0[i] *= c0; acc1[i] *= c1; }
            const bf16x8 a = img_tr<false>(CK + (wid >> 2) * 16384, lo_, wid & 3, 16 * ks);
            acc0 = mfma32(a, ld8(PA + r * 72 + 16 * ks + 8 * hh), acc0); acc1 = mfma32(a, ld8(PA + (32 + r) * 72 + 16 * ks + 8 * hh), acc1); }
        if (tile + 1 < ntile) {
            if (tile + 1 < npt) { wait_vm0(); bar_lds(); sattn_convert(lds); }
            else { bar_lds(); const size_t t0 = (size_t)TP + b * DECS;
                for (int i = tid; i < 64 * 32; i += NTHREADS) { const int key = i >> 5, c32 = i & 31; bf16x8 v = zero8(); if (key < DECS) v = ld8g(p.CKVB + (t0 + key) * 256 + c32 * 8);
                    *(LDS bf16x8*)(CK + (c32 >> 4) * 16384 + imgb(key, c32 & 15)) = v; }
                for (int i = tid; i < 64 * 32; i += NTHREADS) { const int key = i >> 5, c = i & 31; KP[key * 40 + c] = key < DECS ? p.KPB[(t0 + key) * 32 + c] : (bf16)0; } }
            bar_lds();
        }
    }
    { const int t2 = tid_opaque(), w2 = __builtin_amdgcn_readfirstlane(t2 >> 6), l2 = t2 & 63, r2 = l2 & 31, h2 = l2 >> 5;
        float* pa = p.PACC + (size_t)u * 64 * 256;
#pragma unroll
        for (int g = 0; g < 4; ++g) { f32x4 v0 = {acc0[4 * g], acc0[4 * g + 1], acc0[4 * g + 2], acc0[4 * g + 3]}, v1 = {acc1[4 * g], acc1[4 * g + 1], acc1[4 * g + 2], acc1[4 * g + 3]};
            *(f32x4*)(pa + (size_t)r2 * 256 + 32 * w2 + 8 * g + 4 * h2) = v0; *(f32x4*)(pa + (size_t)(32 + r2) * 256 + 32 * w2 + 8 * g + 4 * h2) = v1; }
        l += __shfl_xor(l, 16); l += __shfl_xor(l, 32);
        if (l2 < 8) { p.PML[((size_t)u * 64 + w2 * 8 + r2) * 2] = m; p.PML[((size_t)u * 64 + w2 * 8 + r2) * 2 + 1] = l; } }
}
DI void phase_sattn_combine(const Params& p, LDS unsigned char* lds) {
    const int tid = tid_opaque();
    LDS float* AC = (LDS float*)lds; LDS float* WS = (LDS float*)(lds + 8 * 256 * 4);
    for (int u = blockIdx.x; u < DECB * 8; u += gridDim.x) { const int b = u >> 3, h = u & 7;
        if (tid < 8) { const int hq = h * 8 + tid; float M = -INFINITY; for (int j = 0; j < NSPLIT; ++j) M = fmaxf(M, p.PML[((size_t)(b * NSPLIT + j) * 64 + hq) * 2]);
            float L = 0.f; for (int j = 0; j < NSPLIT; ++j) { const float w = expf(p.PML[((size_t)(b * NSPLIT + j) * 64 + hq) * 2] - M); WS[tid * NSPLIT + j] = w; L += w * p.PML[((size_t)(b * NSPLIT + j) * 64 + hq) * 2 + 1]; }
            const float iL = 1.0f / L; for (int j = 0; j < NSPLIT; ++j) WS[tid * NSPLIT + j] *= iL; }
        __syncthreads();
        { const int q = tid >> 6, l4 = (tid & 63) * 4; f32x4 s = {0.f, 0.f, 0.f, 0.f};
#pragma unroll
            for (int j = 0; j < NSPLIT; ++j) s += WS[q * NSPLIT + j] * *(const f32x4*)(p.PACC + ((size_t)(b * NSPLIT + j) * 64 + h * 8 + q) * 256 + l4);
            *(LDS f32x4*)(AC + q * 256 + l4) = s; }
        __syncthreads();
        { const int q = tid >> 6, dv = tid & 63; const bf16* w = p.wt_kvb + (size_t)(h * 128 + 64 + dv) * 256; float s = 0.f;
#pragma unroll 4
            for (int c = 0; c < 32; ++c) { const bf16x8 wv = ld8g(w + 8 * c); const f32x4 a0 = *(const LDS f32x4*)(AC + q * 256 + 8 * c), a1 = *(const LDS f32x4*)(AC + q * 256 + 8 * c + 4);
                s += a0[0] * bf2f((bf16)wv[0]) + a0[1] * bf2f((bf16)wv[1]) + a0[2] * bf2f((bf16)wv[2]) + a0[3] * bf2f((bf16)wv[3]) + a1[0] * bf2f((bf16)wv[4]) + a1[1] * bf2f((bf16)wv[5]) + a1[2] * bf2f((bf16)wv[6]) + a1[3] * bf2f((bf16)wv[7]); }
            p.OMIX[((size_t)TP + b * DECS + q) * DM + 512 + h * 64 + dv] = f2bf(s); }
        __syncthreads();
    }
}
#ifndef EMU
#define XB_TMO      128
#define XB_XCNT(j)  (256  + 64 * (j))
#define XB_XSUB(j)  (1280 + 64 * (j))
#define XB_XGEN(j)  (2304 + 64 * (j))
#define XB_TOP      3328
#define XB_TOPGEN   3392
#define XCD_BAR_WORDS 3456
#define XB_SPIN_CAP (1u << 18)
#define LAS __attribute__((address_space(3)))
__device__ __forceinline__ unsigned xb_ld(unsigned* p)              { return __hip_atomic_load(p, __ATOMIC_RELAXED, __HIP_MEMORY_SCOPE_AGENT); }
__device__ __forceinline__ unsigned xb_add(unsigned* p, unsigned v) { return __hip_atomic_fetch_add(p, v, __ATOMIC_RELAXED, __HIP_MEMORY_SCOPE_AGENT); }
__device__ __forceinline__ unsigned xb_xcc_id() { return (unsigned)__builtin_amdgcn_s_getreg((3 << 11) | 20) & 0xFu; }
#define XB_SPIN(cond, bar) do { unsigned _sp = 0; while (cond) { __builtin_amdgcn_s_sleep(1); \
    if ((++_sp & 255u) == 0u) { if (xb_ld(&(bar)[XB_TMO])) break; if (_sp > XB_SPIN_CAP) { atomicAdd(&(bar)[XB_TMO], 1u); break; } } } } while (0)
struct XcdBarrier { unsigned* bar; unsigned x; volatile LAS unsigned* st; };
__device__ __forceinline__ XcdBarrier xcd_barrier_post(unsigned* bar, volatile LAS unsigned* st) {
    XcdBarrier b; b.bar = bar; b.x = xb_xcc_id(); b.st = st;
    if (threadIdx.x == 0) (void)xb_add(&bar[XB_XCNT(b.x)], 1u);
    return b;
}
__device__ __forceinline__ void xcd_barrier_complete(unsigned* bar, unsigned x, unsigned& nloc, unsigned& nx) {
    const unsigned G = gridDim.x * gridDim.y * gridDim.z;
    unsigned sum, cnt, mine, sp = 0u;
    for (;;) {
        sum = 0u; cnt = 0u; mine = 0u;
#pragma unroll
        for (unsigned j = 0; j < 16; ++j) { const unsigned c = xb_ld(&bar[XB_XCNT(j)]); sum += c; cnt += (c > 0u) ? 1u : 0u; mine = (j == x) ? c : mine; }
        if (sum == G) break;
        __builtin_amdgcn_s_sleep(1);
        if ((++sp & 255u) == 0u) { if (xb_ld(&bar[XB_TMO])) break; if (sp > XB_SPIN_CAP) { atomicAdd(&bar[XB_TMO], 1u); break; } }
    }
    nloc = mine > 0u ? mine : 1u; nx = cnt > 0u ? cnt : 1u;
}
__device__ __forceinline__ void xcd_barrier(const XcdBarrier& b) {
    asm volatile("s_waitcnt vmcnt(0)" ::: "memory");
    __syncthreads();
    if (threadIdx.x == 0) {
        unsigned* bar = b.bar;
        __builtin_amdgcn_s_waitcnt(0);
        unsigned nloc = b.st[0], nx = b.st[1];
        if (nloc == 0u) { xcd_barrier_complete(bar, b.x, nloc, nx); b.st[0] = nloc; b.st[1] = nx; }
        const unsigned old = xb_add(&bar[XB_XSUB(b.x)], 1u);
        const unsigned gen = old / nloc;
        if (old + 1u == (gen + 1u) * nloc) {
            __builtin_amdgcn_fence(__ATOMIC_RELEASE, "agent");
            asm volatile("s_waitcnt vmcnt(0)" ::: "memory");
            const unsigned og = xb_add(&bar[XB_TOP], 1u);
            const unsigned tg = og / nx;
            if (og + 1u == (tg + 1u) * nx) xb_add(&bar[XB_TOPGEN], 1u);
            else XB_SPIN(xb_ld(&bar[XB_TOPGEN]) == tg, bar);
            __builtin_amdgcn_fence(__ATOMIC_ACQUIRE, "agent");
            xb_add(&bar[XB_XGEN(b.x)], 1u);
            asm volatile("s_waitcnt vmcnt(0)" ::: "memory");
        } else {
            XB_SPIN(xb_ld(&bar[XB_XGEN(b.x)]) == gen, bar);
            __builtin_amdgcn_fence(__ATOMIC_ACQUIRE, "agent");
            asm volatile("s_waitcnt vmcnt(0)" ::: "memory");
        }
    }
    __syncthreads();
}
#endif

DI int wq_next(unsigned* ctr, LDS unsigned* slot) {
    __syncthreads();
    if (threadIdx.x == 0) *slot = atomicAdd(ctr, 1u);
    __syncthreads();
    return __builtin_amdgcn_readfirstlane((int)*slot);
}
struct EpiResF32 {
    static constexpr bool PERM = false, AFTER_DRAIN = false;
    float* C; const float* R0; const float* R1; int split;
    DI void operator()(const f32x4 (&acc)[2][2][4][2], const pg8::Unit& u, int wr, int wc, int fr, int fq) const {
        const int row0 = u.pm * 256 + wr * 64 + fr, col0 = u.pn * 256 + wc * 32 + 4 * fq;
        const float* R = row0 < split ? R0 : R1 - (size_t)split * DM;
#pragma unroll
        for (int ai = 0; ai < 2; ++ai)
#pragma unroll
            for (int mp = 0; mp < 2; ++mp) { f32x4 rr[2][2][2];
#pragma unroll
                for (int mm = 0; mm < 2; ++mm) { const size_t off = (size_t)(row0 + ai * 128 + (2 * mp + mm) * 16) * DM + col0;
#pragma unroll
                    for (int bj = 0; bj < 2; ++bj)
#pragma unroll
                        for (int n = 0; n < 2; ++n) rr[mm][bj][n] = *(const f32x4*)(R + off + bj * 128 + n * 16); }
#pragma unroll
                for (int mm = 0; mm < 2; ++mm) { const size_t off = (size_t)(row0 + ai * 128 + (2 * mp + mm) * 16) * DM + col0;
#pragma unroll
                    for (int bj = 0; bj < 2; ++bj)
#pragma unroll
                        for (int n = 0; n < 2; ++n) *(f32x4*)(C + off + bj * 128 + n * 16) = acc[ai][bj][2 * mp + mm][n] + rr[mm][bj][n]; }
#ifndef EMU
                asm volatile("" ::: "memory");
#endif
            }
    }
};
DI void phase_norm_rows(const Params& p, const float* X, const float* g) {
    const int tid = tid_opaque(), wid = __builtin_amdgcn_readfirstlane(tid >> 6), lane = tid & 63;
    for (int row = blockIdx.x * 8 + wid; row < T; row += gridDim.x * 8) rmsnorm_row_1024(X + (size_t)row * DM, g, p.H + (size_t)row * DM, lane);
}
constexpr int NPHASE = 15;
template <int PH> DI void run_phase(const Params& p, LDS unsigned char* lds) {
    LDS unsigned* slot = (LDS unsigned*)(lds + LDS_CTL + 64);
    if constexpr (PH == 0) phase_prep(p, lds);
    else if constexpr (PH == 1) { run_gemm(lds, p.H, p.wt_in, TP, DINP, DM, EpiStoreBf16<0>{p.Z, DINP}, 0); run_gemm(lds, p.MEMN, p.wt_xkv, MROWS, 1024, DM, EpiStoreF32{p.MKV, nullptr, 1024}, 128);
        small_gemm(lds, p.H, p.wt_in, DINP, DM, SEpiBf16{p.Z, DINP, 0}, 64); }
    else if constexpr (PH == 2) { phase_post_in(p); if (DUPM & 8) phase_post_in(p); }
    else if constexpr (PH == 3) { run_gemm(lds, p.QAN, p.wt_qb, TP, 768, 384, EpiStoreBf16<0>{p.QF, 768}, 0); run_gemm(lds, p.CKVB, p.wt_kvb, TP, 1024, 256, EpiStoreBf16<0>{p.KV, 1024}, 128);
        small_gemm(lds, p.QAN, p.wt_qb, 768, 384, SEpiBf16{p.QF, 768, 0}, 0); __syncthreads(); phase_gla_a(p, lds); }
    else if constexpr (PH == 4) { phase_post_qkv(p); if (DUPM & 16) phase_post_qkv(p); phase_gla_b(p); }
    else if constexpr (PH == 5) {
        for (int rep = 0; rep < ((DUPM & 1) ? 2 : 1); ++rep) for (;;) { const int u = wq_next(p.ctl + CW_Q5 + 192 * rep, slot); if (u >= NU_SA) break; sattn_unit(p, lds, u); }
        for (int rep = 0; rep < ((DUPM & 2) ? 2 : 1); ++rep) for (;;) { const int u = wq_next(p.ctl + CW_Q5 + 64 + 192 * rep, slot); if (u >= NU_PA) break; pattn_unit(p, lds, u); }
        for (int rep = 0; rep < ((DUPM & 4) ? 2 : 1); ++rep) for (;;) { const int u = wq_next(p.ctl + CW_Q5 + 128 + 192 * rep, slot); if (u >= NGU) break; gla_c_unit(p, lds, u); } }
    else if constexpr (PH == 6) phase_sattn_combine(p, lds);
    else if constexpr (PH == 7) { run_gemm(lds, p.OMIX, p.wt_out, TP, DM, DM, EpiResF32{p.X1, p.xp, p.xs, TP}, 0); small_gemm(lds, p.OMIX, p.wt_out, DM, DM, SEpiRes{p.X1, p.xs - (size_t)TP * DM}, 0); }
    else if constexpr (PH == 8) phase_norm_rows(p, p.X1, p.g_x);
    else if constexpr (PH == 9) { run_gemm(lds, p.H, p.wt_xq, TP, 512, DM, EpiStoreBf16<0>{p.XQ, 512}, 0); small_gemm(lds, p.H, p.wt_xq, 512, DM, SEpiBf16{p.XQ, 512, 0}, 0); }
    else if constexpr (PH == 10) { unsigned* ctr = p.ctl + CW_QX; if (DUPP & (1 << 10)) { __syncthreads(); if (*(volatile unsigned*)ctr >= (unsigned)(NU_XS + NU_XP) ) ctr += 64; }
        for (;;) { const int u = wq_next(ctr, slot); if (u >= NU_XS + NU_XP) break; xattn_unit(p, lds, u < NU_XS ? NU_XP + u : u - NU_XS); } }
    else if constexpr (PH == 11) { run_gemm(lds, p.XO, p.wt_xo, TP, DM, 512, EpiResF32{p.X2, p.X1, p.X1, T}, 0); small_gemm(lds, p.XO, p.wt_xo, DM, 512, SEpiRes{p.X2, p.X1}, 0); }
    else if constexpr (PH == 12) phase_norm_rows(p, p.X2, p.g_ff);
    else if constexpr (PH == 13) { run_gemm(lds, p.H, p.wt_ff1, TP, DFF, DM, EpiStoreBf16<1>{p.U, DFF}, 0); small_gemm(lds, p.H, p.wt_ff1, DFF, DM, SEpiBf16{p.U, DFF, 1}, 0); }
    else if constexpr (PH == 14) { run_gemm(lds, p.U, p.wt_ff2, TP, DM, DFF, EpiResF32{p.y, p.X2, p.X2, T}, 0); small_gemm(lds, p.U, p.wt_ff2, DM, DFF, SEpiRes{p.y, p.X2}, 0); }
}
#ifdef EMU
#define GET_LDS() ((LDS unsigned char*)EMU_SMEM())
#define GRID_BAR() emu_grid_barrier()
#else
#define GET_LDS() ((LDS unsigned char*)lds_raw)
#define GRID_BAR() xcd_barrier(bar)
#endif
template <int PH> __global__ void __launch_bounds__(NTHREADS, 2) k_phase(Params p) {
#ifndef EMU
    extern __shared__ __attribute__((aligned(16))) unsigned char lds_raw[];
#endif
    run_phase<PH>(p, GET_LDS());
}
#if N_LAUNCH_MODE == 1
__global__ void __launch_bounds__(NTHREADS, 2) k_mega(Params p) {
#ifndef EMU
    extern __shared__ __attribute__((aligned(16))) unsigned char lds_raw[];
    LDS unsigned char* lds = GET_LDS();
    if (threadIdx.x < 64) ((LDS unsigned*)(lds + LDS_CTL))[threadIdx.x] = 0u;
    __syncthreads();
    XcdBarrier bar = xcd_barrier_post(p.ctl + CW_BAR, (volatile LDS unsigned*)(lds + LDS_CTL));
#else
    LDS unsigned char* lds = GET_LDS();
#endif
    run_phase<0>(p, lds); if (DUPP & (1 << 0)) run_phase<0>(p, lds); GRID_BAR();
    run_phase<1>(p, lds); if (DUPP & (1 << 1)) run_phase<1>(p, lds); GRID_BAR();
    run_phase<2>(p, lds); if (DUPP & (1 << 2)) run_phase<2>(p, lds); GRID_BAR();
    run_phase<3>(p, lds); if (DUPP & (1 << 3)) run_phase<3>(p, lds); GRID_BAR();
    run_phase<4>(p, lds); GRID_BAR();
    run_phase<5>(p, lds); GRID_BAR();
    run_phase<6>(p, lds); if (DUPP & (1 << 6)) run_phase<6>(p, lds); GRID_BAR();
    run_phase<7>(p, lds); if (DUPP & (1 << 7)) run_phase<7>(p, lds); GRID_BAR();
    run_phase<8>(p, lds); if (DUPP & (1 << 8)) run_phase<8>(p, lds); GRID_BAR();
    run_phase<9>(p, lds); if (DUPP & (1 << 9)) run_phase<9>(p, lds); GRID_BAR();
    run_phase<10>(p, lds); if (DUPP & (1 << 10)) run_phase<10>(p, lds); GRID_BAR();
    run_phase<11>(p, lds); if (DUPP & (1 << 11)) run_phase<11>(p, lds); GRID_BAR();
    run_phase<12>(p, lds); if (DUPP & (1 << 12)) run_phase<12>(p, lds); GRID_BAR();
    run_phase<13>(p, lds); if (DUPP & (1 << 13)) run_phase<13>(p, lds); GRID_BAR();
    run_phase<14>(p, lds); if (DUPP & (1 << 14)) run_phase<14>(p, lds);
}
#endif

static size_t ws_take(size_t& off, size_t bytes) { const size_t o = off; off = (off + bytes + 255) & ~(size_t)255; return o; }
template <int PH> static void launch_phase(const Params& p, int grid, hipStream_t stream) {
#ifndef EMU
    static bool attr = false; if (!attr) { (void)hipFuncSetAttribute((const void*)k_phase<PH>, hipFuncAttributeMaxDynamicSharedMemorySize, LDS_BYTES); attr = true; }
#endif
    LAUNCH(k_phase<PH>, dim3(grid), dim3(NTHREADS), LDS_BYTES, stream, p);
}
extern "C" void kernel_launch(void* const* d_in, const int* in_sizes, int n_in, void* d_out, int out_size, void* d_ws, size_t ws_size, hipStream_t stream) {
    Params p{};
    const float* const* in = (const float* const*)d_in;
    p.xp = in[0]; p.xs = in[1]; p.memp = in[2]; p.cckv = in[3]; p.ckpe = in[4]; p.cmk = in[5]; p.cmv = in[6]; p.sgla = in[7]; p.ptab = (const int*)d_in[8];
    p.g_mix = in[9]; p.w_a2 = in[11]; p.b_a = in[12]; p.g_gla_o = in[13]; p.g_qa = in[14]; p.g_kva = in[16]; p.g_qn = in[18]; p.g_kn = in[19]; p.g_qr = in[20]; p.g_kr = in[21];
    p.g_x = in[23]; p.g_mem = in[24]; p.g_xq = in[28]; p.g_xk = in[29]; p.g_ff = in[31];
    float* out = (float*)d_out; size_t oo = 0;
    p.y = out; oo += (size_t)T * DM; p.o_ckvp = out + oo; oo += (size_t)TP * 256; p.o_kpep = out + oo; oo += (size_t)TP * 32; p.o_mkp = out + oo; oo += (size_t)MROWS * 512; p.o_mvp = out + oo; oo += (size_t)MROWS * 512;
    p.o_glap = out + oo; oo += (size_t)BATCH * 4 * 8192; p.o_ckvs = out + oo; oo += (size_t)TS * 256; p.o_kpes = out + oo; oo += (size_t)TS * 32; p.o_glas = out + oo; oo += (size_t)DECB * 4 * 8192;
    if ((size_t)out_size != oo || n_in != 34) { fprintf(stderr, "kernel_launch: unexpected sizes (out %d vs %zu, n_in %d)\n", out_size, oo, n_in); }
    unsigned char* ws = (unsigned char*)d_ws; size_t off = 0;
    p.ctl = (unsigned*)(ws + ws_take(off, 1 << 20));
#define WSB(name, elems) p.name = (bf16*)(ws + ws_take(off, (size_t)(elems) * 2))
#define WSF(name, elems) p.name = (float*)(ws + ws_take(off, (size_t)(elems) * 4))
    WSB(wt_in, (size_t)DINP * DM); WSB(wt_qb, 768 * 384); WSB(wt_kvb, 1024 * 256); WSB(wt_out, DM * DM); WSB(wt_xq, 512 * DM); WSB(wt_xkv, 1024 * DM); WSB(wt_xo, DM * 512); WSB(wt_ff1, (size_t)DFF * DM); WSB(wt_ff2, (size_t)DM * DFF);
    WSB(H, (size_t)T * DM); WSB(MEMN, (size_t)MROWS * DM); WSB(Z, (size_t)T * DINP); WSB(QAN, (size_t)T * 384); WSB(CKVB, (size_t)T * 256); WSB(KPB, (size_t)T * 32); WSB(MKB, (size_t)MROWS * 512); WSB(MVB, (size_t)MROWS * 512);
    WSB(QF, (size_t)T * 768); WSB(KV, (size_t)T * 1024); WSB(QN, (size_t)T * 768); WSB(KN, (size_t)T * 512); WSB(OMIX, (size_t)T * DM); WSB(XQ, (size_t)T * 512); WSB(XO, (size_t)T * 512); WSB(U, (size_t)T * DFF);
    WSF(MKV, (size_t)MROWS * 1024); WSF(LOGA, (size_t)T * 256); WSF(DS, (size_t)NGU * 8192); WSF(DDEC, (size_t)NGU * 64); WSF(X1, (size_t)T * DM); WSF(X2, (size_t)T * DM); WSF(PACC, (size_t)NU_SA * 64 * 256); WSF(PML, (size_t)NU_SA * 128);
    if (off > ws_size) { fprintf(stderr, "kernel_launch: workspace too small (%zu > %zu)\n", off, ws_size); return; }
    p.w_in = in[10]; p.w_qb = in[15]; p.w_kvb = in[17]; p.w_out = in[22]; p.w_xq = in[25]; p.w_xk = in[26]; p.w_xv = in[27]; p.w_xo = in[30]; p.w_ff1 = in[32]; p.w_ff2 = in[33];
    (void)hipMemsetAsync(p.ctl, 0, 1 << 20, stream);
#ifdef EMU
    const int grid = EMU_GRID;
#else
    static int grid = 0;
    if (!grid) { int dev = 0, cus = 0; (void)hipGetDevice(&dev); (void)hipDeviceGetAttribute(&cus, hipDeviceAttributeMultiprocessorCount, dev); grid = cus > 0 ? cus : 256;
#if N_LAUNCH_MODE == 1
        (void)hipFuncSetAttribute((const void*)k_mega, hipFuncAttributeMaxDynamicSharedMemorySize, LDS_BYTES);
        int per_cu = 0; if (hipOccupancyMaxActiveBlocksPerMultiprocessor(&per_cu, (const void*)k_mega, NTHREADS, LDS_BYTES) != hipSuccess || per_cu < 1) fprintf(stderr, "kernel_launch: occupancy query reports %d workgroups per CU\n", per_cu);
#endif
    }
#endif
#if N_LAUNCH_MODE == 1
    LAUNCH(k_mega, dim3(grid), dim3(NTHREADS), LDS_BYTES, stream, p);
#else
    launch_phase<0>(p, grid, stream); launch_phase<1>(p, grid, stream); launch_phase<2>(p, grid, stream); launch_phase<3>(p, grid, stream); launch_phase<4>(p, grid, stream);
    launch_phase<5>(p, grid, stream); launch_phase<6>(p, grid, stream); launch_phase<7>(p, grid, stream); launch_phase<8>(p, grid, stream); launch_phase<9>(p, grid, stream);
    launch_phase<10>(p, grid, stream); launch_phase<11>(p, grid, stream); launch_phase<12>(p, grid, stream); launch_phase<13>(p, grid, stream); launch_phase<14>(p, grid, stream);
#endif
}
```

```cpp
#ifdef EMU
#include "emu.h"
#define LDS
#else
#include <hip/hip_runtime.h>
#define LDS __attribute__((address_space(3)))
#define LAUNCH(kern, grid, block, smem, stream, ...) kern<<<grid, block, smem, stream>>>(__VA_ARGS__)
#endif
#include <cstdio>
#include <cstdint>
#include <cmath>
#define DI __device__ __forceinline__

#ifndef CFG_BATCH
#define CFG_BATCH 16
#define CFG_SEQ 2048
#define CFG_DECB 128
#define CFG_PAST 8192
#endif
#ifndef PROBE_A
#define PROBE_A -1
#define PROBE_B -1
#endif
#define PROBE_K 8
#ifndef DUPP
#define DUPP 0
#endif
#ifndef DUPM
#define DUPM 0
#endif
#ifndef N_LAUNCH_MODE
#define N_LAUNCH_MODE 1
#endif

typedef unsigned short bf16;
typedef short bf16x8 __attribute__((ext_vector_type(8)));
typedef short s16x4 __attribute__((ext_vector_type(4)));
typedef float f32x4 __attribute__((ext_vector_type(4)));
typedef float f32x16 __attribute__((ext_vector_type(16)));
typedef unsigned u32x4 __attribute__((ext_vector_type(4)));
typedef unsigned u32x2 __attribute__((ext_vector_type(2)));

constexpr int DM = 1024, BATCH = CFG_BATCH, SEQ = CFG_SEQ, DECB = CFG_DECB, DECS = 8, PAST = CFG_PAST, PAGE = 128, NPAGES = PAST / PAGE;
constexpr int NMEM = 256, TP = BATCH * SEQ, TS = DECB * DECS, T = TP + TS, MROWS = BATCH * NMEM;
constexpr int DIN = 2224, DINP = 2304, DFF = 4096;
constexpr int ZQ = 0, ZK = 256, ZV = 512, ZR = 1024, ZA = 1536, ZQA = 1552, ZKVA = 1936, ZKPE = 2192;
constexpr float EPS = 1e-6f, MLA_SCALE = 0.10206207261596577f  , X_SCALE = 0.08838834764831845f  ;
constexpr int NC = SEQ / 64;
constexpr int NGP = BATCH * 4 * NC, NGS = DECB * 4, NGU = NGP + NGS;
constexpr int NSPLIT = NPAGES >= 2 ? 2 : NPAGES, PPS = NPAGES / NSPLIT;
static_assert(PPS <= 64, "page ids of a unit live in one wave register");
constexpr int NU_SA = DECB * NSPLIT, NQB = SEQ / 256, NU_PA = BATCH * 8 * NQB;
constexpr int NU_XP = BATCH * 4 * NQB, NU_XS = DECB * 4;
static_assert(T % 256 == 0 && MROWS % 256 == 0 && SEQ % 256 == 0 && NPAGES % NSPLIT == 0, "shape assumptions");
constexpr int NTHREADS = 512, LDS_BYTES = 147456, LDS_CTL = LDS_BYTES - 256;

DI int tid_opaque() {
    int t = threadIdx.x;
#ifndef EMU
    asm volatile("" : "+v"(t));
#endif
    return t;
}
DI float bf2f(bf16 b) { return __uint_as_float(((unsigned)b) << 16); }
DI bf16 f2bf(float x) {
#ifdef EMU
    unsigned u = __float_as_uint(x); u += 0x7fffu + ((u >> 16) & 1u); return (bf16)(u >> 16);
#else
    return __builtin_bit_cast(unsigned short, (__bf16)x);
#endif
}
DI float fexp(float x) {
#ifdef EMU
    return exp2f(x * 1.4426950408889634f);
#else
    return __builtin_amdgcn_exp2f(x * 1.4426950408889634f);
#endif
}
DI float flog2(float x) {
#ifdef EMU
    return log2f(x);
#else
    return __builtin_amdgcn_logf(x);
#endif
}
#ifndef EMU
typedef __bf16 bf16x2_t __attribute__((ext_vector_type(2)));
typedef float f32x2_t __attribute__((ext_vector_type(2)));
#endif
DI float fexp2(float x) {
#ifdef EMU
    return exp2f(x);
#else
    return __builtin_amdgcn_exp2f(x);
#endif
}
DI unsigned pk2(float a, float b) {
#ifdef EMU
    return (unsigned)f2bf(a) | ((unsigned)f2bf(b) << 16);
#else
    const f32x2_t v = {a, b}; return __builtin_bit_cast(unsigned, __builtin_convertvector(v, bf16x2_t));
#endif
}
DI f32x16 zero16() { f32x16 z; for (int i = 0; i < 16; ++i) z[i] = 0.f; return z; }
DI f32x16 mfma32(bf16x8 a, bf16x8 b, f32x16 c) { return __builtin_amdgcn_mfma_f32_32x32x16_bf16(a, b, c, 0, 0, 0); }
DI int crow(int i, int h) { return (i & 3) + 8 * (i >> 2) + 4 * h; }
DI bf16x8 ld8(const LDS bf16* p) { return *(const LDS bf16x8*)p; }
DI bf16x8 ld8g(const bf16* p) { return *(const bf16x8*)p; }
DI bf16x8 ldperm(const LDS bf16* p16, int h) {
    const s16x4 lo = *(const LDS s16x4*)(p16 + 4 * h), hi = *(const LDS s16x4*)(p16 + 8 + 4 * h);
    return __builtin_shufflevector(lo, hi, 0, 1, 2, 3, 4, 5, 6, 7);
}
DI bf16x8 ldpermg(const bf16* p16, int h) {
    const s16x4 lo = *(const s16x4*)(p16 + 4 * h), hi = *(const s16x4*)(p16 + 8 + 4 * h);
    return __builtin_shufflevector(lo, hi, 0, 1, 2, 3, 4, 5, 6, 7);
}
DI bf16x8 pack8(float a0, float a1, float a2, float a3, float a4, float a5, float a6, float a7) {
    u32x4 p; p[0] = pk2(a0, a1); p[1] = pk2(a2, a3); p[2] = pk2(a4, a5); p[3] = pk2(a6, a7); return __builtin_bit_cast(bf16x8, p);
}
#define PACK(x, s) pack8((x)[8 * (s)], (x)[8 * (s) + 1], (x)[8 * (s) + 2], (x)[8 * (s) + 3], (x)[8 * (s) + 4], (x)[8 * (s) + 5], (x)[8 * (s) + 6], (x)[8 * (s) + 7])
DI float wsum(float v) { for (int o = 32; o >= 1; o >>= 1) v += __shfl_xor(v, o); return v; }
DI bf16x8 zero8() { bf16x8 z; for (int i = 0; i < 8; ++i) z[i] = 0; return z; }

DI float xsum16(float v) {
#ifdef EMU
    return v + __shfl_xor(v, 16);
#else
    const auto r = __builtin_amdgcn_permlane16_swap(__float_as_uint(v), __float_as_uint(v), false, false); return __uint_as_float(r[0]) + __uint_as_float(r[1]);
#endif
}
DI float xsum32(float v) {
#ifdef EMU
    return v + __shfl_xor(v, 32);
#else
    const auto r = __builtin_amdgcn_permlane32_swap(__float_as_uint(v), __float_as_uint(v), false, false); return __uint_as_float(r[0]) + __uint_as_float(r[1]);
#endif
}
DI float xmax16(float v) {
#ifdef EMU
    return fmaxf(v, __shfl_xor(v, 16));
#else
    const auto r = __builtin_amdgcn_permlane16_swap(__float_as_uint(v), __float_as_uint(v), false, false); return fmaxf(__uint_as_float(r[0]), __uint_as_float(r[1]));
#endif
}
DI float xmax32(float v) {
#ifdef EMU
    return fmaxf(v, __shfl_xor(v, 32));
#else
    const auto r = __builtin_amdgcn_permlane32_swap(__float_as_uint(v), __float_as_uint(v), false, false); return fmaxf(__uint_as_float(r[0]), __uint_as_float(r[1]));
#endif
}

DI unsigned imgb(unsigned row, unsigned ch) { return 256u * row + 16u * (ch ^ (((row & 3u) << 2) | ((row >> 2) & 3u))); }
DI bf16x8 img_row(const LDS unsigned char* img, unsigned row, unsigned s, unsigned hh) { return *(const LDS bf16x8*)(img + imgb(row, 2 * s + hh)); }
DI s16x4 tr16(const LDS unsigned char* a) {
#ifdef EMU
    return emu_tr16_b64(a);
#else
    return __builtin_amdgcn_ds_read_tr16_b64_v4i16((LDS s16x4*)a);
#endif
}
template <bool PERM> DI bf16x8 img_tr(const LDS unsigned char* img, unsigned lane, unsigned c, unsigned k16) {
    const unsigned hh = lane >> 5, blk = (lane >> 4) & 1, q = (lane & 15) >> 2, pp = lane & 3;
    const unsigned r0 = k16 + (PERM ? 4 * hh : 8 * hh) + q, r1 = r0 + (PERM ? 8 : 4), ch = 4 * c + 2 * blk + (pp >> 1);
    const LDS unsigned char* a0 = img + imgb(r0, ch) + 8 * (pp & 1); const LDS unsigned char* a1 = img + imgb(r1, ch) + 8 * (pp & 1);
#ifdef EMU
    const s16x4 lo = emu_tr16_b64(a0), hi = emu_tr16_b64(a1);
#else
    s16x4 lo, hi;
    asm volatile("ds_read_b64_tr_b16 %0, %2\n\tds_read_b64_tr_b16 %1, %3\n\ts_waitcnt lgkmcnt(0)" : "=&v"(lo), "=&v"(hi) : "v"((unsigned)(size_t)a0), "v"((unsigned)(size_t)a1) : "memory");
#endif
    return __builtin_shufflevector(lo, hi, 0, 1, 2, 3, 4, 5, 6, 7);
}

DI void img_tr4p(const LDS unsigned char* img, unsigned lane, unsigned c0, unsigned c1, unsigned ka, unsigned kb, bf16x8& f0, bf16x8& f1, bf16x8& f2, bf16x8& f3) {
#ifdef EMU
    f0 = img_tr<true>(img, lane, c0, ka); f1 = img_tr<true>(img, lane, c1, ka); f2 = img_tr<true>(img, lane, c0, kb); f3 = img_tr<true>(img, lane, c1, kb);
#else
    const unsigned hh = lane >> 5, blk = (lane >> 4) & 1, q = (lane & 15) >> 2, pp = lane & 3;
    unsigned ad[8]; s16x4 v[8];
#pragma unroll
    for (int f = 0; f < 4; ++f) { const unsigned c = (f & 1) ? c1 : c0, k16 = (f & 2) ? kb : ka, r0 = k16 + 4 * hh + q, ch = 4 * c + 2 * blk + (pp >> 1);
        ad[2 * f] = (unsigned)(size_t)(img + imgb(r0, ch) + 8 * (pp & 1)); ad[2 * f + 1] = (unsigned)(size_t)(img + imgb(r0 + 8, ch) + 8 * (pp & 1)); }
    asm volatile("ds_read_b64_tr_b16 %0, %8\n\tds_read_b64_tr_b16 %1, %9\n\tds_read_b64_tr_b16 %2, %10\n\tds_read_b64_tr_b16 %3, %11\n\tds_read_b64_tr_b16 %4, %12\n\tds_read_b64_tr_b16 %5, %13\n\tds_read_b64_tr_b16 %6, %14\n\tds_read_b64_tr_b16 %7, %15\n\ts_waitcnt lgkmcnt(0)"
                 : "=&v"(v[0]), "=&v"(v[1]), "=&v"(v[2]), "=&v"(v[3]), "=&v"(v[4]), "=&v"(v[5]), "=&v"(v[6]), "=&v"(v[7])
                 : "v"(ad[0]), "v"(ad[1]), "v"(ad[2]), "v"(ad[3]), "v"(ad[4]), "v"(ad[5]), "v"(ad[6]), "v"(ad[7]) : "memory");
    f0 = __builtin_shufflevector(v[0], v[1], 0, 1, 2, 3, 4, 5, 6, 7); f1 = __builtin_shufflevector(v[2], v[3], 0, 1, 2, 3, 4, 5, 6, 7);
    f2 = __builtin_shufflevector(v[4], v[5], 0, 1, 2, 3, 4, 5, 6, 7); f3 = __builtin_shufflevector(v[6], v[7], 0, 1, 2, 3, 4, 5, 6, 7);
#endif
}

DI unsigned tr_lane_off(unsigned lane, unsigned c, unsigned plus8) {
    const unsigned hh = lane >> 5, blk = (lane >> 4) & 1, q = (lane & 15) >> 2, pp = lane & 3;
    return imgb(4 * hh + q + 8 * plus8, 4 * c + 2 * blk + (pp >> 1)) + 8 * (pp & 1);
}
template <int KA, int KB> DI void img_tr4p_pre(const LDS unsigned char* p0, const LDS unsigned char* p1, const LDS unsigned char* p2, const LDS unsigned char* p3, bf16x8& f0, bf16x8& f1, bf16x8& f2, bf16x8& f3) {
#ifdef EMU
    const s16x4 a0 = emu_tr16_b64(p0 + 256 * KA), a1 = emu_tr16_b64(p1 + 256 * KA), a2 = emu_tr16_b64(p2 + 256 * KA), a3 = emu_tr16_b64(p3 + 256 * KA);
    const s16x4 b0 = emu_tr16_b64(p0 + 256 * KB), b1 = emu_tr16_b64(p1 + 256 * KB), b2 = emu_tr16_b64(p2 + 256 * KB), b3 = emu_tr16_b64(p3 + 256 * KB);
    f0 = __builtin_shufflevector(a0, a1, 0, 1, 2, 3, 4, 5, 6, 7); f1 = __builtin_shufflevector(a2, a3, 0, 1, 2, 3, 4, 5, 6, 7); f2 = __builtin_shufflevector(b0, b1, 0, 1, 2, 3, 4, 5, 6, 7); f3 = __builtin_shufflevector(b2, b3, 0, 1, 2, 3, 4, 5, 6, 7);
#else
    s16x4 v[8];
    asm volatile("ds_read_b64_tr_b16 %0, %8 offset:%12\n\tds_read_b64_tr_b16 %1, %9 offset:%12\n\tds_read_b64_tr_b16 %2, %10 offset:%12\n\tds_read_b64_tr_b16 %3, %11 offset:%12\n\t"
                 "ds_read_b64_tr_b16 %4, %8 offset:%13\n\tds_read_b64_tr_b16 %5, %9 offset:%13\n\tds_read_b64_tr_b16 %6, %10 offset:%13\n\tds_read_b64_tr_b16 %7, %11 offset:%13\n\ts_waitcnt lgkmcnt(0)"
                 : "=&v"(v[0]), "=&v"(v[1]), "=&v"(v[2]), "=&v"(v[3]), "=&v"(v[4]), "=&v"(v[5]), "=&v"(v[6]), "=&v"(v[7])
                 : "v"((unsigned)(size_t)p0), "v"((unsigned)(size_t)p1), "v"((unsigned)(size_t)p2), "v"((unsigned)(size_t)p3), "n"(256 * KA), "n"(256 * KB) : "memory");
    f0 = __builtin_shufflevector(v[0], v[1], 0, 1, 2, 3, 4, 5, 6, 7); f1 = __builtin_shufflevector(v[2], v[3], 0, 1, 2, 3, 4, 5, 6, 7);
    f2 = __builtin_shufflevector(v[4], v[5], 0, 1, 2, 3, 4, 5, 6, 7); f3 = __builtin_shufflevector(v[6], v[7], 0, 1, 2, 3, 4, 5, 6, 7);
#endif
}
DI void dma16(const void* g, LDS unsigned char* l) {
#ifdef EMU
    emu_dma16(g, l);
#else
    __builtin_amdgcn_global_load_lds((const unsigned*)g, (LDS unsigned*)l, 16, 0, 0);
#endif
}
#ifdef EMU
#define SCHED_FENCE() do {} while (0)
#else
#define SCHED_FENCE() __builtin_amdgcn_sched_barrier(0)
#endif
DI int rdlane(int v, int l) {
#ifdef EMU
    return __shfl(v, l);
#else
    return __builtin_amdgcn_readlane(v, l);
#endif
}
DI void wait_vm0() {
#ifndef EMU
    asm volatile("s_waitcnt vmcnt(0)" ::: "memory");
#endif
}
DI void bar_lds() {
#ifdef EMU
    __syncthreads();
#else
    asm volatile("s_waitcnt lgkmcnt(0)" ::: "memory"); __builtin_amdgcn_s_barrier(); asm volatile("" ::: "memory");
#endif
}

namespace pg8 {
#define PG8_LAS LDS
typedef unsigned short bf16_t;
constexpr int BM = 256, BK = 64, HALF = 128, HTB = HALF * BK * 2  , STAGE_BYTES = 8 * HTB, NXCD = 8, WGM = 8;
__host__ __device__ __forceinline__ int lds_byte(int r, int c) { const int st = (r >> 4) * 2 + (c >> 5), rr = r & 15, cc = c & 31, ob = rr * 64 + cc * 2; return st * 1024 + (ob ^ (((ob >> 9) & 1) << 5)); }
__host__ __device__ __forceinline__ void stage_rc(int b, int& R, int& C) { const int st = b / 1024, sb = b % 1024, swz = sb ^ (((sb >> 9) & 1) << 5); R = (st >> 1) * 16 + swz / 64; C = (st & 1) * 32 + (swz % 64) / 2; }
__host__ __device__ __forceinline__ int perm32(int rho) { const int n = rho >> 4, i = rho & 15; return 8 * (i >> 2) + 4 * n + (i & 3); }
struct Unit { int pm, pn; };
struct Gemm { const bf16_t* A; const bf16_t* Bt; int M, N, K; };
struct StaticOrder {
    int nM, nN, nwg, G, c;
    __host__ __device__ void init(int M, int N, int G_, int c_) { nM = M / BM; nN = N / BM; nwg = nM * nN; G = G_; c = c_; }
    __host__ __device__ bool next(int i, Unit& u) const {
        const long L = (long)i * G + c; if (L >= nwg) return false;
        int wgid = (int)L; { const int q = nwg / NXCD, r = nwg % NXCD, xcd = wgid % NXCD, off = wgid / NXCD; wgid = (xcd < r ? xcd * (q + 1) : r * (q + 1) + (xcd - r) * q) + off; }
        const int nig = WGM * nN, gid = wgid / nig, fm = gid * WGM, gsz = (nM - fm) < WGM ? (nM - fm) : WGM;
        u.pm = fm + ((wgid % nig) % gsz); u.pn = (wgid % nig) / gsz; return true;
    }
    __device__ __forceinline__ void a_ready(const Unit&) const {}
    __device__ __forceinline__ void done(const Unit&) const {}
};
#ifdef EMU
template <class Epi, class Sched>
__device__ __forceinline__ void gemm_phase(PG8_LAS unsigned char* lds, const Gemm g, const Sched& S, const Epi& E) {
    const int tid = tid_opaque(), wid = __builtin_amdgcn_readfirstlane(tid >> 6), lane = tid & 63, wr = wid >> 2, wc = wid & 3, fr = lane & 15, fq = lane >> 4;
    Unit cur;
    for (int ui = 0; S.next(ui, cur); ++ui) {
        f32x4 acc[2][2][4][2];
        for (int ai = 0; ai < 2; ++ai) for (int bj = 0; bj < 2; ++bj) for (int m = 0; m < 4; ++m) for (int n = 0; n < 2; ++n) for (int j = 0; j < 4; ++j) {
            const int row = 256 * cur.pm + 128 * ai + 64 * wr + 16 * m + fr;
            const int col = Epi::PERM ? 256 * cur.pn + 128 * bj + 32 * wc + 8 * fq + 4 * n + j : 256 * cur.pn + 128 * bj + 32 * wc + 16 * n + 4 * fq + j;
            const bf16_t* a = g.A + (size_t)row * g.K; const bf16_t* b = g.Bt + (size_t)col * g.K; float s = 0.f;
            for (int k = 0; k < g.K; ++k) s += bf2f(a[k]) * bf2f(b[k]);
            acc[ai][bj][m][n][j] = s;
        }
        E(acc, cur, wr, wc, fr, fq);
    }
}
#else
template <class Epi, class Sched>
__device__ __forceinline__ void gemm_phase(PG8_LAS unsigned char* lds, const Gemm g, const Sched& S, const Epi& E) {
    const int tid = tid_opaque(), wid = __builtin_amdgcn_readfirstlane(tid >> 6), lane = tid & 63, wr = wid >> 2, wc = wid & 3, fr = lane & 15, fq = lane >> 4;
    const int K = g.K, nt = K / BK;
    unsigned voffA[2], voffB[2];
#pragma unroll
    for (int i = 0; i < 2; ++i) { int R, C; stage_rc(tid * 16 + i * 8192, R, C); const int Rb = Epi::PERM ? ((R & ~31) + perm32(R & 31)) : R;
        voffA[i] = (unsigned)(R * K + C) * 2u; voffB[i] = (unsigned)(Rb * K + C) * 2u; }
    const size_t kstep = (size_t)(BK * 2);
    const size_t hstep = (size_t)HALF * K * 2;
    const size_t tstep = 2 * hstep;
    const unsigned ldsw = (unsigned)wid * 1024u;
    const int aoff = lds_byte(wr * 64 + fr, fq * 8), boff = lds_byte(wc * 32 + fr, fq * 8);
#define PG8_SA(b, h) (((b) * 2 + (h)) * HTB)
#define PG8_SB(b, h) ((4 + (b) * 2 + (h)) * HTB)
#define PG8_STAGE(bufoff, gbase, voff) do { _Pragma("unroll") for (int _i = 0; _i < 2; ++_i) \
        __builtin_amdgcn_global_load_lds((const unsigned*)((const char*)(gbase) + (voff)[_i]), (PG8_LAS unsigned*)(lds + (bufoff) + ldsw + _i * 8192), 16, 0, 0); } while (0)
#define PG8_LDA(dst, b, h) do { _Pragma("unroll") for (int m = 0; m < 4; ++m) _Pragma("unroll") for (int k = 0; k < 2; ++k) dst[m][k] = *(const PG8_LAS bf16x8*)(lds + PG8_SA(b, h) + aoff + m * 2048 + k * 1024); } while (0)
#define PG8_LDB(dst, b, h) do { _Pragma("unroll") for (int n = 0; n < 2; ++n) _Pragma("unroll") for (int k = 0; k < 2; ++k) dst[n][k] = *(const PG8_LAS bf16x8*)(lds + PG8_SB(b, h) + boff + n * 2048 + k * 1024); } while (0)
#define PG8_MMA(ai, bj, At, Bt) do { __builtin_amdgcn_s_setprio(1); _Pragma("unroll") for (int m = 0; m < 4; ++m) _Pragma("unroll") for (int n = 0; n < 2; ++n) _Pragma("unroll") for (int k = 0; k < 2; ++k) \
        acc[ai][bj][m][n] = __builtin_amdgcn_mfma_f32_16x16x32_bf16(Bt[n][k], At[m][k], acc[ai][bj][m][n], 0, 0, 0); __builtin_amdgcn_s_setprio(0); } while (0)
#define PG8_WAIT_V(n) asm volatile("s_waitcnt vmcnt(" #n ")" ::: "memory")
#define PG8_WAIT_L(n) asm volatile("s_waitcnt lgkmcnt(" #n ")" ::: "memory")
#define PG8_BAR __builtin_amdgcn_s_barrier()
#define PG8_SCHED __builtin_amdgcn_sched_barrier(0)
    Unit cur, nxt; int ui = 0;
    if (!S.next(0, cur)) return;
    f32x4 acc[2][2][4][2];
#pragma unroll
    for (int a = 0; a < 2; ++a)
#pragma unroll
        for (int b = 0; b < 2; ++b)
#pragma unroll
            for (int m = 0; m < 4; ++m)
#pragma unroll
                for (int n = 0; n < 2; ++n) acc[a][b][m][n] = (f32x4){0.f, 0.f, 0.f, 0.f};
    bf16x8 At[4][2], B0[2][2], B1[2][2];
    const char* cA = (const char*)g.A + (size_t)cur.pm * tstep; const char* cB = (const char*)g.Bt + (size_t)cur.pn * tstep;
    S.a_ready(cur);
    PG8_STAGE(PG8_SB(0, 0), cB, voffB); PG8_STAGE(PG8_SA(0, 0), cA, voffA); PG8_STAGE(PG8_SB(0, 1), cB + hstep, voffB); PG8_STAGE(PG8_SA(0, 1), cA + hstep, voffA);
    if (wr == 1) PG8_BAR;
    PG8_WAIT_V(4); PG8_BAR;
    PG8_STAGE(PG8_SB(1, 0), cB + kstep, voffB); PG8_STAGE(PG8_SA(1, 0), cA + kstep, voffA); PG8_STAGE(PG8_SB(1, 1), cB + hstep + kstep, voffB);
    PG8_WAIT_V(6); PG8_BAR;
    for (;;) {
        const bool has_next = S.next(ui + 1, nxt);
        const char* nA = has_next ? (const char*)g.A + (size_t)nxt.pm * tstep : cA; const char* nB = has_next ? (const char*)g.Bt + (size_t)nxt.pn * tstep : cB;
        for (int t = 0; t < nt; t += 2) {
            const bool last = (t == nt - 2);
            const char* a1 = cA + (size_t)(t + 1) * kstep;
            const char* a2 = last ? nA : cA + (size_t)(t + 2) * kstep; const char* b2 = last ? nB : cB + (size_t)(t + 2) * kstep;
            const char* a3 = a2 + kstep; const char* b3 = b2 + kstep;
            if (last && has_next) S.a_ready(nxt);
            PG8_LDB(B0, 0, 0); PG8_SCHED; PG8_LDA(At, 0, 0); PG8_STAGE(PG8_SA(1, 1), a1 + hstep, voffA);
            PG8_WAIT_L(8); PG8_BAR; PG8_WAIT_L(0); PG8_MMA(0, 0, At, B0); PG8_BAR; PG8_SCHED;
            PG8_LDB(B1, 0, 1); PG8_STAGE(PG8_SB(0, 0), b2, voffB);
            PG8_BAR; PG8_WAIT_L(0); PG8_MMA(0, 1, At, B1); PG8_BAR;
            PG8_LDA(At, 0, 1); PG8_STAGE(PG8_SA(0, 0), a2, voffA);
            PG8_BAR; PG8_WAIT_L(0); PG8_MMA(1, 0, At, B0); PG8_BAR; PG8_SCHED;
            PG8_STAGE(PG8_SB(0, 1), b2 + hstep, voffB);
            PG8_WAIT_V(6); PG8_BAR; PG8_MMA(1, 1, At, B1); PG8_BAR;
            PG8_LDB(B0, 1, 0); PG8_SCHED; PG8_LDA(At, 1, 0); PG8_STAGE(PG8_SA(0, 1), a2 + hstep, voffA);
            PG8_WAIT_L(8); PG8_BAR; PG8_WAIT_L(0); PG8_MMA(0, 0, At, B0); PG8_BAR; PG8_SCHED;
            PG8_LDB(B1, 1, 1); PG8_STAGE(PG8_SB(1, 0), b3, voffB);
            PG8_BAR; PG8_WAIT_L(0); PG8_MMA(0, 1, At, B1); PG8_BAR;
            PG8_LDA(At, 1, 1); PG8_STAGE(PG8_SA(1, 0), a3, voffA);
            PG8_BAR; PG8_WAIT_L(0); PG8_MMA(1, 0, At, B0); PG8_BAR; PG8_SCHED;
            PG8_STAGE(PG8_SB(1, 1), b3 + hstep, voffB);
            PG8_WAIT_V(6); PG8_BAR; PG8_MMA(1, 1, At, B1); PG8_BAR;
        }
        if constexpr (!Epi::AFTER_DRAIN) { E(acc, cur, wr, wc, fr, fq); S.done(cur); }
        if (!has_next) break;
#pragma unroll
        for (int a = 0; a < 2; ++a)
#pragma unroll
            for (int b = 0; b < 2; ++b)
#pragma unroll
                for (int m = 0; m < 4; ++m)
#pragma unroll
                    for (int n = 0; n < 2; ++n) acc[a][b][m][n] = (f32x4){0.f, 0.f, 0.f, 0.f};
        cur = nxt; cA = nA; cB = nB; ++ui;
    }
    PG8_WAIT_V(0);
    if (wr == 0) PG8_BAR;
    PG8_BAR;
    if constexpr (Epi::AFTER_DRAIN) { E.fused(acc, cur, wr, wc, fr, fq, lds, wid, lane); S.done(cur); }
#undef PG8_SA
#undef PG8_SB
#undef PG8_STAGE
#undef PG8_LDA
#undef PG8_LDB
#undef PG8_MMA
#undef PG8_WAIT_V
#undef PG8_WAIT_L
#undef PG8_BAR
#undef PG8_SCHED
}
#endif
}

struct Params {
    const float *xp, *xs, *memp, *cckv, *ckpe, *cmk, *cmv, *sgla; const int* ptab;
    const float *g_mix, *w_a2, *b_a, *g_gla_o, *g_qa, *g_kva, *g_qn, *g_kn, *g_qr, *g_kr, *g_x, *g_mem, *g_xq, *g_xk, *g_ff;
    float *y, *o_ckvp, *o_kpep, *o_mkp, *o_mvp, *o_glap, *o_ckvs, *o_kpes, *o_glas;
    unsigned* ctl;
    bf16 *wt_in, *wt_qb, *wt_kvb, *wt_out, *wt_xq, *wt_xkv, *wt_xo, *wt_ff1, *wt_ff2;
    bf16 *H, *MEMN, *Z, *QAN, *CKVB, *KPB, *MKB, *MVB, *QF, *KV, *QN, *KN, *OMIX, *XQ, *XO, *U;
    float *MKV, *LOGA, *DS, *DDEC, *X1, *X2, *PACC, *PML, *ROPE;
    const float *w_in, *w_qb, *w_kvb, *w_out, *w_xq, *w_xk, *w_xv, *w_xo, *w_ff1, *w_ff2;
};
constexpr int CW_Q5 = 0, CW_QX = 512, CW_BAR = 4096, CW_STAMP = 8192;
#ifdef EMU
#define STAMP(i) do {} while (0)
#else
#define STAMP(i) do { if (PROBE_A >= 0 && blockIdx.x == 0 && threadIdx.x == 0) ((volatile unsigned long long*)(p.ctl + CW_STAMP))[i] = wall_clock64(); } while (0)
#endif

template <int ACT  > struct EpiStoreBf16 {
    static constexpr bool PERM = true, AFTER_DRAIN = false;
    bf16* O; int ldc;
    DI void operator()(const f32x4 (&acc)[2][2][4][2], const pg8::Unit& u, int wr, int wc, int fr, int fq) const {
        const int row0 = u.pm * 256 + wr * 64 + fr, col0 = u.pn * 256 + wc * 32 + 8 * fq;
#pragma unroll
        for (int ai = 0; ai < 2; ++ai)
#pragma unroll
            for (int m = 0; m < 4; ++m) { bf16* rowp = O + (size_t)(row0 + ai * 128 + m * 16) * ldc + col0;
#pragma unroll
                for (int bj = 0; bj < 2; ++bj) { f32x4 v0 = acc[ai][bj][m][0], v1 = acc[ai][bj][m][1];
                    if (ACT == 1) {
#pragma unroll
                        for (int j = 0; j < 4; ++j) { const float a = fmaxf(v0[j], 0.f), b = fmaxf(v1[j], 0.f); v0[j] = a * a; v1[j] = b * b; } }
                    u32x4 w; w[0] = pk2(v0[0], v0[1]); w[1] = pk2(v0[2], v0[3]); w[2] = pk2(v1[0], v1[1]); w[3] = pk2(v1[2], v1[3]);
                    *(u32x4*)(rowp + bj * 128) = w; } }
    }
};
struct EpiStoreF32 {
    static constexpr bool PERM = false, AFTER_DRAIN = false;
    float* C; const float* R; int ldc;
    DI void operator()(const f32x4 (&acc)[2][2][4][2], const pg8::Unit& u, int wr, int wc, int fr, int fq) const {
        const int row0 = u.pm * 256 + wr * 64 + fr, col0 = u.pn * 256 + wc * 32 + 4 * fq;
#pragma unroll
        for (int ai = 0; ai < 2; ++ai)
#pragma unroll
            for (int m = 0; m < 4; ++m) { const size_t off = (size_t)(row0 + ai * 128 + m * 16) * ldc + col0;
#pragma unroll
                for (int bj = 0; bj < 2; ++bj)
#pragma unroll
                    for (int n = 0; n < 2; ++n) { f32x4 v = acc[ai][bj][m][n]; if (R) v += *(const f32x4*)(R + off + bj * 128 + n * 16); *(f32x4*)(C + off + bj * 128 + n * 16) = v; } }
    }
};
template <class Epi> DI void run_gemm(LDS unsigned char* lds, const bf16* A, const bf16* Bt, int M, int N, int K, const Epi& E, int rot) {
    pg8::Gemm g{A, Bt, M, N, K}; pg8::StaticOrder S; S.init(M, N, (int)gridDim.x, (int)((blockIdx.x + rot) % gridDim.x));
    pg8::gemm_phase<Epi, pg8::StaticOrder>(lds, g, S, E);
}


struct SEpiBf16 { bf16* O; int ld; int act;
    DI void put(int row, int col, f32x4 v) const { if (act) {
#pragma unroll
            for (int j = 0; j < 4; ++j) { const float a = fmaxf(v[j], 0.f); v[j] = a * a; } }
        u32x2 w; w[0] = pk2(v[0], v[1]); w[1] = pk2(v[2], v[3]); *(u32x2*)(O + (size_t)row * ld + col) = w; } };
struct SEpiRes { float* C; const float* R;
    DI void put(int row, int col, f32x4 v) const { *(f32x4*)(C + (size_t)row * DM + col) = v + *(const f32x4*)(R + (size_t)row * DM + col); } };
template <class SE> DI void small_gemm(LDS unsigned char* lds, const bf16* A, const bf16* Bt, int N, int K, const SE& E, int rot) {
    const int tid = tid_opaque(), wid = __builtin_amdgcn_readfirstlane(tid >> 6), lane = tid & 63, r = lane & 31, hh = lane >> 5;
    const int nN = N / 64, nunits = (TS / 64) * nN, kw = K / 8, nks = kw / 16;
    LDS float* RED = (LDS float*)lds;
    for (int u = (int)((blockIdx.x + rot) % gridDim.x); u < nunits; u += gridDim.x) {
        const int um = u / nN, un = u % nN;
        const bf16* ap = A + (size_t)(TP + um * 64 + r) * K + wid * kw + 8 * hh;
        const bf16* bp = Bt + (size_t)(un * 64 + r) * K + wid * kw + 8 * hh;
        f32x16 acc[2][2];
#pragma unroll
        for (int i = 0; i < 2; ++i)
#pragma unroll
            for (int j = 0; j < 2; ++j) acc[i][j] = zero16();
        for (int k0 = 0; k0 < nks; k0 += 4) {
            bf16x8 af[4][2], bfr[4][2];
#pragma unroll
            for (int q = 0; q < 4; ++q) if (k0 + q < nks) {
#pragma unroll
                for (int t = 0; t < 2; ++t) { af[q][t] = ld8g(ap + (size_t)t * 32 * K + 16 * (k0 + q)); bfr[q][t] = ld8g(bp + (size_t)t * 32 * K + 16 * (k0 + q)); } }
#pragma unroll
            for (int q = 0; q < 4; ++q) if (k0 + q < nks) {
#pragma unroll
                for (int mt = 0; mt < 2; ++mt)
#pragma unroll
                    for (int nt = 0; nt < 2; ++nt) acc[mt][nt] = mfma32(bfr[q][nt], af[q][mt], acc[mt][nt]); }
        }
#pragma unroll
        for (int mt = 0; mt < 2; ++mt)
#pragma unroll
            for (int nt = 0; nt < 2; ++nt)
#pragma unroll
                for (int g = 0; g < 4; ++g) *(LDS f32x4*)(RED + wid * 4096 + (32 * mt + r) * 64 + 32 * nt + 8 * g + 4 * hh) = (f32x4){acc[mt][nt][4 * g], acc[mt][nt][4 * g + 1], acc[mt][nt][4 * g + 2], acc[mt][nt][4 * g + 3]};
        __syncthreads();
#pragma unroll
        for (int j = 0; j < 2; ++j) { const int gidx = tid + NTHREADS * j, row = gidx >> 4, c4 = (gidx & 15) * 4; f32x4 s = *(const LDS f32x4*)(RED + row * 64 + c4);
#pragma unroll
            for (int w = 1; w < 8; ++w) s += *(const LDS f32x4*)(RED + w * 4096 + row * 64 + c4);
            E.put(TP + um * 64 + row, un * 64 + c4, s); }
        __syncthreads();
    }
}

DI const float* xrow(const Params& p, int t) { return t < TP ? p.xp + (size_t)t * DM : p.xs + (size_t)(t - TP) * DM; }
DI void rmsnorm_row_1024(const float* src, const float* g, bf16* dst, int lane) {
    f32x4 v[4]; float ss = 0.f;
#pragma unroll
    for (int i = 0; i < 4; ++i) { v[i] = *(const f32x4*)(src + 4 * (lane + 64 * i)); ss += v[i][0] * v[i][0] + v[i][1] * v[i][1] + v[i][2] * v[i][2] + v[i][3] * v[i][3]; }
    ss = wsum(ss); const float rs = rsqrtf(ss * (1.0f / 1024.0f) + EPS);
#pragma unroll
    for (int i = 0; i < 4; ++i) { const f32x4 gg = *(const f32x4*)(g + 4 * (lane + 64 * i)); u32x2 w; w[0] = pk2(v[i][0] * rs * gg[0], v[i][1] * rs * gg[1]); w[1] = pk2(v[i][2] * rs * gg[2], v[i][3] * rs * gg[3]);
        *(u32x2*)(dst + 4 * (lane + 64 * i)) = w; }
}
template <int NR> DI void rmsnorm_rows(const float* src, const float* g, bf16* dst, int row0, int rstride, int nrows, int lane) {
    f32x4 v[NR][4]; f32x4 gg[4];
#pragma unroll
    for (int j = 0; j < NR; ++j) { const int row = row0 + j * rstride;
#pragma unroll
        for (int i = 0; i < 4; ++i) v[j][i] = row < nrows ? *(const f32x4*)(src + (size_t)row * DM + 4 * (lane + 64 * i)) : (f32x4){0.f, 0.f, 0.f, 0.f}; }
#pragma unroll
    for (int i = 0; i < 4; ++i) gg[i] = *(const f32x4*)(g + 4 * (lane + 64 * i));
    float ss[NR];
#pragma unroll
    for (int j = 0; j < NR; ++j) { ss[j] = 0.f;
#pragma unroll
        for (int i = 0; i < 4; ++i) ss[j] += v[j][i][0] * v[j][i][0] + v[j][i][1] * v[j][i][1] + v[j][i][2] * v[j][i][2] + v[j][i][3] * v[j][i][3]; }
#pragma unroll
    for (int o = 32; o >= 1; o >>= 1) {
#pragma unroll
        for (int j = 0; j < NR; ++j) ss[j] += __shfl_xor(ss[j], o); }
#pragma unroll
    for (int j = 0; j < NR; ++j) { const int row = row0 + j * rstride; if (row < nrows) { const float rs = rsqrtf(ss[j] * (1.0f / 1024.0f) + EPS);
#pragma unroll
            for (int i = 0; i < 4; ++i) { u32x2 w; w[0] = pk2(v[j][i][0] * rs * gg[i][0], v[j][i][1] * rs * gg[i][1]); w[1] = pk2(v[j][i][2] * rs * gg[i][2], v[j][i][3] * rs * gg[i][3]);
                *(u32x2*)(dst + (size_t)row * DM + 4 * (lane + 64 * i)) = w; } } }
}
template <int K, int N, int NPAD> DI void prep_job(const float* W, bf16* Wt, LDS float* tl, int rot) {
    const int tid = tid_opaque(); constexpr int nkt = K / 64, ntiles = (NPAD / 64) * nkt;
    for (int tile = (int)((blockIdx.x + rot) % gridDim.x); tile < ntiles; tile += gridDim.x) {
        const int tn = tile / nkt, tk = tile % nkt;
        { const int kk = tid >> 3, n8 = (tid & 7) * 8; const int n = tn * 64 + n8; const float* s = W + (size_t)(tk * 64 + kk) * N + n;
            f32x4 a = {0.f, 0.f, 0.f, 0.f}, b = a; if (n < N) { a = *(const f32x4*)s; b = *(const f32x4*)(s + 4); }
#pragma unroll
            for (int q = 0; q < 4; ++q) { tl[kk * 65 + n8 + q] = a[q]; tl[kk * 65 + n8 + 4 + q] = b[q]; } }
        __syncthreads();
        { const int nn = tid >> 3, k8 = (tid & 7) * 8; u32x4 w;
#pragma unroll
            for (int q = 0; q < 4; ++q) w[q] = pk2(tl[(k8 + 2 * q) * 65 + nn], tl[(k8 + 2 * q + 1) * 65 + nn]);
            *(u32x4*)(Wt + (size_t)(tn * 64 + nn) * K + tk * 64 + k8) = w; }
        __syncthreads();
    }
}
DI void phase_prep(const Params& p, LDS unsigned char* lds) {
    const int tid = tid_opaque(), wid = __builtin_amdgcn_readfirstlane(tid >> 6), lane = tid & 63;
    LDS float* tl = (LDS float*)lds;
    prep_job<DM, DIN, DINP>(p.w_in, p.wt_in, tl, 0); prep_job<384, 768, 768>(p.w_qb, p.wt_qb, tl, 64); prep_job<256, 1024, 1024>(p.w_kvb, p.wt_kvb, tl, 136); prep_job<DM, DM, DM>(p.w_out, p.wt_out, tl, 200);
    prep_job<DM, 512, 512>(p.w_xq, p.wt_xq, tl, 0); prep_job<DM, 512, 512>(p.w_xk, p.wt_xkv, tl, 128); prep_job<DM, 512, 512>(p.w_xv, p.wt_xkv + (size_t)512 * DM, tl, 0); prep_job<512, DM, DM>(p.w_xo, p.wt_xo, tl, 128);
    prep_job<DM, DFF, DFF>(p.w_ff1, p.wt_ff1, tl, 0); prep_job<DFF, DM, DM>(p.w_ff2, p.wt_ff2, tl, 0);
    for (int e = blockIdx.x * NTHREADS + tid; e < (SEQ + DECS) * 16; e += gridDim.x * NTHREADS) { const int pi = e >> 4, i = e & 15; const int pos = pi < SEQ ? pi : PAST + (pi - SEQ);
        const float ang = (float)pos * expf(-(float)i * (9.210340371976184f / 16.0f)); p.ROPE[2 * e] = cosf(ang); p.ROPE[2 * e + 1] = sinf(ang); }
    { const int ws = gridDim.x * 8, w0 = blockIdx.x * 8 + wid;
        for (int row = w0; row < TP; row += 4 * ws) rmsnorm_rows<4>(p.xp, p.g_mix, p.H, row, ws, TP, lane);
        for (int row = w0; row < TS; row += 4 * ws) rmsnorm_rows<4>(p.xs, p.g_mix, p.H + (size_t)TP * DM, row, ws, TS, lane);
        for (int row = w0; row < MROWS; row += 4 * ws) rmsnorm_rows<4>(p.memp, p.g_mem, p.MEMN, row, ws, MROWS, lane); }
}

DI float rope32(const float* ROPE, float xn, int lane, int pidx) {
    const float partner = __shfl_xor(xn, 16);
    const float c = ROPE[(pidx * 16 + (lane & 15)) * 2], s = ROPE[(pidx * 16 + (lane & 15)) * 2 + 1];
    return (lane & 16) ? xn * c + partner * s : xn * c - partner * s;
}
DI int row_pidx(int t) { return t < TP ? (t % SEQ) : SEQ + ((t - TP) % DECS); }

DI void phase_post_in(const Params& p) {
    const int tid = tid_opaque(), wid = __builtin_amdgcn_readfirstlane(tid >> 6), lane = tid & 63;
    f32x4 w2[16];
#pragma unroll
    for (int i = 0; i < 16; ++i) w2[i] = *(const f32x4*)(p.w_a2 + i * 256 + 4 * lane);
    const f32x4 b2 = *(const f32x4*)(p.b_a + 4 * lane);
    for (int row = blockIdx.x * 8 + wid; row < T + MROWS; row += gridDim.x * 8) {
        if (row < T) {
            const int t = row; const bf16* z = p.Z + (size_t)t * DINP;
            const bf16x8 a0 = ld8g(z + ZA), a1 = ld8g(z + ZA + 8);
            bf16x8 cq = zero8(), ck = zero8(); if (lane < 48) cq = ld8g(z + ZQA + 8 * lane); if (lane < 32) ck = ld8g(z + ZKVA + 8 * lane);
            const float vp = lane < 32 ? bf2f(z[ZKPE + lane]) : 0.f;
            { f32x4 gp = b2;
#pragma unroll
                for (int i = 0; i < 8; ++i) { gp += bf2f((bf16)a0[i]) * w2[i]; gp += bf2f((bf16)a1[i]) * w2[8 + i]; }
                f32x4 la;
#pragma unroll
                for (int j = 0; j < 4; ++j) { const float x = gp[j]; la[j] = (fminf(x, 0.f) - 0.6931471805599453f * flog2(1.0f + fexp(-fabsf(x)))) * (1.0f / 16.0f); }
                *(f32x4*)(p.LOGA + (size_t)t * 256 + 4 * lane) = la; }
            float fq[8], fk[8]; float sq = 0.f, sk = 0.f;
#pragma unroll
            for (int j = 0; j < 8; ++j) { fq[j] = bf2f((bf16)cq[j]); fk[j] = bf2f((bf16)ck[j]); sq += fq[j] * fq[j]; sk += fk[j] * fk[j]; }
            float sp = vp * vp;
#pragma unroll
            for (int o = 32; o >= 1; o >>= 1) { sq += __shfl_xor(sq, o); sk += __shfl_xor(sk, o); sp += __shfl_xor(sp, o); }
            const float rq = rsqrtf(sq * (1.0f / 384.0f) + EPS), rk = rsqrtf(sk * (1.0f / 256.0f) + EPS), rp = rsqrtf(sp * (1.0f / 32.0f) + EPS);
            if (lane < 48) { const f32x4 g0 = *(const f32x4*)(p.g_qa + 8 * lane), g1 = *(const f32x4*)(p.g_qa + 8 * lane + 4);
                *(bf16x8*)(p.QAN + (size_t)t * 384 + 8 * lane) = pack8(fq[0] * rq * g0[0], fq[1] * rq * g0[1], fq[2] * rq * g0[2], fq[3] * rq * g0[3], fq[4] * rq * g1[0], fq[5] * rq * g1[1], fq[6] * rq * g1[2], fq[7] * rq * g1[3]); }
            if (lane < 32) { const f32x4 g0 = *(const f32x4*)(p.g_kva + 8 * lane), g1 = *(const f32x4*)(p.g_kva + 8 * lane + 4);
                const f32x4 c0 = {fk[0] * rk * g0[0], fk[1] * rk * g0[1], fk[2] * rk * g0[2], fk[3] * rk * g0[3]}, c1 = {fk[4] * rk * g1[0], fk[5] * rk * g1[1], fk[6] * rk * g1[2], fk[7] * rk * g1[3]};
                float* oc = t < TP ? p.o_ckvp + (size_t)t * 256 : p.o_ckvs + (size_t)(t - TP) * 256;
                *(f32x4*)(oc + 8 * lane) = c0; *(f32x4*)(oc + 8 * lane + 4) = c1;
                *(bf16x8*)(p.CKVB + (size_t)t * 256 + 8 * lane) = pack8(c0[0], c0[1], c0[2], c0[3], c1[0], c1[1], c1[2], c1[3]); }
            { const float xn = vp * rp * p.g_kr[lane & 31]; const float o = rope32(p.ROPE, xn, lane, row_pidx(t));
                if (lane < 32) { float* ok = t < TP ? p.o_kpep + (size_t)t * 32 : p.o_kpes + (size_t)(t - TP) * 32; ok[lane] = o; p.KPB[(size_t)t * 32 + lane] = f2bf(o); } }
        } else {
            const int r = row - T; const float* s = p.MKV + (size_t)r * 1024;
            const f32x4 k0 = *(const f32x4*)(s + lane * 8), k1 = *(const f32x4*)(s + lane * 8 + 4), v0 = *(const f32x4*)(s + 512 + lane * 8), v1 = *(const f32x4*)(s + 512 + lane * 8 + 4);
            float ss = k0[0] * k0[0] + k0[1] * k0[1] + k0[2] * k0[2] + k0[3] * k0[3] + k1[0] * k1[0] + k1[1] * k1[1] + k1[2] * k1[2] + k1[3] * k1[3];
            ss += __shfl_xor(ss, 1); ss += __shfl_xor(ss, 2); ss += __shfl_xor(ss, 4); ss += __shfl_xor(ss, 8);
            const float rs = rsqrtf(ss * (1.0f / 128.0f) + EPS); const int c = (lane * 8) & 127;
            const f32x4 g0 = *(const f32x4*)(p.g_xk + c), g1 = *(const f32x4*)(p.g_xk + c + 4);
            const f32x4 m0 = {k0[0] * rs * g0[0], k0[1] * rs * g0[1], k0[2] * rs * g0[2], k0[3] * rs * g0[3]}, m1 = {k1[0] * rs * g1[0], k1[1] * rs * g1[1], k1[2] * rs * g1[2], k1[3] * rs * g1[3]};
            *(f32x4*)(p.o_mkp + (size_t)r * 512 + lane * 8) = m0; *(f32x4*)(p.o_mkp + (size_t)r * 512 + lane * 8 + 4) = m1;
            *(bf16x8*)(p.MKB + (size_t)r * 512 + lane * 8) = pack8(m0[0], m0[1], m0[2], m0[3], m1[0], m1[1], m1[2], m1[3]);
            *(f32x4*)(p.o_mvp + (size_t)r * 512 + lane * 8) = v0; *(f32x4*)(p.o_mvp + (size_t)r * 512 + lane * 8 + 4) = v1;
            *(bf16x8*)(p.MVB + (size_t)r * 512 + lane * 8) = pack8(v0[0], v0[1], v0[2], v0[3], v1[0], v1[1], v1[2], v1[3]);
        }
    }
}

DI void phase_post_qkv(const Params& p) {
    const int tid = tid_opaque(), wid = __builtin_amdgcn_readfirstlane(tid >> 6), lane = tid & 63;
    for (int t = TP + blockIdx.x * 8 + wid; t < T; t += gridDim.x * 8) {
        const bf16* qf = p.QF + (size_t)t * 768; const int pos = row_pidx(t);
        for (int h = 0; h < 8; ++h) {
            const float v = bf2f(qf[h * 96 + lane]); const float ss = wsum(v * v); const float rs = rsqrtf(ss * (1.0f / 64.0f) + EPS);
            p.QN[((size_t)t * 8 + h) * 96 + lane] = f2bf(v * rs * p.g_qn[lane] * MLA_SCALE);
            const float vr = lane < 32 ? bf2f(qf[h * 96 + 64 + lane]) : 0.f; const float ssr = wsum(vr * vr); const float rsr = rsqrtf(ssr * (1.0f / 32.0f) + EPS);
            const float xr = vr * rsr * p.g_qr[lane & 31]; const float o = rope32(p.ROPE, xr, lane, pos);
            if (lane < 32) p.QN[((size_t)t * 8 + h) * 96 + 64 + lane] = f2bf(o * MLA_SCALE);
        }
    }
}
struct GlaUnit { int t0, h, nv; };
DI GlaUnit gla_unit(int u) { GlaUnit g; if (u < NGP) { const int b = u / (4 * NC), h = (u / NC) % 4, c = u % NC; g.t0 = b * SEQ + c * 64; g.h = h; g.nv = 64; } else { const int us = u - NGP; g.t0 = TP + (us >> 2) * DECS; g.h = us & 3; g.nv = DECS; } return g; }
constexpr int GL_QK = 0, GL_V = 16384, GL_S = 32768, GL_TOT = 49152, GL_SS = GL_TOT + 2048, GL_END = GL_SS + 1024;
static_assert(GL_END <= LDS_CTL, "GLA LDS map");
struct GlaIn { float la[8]; bf16 q[8], k[8]; bf16x8 v[2]; f32x4 s[4]; s16x4 rg[4]; };
template <bool PHASE_C> DI void gla_load(const Params& p, int u, int tid, GlaIn& in) {
    const GlaUnit g = gla_unit(u); const int c = tid & 63, sb = tid >> 6;
#pragma unroll
    for (int i = 0; i < 8; ++i) { const int s = 8 * sb + i; const bool ok = s < g.nv; const bf16* z = p.Z + (size_t)(g.t0 + (ok ? s : 0)) * DINP;
        in.la[i] = ok ? p.LOGA[(size_t)(g.t0 + s) * 256 + g.h * 64 + c] : 0.f; in.k[i] = ok ? z[ZK + g.h * 64 + c] : (bf16)0; if (PHASE_C) in.q[i] = ok ? z[ZQ + g.h * 64 + c] : (bf16)0; }
#pragma unroll
    for (int j = 0; j < 2; ++j) { const int cidx = tid + NTHREADS * j, s = cidx >> 4, ch = cidx & 15; in.v[j] = zero8(); if (s < g.nv) in.v[j] = ld8g(p.Z + (size_t)(g.t0 + s) * DINP + ZV + g.h * 128 + ch * 8); }
    if (PHASE_C) { const float* sp = u < NGP ? p.DS + (size_t)u * 8192 : p.sgla + (size_t)(u - NGP) * 8192;
#pragma unroll
        for (int j = 0; j < 2; ++j) { const int cidx = tid + NTHREADS * j, kd = cidx >> 4, ch = cidx & 15; in.s[2 * j] = *(const f32x4*)(sp + kd * 128 + ch * 8); in.s[2 * j + 1] = *(const f32x4*)(sp + kd * 128 + ch * 8 + 4); }
        const int wid = tid >> 6, lane = tid & 63, r = lane & 31, hh = lane >> 5, dvt = wid & 3, tt = wid >> 2, t = 32 * tt + r; const bool ok = t < g.nv;
        const bf16* z = p.Z + (size_t)(g.t0 + (ok ? t : 0)) * DINP + ZR + g.h * 128 + 32 * dvt + 4 * hh;
#pragma unroll
        for (int q = 0; q < 4; ++q) in.rg[q] = *(const s16x4*)(z + 8 * q); }
}
DI float gla_scan(LDS unsigned char* lds, int c, int sb, const float (&la)[8], float (&b)[8]) {
    LDS float* TOT = (LDS float*)(lds + GL_TOT); float a = 0.f;
#pragma unroll
    for (int i = 0; i < 8; ++i) { a += la[i]; b[i] = a; }
    TOT[sb * 64 + c] = a;
    __syncthreads();
    float pre = 0.f, tot = 0.f;
#pragma unroll
    for (int q = 0; q < 8; ++q) { const float v = TOT[q * 64 + c]; tot += v; if (q < sb) pre += v; }
#pragma unroll
    for (int i = 0; i < 8; ++i) b[i] += pre;
    return tot;
}
DI void gla_put(LDS unsigned char* img, int row, int col, float v) { *(LDS bf16*)(img + imgb(row, col >> 3) + 2 * (col & 7)) = f2bf(v); }
DI unsigned tr_lane_off_nat(unsigned lane, unsigned c, unsigned plus4) {
    const unsigned hh = lane >> 5, blk = (lane >> 4) & 1, q = (lane & 15) >> 2, pp = lane & 3;
    return imgb(8 * hh + q + 4 * plus4, 4 * c + 2 * blk + (pp >> 1)) + 8 * (pp & 1);
}
DI void phase_gla_a(const Params& p, LDS unsigned char* lds) {
    const int tid = tid_opaque(), wid = __builtin_amdgcn_readfirstlane(tid >> 6), lane = tid & 63, r = lane & 31, hh = lane >> 5;
    const int c = tid & 63, sb = tid >> 6, mt = wid & 1, nt = wid >> 1;
    const LDS unsigned char* pa0 = lds + GL_QK + tr_lane_off_nat(lane, mt, 0); const LDS unsigned char* pa1 = lds + GL_QK + tr_lane_off_nat(lane, mt, 1);
    const LDS unsigned char* pb0 = lds + GL_V + tr_lane_off_nat(lane, nt, 0); const LDS unsigned char* pb1 = lds + GL_V + tr_lane_off_nat(lane, nt, 1);
    GlaIn nx; int u = blockIdx.x;
    if (u < NGU) gla_load<false>(p, u, tid, nx);
    for (; u < NGU; u += gridDim.x) {
        GlaIn in = nx; const int un = u + gridDim.x; if (un < NGU) gla_load<false>(p, un, tid, nx);
        float b[8]; const float bl = gla_scan(lds, c, sb, in.la, b);
#pragma unroll
        for (int i = 0; i < 8; ++i) gla_put(lds + GL_QK, 8 * sb + i, c, bf2f(in.k[i]) * fexp(bl - b[i]));
#pragma unroll
        for (int j = 0; j < 2; ++j) { const int cidx = tid + NTHREADS * j; *(LDS bf16x8*)(lds + GL_V + imgb(cidx >> 4, cidx & 15)) = in.v[j]; }
        if (tid < 64) p.DDEC[(size_t)u * 64 + tid] = fexp(bl);
        __syncthreads();
        { f32x16 acc = zero16(); bf16x8 a0, b0, a1, b1;
            img_tr4p_pre<0, 16>(pa0, pa1, pb0, pb1, a0, b0, a1, b1); acc = mfma32(a0, b0, acc); acc = mfma32(a1, b1, acc);
            img_tr4p_pre<32, 48>(pa0, pa1, pb0, pb1, a0, b0, a1, b1); acc = mfma32(a0, b0, acc); acc = mfma32(a1, b1, acc);
            float* d = p.DS + (size_t)u * 8192;
#pragma unroll
            for (int i = 0; i < 16; ++i) d[(32 * mt + crow(i, hh)) * 128 + 32 * nt + r] = acc[i]; }
        __syncthreads();
    }
}
DI void phase_gla_b(const Params& p) {
    const int gid = blockIdx.x * NTHREADS + tid_opaque(), gsz = gridDim.x * NTHREADS;
    for (int e4 = gid; e4 < BATCH * 4 * 2048; e4 += gsz) { const int bh = e4 >> 11, idx = (e4 & 2047) * 4, kd = idx >> 7; f32x4 S = {0.f, 0.f, 0.f, 0.f};
#pragma unroll 8
        for (int c = 0; c < NC; ++c) { const size_t u = (size_t)bh * NC + c; float* dp = p.DS + u * 8192 + idx; const f32x4 d = *(const f32x4*)dp; *(f32x4*)dp = S; S = S * p.DDEC[u * 64 + kd] + d; }
        *(f32x4*)(p.o_glap + (size_t)bh * 8192 + idx) = S; }
    for (int e4 = gid; e4 < DECB * 4 * 2048; e4 += gsz) { const int bh = e4 >> 11, idx = (e4 & 2047) * 4, kd = idx >> 7; const size_t u = (size_t)NGP + bh;
        *(f32x4*)(p.o_glas + (size_t)bh * 8192 + idx) = *(const f32x4*)(p.sgla + (size_t)bh * 8192 + idx) * p.DDEC[u * 64 + kd] + *(const f32x4*)(p.DS + u * 8192 + idx); }
}
DI void phase_gla_c(const Params& p, LDS unsigned char* lds) {
    const int tid = tid_opaque(), wid = __builtin_amdgcn_readfirstlane(tid >> 6), lane = tid & 63, r = lane & 31, hh = lane >> 5;
    const int c = tid & 63, sb = tid >> 6, dvt = wid & 3, tt = wid >> 2;
    const LDS unsigned char* ps0 = lds + GL_S + tr_lane_off_nat(lane, dvt, 0); const LDS unsigned char* ps1 = lds + GL_S + tr_lane_off_nat(lane, dvt, 1);
    const LDS unsigned char* pv0 = lds + GL_V + tr_lane_off(lane, dvt, 0); const LDS unsigned char* pv1 = lds + GL_V + tr_lane_off(lane, dvt, 1);
    unsigned xo[8];
#pragma unroll
    for (int ks = 0; ks < 8; ++ks) xo[ks] = imgb(r, 2 * ks + hh);
    GlaIn nx; int u = blockIdx.x;
    if (u < NGU) gla_load<true>(p, u, tid, nx);
    for (; u < NGU; u += gridDim.x) {
        GlaIn in = nx; const int un = u + gridDim.x; if (un < NGU) gla_load<true>(p, un, tid, nx);
        const GlaUnit g = gla_unit(u);
        { float b[8]; gla_scan(lds, c, sb, in.la, b);
#pragma unroll
            for (int i = 0; i < 8; ++i) { gla_put(lds + GL_QK, 8 * sb + i, c, bf2f(in.q[i]) * fexp(b[i]) * 0.125f); gla_put(lds + GL_QK, 8 * sb + i, 64 + c, bf2f(in.k[i]) * fexp(-b[i])); } }
#pragma unroll
        for (int j = 0; j < 2; ++j) { const int cidx = tid + NTHREADS * j; *(LDS bf16x8*)(lds + GL_V + imgb(cidx >> 4, cidx & 15)) = in.v[j];
            *(LDS bf16x8*)(lds + GL_S + imgb(cidx >> 4, cidx & 15)) = pack8(in.s[2 * j][0], in.s[2 * j][1], in.s[2 * j][2], in.s[2 * j][3], in.s[2 * j + 1][0], in.s[2 * j + 1][1], in.s[2 * j + 1][2], in.s[2 * j + 1][3]); }
        __syncthreads();
        const LDS unsigned char* qk = lds + GL_QK + 8192 * tt;
#define GL_Q(ks) (*(const LDS bf16x8*)(qk + xo[ks]))
        f32x16 o = zero16();
        { bf16x8 a0, a1, a2, a3; img_tr4p_pre<0, 16>(ps0, ps1, ps0 + 256 * 32, ps1 + 256 * 32, a0, a2, a1, a3);
            o = mfma32(a0, GL_Q(0), o); o = mfma32(a1, GL_Q(1), o); o = mfma32(a2, GL_Q(2), o); o = mfma32(a3, GL_Q(3), o); }
#pragma unroll
        for (int st = 0; st < 2; ++st) if (st <= tt) {
            const LDS unsigned char* kk = lds + GL_QK + 8192 * st;
            f32x16 x = zero16();
#pragma unroll
            for (int ks = 0; ks < 4; ++ks) x = mfma32(*(const LDS bf16x8*)(kk + xo[4 + ks]), GL_Q(ks), x);
            if (st == tt) {
#pragma unroll
                for (int i = 0; i < 16; ++i) if (crow(i, hh) > r) x[i] = 0.f; }
            bf16x8 v0, v1, d0, d1;
            if (st == 0) img_tr4p_pre<0, 16>(pv0, pv1, pv0, pv1, v0, d0, v1, d1); else img_tr4p_pre<32, 48>(pv0, pv1, pv0, pv1, v0, d0, v1, d1);
            o = mfma32(v0, PACK(x, 0), o); o = mfma32(v1, PACK(x, 1), o);
        }
#undef GL_Q
        LDS float* SS = (LDS float*)(lds + GL_SS); float ss = 0.f;
#pragma unroll
        for (int i = 0; i < 16; ++i) ss += o[i] * o[i];
        ss = xsum32(ss); if (hh == 0) SS[dvt * 64 + 32 * tt + r] = ss;
        __syncthreads();
        const int t = 32 * tt + r;
        if (t < g.nv) { const float rs = rsqrtf((SS[t] + SS[64 + t] + SS[128 + t] + SS[192 + t]) * (1.0f / 128.0f) + EPS);
            bf16* op = p.OMIX + (size_t)(g.t0 + t) * DM + g.h * 128 + 32 * dvt + 4 * hh; const float* gg = p.g_gla_o + 32 * dvt + 4 * hh;
#pragma unroll
            for (int q = 0; q < 4; ++q) { const f32x4 g4 = *(const f32x4*)(gg + 8 * q); float w[4];
#pragma unroll
                for (int j = 0; j < 4; ++j) { const float rr = bf2f((bf16)in.rg[q][j]); w[j] = o[4 * q + j] * rs * g4[j] * (rr / (1.0f + fexp(-rr))); }
                u32x2 pk; pk[0] = pk2(w[0], w[1]); pk[1] = pk2(w[2], w[3]); *(u32x2*)(op + 8 * q) = pk; } }
        __syncthreads();
    }
}
constexpr int PA_IMG = 0, PA_KP = 2 * 32768, PA_END = PA_KP + 2 * 128 * 40 * 2;
static_assert(PA_END <= LDS_CTL, "prompt attention LDS map");
DI void pattn_stage_load(const Params& p, size_t kr0, int h, int tid, bf16x8 (&kv)[4], bf16x8& kp) {
#pragma unroll
    for (int j = 0; j < 4; ++j) { const int c = tid + NTHREADS * j, key = c >> 4, ch = c & 15; kv[j] = ld8g(p.KV + (kr0 + key) * 1024 + h * 128 + ch * 8); }
    kp = ld8g(p.KPB + (kr0 + (tid >> 2)) * 32 + (tid & 3) * 8);
}
DI void pattn_stage_store(const Params& p, LDS unsigned char* img, LDS bf16* kpl, int tid, const bf16x8 (&kv)[4], const bf16x8& kp) {
    const int ch = tid & 15;
    f32x4 g0 = {1.f, 1.f, 1.f, 1.f}, g1 = g0; if (ch < 8) { g0 = *(const f32x4*)(p.g_kn + ch * 8); g1 = *(const f32x4*)(p.g_kn + ch * 8 + 4); }
#pragma unroll
    for (int j = 0; j < 4; ++j) { const int key = (tid + NTHREADS * j) >> 4; float f[8]; float ss = 0.f;
#pragma unroll
        for (int q = 0; q < 8; ++q) { f[q] = bf2f((bf16)kv[j][q]); ss += f[q] * f[q]; }
        ss += __shfl_xor(ss, 1); ss += __shfl_xor(ss, 2); ss += __shfl_xor(ss, 4);
        const float rs = ch < 8 ? rsqrtf(ss * (1.0f / 64.0f) + EPS) : 1.0f;
        *(LDS bf16x8*)(img + imgb(key, ch)) = pack8(f[0] * rs * g0[0], f[1] * rs * g0[1], f[2] * rs * g0[2], f[3] * rs * g0[3], f[4] * rs * g1[0], f[5] * rs * g1[1], f[6] * rs * g1[2], f[7] * rs * g1[3]); }
    *(LDS bf16x8*)(kpl + (tid >> 2) * 40 + (tid & 3) * 8) = kp;
}
DI void pattn_unit(const Params& p, LDS unsigned char* lds, int u) {
    const int tid = tid_opaque(), wid = __builtin_amdgcn_readfirstlane(tid >> 6), lane = tid & 63, r = lane & 31, hh = lane >> 5;
    const int qb = NQB - 1 - u / (BATCH * 8), bh = u % (BATCH * 8), b = bh >> 3, h = bh & 7;
    const int qw0 = qb * 256 + 32 * wid, qpos = qw0 + r; const size_t trow = (size_t)b * SEQ + qpos;
    bf16x8 kvr[4], kpr;
    pattn_stage_load(p, (size_t)b * SEQ, h, tid, kvr, kpr);
    bf16x8 qf[6]; float mshift;
    { float ss = 0.f, sr = 0.f; float f[6][8];
#pragma unroll
        for (int ks = 0; ks < 6; ++ks) { const bf16x8 raw = ld8g(p.QF + trow * 768 + h * 96 + 16 * ks + 8 * hh);
#pragma unroll
            for (int j = 0; j < 8; ++j) { f[ks][j] = bf2f((bf16)raw[j]); if (ks < 4) ss += f[ks][j] * f[ks][j]; else sr += f[ks][j] * f[ks][j]; } }
        ss += __shfl_xor(ss, 32); sr += __shfl_xor(sr, 32);
        const float rs = rsqrtf(ss * (1.0f / 64.0f) + EPS) * (MLA_SCALE * 1.4426950408889634f), rr = rsqrtf(sr * (1.0f / 32.0f) + EPS) * (MLA_SCALE * 1.4426950408889634f);
#pragma unroll
        for (int ks = 0; ks < 4; ++ks) { const f32x4 g0 = *(const f32x4*)(p.g_qn + 16 * ks + 8 * hh), g1 = *(const f32x4*)(p.g_qn + 16 * ks + 8 * hh + 4);
            qf[ks] = pack8(f[ks][0] * rs * g0[0], f[ks][1] * rs * g0[1], f[ks][2] * rs * g0[2], f[ks][3] * rs * g0[3], f[ks][4] * rs * g1[0], f[ks][5] * rs * g1[1], f[ks][6] * rs * g1[2], f[ks][7] * rs * g1[3]); }
        float o1[8], o2[8];
#pragma unroll
        for (int j = 0; j < 8; ++j) { const int i = 8 * hh + j; const float x1 = f[4][j] * rr * p.g_qr[i], x2 = f[5][j] * rr * p.g_qr[16 + i];
            const float c = p.ROPE[(qpos * 16 + i) * 2], s = p.ROPE[(qpos * 16 + i) * 2 + 1];
            o1[j] = x1 * c - x2 * s; o2[j] = x2 * c + x1 * s; }
        qf[4] = pack8(o1[0], o1[1], o1[2], o1[3], o1[4], o1[5], o1[6], o1[7]); qf[5] = pack8(o2[0], o2[1], o2[2], o2[3], o2[4], o2[5], o2[6], o2[7]);
        float n2 = 0.f, r2 = 0.f;
#pragma unroll
        for (int ks = 0; ks < 4; ++ks)
#pragma unroll
            for (int j = 0; j < 8; ++j) { const float v = bf2f((bf16)qf[ks][j]); n2 += v * v; }
#pragma unroll
        for (int ks = 4; ks < 6; ++ks)
#pragma unroll
            for (int j = 0; j < 8; ++j) { const float v = bf2f((bf16)qf[ks][j]); r2 += v * v; }
        n2 = xsum32(n2); r2 = xsum32(r2);
        float gkn = 0.f, gkr = 0.f;
        for (int i = 0; i < 64; ++i) gkn = fmaxf(gkn, fabsf(p.g_kn[i]));
        for (int i = 0; i < 32; ++i) gkr = fmaxf(gkr, fabsf(p.g_kr[i]));
        mshift = 1.02f * (sqrtf(n2) * 8.0f * gkn + sqrtf(r2) * 5.656854249f * gkr) + 0.01f; }
    f32x16 o0 = zero16(), o1 = zero16(); float l = 0.f;
    const int nkt = 2 * (qb + 1);
    unsigned xo[4];
#pragma unroll
    for (int ks = 0; ks < 4; ++ks) xo[ks] = imgb(r, 2 * ks + hh);
    const unsigned t0o = tr_lane_off(lane, 2, 0), t1o = tr_lane_off(lane, 2, 1), t2o = tr_lane_off(lane, 3, 0), t3o = tr_lane_off(lane, 3, 1);
    pattn_stage_store(p, lds + PA_IMG, (LDS bf16*)(lds + PA_KP), tid, kvr, kpr);
    __syncthreads();
    for (int kt = 0; kt < nkt; ++kt) {
        const int k0 = kt * 128; LDS unsigned char* img = lds + PA_IMG + (kt & 1) * 32768; const LDS bf16* kpl = (const LDS bf16*)(lds + PA_KP) + (kt & 1) * 128 * 40;
        if (kt + 1 < nkt) pattn_stage_load(p, (size_t)b * SEQ + k0 + 128, h, tid, kvr, kpr);
        if (k0 <= qw0 + 31) {
            const bool hi = k0 + 64 <= qw0 + 31;
            const LDS unsigned char* rb0 = img + xo[0]; const LDS unsigned char* rb1 = img + xo[1]; const LDS unsigned char* rb2 = img + xo[2]; const LDS unsigned char* rb3 = img + xo[3];
            const LDS bf16* kr = kpl + r * 40 + 8 * hh;
#define PA_K(rb, j) (*(const LDS bf16x8*)((rb) + 8192 * (j)))
            f32x16 s0, s1, s2, s3;
#pragma unroll
            for (int i = 0; i < 16; ++i) { s0[i] = -mshift; s1[i] = -mshift; s2[i] = -mshift; s3[i] = -mshift; }
            s0 = mfma32(PA_K(rb0, 0), qf[0], s0); s1 = mfma32(PA_K(rb0, 1), qf[0], s1); s0 = mfma32(PA_K(rb1, 0), qf[1], s0); s1 = mfma32(PA_K(rb1, 1), qf[1], s1);
            s0 = mfma32(PA_K(rb2, 0), qf[2], s0); s1 = mfma32(PA_K(rb2, 1), qf[2], s1); s0 = mfma32(PA_K(rb3, 0), qf[3], s0); s1 = mfma32(PA_K(rb3, 1), qf[3], s1);
            s0 = mfma32(ld8(kr), qf[4], s0); s1 = mfma32(ld8(kr + 32 * 40), qf[4], s1); s0 = mfma32(ld8(kr + 16), qf[5], s0); s1 = mfma32(ld8(kr + 32 * 40 + 16), qf[5], s1);
            if (hi) {
                s2 = mfma32(PA_K(rb0, 2), qf[0], s2); s3 = mfma32(PA_K(rb0, 3), qf[0], s3); s2 = mfma32(PA_K(rb1, 2), qf[1], s2); s3 = mfma32(PA_K(rb1, 3), qf[1], s3);
                s2 = mfma32(PA_K(rb2, 2), qf[2], s2); s3 = mfma32(PA_K(rb2, 3), qf[2], s3); s2 = mfma32(PA_K(rb3, 2), qf[3], s2); s3 = mfma32(PA_K(rb3, 3), qf[3], s3);
                s2 = mfma32(ld8(kr + 64 * 40), qf[4], s2); s3 = mfma32(ld8(kr + 96 * 40), qf[4], s3); s2 = mfma32(ld8(kr + 64 * 40 + 16), qf[5], s2); s3 = mfma32(ld8(kr + 96 * 40 + 16), qf[5], s3); }
#undef PA_K
            if (k0 + 127 > qw0) {
#pragma unroll
                for (int i = 0; i < 16; ++i) { const int key = k0 + crow(i, hh); if (key > qpos) s0[i] = -INFINITY; if (key + 32 > qpos) s1[i] = -INFINITY; if (key + 64 > qpos) s2[i] = -INFINITY; if (key + 96 > qpos) s3[i] = -INFINITY; } }
            if (!hi) {
#pragma unroll
                for (int i = 0; i < 16; ++i) { s2[i] = -INFINITY; s3[i] = -INFINITY; } }
            float ps = 0.f;
#pragma unroll
            for (int i = 0; i < 16; ++i) { s0[i] = fexp2(s0[i]); s1[i] = fexp2(s1[i]); s2[i] = fexp2(s2[i]); s3[i] = fexp2(s3[i]); ps += (s0[i] + s1[i]) + (s2[i] + s3[i]); }
            l += ps;
            const LDS unsigned char* t0 = img + t0o; const LDS unsigned char* t1 = img + t1o; const LDS unsigned char* t2 = img + t2o; const LDS unsigned char* t3 = img + t3o;
            { bf16x8 v0, v1, v2, v3; img_tr4p_pre<0, 32>(t0, t1, t2, t3, v0, v1, v2, v3); bf16x8 pa = PACK(s0, 0), pb = PACK(s1, 0);
                o0 = mfma32(v0, pa, o0); o1 = mfma32(v1, pa, o1); o0 = mfma32(v2, pb, o0); o1 = mfma32(v3, pb, o1);
                img_tr4p_pre<16, 48>(t0, t1, t2, t3, v0, v1, v2, v3); pa = PACK(s0, 1); pb = PACK(s1, 1);
                o0 = mfma32(v0, pa, o0); o1 = mfma32(v1, pa, o1); o0 = mfma32(v2, pb, o0); o1 = mfma32(v3, pb, o1); }
            if (hi) { bf16x8 v0, v1, v2, v3; img_tr4p_pre<64, 96>(t0, t1, t2, t3, v0, v1, v2, v3); bf16x8 pa = PACK(s2, 0), pb = PACK(s3, 0);
                o0 = mfma32(v0, pa, o0); o1 = mfma32(v1, pa, o1); o0 = mfma32(v2, pb, o0); o1 = mfma32(v3, pb, o1);
                img_tr4p_pre<80, 112>(t0, t1, t2, t3, v0, v1, v2, v3); pa = PACK(s2, 1); pb = PACK(s3, 1);
                o0 = mfma32(v0, pa, o0); o1 = mfma32(v1, pa, o1); o0 = mfma32(v2, pb, o0); o1 = mfma32(v3, pb, o1); }
        }
        if (kt + 1 < nkt) pattn_stage_store(p, lds + PA_IMG + ((kt + 1) & 1) * 32768, (LDS bf16*)(lds + PA_KP) + ((kt + 1) & 1) * 128 * 40, tid, kvr, kpr);
        __syncthreads();
    }
    l += __shfl_xor(l, 32); const float il = 1.0f / l;
    bf16* o = p.OMIX + trow * DM + 512 + h * 64;
#pragma unroll
    for (int g = 0; g < 4; ++g) { u32x2 w0, w1; w0[0] = pk2(o0[4 * g] * il, o0[4 * g + 1] * il); w0[1] = pk2(o0[4 * g + 2] * il, o0[4 * g + 3] * il); w1[0] = pk2(o1[4 * g] * il, o1[4 * g + 1] * il); w1[1] = pk2(o1[4 * g + 2] * il, o1[4 * g + 3] * il);
        *(u32x2*)(o + 8 * g + 4 * hh) = w0; *(u32x2*)(o + 32 + 8 * g + 4 * hh) = w1; }
}

constexpr int XA_K = 0, XA_V = 65536, XA_END = 131072;
static_assert(XA_END <= LDS_CTL, "cross-attention LDS map");
DI void xattn_unit(const Params& p, LDS unsigned char* lds, int u) {
    const int tid = tid_opaque(), wid = __builtin_amdgcn_readfirstlane(tid >> 6), lane = tid & 63, r = lane & 31, hh = lane >> 5;
    LDS unsigned char* KI = lds + XA_K; LDS unsigned char* VI = lds + XA_V;
    int b, h, nrows; size_t tbase;
    if (u < NU_XP) { b = u / (4 * NQB); h = (u / NQB) & 3; const int qc = u % NQB; nrows = 256; tbase = (size_t)b * SEQ + qc * 256;
#pragma unroll
        for (int j = 0; j < 8; ++j) { const int i = tid + NTHREADS * j, key = i >> 4, ch = i & 15; const size_t src = ((size_t)b * 256 + key) * 512 + h * 128 + ch * 8;
            *(LDS bf16x8*)(KI + imgb(key, ch)) = ld8g(p.MKB + src); *(LDS bf16x8*)(VI + imgb(key, ch)) = ld8g(p.MVB + src); }
    } else { const int us = u - NU_XP; b = us >> 2; h = us & 3; nrows = DECS; tbase = (size_t)TP + b * DECS;
#pragma unroll 2
        for (int j = 0; j < 8; ++j) { const int i = tid + NTHREADS * j, key = i >> 4, ch = i & 15; const size_t src = (((size_t)b * 256 + key) * 4 + h) * 128 + ch * 8;
            const f32x4 k0 = *(const f32x4*)(p.cmk + src), k1 = *(const f32x4*)(p.cmk + src + 4), v0 = *(const f32x4*)(p.cmv + src), v1 = *(const f32x4*)(p.cmv + src + 4);
            *(LDS bf16x8*)(KI + imgb(key, ch)) = pack8(k0[0], k0[1], k0[2], k0[3], k1[0], k1[1], k1[2], k1[3]); *(LDS bf16x8*)(VI + imgb(key, ch)) = pack8(v0[0], v0[1], v0[2], v0[3], v1[0], v1[1], v1[2], v1[3]); }
    }
    __syncthreads();
    if (32 * wid < nrows) {
        const bool valid = 32 * wid + r < nrows; const size_t trow = tbase + 32 * wid + (valid ? r : 0);
        bf16x8 qf[8]; float ss = 0.f;
#pragma unroll
        for (int ks = 0; ks < 8; ++ks) { qf[ks] = ld8g(p.XQ + trow * 512 + h * 128 + 16 * ks + 8 * hh);
#pragma unroll
            for (int j = 0; j < 8; ++j) { const float v = bf2f((bf16)qf[ks][j]); ss += v * v; } }
        ss += __shfl_xor(ss, 32); const float rs = valid ? rsqrtf(ss * (1.0f / 128.0f) + EPS) * X_SCALE : 0.f;
#pragma unroll
        for (int ks = 0; ks < 8; ++ks) { float q[8];
#pragma unroll
            for (int j = 0; j < 8; ++j) q[j] = bf2f((bf16)qf[ks][j]) * rs * p.g_xq[16 * ks + 8 * hh + j];
            qf[ks] = pack8(q[0], q[1], q[2], q[3], q[4], q[5], q[6], q[7]); }
        f32x16 o[4];
#pragma unroll
        for (int d = 0; d < 4; ++d) o[d] = zero16();
        float m = -INFINITY, l = 0.f;
#pragma unroll 1
        for (int kt = 0; kt < 4; ++kt) {
            f32x16 s0 = zero16(), s1 = zero16();
#pragma unroll
            for (int ks = 0; ks < 8; ++ks) { s0 = mfma32(img_row(KI, 64 * kt + r, ks, hh), qf[ks], s0); s1 = mfma32(img_row(KI, 64 * kt + 32 + r, ks, hh), qf[ks], s1); }
            float tmax = -INFINITY;
#pragma unroll
            for (int i = 0; i < 16; ++i) tmax = fmaxf(tmax, fmaxf(s0[i], s1[i]));
            tmax = fmaxf(tmax, __shfl_xor(tmax, 32));
            const float mn = fmaxf(m, tmax), corr = fexp(m - mn); m = mn; float ps = 0.f;
#pragma unroll
            for (int i = 0; i < 16; ++i) { s0[i] = fexp(s0[i] - mn); s1[i] = fexp(s1[i] - mn); ps += s0[i] + s1[i]; }
            l = l * corr + ps;
#pragma unroll
            for (int d = 0; d < 4; ++d)
#pragma unroll
                for (int i = 0; i < 16; ++i) o[d][i] *= corr;
#pragma unroll
            for (int s = 0; s < 2; ++s) { const bf16x8 pa = PACK(s0, s), pb = PACK(s1, s); bf16x8 v0, v1, v2, v3;
                img_tr4p(VI, lane, 0, 1, 64 * kt + 16 * s, 64 * kt + 32 + 16 * s, v0, v1, v2, v3);
                o[0] = mfma32(v0, pa, o[0]); o[1] = mfma32(v1, pa, o[1]); o[0] = mfma32(v2, pb, o[0]); o[1] = mfma32(v3, pb, o[1]);
                img_tr4p(VI, lane, 2, 3, 64 * kt + 16 * s, 64 * kt + 32 + 16 * s, v0, v1, v2, v3);
                o[2] = mfma32(v0, pa, o[2]); o[3] = mfma32(v1, pa, o[3]); o[2] = mfma32(v2, pb, o[2]); o[3] = mfma32(v3, pb, o[3]); }
        }
        l += __shfl_xor(l, 32); const float il = 1.0f / l;
        if (valid) { bf16* op = p.XO + trow * 512 + h * 128;
#pragma unroll
            for (int d = 0; d < 4; ++d)
#pragma unroll
                for (int g = 0; g < 4; ++g) { u32x2 w; w[0] = pk2(o[d][4 * g] * il, o[d][4 * g + 1] * il); w[1] = pk2(o[d][4 * g + 2] * il, o[d][4 * g + 3] * il); *(u32x2*)(op + 32 * d + 8 * g + 4 * hh) = w; } }
    }
}
constexpr int SA_CK = 0, SA_KP = 32768, SA_P = SA_KP + 64 * 40 * 2, SA_QS = SA_P + 64 * 72 * 2, SA_CORR = SA_QS + 65 * 104 * 2, SA_F32 = (SA_CORR + 1024 + 1023) / 1024 * 1024, SA_KPF = SA_F32 + 65536, SA_END = SA_KPF + 8192;
static_assert(SA_END <= LDS_CTL && SA_KP % 16 == 0 && SA_P % 16 == 0 && SA_QS % 16 == 0 && SA_CORR % 16 == 0 && SA_F32 % 1024 == 0 && SA_KPF % 1024 == 0, "sample attention LDS map");
DI void sattn_issue(const Params& p, LDS unsigned char* lds, int pid, int half, int wid, int lane) {
    const size_t key0 = (size_t)pid * PAGE + half * 64;
#pragma unroll
    for (int i = 0; i < 8; ++i) { const int key = wid * 8 + i; dma16(p.cckv + (key0 + key) * 256 + lane * 4, lds + SA_F32 + key * 1024); }
    dma16(p.ckpe + (key0 + wid * 8 + (lane >> 3)) * 32 + (lane & 7) * 4, lds + SA_KPF + wid * 1024);
}
DI void sattn_convert(LDS unsigned char* lds) {
    const int tid = tid_opaque();
#pragma unroll
    for (int j = 0; j < 4; ++j) { const int i = tid + NTHREADS * j, key = i >> 5, c32 = i & 31;
        const f32x4 a = *(const LDS f32x4*)(lds + SA_F32 + key * 1024 + c32 * 32), bq = *(const LDS f32x4*)(lds + SA_F32 + key * 1024 + c32 * 32 + 16);
        u32x4 w; w[0] = pk2(a[0], a[1]); w[1] = pk2(a[2], a[3]); w[2] = pk2(bq[0], bq[1]); w[3] = pk2(bq[2], bq[3]);
        *(LDS u32x4*)(lds + SA_CK + (c32 >> 4) * 16384 + imgb(key, c32 & 15)) = w; }
    { const int key = tid >> 3, c4 = (tid & 7) * 4; const f32x4 v = *(const LDS f32x4*)(lds + SA_KPF + key * 128 + c4 * 4); u32x2 w; w[0] = pk2(v[0], v[1]); w[1] = pk2(v[2], v[3]);
        *(LDS u32x2*)(lds + SA_KP + (key * 40 + c4) * 2) = w; }
}
DI void sattn_unit(const Params& p, LDS unsigned char* lds, int u) {
    const int tid = tid_opaque(), wid = __builtin_amdgcn_readfirstlane(tid >> 6), lane = tid & 63, r = lane & 31, hh = lane >> 5;
    LDS unsigned char* CK = lds + SA_CK; LDS bf16* KP = (LDS bf16*)(lds + SA_KP); LDS bf16* PA = (LDS bf16*)(lds + SA_P);
    LDS bf16* QS = (LDS bf16*)(lds + SA_QS); LDS float* CORR = (LDS float*)(lds + SA_CORR);
    const int b = u / NSPLIT, sp = u % NSPLIT; const int h = wid;
    STAMP(23);
    const int pidv = p.ptab[b * NPAGES + sp * PPS + (lane % PPS)];
    sattn_issue(p, lds, rdlane(pidv, 0), 0, wid, lane);
    for (int i = tid; i < 65 * 96; i += NTHREADS) { const int row = i / 96, d = i % 96; float v = 0.f;
        if (row < 64) { const int hq = row >> 3, q = row & 7; v = bf2f(p.QN[(((size_t)TP + b * DECS + q) * 8 + hq) * 96 + d]) * 1.4426950408889634f; if (d < 64) v *= p.g_kn[d]; }
        QS[row * 104 + d] = f2bf(v); }
    const int l15 = lane & 15, quad = lane >> 4;
    bf16x8 wk[4][8];
    { const bf16* wkp = p.wt_kvb + (size_t)(h * 128 + l15) * 256 + 8 * quad;
#pragma unroll
        for (int dt = 0; dt < 4; ++dt)
#pragma unroll
            for (int ks = 0; ks < 8; ++ks) wk[dt][ks] = ld8g(wkp + dt * 16 * 256 + 32 * ks); }
#ifndef EMU
#pragma unroll
    for (int dt = 0; dt < 4; ++dt)
#pragma unroll
        for (int ks = 0; ks < 8; ++ks) asm volatile("" : "+v"(wk[dt][ks]));
#endif
    const int qrow = l15 < 8 ? h * 8 + l15 : 64;
    f32x16 acc0 = zero16(), acc1 = zero16(); float m = -INFINITY, l = 0.f;
    const int npt = PPS * 2, ntile = npt + (sp == NSPLIT - 1 ? 1 : 0);
    wait_vm0(); bar_lds(); sattn_convert(lds); bar_lds();
    for (int tile = 0; tile < ntile; ++tile) {
        const bool newt = tile == npt;
        unsigned lo_ = lane;
#ifndef EMU
        asm volatile("" : "+v"(lo_));
#endif
        const unsigned l15o = lo_ & 15, quado = lo_ >> 4;
        if (tile + 1 < npt) sattn_issue(p, lds, rdlane(pidv, (tile + 1) >> 1), (tile + 1) & 1, wid, lane);
#pragma unroll 1
        for (int kg = 0; kg < 4; ++kg) {
            f32x4 x[4];
#pragma unroll
            for (int dt = 0; dt < 4; ++dt) x[dt] = (f32x4){0.f, 0.f, 0.f, 0.f};
#define SA_CB(ks) (*(const LDS bf16x8*)(CK + ((ks) >> 2) * 16384 + imgb(16 * kg + l15o, 4 * ((ks) & 3) + quado)))
#define SA_MM(ks, cbv) do { _Pragma("unroll") for (int dt = 0; dt < 4; ++dt) x[dt] = __builtin_amdgcn_mfma_f32_16x16x32_bf16(wk[dt][ks], cbv, x[dt], 0, 0, 0); } while (0)
            bf16x8 ca0 = SA_CB(0), ca1 = SA_CB(1), cb0 = SA_CB(2), cb1 = SA_CB(3); SCHED_FENCE();
            SA_MM(0, ca0); SA_MM(1, ca1); ca0 = SA_CB(4); ca1 = SA_CB(5); SCHED_FENCE();
            SA_MM(2, cb0); SA_MM(3, cb1); cb0 = SA_CB(6); cb1 = SA_CB(7); SCHED_FENCE();
            const s16x4 qa0 = *(const LDS s16x4*)(QS + qrow * 104 + 4 * quad), qa1 = *(const LDS s16x4*)(QS + qrow * 104 + 16 + 4 * quad), qb0 = *(const LDS s16x4*)(QS + qrow * 104 + 32 + 4 * quad), qb1 = *(const LDS s16x4*)(QS + qrow * 104 + 48 + 4 * quad);
            const bf16x8 kpf = ld8(KP + (16 * kg + l15) * 40 + 8 * quad), qrf = ld8(QS + qrow * 104 + 64 + 8 * quad);
            SA_MM(4, ca0); SA_MM(5, ca1); SCHED_FENCE();
            SA_MM(6, cb0); SA_MM(7, cb1); SCHED_FENCE();
#undef SA_CB
#undef SA_MM
            float ss = 0.f;
#pragma unroll
            for (int dt = 0; dt < 4; ++dt) ss += x[dt][0] * x[dt][0] + x[dt][1] * x[dt][1] + x[dt][2] * x[dt][2] + x[dt][3] * x[dt][3];
            ss = xsum32(xsum16(ss)); const float inv = rsqrtf(ss * (1.0f / 64.0f) + EPS);
            f32x4 z = {0.f, 0.f, 0.f, 0.f};
#pragma unroll
            for (int pp = 0; pp < 2; ++pp) {
                const bf16x8 a = pack8(x[2 * pp][0] * inv, x[2 * pp][1] * inv, x[2 * pp][2] * inv, x[2 * pp][3] * inv, x[2 * pp + 1][0] * inv, x[2 * pp + 1][1] * inv, x[2 * pp + 1][2] * inv, x[2 * pp + 1][3] * inv);
                z = __builtin_amdgcn_mfma_f32_16x16x32_bf16(a, pp == 0 ? __builtin_shufflevector(qa0, qa1, 0, 1, 2, 3, 4, 5, 6, 7) : __builtin_shufflevector(qb0, qb1, 0, 1, 2, 3, 4, 5, 6, 7), z, 0, 0, 0); }
            z = __builtin_amdgcn_mfma_f32_16x16x32_bf16(kpf, qrf, z, 0, 0, 0);
            if (newt) {
#pragma unroll
                for (int j = 0; j < 4; ++j) { const int key = 16 * kg + 4 * quad + j; if (key > l15 || key >= DECS) z[j] = -INFINITY; } }
            float tmax = fmaxf(fmaxf(z[0], z[1]), fmaxf(z[2], z[3]));
            tmax = fmaxf(xmax32(xmax16(tmax)), -1e30f);
            const float mn = fmaxf(m, tmax), corr = fexp2(m - mn); m = mn;
#pragma unroll
            for (int j = 0; j < 4; ++j) z[j] = fexp2(z[j] - mn);
            l = l * corr + (z[0] + z[1]) + (z[2] + z[3]);
            if (l15 < 8) { u32x2 w; w[0] = pk2(z[0], z[1]); w[1] = pk2(z[2], z[3]); *(LDS u32x2*)(PA + (h * 8 + l15) * 72 + 16 * kg + 4 * quad) = w;
                if (quad == 0) CORR[kg * 64 + h * 8 + l15] = corr; }
        }
        bar_lds();
#pragma unroll
        for (int ks = 0; ks < 4; ++ks) { const float c0 = CORR[ks * 64 + r], c1 = CORR[ks * 64 + 32 + r];
#pragma unroll
            for (int i = 0; i < 16; ++i) { acc0[i] *= c0; acc1[i] *= c1; }
            const bf16x8 a = img_tr<false>(CK + (wid >> 2) * 16384, lo_, wid & 3, 16 * ks);
            acc0 = mfma32(a, ld8(PA + r * 72 + 16 * ks + 8 * hh), acc0); acc1 = mfma32(a, ld8(PA + (32 + r) * 72 + 16 * ks + 8 * hh), acc1); }
        if (tile + 1 < ntile) {
            if (tile + 1 < npt) { wait_vm0(); bar_lds(); sattn_convert(lds); }
            else { bar_lds(); const size_t t0 = (size_t)TP + b * DECS;
                for (int i = tid; i < 64 * 32; i += NTHREADS) { const int key = i >> 5, c32 = i & 31; bf16x8 v = zero8(); if (key < DECS) v = ld8g(p.CKVB + (t0 + key) * 256 + c32 * 8);
                    *(LDS bf16x8*)(CK + (c32 >> 4) * 16384 + imgb(key, c32 & 15)) = v; }
                for (int i = tid; i < 64 * 32; i += NTHREADS) { const int key = i >> 5, c = i & 31; KP[key * 40 + c] = key < DECS ? p.KPB[(t0 + key) * 32 + c] : (bf16)0; } }
            bar_lds();
        }
    }
    STAMP(22);
    { const int t2 = tid_opaque(), w2 = __builtin_amdgcn_readfirstlane(t2 >> 6), l2 = t2 & 63, r2 = l2 & 31, h2 = l2 >> 5;
        float* pa = p.PACC + (size_t)u * 64 * 256;
#pragma unroll
        for (int g = 0; g < 4; ++g) { f32x4 v0 = {acc0[4 * g], acc0[4 * g + 1], acc0[4 * g + 2], acc0[4 * g + 3]}, v1 = {acc1[4 * g], acc1[4 * g + 1], acc1[4 * g + 2], acc1[4 * g + 3]};
            *(f32x4*)(pa + (size_t)r2 * 256 + 32 * w2 + 8 * g + 4 * h2) = v0; *(f32x4*)(pa + (size_t)(32 + r2) * 256 + 32 * w2 + 8 * g + 4 * h2) = v1; }
        l += __shfl_xor(l, 16); l += __shfl_xor(l, 32);
        if (l2 < 8) { p.PML[((size_t)u * 64 + w2 * 8 + r2) * 2] = m; p.PML[((size_t)u * 64 + w2 * 8 + r2) * 2 + 1] = l; } }
}
DI void phase_sattn_combine(const Params& p, LDS unsigned char* lds) {
    const int tid = tid_opaque();
    LDS float* AC = (LDS float*)lds; LDS float* WS = (LDS float*)(lds + 8 * 256 * 4);
    for (int u = blockIdx.x; u < DECB * 8; u += gridDim.x) { const int b = u >> 3, h = u & 7;
        if (tid < 8) { const int hq = h * 8 + tid; float M = -INFINITY; for (int j = 0; j < NSPLIT; ++j) M = fmaxf(M, p.PML[((size_t)(b * NSPLIT + j) * 64 + hq) * 2]);
            float L = 0.f; for (int j = 0; j < NSPLIT; ++j) { const float w = exp2f(p.PML[((size_t)(b * NSPLIT + j) * 64 + hq) * 2] - M);     WS[tid * NSPLIT + j] = w; L += w * p.PML[((size_t)(b * NSPLIT + j) * 64 + hq) * 2 + 1]; }
            const float iL = 1.0f / L; for (int j = 0; j < NSPLIT; ++j) WS[tid * NSPLIT + j] *= iL; }
        __syncthreads();
        { const int q = tid >> 6, l4 = (tid & 63) * 4; f32x4 s = {0.f, 0.f, 0.f, 0.f};
#pragma unroll
            for (int j = 0; j < NSPLIT; ++j) s += WS[q * NSPLIT + j] * *(const f32x4*)(p.PACC + ((size_t)(b * NSPLIT + j) * 64 + h * 8 + q) * 256 + l4);
            *(LDS f32x4*)(AC + q * 256 + l4) = s; }
        __syncthreads();
        { const int q = tid >> 6, dv = tid & 63; const bf16* w = p.wt_kvb + (size_t)(h * 128 + 64 + dv) * 256; float s = 0.f;
#pragma unroll 4
            for (int c = 0; c < 32; ++c) { const bf16x8 wv = ld8g(w + 8 * c); const f32x4 a0 = *(const LDS f32x4*)(AC + q * 256 + 8 * c), a1 = *(const LDS f32x4*)(AC + q * 256 + 8 * c + 4);
                s += a0[0] * bf2f((bf16)wv[0]) + a0[1] * bf2f((bf16)wv[1]) + a0[2] * bf2f((bf16)wv[2]) + a0[3] * bf2f((bf16)wv[3]) + a1[0] * bf2f((bf16)wv[4]) + a1[1] * bf2f((bf16)wv[5]) + a1[2] * bf2f((bf16)wv[6]) + a1[3] * bf2f((bf16)wv[7]); }
            p.OMIX[((size_t)TP + b * DECS + q) * DM + 512 + h * 64 + dv] = f2bf(s); }
        __syncthreads();
    }
}
#ifndef EMU
#define XB_TMO      128
#define XB_XCNT(j)  (256  + 64 * (j))
#define XB_XSUB(j)  (1280 + 64 * (j))
#define XB_XGEN(j)  (2304 + 64 * (j))
#define XB_TOP      3328
#define XB_TOPGEN   3392
#define XCD_BAR_WORDS 3456
#define XB_SPIN_CAP (1u << 18)
#define LAS __attribute__((address_space(3)))
__device__ __forceinline__ unsigned xb_ld(unsigned* p)              { return __hip_atomic_load(p, __ATOMIC_RELAXED, __HIP_MEMORY_SCOPE_AGENT); }
__device__ __forceinline__ unsigned xb_add(unsigned* p, unsigned v) { return __hip_atomic_fetch_add(p, v, __ATOMIC_RELAXED, __HIP_MEMORY_SCOPE_AGENT); }
__device__ __forceinline__ unsigned xb_xcc_id() { return (unsigned)__builtin_amdgcn_s_getreg((3 << 11) | 20) & 0xFu; }
#define XB_SPIN(cond, bar) do { unsigned _sp = 0; while (cond) { __builtin_amdgcn_s_sleep(1); \
    if ((++_sp & 255u) == 0u) { if (xb_ld(&(bar)[XB_TMO])) break; if (_sp > XB_SPIN_CAP) { atomicAdd(&(bar)[XB_TMO], 1u); break; } } } } while (0)
struct XcdBarrier { unsigned* bar; unsigned x; volatile LAS unsigned* st; };
__device__ __forceinline__ XcdBarrier xcd_barrier_post(unsigned* bar, volatile LAS unsigned* st) {
    XcdBarrier b; b.bar = bar; b.x = xb_xcc_id(); b.st = st;
    if (threadIdx.x == 0) (void)xb_add(&bar[XB_XCNT(b.x)], 1u);
    return b;
}
__device__ __forceinline__ void xcd_barrier_complete(unsigned* bar, unsigned x, unsigned& nloc, unsigned& nx) {
    const unsigned G = gridDim.x * gridDim.y * gridDim.z;
    unsigned sum, cnt, mine, sp = 0u;
    for (;;) {
        sum = 0u; cnt = 0u; mine = 0u;
#pragma unroll
        for (unsigned j = 0; j < 16; ++j) { const unsigned c = xb_ld(&bar[XB_XCNT(j)]); sum += c; cnt += (c > 0u) ? 1u : 0u; mine = (j == x) ? c : mine; }
        if (sum == G) break;
        __builtin_amdgcn_s_sleep(1);
        if ((++sp & 255u) == 0u) { if (xb_ld(&bar[XB_TMO])) break; if (sp > XB_SPIN_CAP) { atomicAdd(&bar[XB_TMO], 1u); break; } }
    }
    nloc = mine > 0u ? mine : 1u; nx = cnt > 0u ? cnt : 1u;
}
__device__ __forceinline__ void xcd_barrier(const XcdBarrier& b) {
    asm volatile("s_waitcnt vmcnt(0)" ::: "memory");
    __syncthreads();
    if (threadIdx.x == 0) {
        unsigned* bar = b.bar;
        __builtin_amdgcn_s_waitcnt(0);
        unsigned nloc = b.st[0], nx = b.st[1];
        if (nloc == 0u) { xcd_barrier_complete(bar, b.x, nloc, nx); b.st[0] = nloc; b.st[1] = nx; }
        const unsigned old = xb_add(&bar[XB_XSUB(b.x)], 1u);
        const unsigned gen = old / nloc;
        if (old + 1u == (gen + 1u) * nloc) {
            __builtin_amdgcn_fence(__ATOMIC_RELEASE, "agent");
            asm volatile("s_waitcnt vmcnt(0)" ::: "memory");
            const unsigned og = xb_add(&bar[XB_TOP], 1u);
            const unsigned tg = og / nx;
            if (og + 1u == (tg + 1u) * nx) xb_add(&bar[XB_TOPGEN], 1u);
            else XB_SPIN(xb_ld(&bar[XB_TOPGEN]) == tg, bar);
            __builtin_amdgcn_fence(__ATOMIC_ACQUIRE, "agent");
            xb_add(&bar[XB_XGEN(b.x)], 1u);
            asm volatile("s_waitcnt vmcnt(0)" ::: "memory");
        } else {
            XB_SPIN(xb_ld(&bar[XB_XGEN(b.x)]) == gen, bar);
            __builtin_amdgcn_fence(__ATOMIC_ACQUIRE, "agent");
            asm volatile("s_waitcnt vmcnt(0)" ::: "memory");
        }
    }
    __syncthreads();
}
#endif

DI int wq_next(unsigned* ctr, LDS unsigned* slot) {
    __syncthreads();
    if (threadIdx.x == 0) *slot = atomicAdd(ctr, 1u);
    __syncthreads();
    return __builtin_amdgcn_readfirstlane((int)*slot);
}
struct EpiResF32 {
    static constexpr bool PERM = false, AFTER_DRAIN = false;
    float* C; const float* R0; const float* R1; int split;
    DI void operator()(const f32x4 (&acc)[2][2][4][2], const pg8::Unit& u, int wr, int wc, int fr, int fq) const {
        const int row0 = u.pm * 256 + wr * 64 + fr, col0 = u.pn * 256 + wc * 32 + 4 * fq;
        const float* R = row0 < split ? R0 : R1 - (size_t)split * DM;
#pragma unroll
        for (int ai = 0; ai < 2; ++ai)
#pragma unroll
            for (int mp = 0; mp < 2; ++mp) { f32x4 rr[2][2][2];
#pragma unroll
                for (int mm = 0; mm < 2; ++mm) { const size_t off = (size_t)(row0 + ai * 128 + (2 * mp + mm) * 16) * DM + col0;
#pragma unroll
                    for (int bj = 0; bj < 2; ++bj)
#pragma unroll
                        for (int n = 0; n < 2; ++n) rr[mm][bj][n] = *(const f32x4*)(R + off + bj * 128 + n * 16); }
#pragma unroll
                for (int mm = 0; mm < 2; ++mm) { const size_t off = (size_t)(row0 + ai * 128 + (2 * mp + mm) * 16) * DM + col0;
#pragma unroll
                    for (int bj = 0; bj < 2; ++bj)
#pragma unroll
                        for (int n = 0; n < 2; ++n) *(f32x4*)(C + off + bj * 128 + n * 16) = acc[ai][bj][2 * mp + mm][n] + rr[mm][bj][n]; }
#ifndef EMU
                asm volatile("" ::: "memory");
#endif
            }
    }
};
DI void phase_norm_rows(const Params& p, const float* X, const float* g) {
    const int tid = tid_opaque(), wid = __builtin_amdgcn_readfirstlane(tid >> 6), lane = tid & 63;
    { const int ws = gridDim.x * 8, w0 = blockIdx.x * 8 + wid; for (int row = w0; row < T; row += 4 * ws) rmsnorm_rows<4>(X, g, p.H, row, ws, T, lane); }
}
constexpr int NPHASE = 15;
template <int PH> DI void run_phase(const Params& p, LDS unsigned char* lds) {
    LDS unsigned* slot = (LDS unsigned*)(lds + LDS_CTL + 64);
    if constexpr (PH == 0) phase_prep(p, lds);
    else if constexpr (PH == 1) { run_gemm(lds, p.H, p.wt_in, TP, DINP, DM, EpiStoreBf16<0>{p.Z, DINP}, 0); run_gemm(lds, p.MEMN, p.wt_xkv, MROWS, 1024, DM, EpiStoreF32{p.MKV, nullptr, 1024}, 128);
        small_gemm(lds, p.H, p.wt_in, DINP, DM, SEpiBf16{p.Z, DINP, 0}, 64); }
    else if constexpr (PH == 2) { phase_post_in(p); if (DUPM & 8) phase_post_in(p); }
    else if constexpr (PH == 3) { run_gemm(lds, p.QAN, p.wt_qb, TP, 768, 384, EpiStoreBf16<0>{p.QF, 768}, 0); run_gemm(lds, p.CKVB, p.wt_kvb, TP, 1024, 256, EpiStoreBf16<0>{p.KV, 1024}, 128);
        small_gemm(lds, p.QAN, p.wt_qb, 768, 384, SEpiBf16{p.QF, 768, 0}, 0); __syncthreads(); phase_gla_a(p, lds); }
    else if constexpr (PH == 4) { phase_post_qkv(p); if (DUPM & 16) phase_post_qkv(p); phase_gla_b(p); }
    else if constexpr (PH == 5) {
        for (int rep = 0; rep < ((DUPM & 1) ? 2 : 1); ++rep) for (int u = blockIdx.x; u < NU_SA; u += gridDim.x) { __syncthreads(); sattn_unit(p, lds, u); }
        STAMP(20);
        for (int rep = 0; rep < ((DUPM & 2) ? 2 : 1); ++rep) for (;;) { const int u = wq_next(p.ctl + CW_Q5 + 64 + 192 * rep, slot); if (u >= NU_PA) break; pattn_unit(p, lds, u); }
        STAMP(21);
        __syncthreads(); phase_gla_c(p, lds); }
    else if constexpr (PH == 6) phase_sattn_combine(p, lds);
    else if constexpr (PH == 7) { run_gemm(lds, p.OMIX, p.wt_out, TP, DM, DM, EpiResF32{p.X1, p.xp, p.xs, TP}, 0); small_gemm(lds, p.OMIX, p.wt_out, DM, DM, SEpiRes{p.X1, p.xs - (size_t)TP * DM}, 0); }
    else if constexpr (PH == 8) phase_norm_rows(p, p.X1, p.g_x);
    else if constexpr (PH == 9) { run_gemm(lds, p.H, p.wt_xq, TP, 512, DM, EpiStoreBf16<0>{p.XQ, 512}, 0); small_gemm(lds, p.H, p.wt_xq, 512, DM, SEpiBf16{p.XQ, 512, 0}, 0); }
    else if constexpr (PH == 10) { unsigned* ctr = p.ctl + CW_QX; if (DUPP & (1 << 10)) { __syncthreads(); if (*(volatile unsigned*)ctr >= (unsigned)(NU_XS + NU_XP) ) ctr += 64; }
        for (;;) { const int u = wq_next(ctr, slot); if (u >= NU_XS + NU_XP) break; xattn_unit(p, lds, u < NU_XS ? NU_XP + u : u - NU_XS); } }
    else if constexpr (PH == 11) { run_gemm(lds, p.XO, p.wt_xo, TP, DM, 512, EpiResF32{p.X2, p.X1, p.X1, T}, 0); small_gemm(lds, p.XO, p.wt_xo, DM, 512, SEpiRes{p.X2, p.X1}, 0); }
    else if constexpr (PH == 12) phase_norm_rows(p, p.X2, p.g_ff);
    else if constexpr (PH == 13) { run_gemm(lds, p.H, p.wt_ff1, TP, DFF, DM, EpiStoreBf16<1>{p.U, DFF}, 0); small_gemm(lds, p.H, p.wt_ff1, DFF, DM, SEpiBf16{p.U, DFF, 1}, 0); }
    else if constexpr (PH == 14) { run_gemm(lds, p.U, p.wt_ff2, TP, DM, DFF, EpiResF32{p.y, p.X2, p.X2, T}, 0); small_gemm(lds, p.U, p.wt_ff2, DM, DFF, SEpiRes{p.y, p.X2}, 0); }
}
#ifdef EMU
#define GET_LDS() ((LDS unsigned char*)EMU_SMEM())
#define GRID_BAR() emu_grid_barrier()
#else
#define GET_LDS() ((LDS unsigned char*)lds_raw)
#define GRID_BAR() xcd_barrier(bar)
#endif
template <int PH> __global__ void __launch_bounds__(NTHREADS, 2) k_phase(Params p) {
#ifndef EMU
    extern __shared__ __attribute__((aligned(16))) unsigned char lds_raw[];
#endif
    run_phase<PH>(p, GET_LDS());
}
#if N_LAUNCH_MODE == 1
__global__ void __launch_bounds__(NTHREADS, 2) k_mega(Params p) {
#ifndef EMU
    extern __shared__ __attribute__((aligned(16))) unsigned char lds_raw[];
    LDS unsigned char* lds = GET_LDS();
    if (threadIdx.x < 64) ((LDS unsigned*)(lds + LDS_CTL))[threadIdx.x] = 0u;
    __syncthreads();
    XcdBarrier bar = xcd_barrier_post(p.ctl + CW_BAR, (volatile LDS unsigned*)(lds + LDS_CTL));
#else
    LDS unsigned char* lds = GET_LDS();
#endif
    STAMP(0);
    run_phase<0>(p, lds); if (DUPP & (1 << 0)) run_phase<0>(p, lds); GRID_BAR();
    STAMP(1);
    run_phase<1>(p, lds); if (DUPP & (1 << 1)) run_phase<1>(p, lds); GRID_BAR();
    STAMP(2);
    run_phase<2>(p, lds); if (DUPP & (1 << 2)) run_phase<2>(p, lds); GRID_BAR();
    STAMP(3);
    run_phase<3>(p, lds); if (DUPP & (1 << 3)) run_phase<3>(p, lds); GRID_BAR();
    STAMP(4);
    run_phase<4>(p, lds); GRID_BAR();
    STAMP(5);
    run_phase<5>(p, lds); GRID_BAR();
    STAMP(6);
    run_phase<6>(p, lds); if (DUPP & (1 << 6)) run_phase<6>(p, lds); GRID_BAR();
    STAMP(7);
    run_phase<7>(p, lds); if (DUPP & (1 << 7)) run_phase<7>(p, lds); GRID_BAR();
    STAMP(8);
    run_phase<8>(p, lds); if (DUPP & (1 << 8)) run_phase<8>(p, lds); GRID_BAR();
    STAMP(9);
    run_phase<9>(p, lds); if (DUPP & (1 << 9)) run_phase<9>(p, lds); GRID_BAR();
    STAMP(10);
    run_phase<10>(p, lds); if (DUPP & (1 << 10)) run_phase<10>(p, lds); GRID_BAR();
    STAMP(11);
    run_phase<11>(p, lds); if (DUPP & (1 << 11)) run_phase<11>(p, lds); GRID_BAR();
    STAMP(12);
    run_phase<12>(p, lds); if (DUPP & (1 << 12)) run_phase<12>(p, lds); GRID_BAR();
    STAMP(13);
    run_phase<13>(p, lds); if (DUPP & (1 << 13)) run_phase<13>(p, lds); GRID_BAR();
    STAMP(14);
    run_phase<14>(p, lds); if (DUPP & (1 << 14)) run_phase<14>(p, lds);
    STAMP(15);
#ifndef EMU
    if (PROBE_A >= 0 && blockIdx.x == 0 && threadIdx.x == 0) { volatile unsigned long long* st = (volatile unsigned long long*)(p.ctl + CW_STAMP); const unsigned long long span = st[PROBE_B] - st[PROBE_A], t0 = wall_clock64();
        while (wall_clock64() - t0 < PROBE_K * span) __builtin_amdgcn_s_sleep(32); }
#endif
}
#endif

static size_t ws_take(size_t& off, size_t bytes) { const size_t o = off; off = (off + bytes + 255) & ~(size_t)255; return o; }
template <int PH> static void launch_phase(const Params& p, int grid, hipStream_t stream) {
#ifndef EMU
    static bool attr = false; if (!attr) { (void)hipFuncSetAttribute((const void*)k_phase<PH>, hipFuncAttributeMaxDynamicSharedMemorySize, LDS_BYTES); attr = true; }
#endif
    LAUNCH(k_phase<PH>, dim3(grid), dim3(NTHREADS), LDS_BYTES, stream, p);
}
extern "C" void kernel_launch(void* const* d_in, const int* in_sizes, int n_in, void* d_out, int out_size, void* d_ws, size_t ws_size, hipStream_t stream) {
    Params p{};
    const float* const* in = (const float* const*)d_in;
    p.xp = in[0]; p.xs = in[1]; p.memp = in[2]; p.cckv = in[3]; p.ckpe = in[4]; p.cmk = in[5]; p.cmv = in[6]; p.sgla = in[7]; p.ptab = (const int*)d_in[8];
    p.g_mix = in[9]; p.w_a2 = in[11]; p.b_a = in[12]; p.g_gla_o = in[13]; p.g_qa = in[14]; p.g_kva = in[16]; p.g_qn = in[18]; p.g_kn = in[19]; p.g_qr = in[20]; p.g_kr = in[21];
    p.g_x = in[23]; p.g_mem = in[24]; p.g_xq = in[28]; p.g_xk = in[29]; p.g_ff = in[31];
    float* out = (float*)d_out; size_t oo = 0;
    p.y = out; oo += (size_t)T * DM; p.o_ckvp = out + oo; oo += (size_t)TP * 256; p.o_kpep = out + oo; oo += (size_t)TP * 32; p.o_mkp = out + oo; oo += (size_t)MROWS * 512; p.o_mvp = out + oo; oo += (size_t)MROWS * 512;
    p.o_glap = out + oo; oo += (size_t)BATCH * 4 * 8192; p.o_ckvs = out + oo; oo += (size_t)TS * 256; p.o_kpes = out + oo; oo += (size_t)TS * 32; p.o_glas = out + oo; oo += (size_t)DECB * 4 * 8192;
    if ((size_t)out_size != oo || n_in != 34) { fprintf(stderr, "kernel_launch: unexpected sizes (out %d vs %zu, n_in %d)\n", out_size, oo, n_in); }
    unsigned char* ws = (unsigned char*)d_ws; size_t off = 0;
    p.ctl = (unsigned*)(ws + ws_take(off, 1 << 20));
#define WSB(name, elems) p.name = (bf16*)(ws + ws_take(off, (size_t)(elems) * 2))
#define WSF(name, elems) p.name = (float*)(ws + ws_take(off, (size_t)(elems) * 4))
    WSB(wt_in, (size_t)DINP * DM); WSB(wt_qb, 768 * 384); WSB(wt_kvb, 1024 * 256); WSB(wt_out, DM * DM); WSB(wt_xq, 512 * DM); WSB(wt_xkv, 1024 * DM); WSB(wt_xo, DM * 512); WSB(wt_ff1, (size_t)DFF * DM); WSB(wt_ff2, (size_t)DM * DFF);
    WSB(H, (size_t)T * DM); WSB(MEMN, (size_t)MROWS * DM); WSB(Z, (size_t)T * DINP); WSB(QAN, (size_t)T * 384); WSB(CKVB, (size_t)T * 256); WSB(KPB, (size_t)T * 32); WSB(MKB, (size_t)MROWS * 512); WSB(MVB, (size_t)MROWS * 512);
    WSB(QF, (size_t)T * 768); WSB(KV, (size_t)T * 1024); WSB(QN, (size_t)T * 768); WSB(KN, (size_t)T * 512); WSB(OMIX, (size_t)T * DM); WSB(XQ, (size_t)T * 512); WSB(XO, (size_t)T * 512); WSB(U, (size_t)T * DFF);
    WSF(MKV, (size_t)MROWS * 1024); WSF(ROPE, (size_t)(SEQ + DECS) * 32); WSF(LOGA, (size_t)T * 256); WSF(DS, (size_t)NGU * 8192); WSF(DDEC, (size_t)NGU * 64); WSF(X1, (size_t)T * DM); WSF(X2, (size_t)T * DM); WSF(PACC, (size_t)NU_SA * 64 * 256); WSF(PML, (size_t)NU_SA * 128);
    if (off > ws_size) { fprintf(stderr, "kernel_launch: workspace too small (%zu > %zu)\n", off, ws_size); return; }
    p.w_in = in[10]; p.w_qb = in[15]; p.w_kvb = in[17]; p.w_out = in[22]; p.w_xq = in[25]; p.w_xk = in[26]; p.w_xv = in[27]; p.w_xo = in[30]; p.w_ff1 = in[32]; p.w_ff2 = in[33];
    (void)hipMemsetAsync(p.ctl, 0, 1 << 20, stream);
#ifdef EMU
    const int grid = EMU_GRID;
#else
    static int grid = 0;
    if (!grid) { int dev = 0, cus = 0; (void)hipGetDevice(&dev); (void)hipDeviceGetAttribute(&cus, hipDeviceAttributeMultiprocessorCount, dev); grid = cus > 0 ? cus : 256;
#if N_LAUNCH_MODE == 1
        (void)hipFuncSetAttribute((const void*)k_mega, hipFuncAttributeMaxDynamicSharedMemorySize, LDS_BYTES);
        int per_cu = 0; if (hipOccupancyMaxActiveBlocksPerMultiprocessor(&per_cu, (const void*)k_mega, NTHREADS, LDS_BYTES) != hipSuccess || per_cu < 1) fprintf(stderr, "kernel_launch: occupancy query reports %d workgroups per CU\n", per_cu);
#endif
    }
#endif
#if N_LAUNCH_MODE == 1
    LAUNCH(k_mega, dim3(grid), dim3(NTHREADS), LDS_BYTES, stream, p);
#else
    launch_phase<0>(p, grid, stream); launch_phase<1>(p, grid, stream); launch_phase<2>(p, grid, stream); launch_phase<3>(p, grid, stream); launch_phase<4>(p, grid, stream);
    launch_phase<5>(p, grid, stream); launch_phase<6>(p, grid, stream); launch_phase<7>(p, grid, stream); launch_phase<8>(p, grid, stream); launch_phase<9>(p, grid, stream);
    launch_phase<10>(p, grid, stream); launch_phase<11>(p, grid, stream); launch_phase<12>(p, grid, stream); launch_phase<13>(p, grid, stream); launch_phase<14>(p, grid, stream);
#endif
}
```

```cpp
#ifdef EMU
#include "emu.h"
#define LDS
#else
#include <hip/hip_runtime.h>
#define LDS __attribute__((address_space(3)))
#define LAUNCH(kern, grid, block, smem, stream, ...) kern<<<grid, block, smem, stream>>>(__VA_ARGS__)
#endif
#include <cstdio>
#include <cstdint>
#include <cmath>
#define DI __device__ __forceinline__

#ifndef CFG_BATCH
#define CFG_BATCH 16
#define CFG_SEQ 2048
#define CFG_DECB 128
#define CFG_PAST 8192
#endif
#ifndef PROBE_A
#define PROBE_A -1
#define PROBE_B -1
#endif
#define PROBE_K 8
#ifndef DUPP
#define DUPP 0
#endif
#ifndef DUPM
#define DUPM 0
#endif
#ifndef N_LAUNCH_MODE
#define N_LAUNCH_MODE 1
#endif

typedef unsigned short bf16;
typedef short bf16x8 __attribute__((ext_vector_type(8)));
typedef short s16x4 __attribute__((ext_vector_type(4)));
typedef float f32x4 __attribute__((ext_vector_type(4)));
typedef float f32x16 __attribute__((ext_vector_type(16)));
typedef unsigned u32x4 __attribute__((ext_vector_type(4)));
typedef unsigned u32x2 __attribute__((ext_vector_type(2)));

constexpr int DM = 1024, BATCH = CFG_BATCH, SEQ = CFG_SEQ, DECB = CFG_DECB, DECS = 8, PAST = CFG_PAST, PAGE = 128, NPAGES = PAST / PAGE;
constexpr int NMEM = 256, TP = BATCH * SEQ, TS = DECB * DECS, T = TP + TS, MROWS = BATCH * NMEM;
constexpr int DIN = 2224, DINP = 2304, DFF = 4096;
constexpr int ZQ = 0, ZK = 256, ZV = 512, ZR = 1024, ZA = 1536, ZQA = 1552, ZKVA = 1936, ZKPE = 2192;
constexpr float EPS = 1e-6f, MLA_SCALE = 0.10206207261596577f  , X_SCALE = 0.08838834764831845f  ;
constexpr int NC = SEQ / 64;
constexpr int NGP = BATCH * 4 * NC, NGS = DECB * 4, NGU = NGP + NGS;
constexpr int NSPLIT = NPAGES >= 2 ? 2 : NPAGES, PPS = NPAGES / NSPLIT;
static_assert(PPS <= 64, "page ids of a unit live in one wave register");
constexpr int NU_SA = DECB * NSPLIT, NQB = SEQ / 256, NU_PA = BATCH * 8 * NQB;
constexpr int NU_XP = BATCH * 4 * NQB, NU_XS = DECB * 4;
static_assert(T % 256 == 0 && MROWS % 256 == 0 && SEQ % 256 == 0 && NPAGES % NSPLIT == 0, "shape assumptions");
constexpr int NTHREADS = 512, LDS_BYTES = 147456, LDS_CTL = LDS_BYTES - 256;

DI int tid_opaque() {
    int t = threadIdx.x;
#ifndef EMU
    asm volatile("" : "+v"(t));
#endif
    return t;
}
DI float bf2f(bf16 b) { return __uint_as_float(((unsigned)b) << 16); }
DI bf16 f2bf(float x) {
#ifdef EMU
    unsigned u = __float_as_uint(x); u += 0x7fffu + ((u >> 16) & 1u); return (bf16)(u >> 16);
#else
    return __builtin_bit_cast(unsigned short, (__bf16)x);
#endif
}
DI float fexp(float x) {
#ifdef EMU
    return exp2f(x * 1.4426950408889634f);
#else
    return __builtin_amdgcn_exp2f(x * 1.4426950408889634f);
#endif
}
DI float flog2(float x) {
#ifdef EMU
    return log2f(x);
#else
    return __builtin_amdgcn_logf(x);
#endif
}
#ifndef EMU
typedef __bf16 bf16x2_t __attribute__((ext_vector_type(2)));
typedef float f32x2_t __attribute__((ext_vector_type(2)));
#endif
DI float fexp2(float x) {
#ifdef EMU
    return exp2f(x);
#else
    return __builtin_amdgcn_exp2f(x);
#endif
}
DI unsigned pk2(float a, float b) {
#ifdef EMU
    return (unsigned)f2bf(a) | ((unsigned)f2bf(b) << 16);
#else
    const f32x2_t v = {a, b}; return __builtin_bit_cast(unsigned, __builtin_convertvector(v, bf16x2_t));
#endif
}
DI f32x16 zero16() { f32x16 z; for (int i = 0; i < 16; ++i) z[i] = 0.f; return z; }
DI f32x16 mfma32(bf16x8 a, bf16x8 b, f32x16 c) { return __builtin_amdgcn_mfma_f32_32x32x16_bf16(a, b, c, 0, 0, 0); }
DI int crow(int i, int h) { return (i & 3) + 8 * (i >> 2) + 4 * h; }
DI bf16x8 ld8(const LDS bf16* p) { return *(const LDS bf16x8*)p; }
DI bf16x8 ld8g(const bf16* p) { return *(const bf16x8*)p; }
DI bf16x8 ldperm(const LDS bf16* p16, int h) {
    const s16x4 lo = *(const LDS s16x4*)(p16 + 4 * h), hi = *(const LDS s16x4*)(p16 + 8 + 4 * h);
    return __builtin_shufflevector(lo, hi, 0, 1, 2, 3, 4, 5, 6, 7);
}
DI bf16x8 ldpermg(const bf16* p16, int h) {
    const s16x4 lo = *(const s16x4*)(p16 + 4 * h), hi = *(const s16x4*)(p16 + 8 + 4 * h);
    return __builtin_shufflevector(lo, hi, 0, 1, 2, 3, 4, 5, 6, 7);
}
DI bf16x8 pack8(float a0, float a1, float a2, float a3, float a4, float a5, float a6, float a7) {
    u32x4 p; p[0] = pk2(a0, a1); p[1] = pk2(a2, a3); p[2] = pk2(a4, a5); p[3] = pk2(a6, a7); return __builtin_bit_cast(bf16x8, p);
}
#define PACK(x, s) pack8((x)[8 * (s)], (x)[8 * (s) + 1], (x)[8 * (s) + 2], (x)[8 * (s) + 3], (x)[8 * (s) + 4], (x)[8 * (s) + 5], (x)[8 * (s) + 6], (x)[8 * (s) + 7])
DI float wsum(float v) { for (int o = 32; o >= 1; o >>= 1) v += __shfl_xor(v, o); return v; }
DI bf16x8 zero8() { bf16x8 z; for (int i = 0; i < 8; ++i) z[i] = 0; return z; }

DI float xsum16(float v) {
#ifdef EMU
    return v + __shfl_xor(v, 16);
#else
    const auto r = __builtin_amdgcn_permlane16_swap(__float_as_uint(v), __float_as_uint(v), false, false); return __uint_as_float(r[0]) + __uint_as_float(r[1]);
#endif
}
DI float xsum32(float v) {
#ifdef EMU
    return v + __shfl_xor(v, 32);
#else
    const auto r = __builtin_amdgcn_permlane32_swap(__float_as_uint(v), __float_as_uint(v), false, false); return __uint_as_float(r[0]) + __uint_as_float(r[1]);
#endif
}
DI float xmax16(float v) {
#ifdef EMU
    return fmaxf(v, __shfl_xor(v, 16));
#else
    const auto r = __builtin_amdgcn_permlane16_swap(__float_as_uint(v), __float_as_uint(v), false, false); return fmaxf(__uint_as_float(r[0]), __uint_as_float(r[1]));
#endif
}
DI float xmax32(float v) {
#ifdef EMU
    return fmaxf(v, __shfl_xor(v, 32));
#else
    const auto r = __builtin_amdgcn_permlane32_swap(__float_as_uint(v), __float_as_uint(v), false, false); return fmaxf(__uint_as_float(r[0]), __uint_as_float(r[1]));
#endif
}

DI unsigned imgb(unsigned row, unsigned ch) { return 256u * row + 16u * (ch ^ (((row & 3u) << 2) | ((row >> 2) & 3u))); }
DI bf16x8 img_row(const LDS unsigned char* img, unsigned row, unsigned s, unsigned hh) { return *(const LDS bf16x8*)(img + imgb(row, 2 * s + hh)); }
DI s16x4 tr16(const LDS unsigned char* a) {
#ifdef EMU
    return emu_tr16_b64(a);
#else
    return __builtin_amdgcn_ds_read_tr16_b64_v4i16((LDS s16x4*)a);
#endif
}
template <bool PERM> DI bf16x8 img_tr(const LDS unsigned char* img, unsigned lane, unsigned c, unsigned k16) {
    const unsigned hh = lane >> 5, blk = (lane >> 4) & 1, q = (lane & 15) >> 2, pp = lane & 3;
    const unsigned r0 = k16 + (PERM ? 4 * hh : 8 * hh) + q, r1 = r0 + (PERM ? 8 : 4), ch = 4 * c + 2 * blk + (pp >> 1);
    const LDS unsigned char* a0 = img + imgb(r0, ch) + 8 * (pp & 1); const LDS unsigned char* a1 = img + imgb(r1, ch) + 8 * (pp & 1);
#ifdef EMU
    const s16x4 lo = emu_tr16_b64(a0), hi = emu_tr16_b64(a1);
#else
    s16x4 lo, hi;
    asm volatile("ds_read_b64_tr_b16 %0, %2\n\tds_read_b64_tr_b16 %1, %3\n\ts_waitcnt lgkmcnt(0)" : "=&v"(lo), "=&v"(hi) : "v"((unsigned)(size_t)a0), "v"((unsigned)(size_t)a1) : "memory");
#endif
    return __builtin_shufflevector(lo, hi, 0, 1, 2, 3, 4, 5, 6, 7);
}

DI void img_tr4p(const LDS unsigned char* img, unsigned lane, unsigned c0, unsigned c1, unsigned ka, unsigned kb, bf16x8& f0, bf16x8& f1, bf16x8& f2, bf16x8& f3) {
#ifdef EMU
    f0 = img_tr<true>(img, lane, c0, ka); f1 = img_tr<true>(img, lane, c1, ka); f2 = img_tr<true>(img, lane, c0, kb); f3 = img_tr<true>(img, lane, c1, kb);
#else
    const unsigned hh = lane >> 5, blk = (lane >> 4) & 1, q = (lane & 15) >> 2, pp = lane & 3;
    unsigned ad[8]; s16x4 v[8];
#pragma unroll
    for (int f = 0; f < 4; ++f) { const unsigned c = (f & 1) ? c1 : c0, k16 = (f & 2) ? kb : ka, r0 = k16 + 4 * hh + q, ch = 4 * c + 2 * blk + (pp >> 1);
        ad[2 * f] = (unsigned)(size_t)(img + imgb(r0, ch) + 8 * (pp & 1)); ad[2 * f + 1] = (unsigned)(size_t)(img + imgb(r0 + 8, ch) + 8 * (pp & 1)); }
    asm volatile("ds_read_b64_tr_b16 %0, %8\n\tds_read_b64_tr_b16 %1, %9\n\tds_read_b64_tr_b16 %2, %10\n\tds_read_b64_tr_b16 %3, %11\n\tds_read_b64_tr_b16 %4, %12\n\tds_read_b64_tr_b16 %5, %13\n\tds_read_b64_tr_b16 %6, %14\n\tds_read_b64_tr_b16 %7, %15\n\ts_waitcnt lgkmcnt(0)"
                 : "=&v"(v[0]), "=&v"(v[1]), "=&v"(v[2]), "=&v"(v[3]), "=&v"(v[4]), "=&v"(v[5]), "=&v"(v[6]), "=&v"(v[7])
                 : "v"(ad[0]), "v"(ad[1]), "v"(ad[2]), "v"(ad[3]), "v"(ad[4]), "v"(ad[5]), "v"(ad[6]), "v"(ad[7]) : "memory");
    f0 = __builtin_shufflevector(v[0], v[1], 0, 1, 2, 3, 4, 5, 6, 7); f1 = __builtin_shufflevector(v[2], v[3], 0, 1, 2, 3, 4, 5, 6, 7);
    f2 = __builtin_shufflevector(v[4], v[5], 0, 1, 2, 3, 4, 5, 6, 7); f3 = __builtin_shufflevector(v[6], v[7], 0, 1, 2, 3, 4, 5, 6, 7);
#endif
}

DI unsigned tr_lane_off(unsigned lane, unsigned c, unsigned plus8) {
    const unsigned hh = lane >> 5, blk = (lane >> 4) & 1, q = (lane & 15) >> 2, pp = lane & 3;
    return imgb(4 * hh + q + 8 * plus8, 4 * c + 2 * blk + (pp >> 1)) + 8 * (pp & 1);
}
template <int KA, int KB> DI void img_tr4p_pre(const LDS unsigned char* p0, const LDS unsigned char* p1, const LDS unsigned char* p2, const LDS unsigned char* p3, bf16x8& f0, bf16x8& f1, bf16x8& f2, bf16x8& f3) {
#ifdef EMU
    const s16x4 a0 = emu_tr16_b64(p0 + 256 * KA), a1 = emu_tr16_b64(p1 + 256 * KA), a2 = emu_tr16_b64(p2 + 256 * KA), a3 = emu_tr16_b64(p3 + 256 * KA);
    const s16x4 b0 = emu_tr16_b64(p0 + 256 * KB), b1 = emu_tr16_b64(p1 + 256 * KB), b2 = emu_tr16_b64(p2 + 256 * KB), b3 = emu_tr16_b64(p3 + 256 * KB);
    f0 = __builtin_shufflevector(a0, a1, 0, 1, 2, 3, 4, 5, 6, 7); f1 = __builtin_shufflevector(a2, a3, 0, 1, 2, 3, 4, 5, 6, 7); f2 = __builtin_shufflevector(b0, b1, 0, 1, 2, 3, 4, 5, 6, 7); f3 = __builtin_shufflevector(b2, b3, 0, 1, 2, 3, 4, 5, 6, 7);
#else
    s16x4 v[8];
    asm volatile("ds_read_b64_tr_b16 %0, %8 offset:%12\n\tds_read_b64_tr_b16 %1, %9 offset:%12\n\tds_read_b64_tr_b16 %2, %10 offset:%12\n\tds_read_b64_tr_b16 %3, %11 offset:%12\n\t"
                 "ds_read_b64_tr_b16 %4, %8 offset:%13\n\tds_read_b64_tr_b16 %5, %9 offset:%13\n\tds_read_b64_tr_b16 %6, %10 offset:%13\n\tds_read_b64_tr_b16 %7, %11 offset:%13\n\ts_waitcnt lgkmcnt(0)"
                 : "=&v"(v[0]), "=&v"(v[1]), "=&v"(v[2]), "=&v"(v[3]), "=&v"(v[4]), "=&v"(v[5]), "=&v"(v[6]), "=&v"(v[7])
                 : "v"((unsigned)(size_t)p0), "v"((unsigned)(size_t)p1), "v"((unsigned)(size_t)p2), "v"((unsigned)(size_t)p3), "n"(256 * KA), "n"(256 * KB) : "memory");
    f0 = __builtin_shufflevector(v[0], v[1], 0, 1, 2, 3, 4, 5, 6, 7); f1 = __builtin_shufflevector(v[2], v[3], 0, 1, 2, 3, 4, 5, 6, 7);
    f2 = __builtin_shufflevector(v[4], v[5], 0, 1, 2, 3, 4, 5, 6, 7); f3 = __builtin_shufflevector(v[6], v[7], 0, 1, 2, 3, 4, 5, 6, 7);
#endif
}
DI void dma16(const void* g, LDS unsigned char* l) {
#ifdef EMU
    emu_dma16(g, l);
#else
    __builtin_amdgcn_global_load_lds((const unsigned*)g, (LDS unsigned*)l, 16, 0, 0);
#endif
}
#ifdef EMU
#define SCHED_FENCE() do {} while (0)
#else
#define SCHED_FENCE() __builtin_amdgcn_sched_barrier(0)
#endif
DI int rdlane(int v, int l) {
#ifdef EMU
    return __shfl(v, l);
#else
    return __builtin_amdgcn_readlane(v, l);
#endif
}
DI void wait_vm0() {
#ifndef EMU
    asm volatile("s_waitcnt vmcnt(0)" ::: "memory");
#endif
}
DI void bar_lds() {
#ifdef EMU
    __syncthreads();
#else
    asm volatile("s_waitcnt lgkmcnt(0)" ::: "memory"); __builtin_amdgcn_s_barrier(); asm volatile("" ::: "memory");
#endif
}

namespace pg8 {
#define PG8_LAS LDS
typedef unsigned short bf16_t;
constexpr int BM = 256, BK = 64, HALF = 128, HTB = HALF * BK * 2  , STAGE_BYTES = 8 * HTB, NXCD = 8, WGM = 8;
__host__ __device__ __forceinline__ int lds_byte(int r, int c) { const int st = (r >> 4) * 2 + (c >> 5), rr = r & 15, cc = c & 31, ob = rr * 64 + cc * 2; return st * 1024 + (ob ^ (((ob >> 9) & 1) << 5)); }
__host__ __device__ __forceinline__ void stage_rc(int b, int& R, int& C) { const int st = b / 1024, sb = b % 1024, swz = sb ^ (((sb >> 9) & 1) << 5); R = (st >> 1) * 16 + swz / 64; C = (st & 1) * 32 + (swz % 64) / 2; }
__host__ __device__ __forceinline__ int perm32(int rho) { const int n = rho >> 4, i = rho & 15; return 8 * (i >> 2) + 4 * n + (i & 3); }
struct Unit { int pm, pn; };
struct Gemm { const bf16_t* A; const bf16_t* Bt; int M, N, K; };
struct StaticOrder {
    int nM, nN, nwg, G, c;
    __host__ __device__ void init(int M, int N, int G_, int c_) { nM = M / BM; nN = N / BM; nwg = nM * nN; G = G_; c = c_; }
    __host__ __device__ bool next(int i, Unit& u) const {
        const long L = (long)i * G + c; if (L >= nwg) return false;
        int wgid = (int)L; { const int q = nwg / NXCD, r = nwg % NXCD, xcd = wgid % NXCD, off = wgid / NXCD; wgid = (xcd < r ? xcd * (q + 1) : r * (q + 1) + (xcd - r) * q) + off; }
        const int nig = WGM * nN, gid = wgid / nig, fm = gid * WGM, gsz = (nM - fm) < WGM ? (nM - fm) : WGM;
        u.pm = fm + ((wgid % nig) % gsz); u.pn = (wgid % nig) / gsz; return true;
    }
    __device__ __forceinline__ void a_ready(const Unit&) const {}
    __device__ __forceinline__ void done(const Unit&) const {}
};
#ifdef EMU
template <class Epi, class Sched>
__device__ __forceinline__ void gemm_phase(PG8_LAS unsigned char* lds, const Gemm g, const Sched& S, const Epi& E) {
    const int tid = tid_opaque(), wid = __builtin_amdgcn_readfirstlane(tid >> 6), lane = tid & 63, wr = wid >> 2, wc = wid & 3, fr = lane & 15, fq = lane >> 4;
    Unit cur;
    for (int ui = 0; S.next(ui, cur); ++ui) {
        f32x4 acc[2][2][4][2];
        for (int ai = 0; ai < 2; ++ai) for (int bj = 0; bj < 2; ++bj) for (int m = 0; m < 4; ++m) for (int n = 0; n < 2; ++n) for (int j = 0; j < 4; ++j) {
            const int row = 256 * cur.pm + 128 * ai + 64 * wr + 16 * m + fr;
            const int col = Epi::PERM ? 256 * cur.pn + 128 * bj + 32 * wc + 8 * fq + 4 * n + j : 256 * cur.pn + 128 * bj + 32 * wc + 16 * n + 4 * fq + j;
            const bf16_t* a = g.A + (size_t)row * g.K; const bf16_t* b = g.Bt + (size_t)col * g.K; float s = 0.f;
            for (int k = 0; k < g.K; ++k) s += bf2f(a[k]) * bf2f(b[k]);
            acc[ai][bj][m][n][j] = s;
        }
        E(acc, cur, wr, wc, fr, fq);
    }
}
#else
template <class Epi, class Sched>
__device__ __forceinline__ void gemm_phase(PG8_LAS unsigned char* lds, const Gemm g, const Sched& S, const Epi& E) {
    const int tid = tid_opaque(), wid = __builtin_amdgcn_readfirstlane(tid >> 6), lane = tid & 63, wr = wid >> 2, wc = wid & 3, fr = lane & 15, fq = lane >> 4;
    const int K = g.K, nt = K / BK;
    unsigned voffA[2], voffB[2];
#pragma unroll
    for (int i = 0; i < 2; ++i) { int R, C; stage_rc(tid * 16 + i * 8192, R, C); const int Rb = Epi::PERM ? ((R & ~31) + perm32(R & 31)) : R;
        voffA[i] = (unsigned)(R * K + C) * 2u; voffB[i] = (unsigned)(Rb * K + C) * 2u; }
    const size_t kstep = (size_t)(BK * 2);
    const size_t hstep = (size_t)HALF * K * 2;
    const size_t tstep = 2 * hstep;
    const unsigned ldsw = (unsigned)wid * 1024u;
    const int aoff = lds_byte(wr * 64 + fr, fq * 8), boff = lds_byte(wc * 32 + fr, fq * 8);
#define PG8_SA(b, h) (((b) * 2 + (h)) * HTB)
#define PG8_SB(b, h) ((4 + (b) * 2 + (h)) * HTB)
#define PG8_STAGE(bufoff, gbase, voff) do { _Pragma("unroll") for (int _i = 0; _i < 2; ++_i) \
        __builtin_amdgcn_global_load_lds((const unsigned*)((const char*)(gbase) + (voff)[_i]), (PG8_LAS unsigned*)(lds + (bufoff) + ldsw + _i * 8192), 16, 0, 0); } while (0)
#define PG8_LDA(dst, b, h) do { _Pragma("unroll") for (int m = 0; m < 4; ++m) _Pragma("unroll") for (int k = 0; k < 2; ++k) dst[m][k] = *(const PG8_LAS bf16x8*)(lds + PG8_SA(b, h) + aoff + m * 2048 + k * 1024); } while (0)
#define PG8_LDB(dst, b, h) do { _Pragma("unroll") for (int n = 0; n < 2; ++n) _Pragma("unroll") for (int k = 0; k < 2; ++k) dst[n][k] = *(const PG8_LAS bf16x8*)(lds + PG8_SB(b, h) + boff + n * 2048 + k * 1024); } while (0)
#define PG8_MMA(ai, bj, At, Bt) do { __builtin_amdgcn_s_setprio(1); _Pragma("unroll") for (int m = 0; m < 4; ++m) _Pragma("unroll") for (int n = 0; n < 2; ++n) _Pragma("unroll") for (int k = 0; k < 2; ++k) \
        acc[ai][bj][m][n] = __builtin_amdgcn_mfma_f32_16x16x32_bf16(Bt[n][k], At[m][k], acc[ai][bj][m][n], 0, 0, 0); __builtin_amdgcn_s_setprio(0); } while (0)
#define PG8_WAIT_V(n) asm volatile("s_waitcnt vmcnt(" #n ")" ::: "memory")
#define PG8_WAIT_L(n) asm volatile("s_waitcnt lgkmcnt(" #n ")" ::: "memory")
#define PG8_BAR __builtin_amdgcn_s_barrier()
#define PG8_SCHED __builtin_amdgcn_sched_barrier(0)
    Unit cur, nxt; int ui = 0;
    if (!S.next(0, cur)) return;
    f32x4 acc[2][2][4][2];
#pragma unroll
    for (int a = 0; a < 2; ++a)
#pragma unroll
        for (int b = 0; b < 2; ++b)
#pragma unroll
            for (int m = 0; m < 4; ++m)
#pragma unroll
                for (int n = 0; n < 2; ++n) acc[a][b][m][n] = (f32x4){0.f, 0.f, 0.f, 0.f};
    bf16x8 At[4][2], B0[2][2], B1[2][2];
    const char* cA = (const char*)g.A + (size_t)cur.pm * tstep; const char* cB = (const char*)g.Bt + (size_t)cur.pn * tstep;
    S.a_ready(cur);
    PG8_STAGE(PG8_SB(0, 0), cB, voffB); PG8_STAGE(PG8_SA(0, 0), cA, voffA); PG8_STAGE(PG8_SB(0, 1), cB + hstep, voffB); PG8_STAGE(PG8_SA(0, 1), cA + hstep, voffA);
    if (wr == 1) PG8_BAR;
    PG8_WAIT_V(4); PG8_BAR;
    PG8_STAGE(PG8_SB(1, 0), cB + kstep, voffB); PG8_STAGE(PG8_SA(1, 0), cA + kstep, voffA); PG8_STAGE(PG8_SB(1, 1), cB + hstep + kstep, voffB);
    PG8_WAIT_V(6); PG8_BAR;
    for (;;) {
        const bool has_next = S.next(ui + 1, nxt);
        const char* nA = has_next ? (const char*)g.A + (size_t)nxt.pm * tstep : cA; const char* nB = has_next ? (const char*)g.Bt + (size_t)nxt.pn * tstep : cB;
        for (int t = 0; t < nt; t += 2) {
            const bool last = (t == nt - 2);
            const char* a1 = cA + (size_t)(t + 1) * kstep;
            const char* a2 = last ? nA : cA + (size_t)(t + 2) * kstep; const char* b2 = last ? nB : cB + (size_t)(t + 2) * kstep;
            const char* a3 = a2 + kstep; const char* b3 = b2 + kstep;
            if (last && has_next) S.a_ready(nxt);
            PG8_LDB(B0, 0, 0); PG8_SCHED; PG8_LDA(At, 0, 0); PG8_STAGE(PG8_SA(1, 1), a1 + hstep, voffA);
            PG8_WAIT_L(8); PG8_BAR; PG8_WAIT_L(0); PG8_MMA(0, 0, At, B0); PG8_BAR; PG8_SCHED;
            PG8_LDB(B1, 0, 1); PG8_STAGE(PG8_SB(0, 0), b2, voffB);
            PG8_BAR; PG8_WAIT_L(0); PG8_MMA(0, 1, At, B1); PG8_BAR;
            PG8_LDA(At, 0, 1); PG8_STAGE(PG8_SA(0, 0), a2, voffA);
            PG8_BAR; PG8_WAIT_L(0); PG8_MMA(1, 0, At, B0); PG8_BAR; PG8_SCHED;
            PG8_STAGE(PG8_SB(0, 1), b2 + hstep, voffB);
            PG8_WAIT_V(6); PG8_BAR; PG8_MMA(1, 1, At, B1); PG8_BAR;
            PG8_LDB(B0, 1, 0); PG8_SCHED; PG8_LDA(At, 1, 0); PG8_STAGE(PG8_SA(0, 1), a2 + hstep, voffA);
            PG8_WAIT_L(8); PG8_BAR; PG8_WAIT_L(0); PG8_MMA(0, 0, At, B0); PG8_BAR; PG8_SCHED;
            PG8_LDB(B1, 1, 1); PG8_STAGE(PG8_SB(1, 0), b3, voffB);
            PG8_BAR; PG8_WAIT_L(0); PG8_MMA(0, 1, At, B1); PG8_BAR;
            PG8_LDA(At, 1, 1); PG8_STAGE(PG8_SA(1, 0), a3, voffA);
            PG8_BAR; PG8_WAIT_L(0); PG8_MMA(1, 0, At, B0); PG8_BAR; PG8_SCHED;
            PG8_STAGE(PG8_SB(1, 1), b3 + hstep, voffB);
            PG8_WAIT_V(6); PG8_BAR; PG8_MMA(1, 1, At, B1); PG8_BAR;
        }
        if constexpr (!Epi::AFTER_DRAIN) { E(acc, cur, wr, wc, fr, fq); S.done(cur); }
        if (!has_next) break;
#pragma unroll
        for (int a = 0; a < 2; ++a)
#pragma unroll
            for (int b = 0; b < 2; ++b)
#pragma unroll
                for (int m = 0; m < 4; ++m)
#pragma unroll
                    for (int n = 0; n < 2; ++n) acc[a][b][m][n] = (f32x4){0.f, 0.f, 0.f, 0.f};
        cur = nxt; cA = nA; cB = nB; ++ui;
    }
    PG8_WAIT_V(0);
    if (wr == 0) PG8_BAR;
    PG8_BAR;
    if constexpr (Epi::AFTER_DRAIN) { E.fused(acc, cur, wr, wc, fr, fq, lds, wid, lane); S.done(cur); }
#undef PG8_SA
#undef PG8_SB
#undef PG8_STAGE
#undef PG8_LDA
#undef PG8_LDB
#undef PG8_MMA
#undef PG8_WAIT_V
#undef PG8_WAIT_L
#undef PG8_BAR
#undef PG8_SCHED
}
#endif
}

struct Params {
    const float *xp, *xs, *memp, *cckv, *ckpe, *cmk, *cmv, *sgla; const int* ptab;
    const float *g_mix, *w_a2, *b_a, *g_gla_o, *g_qa, *g_kva, *g_qn, *g_kn, *g_qr, *g_kr, *g_x, *g_mem, *g_xq, *g_xk, *g_ff;
    float *y, *o_ckvp, *o_kpep, *o_mkp, *o_mvp, *o_glap, *o_ckvs, *o_kpes, *o_glas;
    unsigned* ctl;
    bf16 *wt_in, *wt_qb, *wt_kvb, *wt_out, *wt_xq, *wt_xkv, *wt_xo, *wt_ff1, *wt_ff2;
    bf16 *X1B, *X2B, *H, *MEMN, *Z, *QAN, *CKVB, *KPB, *MKB, *MVB, *QF, *KV, *QN, *KN, *OMIX, *XQ, *XO, *U;
    float *MKV, *LOGA, *DS, *DDEC, *X1, *X2, *PACC, *PML, *ROPE;
    const float *w_in, *w_qb, *w_kvb, *w_out, *w_xq, *w_xk, *w_xv, *w_xo, *w_ff1, *w_ff2;
};
constexpr int CW_Q5 = 0, CW_QX = 512, CW_BAR = 4096, CW_STAMP = 8192;
#ifdef EMU
#define STAMP(i) do {} while (0)
#else
#define STAMP(i) do { if (PROBE_A >= 0 && blockIdx.x == 0 && threadIdx.x == 0) ((volatile unsigned long long*)(p.ctl + CW_STAMP))[i] = wall_clock64(); } while (0)
#endif

template <int ACT  > struct EpiStoreBf16 {
    static constexpr bool PERM = true, AFTER_DRAIN = false;
    bf16* O; int ldc;
    DI void operator()(const f32x4 (&acc)[2][2][4][2], const pg8::Unit& u, int wr, int wc, int fr, int fq) const {
        const int row0 = u.pm * 256 + wr * 64 + fr, col0 = u.pn * 256 + wc * 32 + 8 * fq;
#pragma unroll
        for (int ai = 0; ai < 2; ++ai)
#pragma unroll
            for (int m = 0; m < 4; ++m) { bf16* rowp = O + (size_t)(row0 + ai * 128 + m * 16) * ldc + col0;
#pragma unroll
                for (int bj = 0; bj < 2; ++bj) { f32x4 v0 = acc[ai][bj][m][0], v1 = acc[ai][bj][m][1];
                    if (ACT == 1) {
#pragma unroll
                        for (int j = 0; j < 4; ++j) { const float a = fmaxf(v0[j], 0.f), b = fmaxf(v1[j], 0.f); v0[j] = a * a; v1[j] = b * b; } }
                    u32x4 w; w[0] = pk2(v0[0], v0[1]); w[1] = pk2(v0[2], v0[3]); w[2] = pk2(v1[0], v1[1]); w[3] = pk2(v1[2], v1[3]);
                    *(u32x4*)(rowp + bj * 128) = w; } }
    }
};
struct EpiStoreF32 {
    static constexpr bool PERM = false, AFTER_DRAIN = false;
    float* C; const float* R; int ldc;
    DI void operator()(const f32x4 (&acc)[2][2][4][2], const pg8::Unit& u, int wr, int wc, int fr, int fq) const {
        const int row0 = u.pm * 256 + wr * 64 + fr, col0 = u.pn * 256 + wc * 32 + 4 * fq;
#pragma unroll
        for (int ai = 0; ai < 2; ++ai)
#pragma unroll
            for (int m = 0; m < 4; ++m) { const size_t off = (size_t)(row0 + ai * 128 + m * 16) * ldc + col0;
#pragma unroll
                for (int bj = 0; bj < 2; ++bj)
#pragma unroll
                    for (int n = 0; n < 2; ++n) { f32x4 v = acc[ai][bj][m][n]; if (R) v += *(const f32x4*)(R + off + bj * 128 + n * 16); *(f32x4*)(C + off + bj * 128 + n * 16) = v; } }
    }
};
template <class Epi> DI void run_gemm(LDS unsigned char* lds, const bf16* A, const bf16* Bt, int M, int N, int K, const Epi& E, int rot) {
    pg8::Gemm g{A, Bt, M, N, K}; pg8::StaticOrder S; S.init(M, N, (int)gridDim.x, (int)((blockIdx.x + rot) % gridDim.x));
    pg8::gemm_phase<Epi, pg8::StaticOrder>(lds, g, S, E);
}


struct SEpiBf16 { bf16* O; int ld; int act;
    DI void put(int row, int col, f32x4 v) const { if (act) {
#pragma unroll
            for (int j = 0; j < 4; ++j) { const float a = fmaxf(v[j], 0.f); v[j] = a * a; } }
        u32x2 w; w[0] = pk2(v[0], v[1]); w[1] = pk2(v[2], v[3]); *(u32x2*)(O + (size_t)row * ld + col) = w; } };
struct SEpiRes { float* C; const float* R;
    DI void put(int row, int col, f32x4 v) const { *(f32x4*)(C + (size_t)row * DM + col) = v + *(const f32x4*)(R + (size_t)row * DM + col); } };
template <class SE> DI void small_gemm(LDS unsigned char* lds, const bf16* A, const bf16* Bt, int N, int K, const SE& E, int rot) {
    const int tid = tid_opaque(), wid = __builtin_amdgcn_readfirstlane(tid >> 6), lane = tid & 63, r = lane & 31, hh = lane >> 5;
    const int nN = N / 64, nunits = (TS / 64) * nN, kw = K / 8, nks = kw / 16;
    LDS float* RED = (LDS float*)lds;
    for (int u = (int)((blockIdx.x + rot) % gridDim.x); u < nunits; u += gridDim.x) {
        const int um = u / nN, un = u % nN;
        const bf16* ap = A + (size_t)(TP + um * 64 + r) * K + wid * kw + 8 * hh;
        const bf16* bp = Bt + (size_t)(un * 64 + r) * K + wid * kw + 8 * hh;
        f32x16 acc[2][2];
#pragma unroll
        for (int i = 0; i < 2; ++i)
#pragma unroll
            for (int j = 0; j < 2; ++j) acc[i][j] = zero16();
        for (int k0 = 0; k0 < nks; k0 += 4) {
            bf16x8 af[4][2], bfr[4][2];
#pragma unroll
            for (int q = 0; q < 4; ++q) if (k0 + q < nks) {
#pragma unroll
                for (int t = 0; t < 2; ++t) { af[q][t] = ld8g(ap + (size_t)t * 32 * K + 16 * (k0 + q)); bfr[q][t] = ld8g(bp + (size_t)t * 32 * K + 16 * (k0 + q)); } }
#pragma unroll
            for (int q = 0; q < 4; ++q) if (k0 + q < nks) {
#pragma unroll
                for (int mt = 0; mt < 2; ++mt)
#pragma unroll
                    for (int nt = 0; nt < 2; ++nt) acc[mt][nt] = mfma32(bfr[q][nt], af[q][mt], acc[mt][nt]); }
        }
#pragma unroll
        for (int mt = 0; mt < 2; ++mt)
#pragma unroll
            for (int nt = 0; nt < 2; ++nt)
#pragma unroll
                for (int g = 0; g < 4; ++g) *(LDS f32x4*)(RED + wid * 4096 + (32 * mt + r) * 64 + 32 * nt + 8 * g + 4 * hh) = (f32x4){acc[mt][nt][4 * g], acc[mt][nt][4 * g + 1], acc[mt][nt][4 * g + 2], acc[mt][nt][4 * g + 3]};
        __syncthreads();
#pragma unroll
        for (int j = 0; j < 2; ++j) { const int gidx = tid + NTHREADS * j, row = gidx >> 4, c4 = (gidx & 15) * 4; f32x4 s = *(const LDS f32x4*)(RED + row * 64 + c4);
#pragma unroll
            for (int w = 1; w < 8; ++w) s += *(const LDS f32x4*)(RED + w * 4096 + row * 64 + c4);
            E.put(TP + um * 64 + row, un * 64 + c4, s); }
        __syncthreads();
    }
}

DI const float* xrow(const Params& p, int t) { return t < TP ? p.xp + (size_t)t * DM : p.xs + (size_t)(t - TP) * DM; }
DI void rmsnorm_row_1024(const float* src, const float* g, bf16* dst, int lane) {
    f32x4 v[4]; float ss = 0.f;
#pragma unroll
    for (int i = 0; i < 4; ++i) { v[i] = *(const f32x4*)(src + 4 * (lane + 64 * i)); ss += v[i][0] * v[i][0] + v[i][1] * v[i][1] + v[i][2] * v[i][2] + v[i][3] * v[i][3]; }
    ss = wsum(ss); const float rs = rsqrtf(ss * (1.0f / 1024.0f) + EPS);
#pragma unroll
    for (int i = 0; i < 4; ++i) { const f32x4 gg = *(const f32x4*)(g + 4 * (lane + 64 * i)); u32x2 w; w[0] = pk2(v[i][0] * rs * gg[0], v[i][1] * rs * gg[1]); w[1] = pk2(v[i][2] * rs * gg[2], v[i][3] * rs * gg[3]);
        *(u32x2*)(dst + 4 * (lane + 64 * i)) = w; }
}
template <int NR> DI void rmsnorm_rows(const float* src, const float* g, bf16* dst, int row0, int rstride, int nrows, int lane) {
    f32x4 v[NR][4]; f32x4 gg[4];
#pragma unroll
    for (int j = 0; j < NR; ++j) { const int row = row0 + j * rstride;
#pragma unroll
        for (int i = 0; i < 4; ++i) v[j][i] = row < nrows ? *(const f32x4*)(src + (size_t)row * DM + 4 * (lane + 64 * i)) : (f32x4){0.f, 0.f, 0.f, 0.f}; }
#pragma unroll
    for (int i = 0; i < 4; ++i) gg[i] = *(const f32x4*)(g + 4 * (lane + 64 * i));
    float ss[NR];
#pragma unroll
    for (int j = 0; j < NR; ++j) { ss[j] = 0.f;
#pragma unroll
        for (int i = 0; i < 4; ++i) ss[j] += v[j][i][0] * v[j][i][0] + v[j][i][1] * v[j][i][1] + v[j][i][2] * v[j][i][2] + v[j][i][3] * v[j][i][3]; }
#pragma unroll
    for (int o = 32; o >= 1; o >>= 1) {
#pragma unroll
        for (int j = 0; j < NR; ++j) ss[j] += __shfl_xor(ss[j], o); }
#pragma unroll
    for (int j = 0; j < NR; ++j) { const int row = row0 + j * rstride; if (row < nrows) { const float rs = rsqrtf(ss[j] * (1.0f / 1024.0f) + EPS);
#pragma unroll
            for (int i = 0; i < 4; ++i) { u32x2 w; w[0] = pk2(v[j][i][0] * rs * gg[i][0], v[j][i][1] * rs * gg[i][1]); w[1] = pk2(v[j][i][2] * rs * gg[i][2], v[j][i][3] * rs * gg[i][3]);
                *(u32x2*)(dst + (size_t)row * DM + 4 * (lane + 64 * i)) = w; } } }
}
template <int K, int N, int NPAD> DI void prep_job(const float* W, bf16* Wt, LDS float* tl, int rot) {
    const int tid = tid_opaque(); constexpr int nkt = K / 64, ntiles = (NPAD / 64) * nkt;
    for (int tile = (int)((blockIdx.x + rot) % gridDim.x); tile < ntiles; tile += gridDim.x) {
        const int tn = tile / nkt, tk = tile % nkt;
        { const int kk = tid >> 3, n8 = (tid & 7) * 8; const int n = tn * 64 + n8; const float* s = W + (size_t)(tk * 64 + kk) * N + n;
            f32x4 a = {0.f, 0.f, 0.f, 0.f}, b = a; if (n < N) { a = *(const f32x4*)s; b = *(const f32x4*)(s + 4); }
#pragma unroll
            for (int q = 0; q < 4; ++q) { tl[kk * 65 + n8 + q] = a[q]; tl[kk * 65 + n8 + 4 + q] = b[q]; } }
        __syncthreads();
        { const int nn = tid >> 3, k8 = (tid & 7) * 8; u32x4 w;
#pragma unroll
            for (int q = 0; q < 4; ++q) w[q] = pk2(tl[(k8 + 2 * q) * 65 + nn], tl[(k8 + 2 * q + 1) * 65 + nn]);
            *(u32x4*)(Wt + (size_t)(tn * 64 + nn) * K + tk * 64 + k8) = w; }
        __syncthreads();
    }
}
DI void phase_prep(const Params& p, LDS unsigned char* lds) {
    const int tid = tid_opaque(), wid = __builtin_amdgcn_readfirstlane(tid >> 6), lane = tid & 63;
    LDS float* tl = (LDS float*)lds;
    prep_job<DM, DIN, DINP>(p.w_in, p.wt_in, tl, 0); prep_job<384, 768, 768>(p.w_qb, p.wt_qb, tl, 64); prep_job<256, 1024, 1024>(p.w_kvb, p.wt_kvb, tl, 136); prep_job<DM, DM, DM>(p.w_out, p.wt_out, tl, 200);
    prep_job<DM, 512, 512>(p.w_xq, p.wt_xq, tl, 0); prep_job<DM, 512, 512>(p.w_xk, p.wt_xkv, tl, 128); prep_job<DM, 512, 512>(p.w_xv, p.wt_xkv + (size_t)512 * DM, tl, 0); prep_job<512, DM, DM>(p.w_xo, p.wt_xo, tl, 128);
    prep_job<DM, DFF, DFF>(p.w_ff1, p.wt_ff1, tl, 0); prep_job<DFF, DM, DM>(p.w_ff2, p.wt_ff2, tl, 0);
    for (int e = blockIdx.x * NTHREADS + tid; e < (SEQ + DECS) * 16; e += gridDim.x * NTHREADS) { const int pi = e >> 4, i = e & 15; const int pos = pi < SEQ ? pi : PAST + (pi - SEQ);
        const float ang = (float)pos * expf(-(float)i * (9.210340371976184f / 16.0f)); p.ROPE[2 * e] = cosf(ang); p.ROPE[2 * e + 1] = sinf(ang); }
    { const int ws = gridDim.x * 8, w0 = blockIdx.x * 8 + wid;
        for (int row = w0; row < TP; row += 4 * ws) rmsnorm_rows<4>(p.xp, p.g_mix, p.H, row, ws, TP, lane);
        for (int row = w0; row < TS; row += 4 * ws) rmsnorm_rows<4>(p.xs, p.g_mix, p.H + (size_t)TP * DM, row, ws, TS, lane);
        for (int row = w0; row < MROWS; row += 4 * ws) rmsnorm_rows<4>(p.memp, p.g_mem, p.MEMN, row, ws, MROWS, lane); }
}

DI float rope32(const float* ROPE, float xn, int lane, int pidx) {
    const float partner = __shfl_xor(xn, 16);
    const float c = ROPE[(pidx * 16 + (lane & 15)) * 2], s = ROPE[(pidx * 16 + (lane & 15)) * 2 + 1];
    return (lane & 16) ? xn * c + partner * s : xn * c - partner * s;
}
DI int row_pidx(int t) { return t < TP ? (t % SEQ) : SEQ + ((t - TP) % DECS); }

DI void phase_post_in(const Params& p) {
    const int tid = tid_opaque(), wid = __builtin_amdgcn_readfirstlane(tid >> 6), lane = tid & 63;
    f32x4 w2[16];
#pragma unroll
    for (int i = 0; i < 16; ++i) w2[i] = *(const f32x4*)(p.w_a2 + i * 256 + 4 * lane);
    const f32x4 b2 = *(const f32x4*)(p.b_a + 4 * lane);
    for (int row = blockIdx.x * 8 + wid; row < T + MROWS; row += gridDim.x * 8) {
        if (row < T) {
            const int t = row; const bf16* z = p.Z + (size_t)t * DINP;
            const bf16x8 a0 = ld8g(z + ZA), a1 = ld8g(z + ZA + 8);
            bf16x8 cq = zero8(), ck = zero8(); if (lane < 48) cq = ld8g(z + ZQA + 8 * lane); if (lane < 32) ck = ld8g(z + ZKVA + 8 * lane);
            const float vp = lane < 32 ? bf2f(z[ZKPE + lane]) : 0.f;
            { f32x4 gp = b2;
#pragma unroll
                for (int i = 0; i < 8; ++i) { gp += bf2f((bf16)a0[i]) * w2[i]; gp += bf2f((bf16)a1[i]) * w2[8 + i]; }
                f32x4 la;
#pragma unroll
                for (int j = 0; j < 4; ++j) { const float x = gp[j]; la[j] = (fminf(x, 0.f) - 0.6931471805599453f * flog2(1.0f + fexp(-fabsf(x)))) * (1.0f / 16.0f); }
                *(f32x4*)(p.LOGA + (size_t)t * 256 + 4 * lane) = la; }
            float fq[8], fk[8]; float sq = 0.f, sk = 0.f;
#pragma unroll
            for (int j = 0; j < 8; ++j) { fq[j] = bf2f((bf16)cq[j]); fk[j] = bf2f((bf16)ck[j]); sq += fq[j] * fq[j]; sk += fk[j] * fk[j]; }
            float sp = vp * vp;
#pragma unroll
            for (int o = 32; o >= 1; o >>= 1) { sq += __shfl_xor(sq, o); sk += __shfl_xor(sk, o); sp += __shfl_xor(sp, o); }
            const float rq = rsqrtf(sq * (1.0f / 384.0f) + EPS), rk = rsqrtf(sk * (1.0f / 256.0f) + EPS), rp = rsqrtf(sp * (1.0f / 32.0f) + EPS);
            if (lane < 48) { const f32x4 g0 = *(const f32x4*)(p.g_qa + 8 * lane), g1 = *(const f32x4*)(p.g_qa + 8 * lane + 4);
                *(bf16x8*)(p.QAN + (size_t)t * 384 + 8 * lane) = pack8(fq[0] * rq * g0[0], fq[1] * rq * g0[1], fq[2] * rq * g0[2], fq[3] * rq * g0[3], fq[4] * rq * g1[0], fq[5] * rq * g1[1], fq[6] * rq * g1[2], fq[7] * rq * g1[3]); }
            if (lane < 32) { const f32x4 g0 = *(const f32x4*)(p.g_kva + 8 * lane), g1 = *(const f32x4*)(p.g_kva + 8 * lane + 4);
                const f32x4 c0 = {fk[0] * rk * g0[0], fk[1] * rk * g0[1], fk[2] * rk * g0[2], fk[3] * rk * g0[3]}, c1 = {fk[4] * rk * g1[0], fk[5] * rk * g1[1], fk[6] * rk * g1[2], fk[7] * rk * g1[3]};
                float* oc = t < TP ? p.o_ckvp + (size_t)t * 256 : p.o_ckvs + (size_t)(t - TP) * 256;
                *(f32x4*)(oc + 8 * lane) = c0; *(f32x4*)(oc + 8 * lane + 4) = c1;
                *(bf16x8*)(p.CKVB + (size_t)t * 256 + 8 * lane) = pack8(c0[0], c0[1], c0[2], c0[3], c1[0], c1[1], c1[2], c1[3]); }
            { const float xn = vp * rp * p.g_kr[lane & 31]; const float o = rope32(p.ROPE, xn, lane, row_pidx(t));
                if (lane < 32) { float* ok = t < TP ? p.o_kpep + (size_t)t * 32 : p.o_kpes + (size_t)(t - TP) * 32; ok[lane] = o; p.KPB[(size_t)t * 32 + lane] = f2bf(o); } }
        } else {
            const int r = row - T; const float* s = p.MKV + (size_t)r * 1024;
            const f32x4 k0 = *(const f32x4*)(s + lane * 8), k1 = *(const f32x4*)(s + lane * 8 + 4), v0 = *(const f32x4*)(s + 512 + lane * 8), v1 = *(const f32x4*)(s + 512 + lane * 8 + 4);
            float ss = k0[0] * k0[0] + k0[1] * k0[1] + k0[2] * k0[2] + k0[3] * k0[3] + k1[0] * k1[0] + k1[1] * k1[1] + k1[2] * k1[2] + k1[3] * k1[3];
            ss += __shfl_xor(ss, 1); ss += __shfl_xor(ss, 2); ss += __shfl_xor(ss, 4); ss += __shfl_xor(ss, 8);
            const float rs = rsqrtf(ss * (1.0f / 128.0f) + EPS); const int c = (lane * 8) & 127;
            const f32x4 g0 = *(const f32x4*)(p.g_xk + c), g1 = *(const f32x4*)(p.g_xk + c + 4);
            const f32x4 m0 = {k0[0] * rs * g0[0], k0[1] * rs * g0[1], k0[2] * rs * g0[2], k0[3] * rs * g0[3]}, m1 = {k1[0] * rs * g1[0], k1[1] * rs * g1[1], k1[2] * rs * g1[2], k1[3] * rs * g1[3]};
            *(f32x4*)(p.o_mkp + (size_t)r * 512 + lane * 8) = m0; *(f32x4*)(p.o_mkp + (size_t)r * 512 + lane * 8 + 4) = m1;
            *(bf16x8*)(p.MKB + (size_t)r * 512 + lane * 8) = pack8(m0[0], m0[1], m0[2], m0[3], m1[0], m1[1], m1[2], m1[3]);
            *(f32x4*)(p.o_mvp + (size_t)r * 512 + lane * 8) = v0; *(f32x4*)(p.o_mvp + (size_t)r * 512 + lane * 8 + 4) = v1;
            *(bf16x8*)(p.MVB + (size_t)r * 512 + lane * 8) = pack8(v0[0], v0[1], v0[2], v0[3], v1[0], v1[1], v1[2], v1[3]);
        }
    }
}

DI void phase_post_qkv(const Params& p) {
    const int tid = tid_opaque(), wid = __builtin_amdgcn_readfirstlane(tid >> 6), lane = tid & 63;
    for (int t = TP + blockIdx.x * 8 + wid; t < T; t += gridDim.x * 8) {
        const bf16* qf = p.QF + (size_t)t * 768; const int pos = row_pidx(t);
        for (int h = 0; h < 8; ++h) {
            const float v = bf2f(qf[h * 96 + lane]); const float ss = wsum(v * v); const float rs = rsqrtf(ss * (1.0f / 64.0f) + EPS);
            p.QN[((size_t)t * 8 + h) * 96 + lane] = f2bf(v * rs * p.g_qn[lane] * MLA_SCALE);
            const float vr = lane < 32 ? bf2f(qf[h * 96 + 64 + lane]) : 0.f; const float ssr = wsum(vr * vr); const float rsr = rsqrtf(ssr * (1.0f / 32.0f) + EPS);
            const float xr = vr * rsr * p.g_qr[lane & 31]; const float o = rope32(p.ROPE, xr, lane, pos);
            if (lane < 32) p.QN[((size_t)t * 8 + h) * 96 + 64 + lane] = f2bf(o * MLA_SCALE);
        }
    }
}
struct GlaUnit { int t0, h, nv; };
DI GlaUnit gla_unit(int u) { GlaUnit g; if (u < NGP) { const int b = u / (4 * NC), h = (u / NC) % 4, c = u % NC; g.t0 = b * SEQ + c * 64; g.h = h; g.nv = 64; } else { const int us = u - NGP; g.t0 = TP + (us >> 2) * DECS; g.h = us & 3; g.nv = DECS; } return g; }
constexpr int GL_QK = 0, GL_V = 16384, GL_S = 32768, GL_TOT = 49152, GL_SS = GL_TOT + 2048, GL_END = GL_SS + 1024;
static_assert(GL_END <= LDS_CTL, "GLA LDS map");
struct GlaIn { float la[8]; bf16 q[8], k[8]; bf16x8 v[2]; f32x4 s[4]; s16x4 rg[4]; };
template <bool PHASE_C> DI void gla_load(const Params& p, int u, int tid, GlaIn& in) {
    const GlaUnit g = gla_unit(u); const int c = tid & 63, sb = tid >> 6;
#pragma unroll
    for (int i = 0; i < 8; ++i) { const int s = 8 * sb + i; const bool ok = s < g.nv; const bf16* z = p.Z + (size_t)(g.t0 + (ok ? s : 0)) * DINP;
        in.la[i] = ok ? p.LOGA[(size_t)(g.t0 + s) * 256 + g.h * 64 + c] : 0.f; in.k[i] = ok ? z[ZK + g.h * 64 + c] : (bf16)0; if (PHASE_C) in.q[i] = ok ? z[ZQ + g.h * 64 + c] : (bf16)0; }
#pragma unroll
    for (int j = 0; j < 2; ++j) { const int cidx = tid + NTHREADS * j, s = cidx >> 4, ch = cidx & 15; in.v[j] = zero8(); if (s < g.nv) in.v[j] = ld8g(p.Z + (size_t)(g.t0 + s) * DINP + ZV + g.h * 128 + ch * 8); }
    if (PHASE_C) { const float* sp = u < NGP ? p.DS + (size_t)u * 8192 : p.sgla + (size_t)(u - NGP) * 8192;
#pragma unroll
        for (int j = 0; j < 2; ++j) { const int cidx = tid + NTHREADS * j, kd = cidx >> 4, ch = cidx & 15; in.s[2 * j] = *(const f32x4*)(sp + kd * 128 + ch * 8); in.s[2 * j + 1] = *(const f32x4*)(sp + kd * 128 + ch * 8 + 4); }
        const int wid = tid >> 6, lane = tid & 63, r = lane & 31, hh = lane >> 5, dvt = wid & 3, tt = wid >> 2, t = 32 * tt + r; const bool ok = t < g.nv;
        const bf16* z = p.Z + (size_t)(g.t0 + (ok ? t : 0)) * DINP + ZR + g.h * 128 + 32 * dvt + 4 * hh;
#pragma unroll
        for (int q = 0; q < 4; ++q) in.rg[q] = *(const s16x4*)(z + 8 * q); }
}
DI float gla_scan(LDS unsigned char* lds, int c, int sb, const float (&la)[8], float (&b)[8]) {
    LDS float* TOT = (LDS float*)(lds + GL_TOT); float a = 0.f;
#pragma unroll
    for (int i = 0; i < 8; ++i) { a += la[i]; b[i] = a; }
    TOT[sb * 64 + c] = a;
    __syncthreads();
    float pre = 0.f, tot = 0.f;
#pragma unroll
    for (int q = 0; q < 8; ++q) { const float v = TOT[q * 64 + c]; tot += v; if (q < sb) pre += v; }
#pragma unroll
    for (int i = 0; i < 8; ++i) b[i] += pre;
    return tot;
}
DI void gla_put(LDS unsigned char* img, int row, int col, float v) { *(LDS bf16*)(img + imgb(row, col >> 3) + 2 * (col & 7)) = f2bf(v); }
DI unsigned tr_lane_off_nat(unsigned lane, unsigned c, unsigned plus4) {
    const unsigned hh = lane >> 5, blk = (lane >> 4) & 1, q = (lane & 15) >> 2, pp = lane & 3;
    return imgb(8 * hh + q + 4 * plus4, 4 * c + 2 * blk + (pp >> 1)) + 8 * (pp & 1);
}
DI void phase_gla_a(const Params& p, LDS unsigned char* lds) {
    const int tid = tid_opaque(), wid = __builtin_amdgcn_readfirstlane(tid >> 6), lane = tid & 63, r = lane & 31, hh = lane >> 5;
    const int c = tid & 63, sb = tid >> 6, mt = wid & 1, nt = wid >> 1;
    const LDS unsigned char* pa0 = lds + GL_QK + tr_lane_off_nat(lane, mt, 0); const LDS unsigned char* pa1 = lds + GL_QK + tr_lane_off_nat(lane, mt, 1);
    const LDS unsigned char* pb0 = lds + GL_V + tr_lane_off_nat(lane, nt, 0); const LDS unsigned char* pb1 = lds + GL_V + tr_lane_off_nat(lane, nt, 1);
    GlaIn nx; int u = blockIdx.x;
    if (u < NGU) gla_load<false>(p, u, tid, nx);
    for (; u < NGU; u += gridDim.x) {
        GlaIn in = nx; const int un = u + gridDim.x; if (un < NGU) gla_load<false>(p, un, tid, nx);
        float b[8]; const float bl = gla_scan(lds, c, sb, in.la, b);
#pragma unroll
        for (int i = 0; i < 8; ++i) gla_put(lds + GL_QK, 8 * sb + i, c, bf2f(in.k[i]) * fexp(bl - b[i]));
#pragma unroll
        for (int j = 0; j < 2; ++j) { const int cidx = tid + NTHREADS * j; *(LDS bf16x8*)(lds + GL_V + imgb(cidx >> 4, cidx & 15)) = in.v[j]; }
        if (tid < 64) p.DDEC[(size_t)u * 64 + tid] = fexp(bl);
        __syncthreads();
        { f32x16 acc = zero16(); bf16x8 a0, b0, a1, b1;
            img_tr4p_pre<0, 16>(pa0, pa1, pb0, pb1, a0, b0, a1, b1); acc = mfma32(a0, b0, acc); acc = mfma32(a1, b1, acc);
            img_tr4p_pre<32, 48>(pa0, pa1, pb0, pb1, a0, b0, a1, b1); acc = mfma32(a0, b0, acc); acc = mfma32(a1, b1, acc);
            float* d = p.DS + (size_t)u * 8192;
#pragma unroll
            for (int i = 0; i < 16; ++i) d[(32 * mt + crow(i, hh)) * 128 + 32 * nt + r] = acc[i]; }
        __syncthreads();
    }
}
DI void phase_gla_b(const Params& p) {
    const int gid = blockIdx.x * NTHREADS + tid_opaque(), gsz = gridDim.x * NTHREADS;
    for (int e4 = gid; e4 < BATCH * 4 * 2048; e4 += gsz) { const int bh = e4 >> 11, idx = (e4 & 2047) * 4, kd = idx >> 7; f32x4 S = {0.f, 0.f, 0.f, 0.f};
#pragma unroll 8
        for (int c = 0; c < NC; ++c) { const size_t u = (size_t)bh * NC + c; float* dp = p.DS + u * 8192 + idx; const f32x4 d = *(const f32x4*)dp; *(f32x4*)dp = S; S = S * p.DDEC[u * 64 + kd] + d; }
        *(f32x4*)(p.o_glap + (size_t)bh * 8192 + idx) = S; }
    for (int e4 = gid; e4 < DECB * 4 * 2048; e4 += gsz) { const int bh = e4 >> 11, idx = (e4 & 2047) * 4, kd = idx >> 7; const size_t u = (size_t)NGP + bh;
        *(f32x4*)(p.o_glas + (size_t)bh * 8192 + idx) = *(const f32x4*)(p.sgla + (size_t)bh * 8192 + idx) * p.DDEC[u * 64 + kd] + *(const f32x4*)(p.DS + u * 8192 + idx); }
}
DI void phase_gla_c(const Params& p, LDS unsigned char* lds) {
    const int tid = tid_opaque(), wid = __builtin_amdgcn_readfirstlane(tid >> 6), lane = tid & 63, r = lane & 31, hh = lane >> 5;
    const int c = tid & 63, sb = tid >> 6, dvt = wid & 3, tt = wid >> 2;
    const LDS unsigned char* ps0 = lds + GL_S + tr_lane_off_nat(lane, dvt, 0); const LDS unsigned char* ps1 = lds + GL_S + tr_lane_off_nat(lane, dvt, 1);
    const LDS unsigned char* pv0 = lds + GL_V + tr_lane_off(lane, dvt, 0); const LDS unsigned char* pv1 = lds + GL_V + tr_lane_off(lane, dvt, 1);
    unsigned xo[8];
#pragma unroll
    for (int ks = 0; ks < 8; ++ks) xo[ks] = imgb(r, 2 * ks + hh);
    GlaIn nx; int u = blockIdx.x;
    if (u < NGU) gla_load<true>(p, u, tid, nx);
    for (; u < NGU; u += gridDim.x) {
        GlaIn in = nx; const int un = u + gridDim.x; if (un < NGU) gla_load<true>(p, un, tid, nx);
        const GlaUnit g = gla_unit(u);
        { float b[8]; gla_scan(lds, c, sb, in.la, b);
#pragma unroll
            for (int i = 0; i < 8; ++i) { gla_put(lds + GL_QK, 8 * sb + i, c, bf2f(in.q[i]) * fexp(b[i]) * 0.125f); gla_put(lds + GL_QK, 8 * sb + i, 64 + c, bf2f(in.k[i]) * fexp(-b[i])); } }
#pragma unroll
        for (int j = 0; j < 2; ++j) { const int cidx = tid + NTHREADS * j; *(LDS bf16x8*)(lds + GL_V + imgb(cidx >> 4, cidx & 15)) = in.v[j];
            *(LDS bf16x8*)(lds + GL_S + imgb(cidx >> 4, cidx & 15)) = pack8(in.s[2 * j][0], in.s[2 * j][1], in.s[2 * j][2], in.s[2 * j][3], in.s[2 * j + 1][0], in.s[2 * j + 1][1], in.s[2 * j + 1][2], in.s[2 * j + 1][3]); }
        __syncthreads();
        const LDS unsigned char* qk = lds + GL_QK + 8192 * tt;
#define GL_Q(ks) (*(const LDS bf16x8*)(qk + xo[ks]))
        f32x16 o = zero16();
        { bf16x8 a0, a1, a2, a3; img_tr4p_pre<0, 16>(ps0, ps1, ps0 + 256 * 32, ps1 + 256 * 32, a0, a2, a1, a3);
            o = mfma32(a0, GL_Q(0), o); o = mfma32(a1, GL_Q(1), o); o = mfma32(a2, GL_Q(2), o); o = mfma32(a3, GL_Q(3), o); }
#pragma unroll
        for (int st = 0; st < 2; ++st) if (st <= tt) {
            const LDS unsigned char* kk = lds + GL_QK + 8192 * st;
            f32x16 x = zero16();
#pragma unroll
            for (int ks = 0; ks < 4; ++ks) x = mfma32(*(const LDS bf16x8*)(kk + xo[4 + ks]), GL_Q(ks), x);
            if (st == tt) {
#pragma unroll
                for (int i = 0; i < 16; ++i) if (crow(i, hh) > r) x[i] = 0.f; }
            bf16x8 v0, v1, d0, d1;
            if (st == 0) img_tr4p_pre<0, 16>(pv0, pv1, pv0, pv1, v0, d0, v1, d1); else img_tr4p_pre<32, 48>(pv0, pv1, pv0, pv1, v0, d0, v1, d1);
            o = mfma32(v0, PACK(x, 0), o); o = mfma32(v1, PACK(x, 1), o);
        }
#undef GL_Q
        LDS float* SS = (LDS float*)(lds + GL_SS); float ss = 0.f;
#pragma unroll
        for (int i = 0; i < 16; ++i) ss += o[i] * o[i];
        ss = xsum32(ss); if (hh == 0) SS[dvt * 64 + 32 * tt + r] = ss;
        __syncthreads();
        const int t = 32 * tt + r;
        if (t < g.nv) { const float rs = rsqrtf((SS[t] + SS[64 + t] + SS[128 + t] + SS[192 + t]) * (1.0f / 128.0f) + EPS);
            bf16* op = p.OMIX + (size_t)(g.t0 + t) * DM + g.h * 128 + 32 * dvt + 4 * hh; const float* gg = p.g_gla_o + 32 * dvt + 4 * hh;
#pragma unroll
            for (int q = 0; q < 4; ++q) { const f32x4 g4 = *(const f32x4*)(gg + 8 * q); float w[4];
#pragma unroll
                for (int j = 0; j < 4; ++j) { const float rr = bf2f((bf16)in.rg[q][j]); w[j] = o[4 * q + j] * rs * g4[j] * (rr / (1.0f + fexp(-rr))); }
                u32x2 pk; pk[0] = pk2(w[0], w[1]); pk[1] = pk2(w[2], w[3]); *(u32x2*)(op + 8 * q) = pk; } }
        __syncthreads();
    }
}
constexpr int PA_IMG = 0, PA_KP = 2 * 32768, PA_END = PA_KP + 2 * 128 * 40 * 2;
static_assert(PA_END <= LDS_CTL, "prompt attention LDS map");
DI void pattn_stage_load(const Params& p, size_t kr0, int h, int tid, bf16x8 (&kv)[4], bf16x8& kp) {
#pragma unroll
    for (int j = 0; j < 4; ++j) { const int c = tid + NTHREADS * j, key = c >> 4, ch = c & 15; kv[j] = ld8g(p.KV + (kr0 + key) * 1024 + h * 128 + ch * 8); }
    kp = ld8g(p.KPB + (kr0 + (tid >> 2)) * 32 + (tid & 3) * 8);
}
DI void pattn_stage_store(const Params& p, LDS unsigned char* img, LDS bf16* kpl, int tid, const bf16x8 (&kv)[4], const bf16x8& kp) {
    const int ch = tid & 15;
    f32x4 g0 = {1.f, 1.f, 1.f, 1.f}, g1 = g0; if (ch < 8) { g0 = *(const f32x4*)(p.g_kn + ch * 8); g1 = *(const f32x4*)(p.g_kn + ch * 8 + 4); }
#pragma unroll
    for (int j = 0; j < 4; ++j) { const int key = (tid + NTHREADS * j) >> 4; float f[8]; float ss = 0.f;
#pragma unroll
        for (int q = 0; q < 8; ++q) { f[q] = bf2f((bf16)kv[j][q]); ss += f[q] * f[q]; }
        ss += __shfl_xor(ss, 1); ss += __shfl_xor(ss, 2); ss += __shfl_xor(ss, 4);
        const float rs = ch < 8 ? rsqrtf(ss * (1.0f / 64.0f) + EPS) : 1.0f;
        *(LDS bf16x8*)(img + imgb(key, ch)) = pack8(f[0] * rs * g0[0], f[1] * rs * g0[1], f[2] * rs * g0[2], f[3] * rs * g0[3], f[4] * rs * g1[0], f[5] * rs * g1[1], f[6] * rs * g1[2], f[7] * rs * g1[3]); }
    *(LDS bf16x8*)(kpl + (tid >> 2) * 40 + (tid & 3) * 8) = kp;
}
DI void pattn_unit(const Params& p, LDS unsigned char* lds, int u) {
    const int tid = tid_opaque(), wid = __builtin_amdgcn_readfirstlane(tid >> 6), lane = tid & 63, r = lane & 31, hh = lane >> 5;
    const int qb = NQB - 1 - u / (BATCH * 8), bh = u % (BATCH * 8), b = bh >> 3, h = bh & 7;
    const int qw0 = qb * 256 + 32 * wid, qpos = qw0 + r; const size_t trow = (size_t)b * SEQ + qpos;
    bf16x8 kvr[4], kpr;
    pattn_stage_load(p, (size_t)b * SEQ, h, tid, kvr, kpr);
    bf16x8 qf[6];
    { float ss = 0.f, sr = 0.f; float f[6][8];
#pragma unroll
        for (int ks = 0; ks < 6; ++ks) { const bf16x8 raw = ld8g(p.QF + trow * 768 + h * 96 + 16 * ks + 8 * hh);
#pragma unroll
            for (int j = 0; j < 8; ++j) { f[ks][j] = bf2f((bf16)raw[j]); if (ks < 4) ss += f[ks][j] * f[ks][j]; else sr += f[ks][j] * f[ks][j]; } }
        ss += __shfl_xor(ss, 32); sr += __shfl_xor(sr, 32);
        const float rs = rsqrtf(ss * (1.0f / 64.0f) + EPS) * (MLA_SCALE * 1.4426950408889634f), rr = rsqrtf(sr * (1.0f / 32.0f) + EPS) * (MLA_SCALE * 1.4426950408889634f);
#pragma unroll
        for (int ks = 0; ks < 4; ++ks) { const f32x4 g0 = *(const f32x4*)(p.g_qn + 16 * ks + 8 * hh), g1 = *(const f32x4*)(p.g_qn + 16 * ks + 8 * hh + 4);
            qf[ks] = pack8(f[ks][0] * rs * g0[0], f[ks][1] * rs * g0[1], f[ks][2] * rs * g0[2], f[ks][3] * rs * g0[3], f[ks][4] * rs * g1[0], f[ks][5] * rs * g1[1], f[ks][6] * rs * g1[2], f[ks][7] * rs * g1[3]); }
        float o1[8], o2[8];
#pragma unroll
        for (int j = 0; j < 8; ++j) { const int i = 8 * hh + j; const float x1 = f[4][j] * rr * p.g_qr[i], x2 = f[5][j] * rr * p.g_qr[16 + i];
            const float c = p.ROPE[(qpos * 16 + i) * 2], s = p.ROPE[(qpos * 16 + i) * 2 + 1];
            o1[j] = x1 * c - x2 * s; o2[j] = x2 * c + x1 * s; }
        qf[4] = pack8(o1[0], o1[1], o1[2], o1[3], o1[4], o1[5], o1[6], o1[7]); qf[5] = pack8(o2[0], o2[1], o2[2], o2[3], o2[4], o2[5], o2[6], o2[7]); }
    f32x16 o0 = zero16(), o1 = zero16(); float m = -INFINITY, l = 0.f;
    const int nkt = 2 * (qb + 1);
    unsigned xo[4];
#pragma unroll
    for (int ks = 0; ks < 4; ++ks) xo[ks] = imgb(r, 2 * ks + hh);
    const unsigned t0o = tr_lane_off(lane, 2, 0), t1o = tr_lane_off(lane, 2, 1), t2o = tr_lane_off(lane, 3, 0), t3o = tr_lane_off(lane, 3, 1);
    pattn_stage_store(p, lds + PA_IMG, (LDS bf16*)(lds + PA_KP), tid, kvr, kpr);
    __syncthreads();
    for (int kt = 0; kt < nkt; ++kt) {
        const int k0 = kt * 128; LDS unsigned char* img = lds + PA_IMG + (kt & 1) * 32768; const LDS bf16* kpl = (const LDS bf16*)(lds + PA_KP) + (kt & 1) * 128 * 40;
        if (kt + 1 < nkt) pattn_stage_load(p, (size_t)b * SEQ + k0 + 128, h, tid, kvr, kpr);
        if (k0 <= qw0 + 31) {
            const bool hi = k0 + 64 <= qw0 + 31;
            const LDS unsigned char* rb0 = img + xo[0]; const LDS unsigned char* rb1 = img + xo[1]; const LDS unsigned char* rb2 = img + xo[2]; const LDS unsigned char* rb3 = img + xo[3];
            const LDS bf16* kr = kpl + r * 40 + 8 * hh;
#define PA_K(rb, j) (*(const LDS bf16x8*)((rb) + 8192 * (j)))
            f32x16 s0 = zero16(), s1 = zero16(), s2 = zero16(), s3 = zero16();
            s0 = mfma32(PA_K(rb0, 0), qf[0], s0); s1 = mfma32(PA_K(rb0, 1), qf[0], s1); s0 = mfma32(PA_K(rb1, 0), qf[1], s0); s1 = mfma32(PA_K(rb1, 1), qf[1], s1);
            s0 = mfma32(PA_K(rb2, 0), qf[2], s0); s1 = mfma32(PA_K(rb2, 1), qf[2], s1); s0 = mfma32(PA_K(rb3, 0), qf[3], s0); s1 = mfma32(PA_K(rb3, 1), qf[3], s1);
            s0 = mfma32(ld8(kr), qf[4], s0); s1 = mfma32(ld8(kr + 32 * 40), qf[4], s1); s0 = mfma32(ld8(kr + 16), qf[5], s0); s1 = mfma32(ld8(kr + 32 * 40 + 16), qf[5], s1);
            if (hi) {
                s2 = mfma32(PA_K(rb0, 2), qf[0], s2); s3 = mfma32(PA_K(rb0, 3), qf[0], s3); s2 = mfma32(PA_K(rb1, 2), qf[1], s2); s3 = mfma32(PA_K(rb1, 3), qf[1], s3);
                s2 = mfma32(PA_K(rb2, 2), qf[2], s2); s3 = mfma32(PA_K(rb2, 3), qf[2], s3); s2 = mfma32(PA_K(rb3, 2), qf[3], s2); s3 = mfma32(PA_K(rb3, 3), qf[3], s3);
                s2 = mfma32(ld8(kr + 64 * 40), qf[4], s2); s3 = mfma32(ld8(kr + 96 * 40), qf[4], s3); s2 = mfma32(ld8(kr + 64 * 40 + 16), qf[5], s2); s3 = mfma32(ld8(kr + 96 * 40 + 16), qf[5], s3); }
#undef PA_K
            if (k0 + 127 > qw0) {
#pragma unroll
                for (int i = 0; i < 16; ++i) { const int key = k0 + crow(i, hh); if (key > qpos) s0[i] = -INFINITY; if (key + 32 > qpos) s1[i] = -INFINITY; if (key + 64 > qpos) s2[i] = -INFINITY; if (key + 96 > qpos) s3[i] = -INFINITY; } }
            if (!hi) {
#pragma unroll
                for (int i = 0; i < 16; ++i) { s2[i] = -INFINITY; s3[i] = -INFINITY; } }
            float tmax = -INFINITY;
#pragma unroll
            for (int i = 0; i < 16; ++i) tmax = fmaxf(tmax, fmaxf(fmaxf(s0[i], s1[i]), fmaxf(s2[i], s3[i])));
            tmax = xmax32(tmax);
            const float mn = fmaxf(m, tmax), corr = fexp2(m - mn); m = mn; float ps = 0.f;
#pragma unroll
            for (int i = 0; i < 16; ++i) { s0[i] = fexp2(s0[i] - mn); s1[i] = fexp2(s1[i] - mn); s2[i] = fexp2(s2[i] - mn); s3[i] = fexp2(s3[i] - mn); ps += (s0[i] + s1[i]) + (s2[i] + s3[i]); }
            l = l * corr + ps;
#pragma unroll
            for (int i = 0; i < 16; ++i) { o0[i] *= corr; o1[i] *= corr; }
            const LDS unsigned char* t0 = img + t0o; const LDS unsigned char* t1 = img + t1o; const LDS unsigned char* t2 = img + t2o; const LDS unsigned char* t3 = img + t3o;
            { bf16x8 v0, v1, v2, v3; img_tr4p_pre<0, 32>(t0, t1, t2, t3, v0, v1, v2, v3); bf16x8 pa = PACK(s0, 0), pb = PACK(s1, 0);
                o0 = mfma32(v0, pa, o0); o1 = mfma32(v1, pa, o1); o0 = mfma32(v2, pb, o0); o1 = mfma32(v3, pb, o1);
                img_tr4p_pre<16, 48>(t0, t1, t2, t3, v0, v1, v2, v3); pa = PACK(s0, 1); pb = PACK(s1, 1);
                o0 = mfma32(v0, pa, o0); o1 = mfma32(v1, pa, o1); o0 = mfma32(v2, pb, o0); o1 = mfma32(v3, pb, o1); }
            if (hi) { bf16x8 v0, v1, v2, v3; img_tr4p_pre<64, 96>(t0, t1, t2, t3, v0, v1, v2, v3); bf16x8 pa = PACK(s2, 0), pb = PACK(s3, 0);
                o0 = mfma32(v0, pa, o0); o1 = mfma32(v1, pa, o1); o0 = mfma32(v2, pb, o0); o1 = mfma32(v3, pb, o1);
                img_tr4p_pre<80, 112>(t0, t1, t2, t3, v0, v1, v2, v3); pa = PACK(s2, 1); pb = PACK(s3, 1);
                o0 = mfma32(v0, pa, o0); o1 = mfma32(v1, pa, o1); o0 = mfma32(v2, pb, o0); o1 = mfma32(v3, pb, o1); }
        }
        if (kt + 1 < nkt) pattn_stage_store(p, lds + PA_IMG + ((kt + 1) & 1) * 32768, (LDS bf16*)(lds + PA_KP) + ((kt + 1) & 1) * 128 * 40, tid, kvr, kpr);
        __syncthreads();
    }
    l += __shfl_xor(l, 32); const float il = 1.0f / l;
    bf16* o = p.OMIX + trow * DM + 512 + h * 64;
#pragma unroll
    for (int g = 0; g < 4; ++g) { u32x2 w0, w1; w0[0] = pk2(o0[4 * g] * il, o0[4 * g + 1] * il); w0[1] = pk2(o0[4 * g + 2] * il, o0[4 * g + 3] * il); w1[0] = pk2(o1[4 * g] * il, o1[4 * g + 1] * il); w1[1] = pk2(o1[4 * g + 2] * il, o1[4 * g + 3] * il);
        *(u32x2*)(o + 8 * g + 4 * hh) = w0; *(u32x2*)(o + 32 + 8 * g + 4 * hh) = w1; }
}

constexpr int XA_K = 0, XA_V = 65536, XA_END = 131072;
static_assert(XA_END <= LDS_CTL, "cross-attention LDS map");
DI void xattn_unit(const Params& p, LDS unsigned char* lds, int u) {
    const int tid = tid_opaque(), wid = __builtin_amdgcn_readfirstlane(tid >> 6), lane = tid & 63, r = lane & 31, hh = lane >> 5;
    LDS unsigned char* KI = lds + XA_K; LDS unsigned char* VI = lds + XA_V;
    int b, h, nrows; size_t tbase;
    if (u < NU_XP) { b = u / (4 * NQB); h = (u / NQB) & 3; const int qc = u % NQB; nrows = 256; tbase = (size_t)b * SEQ + qc * 256;
#pragma unroll
        for (int j = 0; j < 8; ++j) { const int i = tid + NTHREADS * j, key = i >> 4, ch = i & 15; const size_t src = ((size_t)b * 256 + key) * 512 + h * 128 + ch * 8;
            *(LDS bf16x8*)(KI + imgb(key, ch)) = ld8g(p.MKB + src); *(LDS bf16x8*)(VI + imgb(key, ch)) = ld8g(p.MVB + src); }
    } else { const int us = u - NU_XP; b = us >> 2; h = us & 3; nrows = DECS; tbase = (size_t)TP + b * DECS;
#pragma unroll 2
        for (int j = 0; j < 8; ++j) { const int i = tid + NTHREADS * j, key = i >> 4, ch = i & 15; const size_t src = (((size_t)b * 256 + key) * 4 + h) * 128 + ch * 8;
            const f32x4 k0 = *(const f32x4*)(p.cmk + src), k1 = *(const f32x4*)(p.cmk + src + 4), v0 = *(const f32x4*)(p.cmv + src), v1 = *(const f32x4*)(p.cmv + src + 4);
            *(LDS bf16x8*)(KI + imgb(key, ch)) = pack8(k0[0], k0[1], k0[2], k0[3], k1[0], k1[1], k1[2], k1[3]); *(LDS bf16x8*)(VI + imgb(key, ch)) = pack8(v0[0], v0[1], v0[2], v0[3], v1[0], v1[1], v1[2], v1[3]); }
    }
    __syncthreads();
    if (32 * wid < nrows) {
        const bool valid = 32 * wid + r < nrows; const size_t trow = tbase + 32 * wid + (valid ? r : 0);
        bf16x8 qf[8]; float ss = 0.f;
#pragma unroll
        for (int ks = 0; ks < 8; ++ks) { qf[ks] = ld8g(p.XQ + trow * 512 + h * 128 + 16 * ks + 8 * hh);
#pragma unroll
            for (int j = 0; j < 8; ++j) { const float v = bf2f((bf16)qf[ks][j]); ss += v * v; } }
        ss += __shfl_xor(ss, 32); const float rs = valid ? rsqrtf(ss * (1.0f / 128.0f) + EPS) * X_SCALE : 0.f;
#pragma unroll
        for (int ks = 0; ks < 8; ++ks) { float q[8];
#pragma unroll
            for (int j = 0; j < 8; ++j) q[j] = bf2f((bf16)qf[ks][j]) * rs * p.g_xq[16 * ks + 8 * hh + j];
            qf[ks] = pack8(q[0], q[1], q[2], q[3], q[4], q[5], q[6], q[7]); }
        f32x16 o[4];
#pragma unroll
        for (int d = 0; d < 4; ++d) o[d] = zero16();
        float m = -INFINITY, l = 0.f;
#pragma unroll 1
        for (int kt = 0; kt < 4; ++kt) {
            f32x16 s0 = zero16(), s1 = zero16();
#pragma unroll
            for (int ks = 0; ks < 8; ++ks) { s0 = mfma32(img_row(KI, 64 * kt + r, ks, hh), qf[ks], s0); s1 = mfma32(img_row(KI, 64 * kt + 32 + r, ks, hh), qf[ks], s1); }
            float tmax = -INFINITY;
#pragma unroll
            for (int i = 0; i < 16; ++i) tmax = fmaxf(tmax, fmaxf(s0[i], s1[i]));
            tmax = fmaxf(tmax, __shfl_xor(tmax, 32));
            const float mn = fmaxf(m, tmax), corr = fexp(m - mn); m = mn; float ps = 0.f;
#pragma unroll
            for (int i = 0; i < 16; ++i) { s0[i] = fexp(s0[i] - mn); s1[i] = fexp(s1[i] - mn); ps += s0[i] + s1[i]; }
            l = l * corr + ps;
#pragma unroll
            for (int d = 0; d < 4; ++d)
#pragma unroll
                for (int i = 0; i < 16; ++i) o[d][i] *= corr;
#pragma unroll
            for (int s = 0; s < 2; ++s) { const bf16x8 pa = PACK(s0, s), pb = PACK(s1, s); bf16x8 v0, v1, v2, v3;
                img_tr4p(VI, lane, 0, 1, 64 * kt + 16 * s, 64 * kt + 32 + 16 * s, v0, v1, v2, v3);
                o[0] = mfma32(v0, pa, o[0]); o[1] = mfma32(v1, pa, o[1]); o[0] = mfma32(v2, pb, o[0]); o[1] = mfma32(v3, pb, o[1]);
                img_tr4p(VI, lane, 2, 3, 64 * kt + 16 * s, 64 * kt + 32 + 16 * s, v0, v1, v2, v3);
                o[2] = mfma32(v0, pa, o[2]); o[3] = mfma32(v1, pa, o[3]); o[2] = mfma32(v2, pb, o[2]); o[3] = mfma32(v3, pb, o[3]); }
        }
        l += __shfl_xor(l, 32); const float il = 1.0f / l;
        if (valid) { bf16* op = p.XO + trow * 512 + h * 128;
#pragma unroll
            for (int d = 0; d < 4; ++d)
#pragma unroll
                for (int g = 0; g < 4; ++g) { u32x2 w; w[0] = pk2(o[d][4 * g] * il, o[d][4 * g + 1] * il); w[1] = pk2(o[d][4 * g + 2] * il, o[d][4 * g + 3] * il); *(u32x2*)(op + 32 * d + 8 * g + 4 * hh) = w; } }
    }
}
constexpr int SA_CK = 0, SA_KP = 32768, SA_P = SA_KP + 64 * 40 * 2, SA_QS = SA_P + 64 * 72 * 2, SA_CORR = SA_QS + 65 * 104 * 2, SA_F32 = (SA_CORR + 1024 + 1023) / 1024 * 1024, SA_KPF = SA_F32 + 65536, SA_END = SA_KPF + 8192;
static_assert(SA_END <= LDS_CTL && SA_KP % 16 == 0 && SA_P % 16 == 0 && SA_QS % 16 == 0 && SA_CORR % 16 == 0 && SA_F32 % 1024 == 0 && SA_KPF % 1024 == 0, "sample attention LDS map");
DI void sattn_issue(const Params& p, LDS unsigned char* lds, int pid, int half, int wid, int lane) {
    const size_t key0 = (size_t)pid * PAGE + half * 64;
#pragma unroll
    for (int i = 0; i < 8; ++i) { const int key = wid * 8 + i; dma16(p.cckv + (key0 + key) * 256 + lane * 4, lds + SA_F32 + key * 1024); }
    dma16(p.ckpe + (key0 + wid * 8 + (lane >> 3)) * 32 + (lane & 7) * 4, lds + SA_KPF + wid * 1024);
}
DI void sattn_convert(LDS unsigned char* lds) {
    const int tid = tid_opaque();
#pragma unroll
    for (int j = 0; j < 4; ++j) { const int i = tid + NTHREADS * j, key = i >> 5, c32 = i & 31;
        const f32x4 a = *(const LDS f32x4*)(lds + SA_F32 + key * 1024 + c32 * 32), bq = *(const LDS f32x4*)(lds + SA_F32 + key * 1024 + c32 * 32 + 16);
        u32x4 w; w[0] = pk2(a[0], a[1]); w[1] = pk2(a[2], a[3]); w[2] = pk2(bq[0], bq[1]); w[3] = pk2(bq[2], bq[3]);
        *(LDS u32x4*)(lds + SA_CK + (c32 >> 4) * 16384 + imgb(key, c32 & 15)) = w; }
    { const int key = tid >> 3, c4 = (tid & 7) * 4; const f32x4 v = *(const LDS f32x4*)(lds + SA_KPF + key * 128 + c4 * 4); u32x2 w; w[0] = pk2(v[0], v[1]); w[1] = pk2(v[2], v[3]);
        *(LDS u32x2*)(lds + SA_KP + (key * 40 + c4) * 2) = w; }
}
DI void sattn_unit(const Params& p, LDS unsigned char* lds, int u) {
    const int tid = tid_opaque(), wid = __builtin_amdgcn_readfirstlane(tid >> 6), lane = tid & 63, r = lane & 31, hh = lane >> 5;
    LDS unsigned char* CK = lds + SA_CK; LDS bf16* KP = (LDS bf16*)(lds + SA_KP); LDS bf16* PA = (LDS bf16*)(lds + SA_P);
    LDS bf16* QS = (LDS bf16*)(lds + SA_QS); LDS float* CORR = (LDS float*)(lds + SA_CORR);
    const int b = u / NSPLIT, sp = u % NSPLIT; const int h = wid;
    STAMP(23);
    const int pidv = p.ptab[b * NPAGES + sp * PPS + (lane % PPS)];
    sattn_issue(p, lds, rdlane(pidv, 0), 0, wid, lane);
    for (int i = tid; i < 65 * 96; i += NTHREADS) { const int row = i / 96, d = i % 96; float v = 0.f;
        if (row < 64) { const int hq = row >> 3, q = row & 7; v = bf2f(p.QN[(((size_t)TP + b * DECS + q) * 8 + hq) * 96 + d]) * 1.4426950408889634f; if (d < 64) v *= p.g_kn[d]; }
        QS[row * 104 + d] = f2bf(v); }
    const int l15 = lane & 15, quad = lane >> 4;
    bf16x8 wk[4][8];
    { const bf16* wkp = p.wt_kvb + (size_t)(h * 128 + l15) * 256 + 8 * quad;
#pragma unroll
        for (int dt = 0; dt < 4; ++dt)
#pragma unroll
            for (int ks = 0; ks < 8; ++ks) wk[dt][ks] = ld8g(wkp + dt * 16 * 256 + 32 * ks); }
#ifndef EMU
#pragma unroll
    for (int dt = 0; dt < 4; ++dt)
#pragma unroll
        for (int ks = 0; ks < 8; ++ks) asm volatile("" : "+v"(wk[dt][ks]));
#endif
    const int qrow = l15 < 8 ? h * 8 + l15 : 64;
    f32x16 acc0 = zero16(), acc1 = zero16(); float m = -INFINITY, l = 0.f;
    const int npt = PPS * 2, ntile = npt + (sp == NSPLIT - 1 ? 1 : 0);
    wait_vm0(); bar_lds(); sattn_convert(lds); bar_lds();
    for (int tile = 0; tile < ntile; ++tile) {
        const bool newt = tile == npt;
        unsigned lo_ = lane;
#ifndef EMU
        asm volatile("" : "+v"(lo_));
#endif
        const unsigned l15o = lo_ & 15, quado = lo_ >> 4;
        if (tile + 1 < npt) sattn_issue(p, lds, rdlane(pidv, (tile + 1) >> 1), (tile + 1) & 1, wid, lane);
#pragma unroll 1
        for (int kg = 0; kg < 4; ++kg) {
            f32x4 x[4];
#pragma unroll
            for (int dt = 0; dt < 4; ++dt) x[dt] = (f32x4){0.f, 0.f, 0.f, 0.f};
#define SA_CB(ks) (*(const LDS bf16x8*)(CK + ((ks) >> 2) * 16384 + imgb(16 * kg + l15o, 4 * ((ks) & 3) + quado)))
#define SA_MM(ks, cbv) do { _Pragma("unroll") for (int dt = 0; dt < 4; ++dt) x[dt] = __builtin_amdgcn_mfma_f32_16x16x32_bf16(wk[dt][ks], cbv, x[dt], 0, 0, 0); } while (0)
            bf16x8 ca0 = SA_CB(0), ca1 = SA_CB(1), cb0 = SA_CB(2), cb1 = SA_CB(3); SCHED_FENCE();
            SA_MM(0, ca0); SA_MM(1, ca1); ca0 = SA_CB(4); ca1 = SA_CB(5); SCHED_FENCE();
            SA_MM(2, cb0); SA_MM(3, cb1); cb0 = SA_CB(6); cb1 = SA_CB(7); SCHED_FENCE();
            const s16x4 qa0 = *(const LDS s16x4*)(QS + qrow * 104 + 4 * quad), qa1 = *(const LDS s16x4*)(QS + qrow * 104 + 16 + 4 * quad), qb0 = *(const LDS s16x4*)(QS + qrow * 104 + 32 + 4 * quad), qb1 = *(const LDS s16x4*)(QS + qrow * 104 + 48 + 4 * quad);
            const bf16x8 kpf = ld8(KP + (16 * kg + l15) * 40 + 8 * quad), qrf = ld8(QS + qrow * 104 + 64 + 8 * quad);
            SA_MM(4, ca0); SA_MM(5, ca1); SCHED_FENCE();
            SA_MM(6, cb0); SA_MM(7, cb1); SCHED_FENCE();
#undef SA_CB
#undef SA_MM
            float ss = 0.f;
#pragma unroll
            for (int dt = 0; dt < 4; ++dt) ss += x[dt][0] * x[dt][0] + x[dt][1] * x[dt][1] + x[dt][2] * x[dt][2] + x[dt][3] * x[dt][3];
            ss = xsum32(xsum16(ss)); const float inv = rsqrtf(ss * (1.0f / 64.0f) + EPS);
            f32x4 z = {0.f, 0.f, 0.f, 0.f};
#pragma unroll
            for (int pp = 0; pp < 2; ++pp) {
                const bf16x8 a = pack8(x[2 * pp][0] * inv, x[2 * pp][1] * inv, x[2 * pp][2] * inv, x[2 * pp][3] * inv, x[2 * pp + 1][0] * inv, x[2 * pp + 1][1] * inv, x[2 * pp + 1][2] * inv, x[2 * pp + 1][3] * inv);
                z = __builtin_amdgcn_mfma_f32_16x16x32_bf16(a, pp == 0 ? __builtin_shufflevector(qa0, qa1, 0, 1, 2, 3, 4, 5, 6, 7) : __builtin_shufflevector(qb0, qb1, 0, 1, 2, 3, 4, 5, 6, 7), z, 0, 0, 0); }
            z = __builtin_amdgcn_mfma_f32_16x16x32_bf16(kpf, qrf, z, 0, 0, 0);
            if (newt) {
#pragma unroll
                for (int j = 0; j < 4; ++j) { const int key = 16 * kg + 4 * quad + j; if (key > l15 || key >= DECS) z[j] = -INFINITY; } }
            float tmax = fmaxf(fmaxf(z[0], z[1]), fmaxf(z[2], z[3]));
            tmax = fmaxf(xmax32(xmax16(tmax)), -1e30f);
            const float mn = fmaxf(m, tmax), corr = fexp2(m - mn); m = mn;
#pragma unroll
            for (int j = 0; j < 4; ++j) z[j] = fexp2(z[j] - mn);
            l = l * corr + (z[0] + z[1]) + (z[2] + z[3]);
            if (l15 < 8) { u32x2 w; w[0] = pk2(z[0], z[1]); w[1] = pk2(z[2], z[3]); *(LDS u32x2*)(PA + (h * 8 + l15) * 72 + 16 * kg + 4 * quad) = w;
                if (quad == 0) CORR[kg * 64 + h * 8 + l15] = corr; }
        }
        bar_lds();
#pragma unroll
        for (int ks = 0; ks < 4; ++ks) { const float c0 = CORR[ks * 64 + r], c1 = CORR[ks * 64 + 32 + r];
#pragma unroll
            for (int i = 0; i < 16; ++i) { acc0[i] *= c0; acc1[i] *= c1; }
            const bf16x8 a = img_tr<false>(CK + (wid >> 2) * 16384, lo_, wid & 3, 16 * ks);
            acc0 = mfma32(a, ld8(PA + r * 72 + 16 * ks + 8 * hh), acc0); acc1 = mfma32(a, ld8(PA + (32 + r) * 72 + 16 * ks + 8 * hh), acc1); }
        if (tile + 1 < ntile) {
            if (tile + 1 < npt) { wait_vm0(); bar_lds(); sattn_convert(lds); }
            else { bar_lds(); const size_t t0 = (size_t)TP + b * DECS;
                for (int i = tid; i < 64 * 32; i += NTHREADS) { const int key = i >> 5, c32 = i & 31; bf16x8 v = zero8(); if (key < DECS) v = ld8g(p.CKVB + (t0 + key) * 256 + c32 * 8);
                    *(LDS bf16x8*)(CK + (c32 >> 4) * 16384 + imgb(key, c32 & 15)) = v; }
                for (int i = tid; i < 64 * 32; i += NTHREADS) { const int key = i >> 5, c = i & 31; KP[key * 40 + c] = key < DECS ? p.KPB[(t0 + key) * 32 + c] : (bf16)0; } }
            bar_lds();
        }
    }
    STAMP(22);
    { const int t2 = tid_opaque(), w2 = __builtin_amdgcn_readfirstlane(t2 >> 6), l2 = t2 & 63, r2 = l2 & 31, h2 = l2 >> 5;
        float* pa = p.PACC + (size_t)u * 64 * 256;
#pragma unroll
        for (int g = 0; g < 4; ++g) { f32x4 v0 = {acc0[4 * g], acc0[4 * g + 1], acc0[4 * g + 2], acc0[4 * g + 3]}, v1 = {acc1[4 * g], acc1[4 * g + 1], acc1[4 * g + 2], acc1[4 * g + 3]};
            *(f32x4*)(pa + (size_t)r2 * 256 + 32 * w2 + 8 * g + 4 * h2) = v0; *(f32x4*)(pa + (size_t)(32 + r2) * 256 + 32 * w2 + 8 * g + 4 * h2) = v1; }
        l += __shfl_xor(l, 16); l += __shfl_xor(l, 32);
        if (l2 < 8) { p.PML[((size_t)u * 64 + w2 * 8 + r2) * 2] = m; p.PML[((size_t)u * 64 + w2 * 8 + r2) * 2 + 1] = l; } }
}
DI void phase_sattn_combine(const Params& p, LDS unsigned char* lds) {
    const int tid = tid_opaque();
    LDS float* AC = (LDS float*)lds; LDS float* WS = (LDS float*)(lds + 8 * 256 * 4);
    for (int u = blockIdx.x; u < DECB * 8; u += gridDim.x) { const int b = u >> 3, h = u & 7;
        if (tid < 8) { const int hq = h * 8 + tid; float M = -INFINITY; for (int j = 0; j < NSPLIT; ++j) M = fmaxf(M, p.PML[((size_t)(b * NSPLIT + j) * 64 + hq) * 2]);
            float L = 0.f; for (int j = 0; j < NSPLIT; ++j) { const float w = exp2f(p.PML[((size_t)(b * NSPLIT + j) * 64 + hq) * 2] - M);     WS[tid * NSPLIT + j] = w; L += w * p.PML[((size_t)(b * NSPLIT + j) * 64 + hq) * 2 + 1]; }
            const float iL = 1.0f / L; for (int j = 0; j < NSPLIT; ++j) WS[tid * NSPLIT + j] *= iL; }
        __syncthreads();
        { const int q = tid >> 6, l4 = (tid & 63) * 4; f32x4 s = {0.f, 0.f, 0.f, 0.f};
#pragma unroll
            for (int j = 0; j < NSPLIT; ++j) s += WS[q * NSPLIT + j] * *(const f32x4*)(p.PACC + ((size_t)(b * NSPLIT + j) * 64 + h * 8 + q) * 256 + l4);
            *(LDS f32x4*)(AC + q * 256 + l4) = s; }
        __syncthreads();
        { const int q = tid >> 6, dv = tid & 63; const bf16* w = p.wt_kvb + (size_t)(h * 128 + 64 + dv) * 256; float s = 0.f;
#pragma unroll 4
            for (int c = 0; c < 32; ++c) { const bf16x8 wv = ld8g(w + 8 * c); const f32x4 a0 = *(const LDS f32x4*)(AC + q * 256 + 8 * c), a1 = *(const LDS f32x4*)(AC + q * 256 + 8 * c + 4);
                s += a0[0] * bf2f((bf16)wv[0]) + a0[1] * bf2f((bf16)wv[1]) + a0[2] * bf2f((bf16)wv[2]) + a0[3] * bf2f((bf16)wv[3]) + a1[0] * bf2f((bf16)wv[4]) + a1[1] * bf2f((bf16)wv[5]) + a1[2] * bf2f((bf16)wv[6]) + a1[3] * bf2f((bf16)wv[7]); }
            p.OMIX[((size_t)TP + b * DECS + q) * DM + 512 + h * 64 + dv] = f2bf(s); }
        __syncthreads();
    }
}
#ifndef EMU
#define XB_TMO      128
#define XB_XCNT(j)  (256  + 64 * (j))
#define XB_XSUB(j)  (1280 + 64 * (j))
#define XB_XGEN(j)  (2304 + 64 * (j))
#define XB_TOP      3328
#define XB_TOPGEN   3392
#define XCD_BAR_WORDS 3456
#define XB_SPIN_CAP (1u << 18)
#define LAS __attribute__((address_space(3)))
__device__ __forceinline__ unsigned xb_ld(unsigned* p)              { return __hip_atomic_load(p, __ATOMIC_RELAXED, __HIP_MEMORY_SCOPE_AGENT); }
__device__ __forceinline__ unsigned xb_add(unsigned* p, unsigned v) { return __hip_atomic_fetch_add(p, v, __ATOMIC_RELAXED, __HIP_MEMORY_SCOPE_AGENT); }
__device__ __forceinline__ unsigned xb_xcc_id() { return (unsigned)__builtin_amdgcn_s_getreg((3 << 11) | 20) & 0xFu; }
#define XB_SPIN(cond, bar) do { unsigned _sp = 0; while (cond) { __builtin_amdgcn_s_sleep(1); \
    if ((++_sp & 255u) == 0u) { if (xb_ld(&(bar)[XB_TMO])) break; if (_sp > XB_SPIN_CAP) { atomicAdd(&(bar)[XB_TMO], 1u); break; } } } } while (0)
struct XcdBarrier { unsigned* bar; unsigned x; volatile LAS unsigned* st; };
__device__ __forceinline__ XcdBarrier xcd_barrier_post(unsigned* bar, volatile LAS unsigned* st) {
    XcdBarrier b; b.bar = bar; b.x = xb_xcc_id(); b.st = st;
    if (threadIdx.x == 0) (void)xb_add(&bar[XB_XCNT(b.x)], 1u);
    return b;
}
__device__ __forceinline__ void xcd_barrier_complete(unsigned* bar, unsigned x, unsigned& nloc, unsigned& nx) {
    const unsigned G = gridDim.x * gridDim.y * gridDim.z;
    unsigned sum, cnt, mine, sp = 0u;
    for (;;) {
        sum = 0u; cnt = 0u; mine = 0u;
#pragma unroll
        for (unsigned j = 0; j < 16; ++j) { const unsigned c = xb_ld(&bar[XB_XCNT(j)]); sum += c; cnt += (c > 0u) ? 1u : 0u; mine = (j == x) ? c : mine; }
        if (sum == G) break;
        __builtin_amdgcn_s_sleep(1);
        if ((++sp & 255u) == 0u) { if (xb_ld(&bar[XB_TMO])) break; if (sp > XB_SPIN_CAP) { atomicAdd(&bar[XB_TMO], 1u); break; } }
    }
    nloc = mine > 0u ? mine : 1u; nx = cnt > 0u ? cnt : 1u;
}
__device__ __forceinline__ void xcd_barrier(const XcdBarrier& b) {
    asm volatile("s_waitcnt vmcnt(0)" ::: "memory");
    __syncthreads();
    if (threadIdx.x == 0) {
        unsigned* bar = b.bar;
        __builtin_amdgcn_s_waitcnt(0);
        unsigned nloc = b.st[0], nx = b.st[1];
        if (nloc == 0u) { xcd_barrier_complete(bar, b.x, nloc, nx); b.st[0] = nloc; b.st[1] = nx; }
        const unsigned old = xb_add(&bar[XB_XSUB(b.x)], 1u);
        const unsigned gen = old / nloc;
        if (old + 1u == (gen + 1u) * nloc) {
            __builtin_amdgcn_fence(__ATOMIC_RELEASE, "agent");
            asm volatile("s_waitcnt vmcnt(0)" ::: "memory");
            const unsigned og = xb_add(&bar[XB_TOP], 1u);
            const unsigned tg = og / nx;
            if (og + 1u == (tg + 1u) * nx) xb_add(&bar[XB_TOPGEN], 1u);
            else XB_SPIN(xb_ld(&bar[XB_TOPGEN]) == tg, bar);
            __builtin_amdgcn_fence(__ATOMIC_ACQUIRE, "agent");
            xb_add(&bar[XB_XGEN(b.x)], 1u);
            asm volatile("s_waitcnt vmcnt(0)" ::: "memory");
        } else {
            XB_SPIN(xb_ld(&bar[XB_XGEN(b.x)]) == gen, bar);
            __builtin_amdgcn_fence(__ATOMIC_ACQUIRE, "agent");
            asm volatile("s_waitcnt vmcnt(0)" ::: "memory");
        }
    }
    __syncthreads();
}
#endif

DI int wq_next(unsigned* ctr, LDS unsigned* slot) {
    __syncthreads();
    if (threadIdx.x == 0) *slot = atomicAdd(ctr, 1u);
    __syncthreads();
    return __builtin_amdgcn_readfirstlane((int)*slot);
}
struct EpiResF32 {
    static constexpr bool PERM = false, AFTER_DRAIN = false;
    float* C; const float* R0; const float* R1; int split;
    DI void operator()(const f32x4 (&acc)[2][2][4][2], const pg8::Unit& u, int wr, int wc, int fr, int fq) const {
        const int row0 = u.pm * 256 + wr * 64 + fr, col0 = u.pn * 256 + wc * 32 + 4 * fq;
        const float* R = row0 < split ? R0 : R1 - (size_t)split * DM;
#pragma unroll
        for (int ai = 0; ai < 2; ++ai)
#pragma unroll
            for (int mp = 0; mp < 2; ++mp) { f32x4 rr[2][2][2];
#pragma unroll
                for (int mm = 0; mm < 2; ++mm) { const size_t off = (size_t)(row0 + ai * 128 + (2 * mp + mm) * 16) * DM + col0;
#pragma unroll
                    for (int bj = 0; bj < 2; ++bj)
#pragma unroll
                        for (int n = 0; n < 2; ++n) rr[mm][bj][n] = *(const f32x4*)(R + off + bj * 128 + n * 16); }
#pragma unroll
                for (int mm = 0; mm < 2; ++mm) { const size_t off = (size_t)(row0 + ai * 128 + (2 * mp + mm) * 16) * DM + col0;
#pragma unroll
                    for (int bj = 0; bj < 2; ++bj)
#pragma unroll
                        for (int n = 0; n < 2; ++n) *(f32x4*)(C + off + bj * 128 + n * 16) = acc[ai][bj][2 * mp + mm][n] + rr[mm][bj][n]; }
#ifndef EMU
                asm volatile("" ::: "memory");
#endif
            }
    }
};

struct EpiResInBf16Out {
    static constexpr bool PERM = true, AFTER_DRAIN = false;
    bf16* O; const float* R0; const float* R1; int split;
    DI void operator()(const f32x4 (&acc)[2][2][4][2], const pg8::Unit& u, int wr, int wc, int fr, int fq) const {
        const int row0 = u.pm * 256 + wr * 64 + fr, col0 = u.pn * 256 + wc * 32 + 8 * fq;
        const float* R = row0 < split ? R0 : R1 - (size_t)split * DM;
#pragma unroll
        for (int ai = 0; ai < 2; ++ai)
#pragma unroll
            for (int mp = 0; mp < 2; ++mp) { f32x4 rr[2][2][2];
#pragma unroll
                for (int mm = 0; mm < 2; ++mm) { const size_t off = (size_t)(row0 + ai * 128 + (2 * mp + mm) * 16) * DM + col0;
#pragma unroll
                    for (int bj = 0; bj < 2; ++bj) { rr[mm][bj][0] = *(const f32x4*)(R + off + bj * 128); rr[mm][bj][1] = *(const f32x4*)(R + off + bj * 128 + 4); } }
#pragma unroll
                for (int mm = 0; mm < 2; ++mm) { const size_t off = (size_t)(row0 + ai * 128 + (2 * mp + mm) * 16) * DM + col0;
#pragma unroll
                    for (int bj = 0; bj < 2; ++bj) { const f32x4 v0 = acc[ai][bj][2 * mp + mm][0] + rr[mm][bj][0], v1 = acc[ai][bj][2 * mp + mm][1] + rr[mm][bj][1];
                        u32x4 w; w[0] = pk2(v0[0], v0[1]); w[1] = pk2(v0[2], v0[3]); w[2] = pk2(v1[0], v1[1]); w[3] = pk2(v1[2], v1[3]); *(u32x4*)(O + off + bj * 128) = w; } }
#ifndef EMU
                asm volatile("" ::: "memory");
#endif
            }
    }
};
struct EpiResBf16 {
    static constexpr bool PERM = true, AFTER_DRAIN = false;
    bf16* O; const bf16* R;
    DI void operator()(const f32x4 (&acc)[2][2][4][2], const pg8::Unit& u, int wr, int wc, int fr, int fq) const {
        const int row0 = u.pm * 256 + wr * 64 + fr, col0 = u.pn * 256 + wc * 32 + 8 * fq;
#pragma unroll
        for (int ai = 0; ai < 2; ++ai) { bf16x8 rr[4][2];
#pragma unroll
            for (int m = 0; m < 4; ++m) { const size_t off = (size_t)(row0 + ai * 128 + m * 16) * DM + col0; rr[m][0] = ld8g(R + off); rr[m][1] = ld8g(R + off + 128); }
#pragma unroll
            for (int m = 0; m < 4; ++m) { const size_t off = (size_t)(row0 + ai * 128 + m * 16) * DM + col0;
#pragma unroll
                for (int bj = 0; bj < 2; ++bj) { const f32x4 a0 = acc[ai][bj][m][0], a1 = acc[ai][bj][m][1]; const bf16x8 q = rr[m][bj];
                    *(bf16x8*)(O + off + bj * 128) = pack8(a0[0] + bf2f((bf16)q[0]), a0[1] + bf2f((bf16)q[1]), a0[2] + bf2f((bf16)q[2]), a0[3] + bf2f((bf16)q[3]), a1[0] + bf2f((bf16)q[4]), a1[1] + bf2f((bf16)q[5]), a1[2] + bf2f((bf16)q[6]), a1[3] + bf2f((bf16)q[7])); } }
#ifndef EMU
            asm volatile("" ::: "memory");
#endif
        }
    }
};
struct EpiResBf16InF32Out {
    static constexpr bool PERM = false, AFTER_DRAIN = false;
    float* C; const bf16* R;
    DI void operator()(const f32x4 (&acc)[2][2][4][2], const pg8::Unit& u, int wr, int wc, int fr, int fq) const {
        const int row0 = u.pm * 256 + wr * 64 + fr, col0 = u.pn * 256 + wc * 32 + 4 * fq;
#pragma unroll
        for (int ai = 0; ai < 2; ++ai)
#pragma unroll
            for (int mp = 0; mp < 2; ++mp) { s16x4 rr[2][2][2];
#pragma unroll
                for (int mm = 0; mm < 2; ++mm) { const size_t off = (size_t)(row0 + ai * 128 + (2 * mp + mm) * 16) * DM + col0;
#pragma unroll
                    for (int bj = 0; bj < 2; ++bj)
#pragma unroll
                        for (int n = 0; n < 2; ++n) rr[mm][bj][n] = *(const s16x4*)(R + off + bj * 128 + n * 16); }
#pragma unroll
                for (int mm = 0; mm < 2; ++mm) { const size_t off = (size_t)(row0 + ai * 128 + (2 * mp + mm) * 16) * DM + col0;
#pragma unroll
                    for (int bj = 0; bj < 2; ++bj)
#pragma unroll
                        for (int n = 0; n < 2; ++n) { const s16x4 q = rr[mm][bj][n]; f32x4 v = acc[ai][bj][2 * mp + mm][n]; v[0] += bf2f((bf16)q[0]); v[1] += bf2f((bf16)q[1]); v[2] += bf2f((bf16)q[2]); v[3] += bf2f((bf16)q[3]);
                            *(f32x4*)(C + off + bj * 128 + n * 16) = v; } }
#ifndef EMU
                asm volatile("" ::: "memory");
#endif
            }
    }
};
struct SEpiResInBf16Out { bf16* O; const float* R;
    DI void put(int row, int col, f32x4 v) const { v += *(const f32x4*)(R + (size_t)row * DM + col); u32x2 w; w[0] = pk2(v[0], v[1]); w[1] = pk2(v[2], v[3]); *(u32x2*)(O + (size_t)row * DM + col) = w; } };
struct SEpiResBf16 { bf16* O; const bf16* R;
    DI void put(int row, int col, f32x4 v) const { const s16x4 q = *(const s16x4*)(R + (size_t)row * DM + col); u32x2 w; w[0] = pk2(v[0] + bf2f((bf16)q[0]), v[1] + bf2f((bf16)q[1])); w[1] = pk2(v[2] + bf2f((bf16)q[2]), v[3] + bf2f((bf16)q[3])); *(u32x2*)(O + (size_t)row * DM + col) = w; } };
struct SEpiResBf16InF32Out { float* C; const bf16* R;
    DI void put(int row, int col, f32x4 v) const { const s16x4 q = *(const s16x4*)(R + (size_t)row * DM + col); v[0] += bf2f((bf16)q[0]); v[1] += bf2f((bf16)q[1]); v[2] += bf2f((bf16)q[2]); v[3] += bf2f((bf16)q[3]); *(f32x4*)(C + (size_t)row * DM + col) = v; } };
template <int NR> DI void rmsnorm_rows_b16(const bf16* src, const float* g, bf16* dst, int row0, int rstride, int nrows, int lane) {
    bf16x8 v[NR][2]; f32x4 gg[4];
#pragma unroll
    for (int j = 0; j < NR; ++j) { const int row = row0 + j * rstride;
#pragma unroll
        for (int i = 0; i < 2; ++i) v[j][i] = row < nrows ? ld8g(src + (size_t)row * DM + 8 * (lane + 64 * i)) : zero8(); }
#pragma unroll
    for (int i = 0; i < 2; ++i) { gg[2 * i] = *(const f32x4*)(g + 8 * (lane + 64 * i)); gg[2 * i + 1] = *(const f32x4*)(g + 8 * (lane + 64 * i) + 4); }
    float ss[NR];
#pragma unroll
    for (int j = 0; j < NR; ++j) { ss[j] = 0.f;
#pragma unroll
        for (int i = 0; i < 2; ++i)
#pragma unroll
            for (int q = 0; q < 8; ++q) { const float f = bf2f((bf16)v[j][i][q]); ss[j] += f * f; } }
#pragma unroll
    for (int o = 32; o >= 1; o >>= 1) {
#pragma unroll
        for (int j = 0; j < NR; ++j) ss[j] += __shfl_xor(ss[j], o); }
#pragma unroll
    for (int j = 0; j < NR; ++j) { const int row = row0 + j * rstride; if (row < nrows) { const float rs = rsqrtf(ss[j] * (1.0f / 1024.0f) + EPS);
#pragma unroll
            for (int i = 0; i < 2; ++i) { const bf16x8 q = v[j][i]; const f32x4 g0 = gg[2 * i], g1 = gg[2 * i + 1];
                *(bf16x8*)(dst + (size_t)row * DM + 8 * (lane + 64 * i)) = pack8(bf2f((bf16)q[0]) * rs * g0[0], bf2f((bf16)q[1]) * rs * g0[1], bf2f((bf16)q[2]) * rs * g0[2], bf2f((bf16)q[3]) * rs * g0[3], bf2f((bf16)q[4]) * rs * g1[0], bf2f((bf16)q[5]) * rs * g1[1], bf2f((bf16)q[6]) * rs * g1[2], bf2f((bf16)q[7]) * rs * g1[3]); } } }
}
DI void phase_norm_rows_b16(const Params& p, const bf16* X, const float* g) {
    const int tid = tid_opaque(), wid = __builtin_amdgcn_readfirstlane(tid >> 6), lane = tid & 63;
    { const int ws = gridDim.x * 8, w0 = blockIdx.x * 8 + wid; for (int row = w0; row < T; row += 4 * ws) rmsnorm_rows_b16<4>(X, g, p.H, row, ws, T, lane); }
}
DI void phase_norm_rows(const Params& p, const float* X, const float* g) {
    const int tid = tid_opaque(), wid = __builtin_amdgcn_readfirstlane(tid >> 6), lane = tid & 63;
    { const int ws = gridDim.x * 8, w0 = blockIdx.x * 8 + wid; for (int row = w0; row < T; row += 4 * ws) rmsnorm_rows<4>(X, g, p.H, row, ws, T, lane); }
}
constexpr int NPHASE = 15;
template <int PH> DI void run_phase(const Params& p, LDS unsigned char* lds) {
    LDS unsigned* slot = (LDS unsigned*)(lds + LDS_CTL + 64);
    if constexpr (PH == 0) phase_prep(p, lds);
    else if constexpr (PH == 1) { run_gemm(lds, p.H, p.wt_in, TP, DINP, DM, EpiStoreBf16<0>{p.Z, DINP}, 0); run_gemm(lds, p.MEMN, p.wt_xkv, MROWS, 1024, DM, EpiStoreF32{p.MKV, nullptr, 1024}, 128);
        small_gemm(lds, p.H, p.wt_in, DINP, DM, SEpiBf16{p.Z, DINP, 0}, 64); }
    else if constexpr (PH == 2) { phase_post_in(p); if (DUPM & 8) phase_post_in(p); }
    else if constexpr (PH == 3) { run_gemm(lds, p.QAN, p.wt_qb, TP, 768, 384, EpiStoreBf16<0>{p.QF, 768}, 0); run_gemm(lds, p.CKVB, p.wt_kvb, TP, 1024, 256, EpiStoreBf16<0>{p.KV, 1024}, 128);
        small_gemm(lds, p.QAN, p.wt_qb, 768, 384, SEpiBf16{p.QF, 768, 0}, 0); __syncthreads(); phase_gla_a(p, lds); }
    else if constexpr (PH == 4) { phase_post_qkv(p); if (DUPM & 16) phase_post_qkv(p); phase_gla_b(p); }
    else if constexpr (PH == 5) {
        for (int rep = 0; rep < ((DUPM & 1) ? 2 : 1); ++rep) for (int u = blockIdx.x; u < NU_SA; u += gridDim.x) { __syncthreads(); sattn_unit(p, lds, u); }
        STAMP(20);
        for (int rep = 0; rep < ((DUPM & 2) ? 2 : 1); ++rep) for (;;) { const int u = wq_next(p.ctl + CW_Q5 + 64 + 192 * rep, slot); if (u >= NU_PA) break; pattn_unit(p, lds, u); }
        STAMP(21);
        __syncthreads(); phase_gla_c(p, lds); }
    else if constexpr (PH == 6) phase_sattn_combine(p, lds);
    else if constexpr (PH == 7) { run_gemm(lds, p.OMIX, p.wt_out, TP, DM, DM, EpiResInBf16Out{p.X1B, p.xp, p.xs, TP}, 0); small_gemm(lds, p.OMIX, p.wt_out, DM, DM, SEpiResInBf16Out{p.X1B, p.xs - (size_t)TP * DM}, 0); }
    else if constexpr (PH == 8) phase_norm_rows_b16(p, p.X1B, p.g_x);
    else if constexpr (PH == 9) { run_gemm(lds, p.H, p.wt_xq, TP, 512, DM, EpiStoreBf16<0>{p.XQ, 512}, 0); small_gemm(lds, p.H, p.wt_xq, 512, DM, SEpiBf16{p.XQ, 512, 0}, 0); }
    else if constexpr (PH == 10) { unsigned* ctr = p.ctl + CW_QX; if (DUPP & (1 << 10)) { __syncthreads(); if (*(volatile unsigned*)ctr >= (unsigned)(NU_XS + NU_XP) ) ctr += 64; }
        for (;;) { const int u = wq_next(ctr, slot); if (u >= NU_XS + NU_XP) break; xattn_unit(p, lds, u < NU_XS ? NU_XP + u : u - NU_XS); } }
    else if constexpr (PH == 11) { run_gemm(lds, p.XO, p.wt_xo, TP, DM, 512, EpiResBf16{p.X2B, p.X1B}, 0); small_gemm(lds, p.XO, p.wt_xo, DM, 512, SEpiResBf16{p.X2B, p.X1B}, 0); }
    else if constexpr (PH == 12) phase_norm_rows_b16(p, p.X2B, p.g_ff);
    else if constexpr (PH == 13) { run_gemm(lds, p.H, p.wt_ff1, TP, DFF, DM, EpiStoreBf16<1>{p.U, DFF}, 0); small_gemm(lds, p.H, p.wt_ff1, DFF, DM, SEpiBf16{p.U, DFF, 1}, 0); }
    else if constexpr (PH == 14) { run_gemm(lds, p.U, p.wt_ff2, TP, DM, DFF, EpiResBf16InF32Out{p.y, p.X2B}, 0); small_gemm(lds, p.U, p.wt_ff2, DM, DFF, SEpiResBf16InF32Out{p.y, p.X2B}, 0); }
}
#ifdef EMU
#define GET_LDS() ((LDS unsigned char*)EMU_SMEM())
#define GRID_BAR() emu_grid_barrier()
#else
#define GET_LDS() ((LDS unsigned char*)lds_raw)
#define GRID_BAR() xcd_barrier(bar)
#endif
template <int PH> __global__ void __launch_bounds__(NTHREADS, 2) k_phase(Params p) {
#ifndef EMU
    extern __shared__ __attribute__((aligned(16))) unsigned char lds_raw[];
#endif
    run_phase<PH>(p, GET_LDS());
}
#if N_LAUNCH_MODE == 1
__global__ void __launch_bounds__(NTHREADS, 2) k_mega(Params p) {
#ifndef EMU
    extern __shared__ __attribute__((aligned(16))) unsigned char lds_raw[];
    LDS unsigned char* lds = GET_LDS();
    if (threadIdx.x < 64) ((LDS unsigned*)(lds + LDS_CTL))[threadIdx.x] = 0u;
    __syncthreads();
    XcdBarrier bar = xcd_barrier_post(p.ctl + CW_BAR, (volatile LDS unsigned*)(lds + LDS_CTL));
#else
    LDS unsigned char* lds = GET_LDS();
#endif
    STAMP(0);
    run_phase<0>(p, lds); if (DUPP & (1 << 0)) run_phase<0>(p, lds); GRID_BAR();
    STAMP(1);
    run_phase<1>(p, lds); if (DUPP & (1 << 1)) run_phase<1>(p, lds); GRID_BAR();
    STAMP(2);
    run_phase<2>(p, lds); if (DUPP & (1 << 2)) run_phase<2>(p, lds); GRID_BAR();
    STAMP(3);
    run_phase<3>(p, lds); if (DUPP & (1 << 3)) run_phase<3>(p, lds); GRID_BAR();
    STAMP(4);
    run_phase<4>(p, lds); GRID_BAR();
    STAMP(5);
    run_phase<5>(p, lds); GRID_BAR();
    STAMP(6);
    run_phase<6>(p, lds); if (DUPP & (1 << 6)) run_phase<6>(p, lds); GRID_BAR();
    STAMP(7);
    run_phase<7>(p, lds); if (DUPP & (1 << 7)) run_phase<7>(p, lds); GRID_BAR();
    STAMP(8);
    run_phase<8>(p, lds); if (DUPP & (1 << 8)) run_phase<8>(p, lds); GRID_BAR();
    STAMP(9);
    run_phase<9>(p, lds); if (DUPP & (1 << 9)) run_phase<9>(p, lds); GRID_BAR();
    STAMP(10);
    run_phase<10>(p, lds); if (DUPP & (1 << 10)) run_phase<10>(p, lds); GRID_BAR();
    STAMP(11);
    run_phase<11>(p, lds); if (DUPP & (1 << 11)) run_phase<11>(p, lds); GRID_BAR();
    STAMP(12);
    run_phase<12>(p, lds); if (DUPP & (1 << 12)) run_phase<12>(p, lds); GRID_BAR();
    STAMP(13);
    run_phase<13>(p, lds); if (DUPP & (1 << 13)) run_phase<13>(p, lds); GRID_BAR();
    STAMP(14);
    run_phase<14>(p, lds); if (DUPP & (1 << 14)) run_phase<14>(p, lds);
    STAMP(15);
#ifndef EMU
    if (PROBE_A >= 0 && blockIdx.x == 0 && threadIdx.x == 0) { volatile unsigned long long* st = (volatile unsigned long long*)(p.ctl + CW_STAMP); const unsigned long long span = st[PROBE_B] - st[PROBE_A], t0 = wall_clock64();
        while (wall_clock64() - t0 < PROBE_K * span) __builtin_amdgcn_s_sleep(32); }
#endif
}
#endif

static size_t ws_take(size_t& off, size_t bytes) { const size_t o = off; off = (off + bytes + 255) & ~(size_t)255; return o; }
template <int PH> static void launch_phase(const Params& p, int grid, hipStream_t stream) {
#ifndef EMU
    static bool attr = false; if (!attr) { (void)hipFuncSetAttribute((const void*)k_phase<PH>, hipFuncAttributeMaxDynamicSharedMemorySize, LDS_BYTES); attr = true; }
#endif
    LAUNCH(k_phase<PH>, dim3(grid), dim3(NTHREADS), LDS_BYTES, stream, p);
}
extern "C" void kernel_launch(void* const* d_in, const int* in_sizes, int n_in, void* d_out, int out_size, void* d_ws, size_t ws_size, hipStream_t stream) {
    Params p{};
    const float* const* in = (const float* const*)d_in;
    p.xp = in[0]; p.xs = in[1]; p.memp = in[2]; p.cckv = in[3]; p.ckpe = in[4]; p.cmk = in[5]; p.cmv = in[6]; p.sgla = in[7]; p.ptab = (const int*)d_in[8];
    p.g_mix = in[9]; p.w_a2 = in[11]; p.b_a = in[12]; p.g_gla_o = in[13]; p.g_qa = in[14]; p.g_kva = in[16]; p.g_qn = in[18]; p.g_kn = in[19]; p.g_qr = in[20]; p.g_kr = in[21];
    p.g_x = in[23]; p.g_mem = in[24]; p.g_xq = in[28]; p.g_xk = in[29]; p.g_ff = in[31];
    float* out = (float*)d_out; size_t oo = 0;
    p.y = out; oo += (size_t)T * DM; p.o_ckvp = out + oo; oo += (size_t)TP * 256; p.o_kpep = out + oo; oo += (size_t)TP * 32; p.o_mkp = out + oo; oo += (size_t)MROWS * 512; p.o_mvp = out + oo; oo += (size_t)MROWS * 512;
    p.o_glap = out + oo; oo += (size_t)BATCH * 4 * 8192; p.o_ckvs = out + oo; oo += (size_t)TS * 256; p.o_kpes = out + oo; oo += (size_t)TS * 32; p.o_glas = out + oo; oo += (size_t)DECB * 4 * 8192;
    if ((size_t)out_size != oo || n_in != 34) { fprintf(stderr, "kernel_launch: unexpected sizes (out %d vs %zu, n_in %d)\n", out_size, oo, n_in); }
    unsigned char* ws = (unsigned char*)d_ws; size_t off = 0;
    p.ctl = (unsigned*)(ws + ws_take(off, 1 << 20));
#define WSB(name, elems) p.name = (bf16*)(ws + ws_take(off, (size_t)(elems) * 2))
#define WSF(name, elems) p.name = (float*)(ws + ws_take(off, (size_t)(elems) * 4))
    WSB(wt_in, (size_t)DINP * DM); WSB(wt_qb, 768 * 384); WSB(wt_kvb, 1024 * 256); WSB(wt_out, DM * DM); WSB(wt_xq, 512 * DM); WSB(wt_xkv, 1024 * DM); WSB(wt_xo, DM * 512); WSB(wt_ff1, (size_t)DFF * DM); WSB(wt_ff2, (size_t)DM * DFF);
    WSB(H, (size_t)T * DM); WSB(MEMN, (size_t)MROWS * DM); WSB(Z, (size_t)T * DINP); WSB(QAN, (size_t)T * 384); WSB(CKVB, (size_t)T * 256); WSB(KPB, (size_t)T * 32); WSB(MKB, (size_t)MROWS * 512); WSB(MVB, (size_t)MROWS * 512);
    WSB(QF, (size_t)T * 768); WSB(KV, (size_t)T * 1024); WSB(QN, (size_t)T * 768); WSB(KN, (size_t)T * 512); WSB(OMIX, (size_t)T * DM); WSB(XQ, (size_t)T * 512); WSB(X1B, (size_t)T * DM); WSB(X2B, (size_t)T * DM); WSB(XO, (size_t)T * 512); WSB(U, (size_t)T * DFF);
    WSF(MKV, (size_t)MROWS * 1024); WSF(ROPE, (size_t)(SEQ + DECS) * 32); WSF(LOGA, (size_t)T * 256); WSF(DS, (size_t)NGU * 8192); WSF(DDEC, (size_t)NGU * 64); WSF(X1, (size_t)T * DM); WSF(X2, (size_t)T * DM); WSF(PACC, (size_t)NU_SA * 64 * 256); WSF(PML, (size_t)NU_SA * 128);
    if (off > ws_size) { fprintf(stderr, "kernel_launch: workspace too small (%zu > %zu)\n", off, ws_size); return; }
    p.w_in = in[10]; p.w_qb = in[15]; p.w_kvb = in[17]; p.w_out = in[22]; p.w_xq = in[25]; p.w_xk = in[26]; p.w_xv = in[27]; p.w_xo = in[30]; p.w_ff1 = in[32]; p.w_ff2 = in[33];
    (void)hipMemsetAsync(p.ctl, 0, 1 << 20, stream);
#ifdef EMU
    const int grid = EMU_GRID;
#else
    static int grid = 0;
    if (!grid) { int dev = 0, cus = 0; (void)hipGetDevice(&dev); (void)hipDeviceGetAttribute(&cus, hipDeviceAttributeMultiprocessorCount, dev); grid = cus > 0 ? cus : 256;
#if N_LAUNCH_MODE == 1
        (void)hipFuncSetAttribute((const void*)k_mega, hipFuncAttributeMaxDynamicSharedMemorySize, LDS_BYTES);
        int per_cu = 0; if (hipOccupancyMaxActiveBlocksPerMultiprocessor(&per_cu, (const void*)k_mega, NTHREADS, LDS_BYTES) != hipSuccess || per_cu < 1) fprintf(stderr, "kernel_launch: occupancy query reports %d workgroups per CU\n", per_cu);
#endif
    }
#endif
#if N_LAUNCH_MODE == 1
    LAUNCH(k_mega, dim3(grid), dim3(NTHREADS), LDS_BYTES, stream, p);
#else
    launch_phase<0>(p, grid, stream); launch_phase<1>(p, grid, stream); launch_phase<2>(p, grid, stream); launch_phase<3>(p, grid, stream); launch_phase<4>(p, grid, stream);
    launch_phase<5>(p, grid, stream); launch_phase<6>(p, grid, stream); launch_phase<7>(p, grid, stream); launch_phase<8>(p, grid, stream); launch_phase<9>(p, grid, stream);
    launch_phase<10>(p, grid, stream); launch_phase<11>(p, grid, stream); launch_phase<12>(p, grid, stream); launch_phase<13>(p, grid, stream); launch_phase<14>(p, grid, stream);
#endif
}
```

```cpp
#ifdef EMU
#include "emu.h"
#define LDS
#else
#include <hip/hip_runtime.h>
#define LDS __attribute__((address_space(3)))
#define LAUNCH(kern, grid, block, smem, stream, ...) kern<<<grid, block, smem, stream>>>(__VA_ARGS__)
#endif
#include <cstdio>
#include <cstdint>
#include <cmath>
#define DI __device__ __forceinline__

#ifndef CFG_BATCH
#define CFG_BATCH 16
#define CFG_SEQ 2048
#define CFG_DECB 128
#define CFG_PAST 8192
#endif
#ifndef PROBE_A
#define PROBE_A -1
#define PROBE_B -1
#endif
#define PROBE_K 8
#ifndef GEMM_SP2
#define GEMM_SP2 true
#define GEMM_ALIGN true
#endif
#ifndef DUPP
#define DUPP 0
#endif
#ifndef DUPM
#define DUPM 0
#endif
#ifndef N_LAUNCH_MODE
#define N_LAUNCH_MODE 1
#endif

typedef unsigned short bf16;
typedef short bf16x8 __attribute__((ext_vector_type(8)));
typedef short s16x4 __attribute__((ext_vector_type(4)));
typedef float f32x4 __attribute__((ext_vector_type(4)));
typedef float f32x16 __attribute__((ext_vector_type(16)));
typedef unsigned u32x4 __attribute__((ext_vector_type(4)));
typedef unsigned u32x2 __attribute__((ext_vector_type(2)));

constexpr int DM = 1024, BATCH = CFG_BATCH, SEQ = CFG_SEQ, DECB = CFG_DECB, DECS = 8, PAST = CFG_PAST, PAGE = 128, NPAGES = PAST / PAGE;
constexpr int NMEM = 256, TP = BATCH * SEQ, TS = DECB * DECS, T = TP + TS, MROWS = BATCH * NMEM;
constexpr int DIN = 2224, DINP = 2304, DFF = 4096;
constexpr int ZQ = 0, ZK = 256, ZV = 512, ZR = 1024, ZA = 1536, ZQA = 1552, ZKVA = 1936, ZKPE = 2192;
constexpr float EPS = 1e-6f, MLA_SCALE = 0.10206207261596577f  , X_SCALE = 0.08838834764831845f  ;
constexpr int NC = SEQ / 64;
constexpr int NGP = BATCH * 4 * NC, NGS = DECB * 4, NGU = NGP + NGS;
constexpr int NSPLIT = NPAGES >= 2 ? 2 : NPAGES, PPS = NPAGES / NSPLIT;
static_assert(PPS <= 64, "page ids of a unit live in one wave register");
constexpr int NU_SA = DECB * NSPLIT, NQB = SEQ / 256, NU_PA = BATCH * 8 * NQB;
constexpr int NU_XP = BATCH * 4 * NQB, NU_XS = DECB * 4;
static_assert(T % 256 == 0 && MROWS % 256 == 0 && SEQ % 256 == 0 && NPAGES % NSPLIT == 0, "shape assumptions");
constexpr int NTHREADS = 512, LDS_BYTES = 147456, LDS_CTL = LDS_BYTES - 256;

DI int tid_opaque() {
    int t = threadIdx.x;
#ifndef EMU
    asm volatile("" : "+v"(t));
#endif
    return t;
}
DI float bf2f(bf16 b) { return __uint_as_float(((unsigned)b) << 16); }
DI bf16 f2bf(float x) {
#ifdef EMU
    unsigned u = __float_as_uint(x); u += 0x7fffu + ((u >> 16) & 1u); return (bf16)(u >> 16);
#else
    return __builtin_bit_cast(unsigned short, (__bf16)x);
#endif
}
DI float fexp(float x) {
#ifdef EMU
    return exp2f(x * 1.4426950408889634f);
#else
    return __builtin_amdgcn_exp2f(x * 1.4426950408889634f);
#endif
}
DI float flog2(float x) {
#ifdef EMU
    return log2f(x);
#else
    return __builtin_amdgcn_logf(x);
#endif
}
#ifndef EMU
typedef __bf16 bf16x2_t __attribute__((ext_vector_type(2)));
typedef float f32x2_t __attribute__((ext_vector_type(2)));
#endif
DI float fexp2(float x) {
#ifdef EMU
    return exp2f(x);
#else
    return __builtin_amdgcn_exp2f(x);
#endif
}
DI unsigned pk2(float a, float b) {
#ifdef EMU
    return (unsigned)f2bf(a) | ((unsigned)f2bf(b) << 16);
#else
    const f32x2_t v = {a, b}; return __builtin_bit_cast(unsigned, __builtin_convertvector(v, bf16x2_t));
#endif
}
DI f32x16 zero16() { f32x16 z; for (int i = 0; i < 16; ++i) z[i] = 0.f; return z; }
DI f32x16 mfma32(bf16x8 a, bf16x8 b, f32x16 c) { return __builtin_amdgcn_mfma_f32_32x32x16_bf16(a, b, c, 0, 0, 0); }
DI int crow(int i, int h) { return (i & 3) + 8 * (i >> 2) + 4 * h; }
DI bf16x8 ld8(const LDS bf16* p) { return *(const LDS bf16x8*)p; }
DI bf16x8 ld8g(const bf16* p) { return *(const bf16x8*)p; }
DI bf16x8 ldperm(const LDS bf16* p16, int h) {
    const s16x4 lo = *(const LDS s16x4*)(p16 + 4 * h), hi = *(const LDS s16x4*)(p16 + 8 + 4 * h);
    return __builtin_shufflevector(lo, hi, 0, 1, 2, 3, 4, 5, 6, 7);
}
DI bf16x8 ldpermg(const bf16* p16, int h) {
    const s16x4 lo = *(const s16x4*)(p16 + 4 * h), hi = *(const s16x4*)(p16 + 8 + 4 * h);
    return __builtin_shufflevector(lo, hi, 0, 1, 2, 3, 4, 5, 6, 7);
}
DI bf16x8 pack8(float a0, float a1, float a2, float a3, float a4, float a5, float a6, float a7) {
    u32x4 p; p[0] = pk2(a0, a1); p[1] = pk2(a2, a3); p[2] = pk2(a4, a5); p[3] = pk2(a6, a7); return __builtin_bit_cast(bf16x8, p);
}
#define PACK(x, s) pack8((x)[8 * (s)], (x)[8 * (s) + 1], (x)[8 * (s) + 2], (x)[8 * (s) + 3], (x)[8 * (s) + 4], (x)[8 * (s) + 5], (x)[8 * (s) + 6], (x)[8 * (s) + 7])
DI float wsum(float v) { for (int o = 32; o >= 1; o >>= 1) v += __shfl_xor(v, o); return v; }
DI bf16x8 zero8() { bf16x8 z; for (int i = 0; i < 8; ++i) z[i] = 0; return z; }

DI float xsum16(float v) {
#ifdef EMU
    return v + __shfl_xor(v, 16);
#else
    const auto r = __builtin_amdgcn_permlane16_swap(__float_as_uint(v), __float_as_uint(v), false, false); return __uint_as_float(r[0]) + __uint_as_float(r[1]);
#endif
}
DI float xsum32(float v) {
#ifdef EMU
    return v + __shfl_xor(v, 32);
#else
    const auto r = __builtin_amdgcn_permlane32_swap(__float_as_uint(v), __float_as_uint(v), false, false); return __uint_as_float(r[0]) + __uint_as_float(r[1]);
#endif
}
DI float xmax16(float v) {
#ifdef EMU
    return fmaxf(v, __shfl_xor(v, 16));
#else
    const auto r = __builtin_amdgcn_permlane16_swap(__float_as_uint(v), __float_as_uint(v), false, false); return fmaxf(__uint_as_float(r[0]), __uint_as_float(r[1]));
#endif
}
DI float xmax32(float v) {
#ifdef EMU
    return fmaxf(v, __shfl_xor(v, 32));
#else
    const auto r = __builtin_amdgcn_permlane32_swap(__float_as_uint(v), __float_as_uint(v), false, false); return fmaxf(__uint_as_float(r[0]), __uint_as_float(r[1]));
#endif
}

DI unsigned imgb(unsigned row, unsigned ch) { return 256u * row + 16u * (ch ^ (((row & 3u) << 2) | ((row >> 2) & 3u))); }
DI bf16x8 img_row(const LDS unsigned char* img, unsigned row, unsigned s, unsigned hh) { return *(const LDS bf16x8*)(img + imgb(row, 2 * s + hh)); }
DI s16x4 tr16(const LDS unsigned char* a) {
#ifdef EMU
    return emu_tr16_b64(a);
#else
    return __builtin_amdgcn_ds_read_tr16_b64_v4i16((LDS s16x4*)a);
#endif
}
template <bool PERM> DI bf16x8 img_tr(const LDS unsigned char* img, unsigned lane, unsigned c, unsigned k16) {
    const unsigned hh = lane >> 5, blk = (lane >> 4) & 1, q = (lane & 15) >> 2, pp = lane & 3;
    const unsigned r0 = k16 + (PERM ? 4 * hh : 8 * hh) + q, r1 = r0 + (PERM ? 8 : 4), ch = 4 * c + 2 * blk + (pp >> 1);
    const LDS unsigned char* a0 = img + imgb(r0, ch) + 8 * (pp & 1); const LDS unsigned char* a1 = img + imgb(r1, ch) + 8 * (pp & 1);
#ifdef EMU
    const s16x4 lo = emu_tr16_b64(a0), hi = emu_tr16_b64(a1);
#else
    s16x4 lo, hi;
    asm volatile("ds_read_b64_tr_b16 %0, %2\n\tds_read_b64_tr_b16 %1, %3\n\ts_waitcnt lgkmcnt(0)" : "=&v"(lo), "=&v"(hi) : "v"((unsigned)(size_t)a0), "v"((unsigned)(size_t)a1) : "memory");
#endif
    return __builtin_shufflevector(lo, hi, 0, 1, 2, 3, 4, 5, 6, 7);
}

DI void img_tr4p(const LDS unsigned char* img, unsigned lane, unsigned c0, unsigned c1, unsigned ka, unsigned kb, bf16x8& f0, bf16x8& f1, bf16x8& f2, bf16x8& f3) {
#ifdef EMU
    f0 = img_tr<true>(img, lane, c0, ka); f1 = img_tr<true>(img, lane, c1, ka); f2 = img_tr<true>(img, lane, c0, kb); f3 = img_tr<true>(img, lane, c1, kb);
#else
    const unsigned hh = lane >> 5, blk = (lane >> 4) & 1, q = (lane & 15) >> 2, pp = lane & 3;
    unsigned ad[8]; s16x4 v[8];
#pragma unroll
    for (int f = 0; f < 4; ++f) { const unsigned c = (f & 1) ? c1 : c0, k16 = (f & 2) ? kb : ka, r0 = k16 + 4 * hh + q, ch = 4 * c + 2 * blk + (pp >> 1);
        ad[2 * f] = (unsigned)(size_t)(img + imgb(r0, ch) + 8 * (pp & 1)); ad[2 * f + 1] = (unsigned)(size_t)(img + imgb(r0 + 8, ch) + 8 * (pp & 1)); }
    asm volatile("ds_read_b64_tr_b16 %0, %8\n\tds_read_b64_tr_b16 %1, %9\n\tds_read_b64_tr_b16 %2, %10\n\tds_read_b64_tr_b16 %3, %11\n\tds_read_b64_tr_b16 %4, %12\n\tds_read_b64_tr_b16 %5, %13\n\tds_read_b64_tr_b16 %6, %14\n\tds_read_b64_tr_b16 %7, %15\n\ts_waitcnt lgkmcnt(0)"
                 : "=&v"(v[0]), "=&v"(v[1]), "=&v"(v[2]), "=&v"(v[3]), "=&v"(v[4]), "=&v"(v[5]), "=&v"(v[6]), "=&v"(v[7])
                 : "v"(ad[0]), "v"(ad[1]), "v"(ad[2]), "v"(ad[3]), "v"(ad[4]), "v"(ad[5]), "v"(ad[6]), "v"(ad[7]) : "memory");
    f0 = __builtin_shufflevector(v[0], v[1], 0, 1, 2, 3, 4, 5, 6, 7); f1 = __builtin_shufflevector(v[2], v[3], 0, 1, 2, 3, 4, 5, 6, 7);
    f2 = __builtin_shufflevector(v[4], v[5], 0, 1, 2, 3, 4, 5, 6, 7); f3 = __builtin_shufflevector(v[6], v[7], 0, 1, 2, 3, 4, 5, 6, 7);
#endif
}

DI unsigned tr_lane_off(unsigned lane, unsigned c, unsigned plus8) {
    const unsigned hh = lane >> 5, blk = (lane >> 4) & 1, q = (lane & 15) >> 2, pp = lane & 3;
    return imgb(4 * hh + q + 8 * plus8, 4 * c + 2 * blk + (pp >> 1)) + 8 * (pp & 1);
}
template <int KA, int KB, bool USE_ASM = true> DI void img_tr4p_pre(const LDS unsigned char* p0, const LDS unsigned char* p1, const LDS unsigned char* p2, const LDS unsigned char* p3, bf16x8& f0, bf16x8& f1, bf16x8& f2, bf16x8& f3) {
#ifndef EMU
    if constexpr (!USE_ASM) {
        const s16x4 a0 = __builtin_amdgcn_ds_read_tr16_b64_v4i16((LDS s16x4*)(p0 + 256 * KA)), a1 = __builtin_amdgcn_ds_read_tr16_b64_v4i16((LDS s16x4*)(p1 + 256 * KA)), a2 = __builtin_amdgcn_ds_read_tr16_b64_v4i16((LDS s16x4*)(p2 + 256 * KA)), a3 = __builtin_amdgcn_ds_read_tr16_b64_v4i16((LDS s16x4*)(p3 + 256 * KA));
        const s16x4 b0 = __builtin_amdgcn_ds_read_tr16_b64_v4i16((LDS s16x4*)(p0 + 256 * KB)), b1 = __builtin_amdgcn_ds_read_tr16_b64_v4i16((LDS s16x4*)(p1 + 256 * KB)), b2 = __builtin_amdgcn_ds_read_tr16_b64_v4i16((LDS s16x4*)(p2 + 256 * KB)), b3 = __builtin_amdgcn_ds_read_tr16_b64_v4i16((LDS s16x4*)(p3 + 256 * KB));
        f0 = __builtin_shufflevector(a0, a1, 0, 1, 2, 3, 4, 5, 6, 7); f1 = __builtin_shufflevector(a2, a3, 0, 1, 2, 3, 4, 5, 6, 7); f2 = __builtin_shufflevector(b0, b1, 0, 1, 2, 3, 4, 5, 6, 7); f3 = __builtin_shufflevector(b2, b3, 0, 1, 2, 3, 4, 5, 6, 7);
        return; }
#endif
#ifdef EMU
    const s16x4 a0 = emu_tr16_b64(p0 + 256 * KA), a1 = emu_tr16_b64(p1 + 256 * KA), a2 = emu_tr16_b64(p2 + 256 * KA), a3 = emu_tr16_b64(p3 + 256 * KA);
    const s16x4 b0 = emu_tr16_b64(p0 + 256 * KB), b1 = emu_tr16_b64(p1 + 256 * KB), b2 = emu_tr16_b64(p2 + 256 * KB), b3 = emu_tr16_b64(p3 + 256 * KB);
    f0 = __builtin_shufflevector(a0, a1, 0, 1, 2, 3, 4, 5, 6, 7); f1 = __builtin_shufflevector(a2, a3, 0, 1, 2, 3, 4, 5, 6, 7); f2 = __builtin_shufflevector(b0, b1, 0, 1, 2, 3, 4, 5, 6, 7); f3 = __builtin_shufflevector(b2, b3, 0, 1, 2, 3, 4, 5, 6, 7);
#else
    s16x4 v[8];
    asm volatile("ds_read_b64_tr_b16 %0, %8 offset:%12\n\tds_read_b64_tr_b16 %1, %9 offset:%12\n\tds_read_b64_tr_b16 %2, %10 offset:%12\n\tds_read_b64_tr_b16 %3, %11 offset:%12\n\t"
                 "ds_read_b64_tr_b16 %4, %8 offset:%13\n\tds_read_b64_tr_b16 %5, %9 offset:%13\n\tds_read_b64_tr_b16 %6, %10 offset:%13\n\tds_read_b64_tr_b16 %7, %11 offset:%13\n\ts_waitcnt lgkmcnt(0)"
                 : "=&v"(v[0]), "=&v"(v[1]), "=&v"(v[2]), "=&v"(v[3]), "=&v"(v[4]), "=&v"(v[5]), "=&v"(v[6]), "=&v"(v[7])
                 : "v"((unsigned)(size_t)p0), "v"((unsigned)(size_t)p1), "v"((unsigned)(size_t)p2), "v"((unsigned)(size_t)p3), "n"(256 * KA), "n"(256 * KB) : "memory");
    f0 = __builtin_shufflevector(v[0], v[1], 0, 1, 2, 3, 4, 5, 6, 7); f1 = __builtin_shufflevector(v[2], v[3], 0, 1, 2, 3, 4, 5, 6, 7);
    f2 = __builtin_shufflevector(v[4], v[5], 0, 1, 2, 3, 4, 5, 6, 7); f3 = __builtin_shufflevector(v[6], v[7], 0, 1, 2, 3, 4, 5, 6, 7);
#endif
}
DI void dma16(const void* g, LDS unsigned char* l) {
#ifdef EMU
    emu_dma16(g, l);
#else
    __builtin_amdgcn_global_load_lds((const unsigned*)g, (LDS unsigned*)l, 16, 0, 2);
#endif
}
#ifdef EMU
#define SCHED_FENCE() do {} while (0)
#else
#define SCHED_FENCE() __builtin_amdgcn_sched_barrier(0)
#endif
DI int rdlane(int v, int l) {
#ifdef EMU
    return __shfl(v, l);
#else
    return __builtin_amdgcn_readlane(v, l);
#endif
}
DI void wait_vm0() {
#ifndef EMU
    asm volatile("s_waitcnt vmcnt(0)" ::: "memory");
#else
    int z_ = 0; (void)__shfl_xor(z_, 1);
#endif
}
DI void bar_lds() {
#ifdef EMU
    __syncthreads();
#else
    asm volatile("s_waitcnt lgkmcnt(0)" ::: "memory"); __builtin_amdgcn_s_barrier(); asm volatile("" ::: "memory");
#endif
}

namespace pg8 {
#define PG8_LAS LDS
typedef unsigned short bf16_t;
constexpr int BM = 256, BK = 64, HALF = 128, HTB = HALF * BK * 2  , STAGE_BYTES = 8 * HTB, NXCD = 8, WGM = 8;
__host__ __device__ __forceinline__ int lds_byte(int r, int c) { const int st = (r >> 4) * 2 + (c >> 5), rr = r & 15, cc = c & 31, ob = rr * 64 + cc * 2; return st * 1024 + (ob ^ (((ob >> 9) & 1) << 5)); }
__host__ __device__ __forceinline__ void stage_rc(int b, int& R, int& C) { const int st = b / 1024, sb = b % 1024, swz = sb ^ (((sb >> 9) & 1) << 5); R = (st >> 1) * 16 + swz / 64; C = (st & 1) * 32 + (swz % 64) / 2; }
__host__ __device__ __forceinline__ int perm32(int rho) { const int n = rho >> 4, i = rho & 15; return 8 * (i >> 2) + 4 * n + (i & 3); }
struct Unit { int pm, pn; };
struct Gemm { const bf16_t* A; const bf16_t* Bt; int M, N, K; };
struct StaticOrder {
    int nM, nN, nwg, G, c;
    __host__ __device__ void init(int M, int N, int G_, int c_) { nM = M / BM; nN = N / BM; nwg = nM * nN; G = G_; c = c_; }
    __host__ __device__ bool next(int i, Unit& u) const {
        const long L = (long)i * G + c; if (L >= nwg) return false;
        int wgid = (int)L; { const int q = nwg / NXCD, r = nwg % NXCD, xcd = wgid % NXCD, off = wgid / NXCD; wgid = (xcd < r ? xcd * (q + 1) : r * (q + 1) + (xcd - r) * q) + off; }
        const int nig = WGM * nN, gid = wgid / nig, fm = gid * WGM, gsz = (nM - fm) < WGM ? (nM - fm) : WGM;
        u.pm = fm + ((wgid % nig) % gsz); u.pn = (wgid % nig) / gsz; return true;
    }
    __device__ __forceinline__ void a_ready(const Unit&) const {}
    __device__ __forceinline__ void done(const Unit&) const {}
};
#ifdef EMU
template <class Epi, class Sched, bool ALIGN_EPI = false, bool SP2 = false>
__device__ __forceinline__ void gemm_phase(PG8_LAS unsigned char* lds, const Gemm g, const Sched& S, const Epi& E) {
    const int tid = tid_opaque(), wid = __builtin_amdgcn_readfirstlane(tid >> 6), lane = tid & 63, wr = wid >> 2, wc = wid & 3, fr = lane & 15, fq = lane >> 4;
    Unit cur;
    for (int ui = 0; S.next(ui, cur); ++ui) {
        f32x4 acc[2][2][4][2];
        for (int ai = 0; ai < 2; ++ai) for (int bj = 0; bj < 2; ++bj) for (int m = 0; m < 4; ++m) for (int n = 0; n < 2; ++n) for (int j = 0; j < 4; ++j) {
            const int row = 256 * cur.pm + 128 * ai + 64 * wr + 16 * m + fr;
            const int col = Epi::PERM ? 256 * cur.pn + 128 * bj + 32 * wc + 8 * fq + 4 * n + j : 256 * cur.pn + 128 * bj + 32 * wc + 16 * n + 4 * fq + j;
            const bf16_t* a = g.A + (size_t)row * g.K; const bf16_t* b = g.Bt + (size_t)col * g.K; float s = 0.f;
            for (int k = 0; k < g.K; ++k) s += bf2f(a[k]) * bf2f(b[k]);
            acc[ai][bj][m][n][j] = s;
        }
        E(acc, cur, wr, wc, fr, fq);
    }
}
#else
template <class Epi, class Sched, bool ALIGN_EPI = false, bool SP2 = false>
__device__ __forceinline__ void gemm_phase(PG8_LAS unsigned char* lds, const Gemm g, const Sched& S, const Epi& E) {
    const int tid = tid_opaque(), wid = __builtin_amdgcn_readfirstlane(tid >> 6), lane = tid & 63, wr = wid >> 2, wc = wid & 3, fr = lane & 15, fq = lane >> 4;
    const int K = g.K, nt = K / BK;
    unsigned voffA[2], voffB[2];
#pragma unroll
    for (int i = 0; i < 2; ++i) { int R, C; stage_rc(tid * 16 + i * 8192, R, C); const int Rb = Epi::PERM ? ((R & ~31) + perm32(R & 31)) : R;
        voffA[i] = (unsigned)(R * K + C) * 2u; voffB[i] = (unsigned)(Rb * K + C) * 2u; }
    const size_t kstep = (size_t)(BK * 2);
    const size_t hstep = (size_t)HALF * K * 2;
    const size_t tstep = 2 * hstep;
    const unsigned ldsw = (unsigned)wid * 1024u;
    const int aoff = lds_byte(wr * 64 + fr, fq * 8), boff = lds_byte(wc * 32 + fr, fq * 8);
#define PG8_SA(b, h) (((b) * 2 + (h)) * HTB)
#define PG8_SB(b, h) ((4 + (b) * 2 + (h)) * HTB)
#define PG8_STAGE(bufoff, gbase, voff) do { _Pragma("unroll") for (int _i = 0; _i < 2; ++_i) \
        __builtin_amdgcn_global_load_lds((const unsigned*)((const char*)(gbase) + (voff)[_i]), (PG8_LAS unsigned*)(lds + (bufoff) + ldsw + _i * 8192), 16, 0, 0); } while (0)
#define PG8_LDA(dst, b, h) do { _Pragma("unroll") for (int m = 0; m < 4; ++m) _Pragma("unroll") for (int k = 0; k < 2; ++k) dst[m][k] = *(const PG8_LAS bf16x8*)(lds + PG8_SA(b, h) + aoff + m * 2048 + k * 1024); } while (0)
#define PG8_LDB(dst, b, h) do { _Pragma("unroll") for (int n = 0; n < 2; ++n) _Pragma("unroll") for (int k = 0; k < 2; ++k) dst[n][k] = *(const PG8_LAS bf16x8*)(lds + PG8_SB(b, h) + boff + n * 2048 + k * 1024); } while (0)
#define PG8_MMA(ai, bj, At, Bt) do { __builtin_amdgcn_s_setprio(1); _Pragma("unroll") for (int m = 0; m < 4; ++m) _Pragma("unroll") for (int n = 0; n < 2; ++n) _Pragma("unroll") for (int k = 0; k < 2; ++k) \
        acc[ai][bj][m][n] = __builtin_amdgcn_mfma_f32_16x16x32_bf16(Bt[n][k], At[m][k], acc[ai][bj][m][n], 0, 0, 0); __builtin_amdgcn_s_setprio(0); } while (0)
#define PG8_WAIT_V(n) asm volatile("s_waitcnt vmcnt(" #n ")" ::: "memory")
#define PG8_WAIT_L(n) asm volatile("s_waitcnt lgkmcnt(" #n ")" ::: "memory")
#define PG8_BAR __builtin_amdgcn_s_barrier()
#define PG8_SCHED __builtin_amdgcn_sched_barrier(0)
    Unit cur, nxt; int ui = 0;
    if (!S.next(0, cur)) return;
    f32x4 acc[2][2][4][2];
#pragma unroll
    for (int a = 0; a < 2; ++a)
#pragma unroll
        for (int b = 0; b < 2; ++b)
#pragma unroll
            for (int m = 0; m < 4; ++m)
#pragma unroll
                for (int n = 0; n < 2; ++n) acc[a][b][m][n] = (f32x4){0.f, 0.f, 0.f, 0.f};
    bf16x8 At[4][2], B0[2][2], B1[2][2];
    const char* cA = (const char*)g.A + (size_t)cur.pm * tstep; const char* cB = (const char*)g.Bt + (size_t)cur.pn * tstep;
    S.a_ready(cur);
    if constexpr (SP2) {
        PG8_STAGE(PG8_SB(0, 0), cB, voffB); PG8_STAGE(PG8_SB(0, 1), cB + hstep, voffB); PG8_STAGE(PG8_SA(0, 0), cA, voffA); PG8_STAGE(PG8_SA(0, 1), cA + hstep, voffA);
        if (wr == 1) PG8_BAR;
        PG8_WAIT_V(2); PG8_BAR;
        PG8_STAGE(PG8_SB(1, 0), cB + kstep, voffB); PG8_STAGE(PG8_SA(1, 0), cA + kstep, voffA); PG8_STAGE(PG8_SB(1, 1), cB + hstep + kstep, voffB);
        PG8_WAIT_V(6); PG8_BAR;
    } else {
        PG8_STAGE(PG8_SB(0, 0), cB, voffB); PG8_STAGE(PG8_SA(0, 0), cA, voffA); PG8_STAGE(PG8_SB(0, 1), cB + hstep, voffB); PG8_STAGE(PG8_SA(0, 1), cA + hstep, voffA);
        if (wr == 1) PG8_BAR;
        PG8_WAIT_V(4); PG8_BAR;
        PG8_STAGE(PG8_SB(1, 0), cB + kstep, voffB); PG8_STAGE(PG8_SA(1, 0), cA + kstep, voffA); PG8_STAGE(PG8_SB(1, 1), cB + hstep + kstep, voffB);
        PG8_WAIT_V(6); PG8_BAR;
    }
    for (;;) {
        const bool has_next = S.next(ui + 1, nxt);
        const char* nA = has_next ? (const char*)g.A + (size_t)nxt.pm * tstep : cA; const char* nB = has_next ? (const char*)g.Bt + (size_t)nxt.pn * tstep : cB;
        for (int t = 0; t < nt; t += 2) {
            const bool last = (t == nt - 2);
            const char* a1 = cA + (size_t)(t + 1) * kstep;
            const char* a2 = last ? nA : cA + (size_t)(t + 2) * kstep; const char* b2 = last ? nB : cB + (size_t)(t + 2) * kstep;
            const char* a3 = a2 + kstep; const char* b3 = b2 + kstep;
            if (last && has_next) S.a_ready(nxt);
            if constexpr (SP2) {
            PG8_LDB(B0, 0, 0); PG8_LDB(B1, 0, 1); PG8_SCHED; PG8_LDA(At, 0, 0); PG8_STAGE(PG8_SA(1, 1), a1 + hstep, voffA);
            PG8_WAIT_V(8); PG8_WAIT_L(0); PG8_BAR; PG8_MMA(0, 0, At, B0); PG8_MMA(0, 1, At, B1); PG8_BAR; PG8_SCHED;
            PG8_LDA(At, 0, 1); PG8_STAGE(PG8_SB(0, 0), b2, voffB); PG8_STAGE(PG8_SB(0, 1), b2 + hstep, voffB); PG8_STAGE(PG8_SA(0, 0), a2, voffA);
            PG8_WAIT_V(8); PG8_WAIT_L(0); PG8_BAR; PG8_MMA(1, 0, At, B0); PG8_MMA(1, 1, At, B1); PG8_BAR; PG8_SCHED;
            PG8_LDB(B0, 1, 0); PG8_LDB(B1, 1, 1); PG8_SCHED; PG8_LDA(At, 1, 0); PG8_STAGE(PG8_SA(0, 1), a2 + hstep, voffA);
            PG8_WAIT_V(8); PG8_WAIT_L(0); PG8_BAR; PG8_MMA(0, 0, At, B0); PG8_MMA(0, 1, At, B1); PG8_BAR; PG8_SCHED;
            PG8_LDA(At, 1, 1); PG8_STAGE(PG8_SB(1, 0), b3, voffB); PG8_STAGE(PG8_SB(1, 1), b3 + hstep, voffB); PG8_STAGE(PG8_SA(1, 0), a3, voffA);
            PG8_WAIT_V(8); PG8_WAIT_L(0); PG8_BAR; PG8_MMA(1, 0, At, B0); PG8_MMA(1, 1, At, B1); PG8_BAR; PG8_SCHED;
            } else {
            PG8_LDB(B0, 0, 0); PG8_SCHED; PG8_LDA(At, 0, 0); PG8_STAGE(PG8_SA(1, 1), a1 + hstep, voffA);
            PG8_WAIT_L(8); PG8_BAR; PG8_WAIT_L(0); PG8_MMA(0, 0, At, B0); PG8_BAR; PG8_SCHED;
            PG8_LDB(B1, 0, 1); PG8_STAGE(PG8_SB(0, 0), b2, voffB);
            PG8_BAR; PG8_WAIT_L(0); PG8_MMA(0, 1, At, B1); PG8_BAR;
            PG8_LDA(At, 0, 1); PG8_STAGE(PG8_SA(0, 0), a2, voffA);
            PG8_BAR; PG8_WAIT_L(0); PG8_MMA(1, 0, At, B0); PG8_BAR; PG8_SCHED;
            PG8_STAGE(PG8_SB(0, 1), b2 + hstep, voffB);
            PG8_WAIT_V(6); PG8_BAR; PG8_MMA(1, 1, At, B1); PG8_BAR;
            PG8_LDB(B0, 1, 0); PG8_SCHED; PG8_LDA(At, 1, 0); PG8_STAGE(PG8_SA(0, 1), a2 + hstep, voffA);
            PG8_WAIT_L(8); PG8_BAR; PG8_WAIT_L(0); PG8_MMA(0, 0, At, B0); PG8_BAR; PG8_SCHED;
            PG8_LDB(B1, 1, 1); PG8_STAGE(PG8_SB(1, 0), b3, voffB);
            PG8_BAR; PG8_WAIT_L(0); PG8_MMA(0, 1, At, B1); PG8_BAR;
            PG8_LDA(At, 1, 1); PG8_STAGE(PG8_SA(1, 0), a3, voffA);
            PG8_BAR; PG8_WAIT_L(0); PG8_MMA(1, 0, At, B0); PG8_BAR; PG8_SCHED;
            PG8_STAGE(PG8_SB(1, 1), b3 + hstep, voffB);
            PG8_WAIT_V(6); PG8_BAR; PG8_MMA(1, 1, At, B1); PG8_BAR;
            }
        }
        if constexpr (ALIGN_EPI) { if (wr == 0) PG8_BAR; }
        if constexpr (!Epi::AFTER_DRAIN) { E(acc, cur, wr, wc, fr, fq); S.done(cur); }
        if (!has_next) break;
#pragma unroll
        for (int a = 0; a < 2; ++a)
#pragma unroll
            for (int b = 0; b < 2; ++b)
#pragma unroll
                for (int m = 0; m < 4; ++m)
#pragma unroll
                    for (int n = 0; n < 2; ++n) acc[a][b][m][n] = (f32x4){0.f, 0.f, 0.f, 0.f};
        cur = nxt; cA = nA; cB = nB; ++ui;
        if constexpr (ALIGN_EPI) { if (wr == 1) PG8_BAR; }
    }
    PG8_WAIT_V(0);
    if constexpr (!ALIGN_EPI) { if (wr == 0) PG8_BAR; }
    PG8_BAR;
    if constexpr (Epi::AFTER_DRAIN) { E.fused(acc, cur, wr, wc, fr, fq, lds, wid, lane); S.done(cur); }
#undef PG8_SA
#undef PG8_SB
#undef PG8_STAGE
#undef PG8_LDA
#undef PG8_LDB
#undef PG8_MMA
#undef PG8_WAIT_V
#undef PG8_WAIT_L
#undef PG8_BAR
#undef PG8_SCHED
}
#endif
}

struct Params {
    const float *xp, *xs, *memp, *cckv, *ckpe, *cmk, *cmv, *sgla; const int* ptab;
    const float *g_mix, *w_a2, *b_a, *g_gla_o, *g_qa, *g_kva, *g_qn, *g_kn, *g_qr, *g_kr, *g_x, *g_mem, *g_xq, *g_xk, *g_ff;
    float *y, *o_ckvp, *o_kpep, *o_mkp, *o_mvp, *o_glap, *o_ckvs, *o_kpes, *o_glas;
    unsigned* ctl;
    bf16 *wt_in, *wt_qb, *wt_kvb, *wt_out, *wt_xq, *wt_xkv, *wt_xo, *wt_ff1, *wt_ff2;
    bf16 *X1B, *X2B, *H, *MEMN, *Z, *QAN, *CKVB, *KPB, *MKB, *MVB, *QF, *KV, *QN, *KN, *OMIX, *XQ, *XO, *U;
    float *MKV, *LOGA, *DS, *DDEC, *X1, *X2, *PACC, *PML, *ROPE, *GMAX, *SS1, *SS2;
    const float *w_in, *w_qb, *w_kvb, *w_out, *w_xq, *w_xk, *w_xv, *w_xo, *w_ff1, *w_ff2;
};
constexpr int CW_Q5 = 0, CW_QX = 512, CW_SC = 1024  , CW_BAR = 4096, CW_STAMP = 8192;
#ifdef EMU
#define STAMP(i) do {} while (0)
#else
#define STAMP(i) do { if (PROBE_A >= 0 && blockIdx.x == 0 && threadIdx.x == 0) ((volatile unsigned long long*)(p.ctl + CW_STAMP))[i] = wall_clock64(); } while (0)
#endif

template <int ACT  , bool SCALE = false> struct EpiStoreBf16 {
    static constexpr bool PERM = true, AFTER_DRAIN = false;
    bf16* O; int ldc; const float* SS = nullptr;
    DI void operator()(const f32x4 (&acc)[2][2][4][2], const pg8::Unit& u, int wr, int wc, int fr, int fq) const {
        const int row0 = u.pm * 256 + wr * 64 + fr, col0 = u.pn * 256 + wc * 32 + 8 * fq;
        float rs[2][4];
        if constexpr (SCALE) { f32x4 t[2][4];
#pragma unroll
            for (int ai = 0; ai < 2; ++ai)
#pragma unroll
                for (int m = 0; m < 4; ++m) t[ai][m] = *(const f32x4*)(SS + (size_t)(row0 + ai * 128 + m * 16) * 16 + 4 * fq);
#pragma unroll
            for (int ai = 0; ai < 2; ++ai)
#pragma unroll
                for (int m = 0; m < 4; ++m) { float q = (t[ai][m][0] + t[ai][m][1]) + (t[ai][m][2] + t[ai][m][3]); q = xsum16(q); q = xsum32(q); rs[ai][m] = rsqrtf(q * (1.0f / 1024.0f) + EPS); } }
#pragma unroll
        for (int ai = 0; ai < 2; ++ai)
#pragma unroll
            for (int m = 0; m < 4; ++m) { bf16* rowp = O + (size_t)(row0 + ai * 128 + m * 16) * ldc + col0;
#pragma unroll
                for (int bj = 0; bj < 2; ++bj) { f32x4 v0 = acc[ai][bj][m][0], v1 = acc[ai][bj][m][1];
                    if constexpr (SCALE) { v0 *= rs[ai][m]; v1 *= rs[ai][m]; }
                    if (ACT == 1) {
#pragma unroll
                        for (int j = 0; j < 4; ++j) { const float a = fmaxf(v0[j], 0.f), b = fmaxf(v1[j], 0.f); v0[j] = a * a; v1[j] = b * b; } }
                    u32x4 w; w[0] = pk2(v0[0], v0[1]); w[1] = pk2(v0[2], v0[3]); w[2] = pk2(v1[0], v1[1]); w[3] = pk2(v1[2], v1[3]);
                    *(u32x4*)(rowp + bj * 128) = w; } }
    }
};
struct EpiStoreF32 {
    static constexpr bool PERM = false, AFTER_DRAIN = false;
    float* C; const float* R; int ldc;
    DI void operator()(const f32x4 (&acc)[2][2][4][2], const pg8::Unit& u, int wr, int wc, int fr, int fq) const {
        const int row0 = u.pm * 256 + wr * 64 + fr, col0 = u.pn * 256 + wc * 32 + 4 * fq;
#pragma unroll
        for (int ai = 0; ai < 2; ++ai)
#pragma unroll
            for (int m = 0; m < 4; ++m) { const size_t off = (size_t)(row0 + ai * 128 + m * 16) * ldc + col0;
#pragma unroll
                for (int bj = 0; bj < 2; ++bj)
#pragma unroll
                    for (int n = 0; n < 2; ++n) { f32x4 v = acc[ai][bj][m][n]; if (R) v += *(const f32x4*)(R + off + bj * 128 + n * 16); *(f32x4*)(C + off + bj * 128 + n * 16) = v; } }
    }
};
template <class Epi> DI void run_gemm(LDS unsigned char* lds, const bf16* A, const bf16* Bt, int M, int N, int K, const Epi& E, int rot) {
    pg8::Gemm g{A, Bt, M, N, K}; pg8::StaticOrder S; S.init(M, N, (int)gridDim.x, (int)((blockIdx.x + rot) % gridDim.x));
    pg8::gemm_phase<Epi, pg8::StaticOrder, GEMM_ALIGN, GEMM_SP2>(lds, g, S, E);
}


struct SEpiBf16 { bf16* O; int ld; int act; const float* SS = nullptr;
    DI void put(int row, int col, f32x4 v) const {
        if (SS) { float q = SS[(size_t)row * 16 + (tid_opaque() & 15)]; q += __shfl_xor(q, 1); q += __shfl_xor(q, 2); q += __shfl_xor(q, 4); q += __shfl_xor(q, 8); v *= rsqrtf(q * (1.0f / 1024.0f) + EPS); }
        if (act) {
#pragma unroll
            for (int j = 0; j < 4; ++j) { const float a = fmaxf(v[j], 0.f); v[j] = a * a; } }
        u32x2 w; w[0] = pk2(v[0], v[1]); w[1] = pk2(v[2], v[3]); *(u32x2*)(O + (size_t)row * ld + col) = w; } };
struct SEpiRes { float* C; const float* R;
    DI void put(int row, int col, f32x4 v) const { *(f32x4*)(C + (size_t)row * DM + col) = v + *(const f32x4*)(R + (size_t)row * DM + col); } };
template <class SE> DI void small_gemm(LDS unsigned char* lds, const bf16* A, const bf16* Bt, int N, int K, const SE& E, int rot) {
    const int tid = tid_opaque(), wid = __builtin_amdgcn_readfirstlane(tid >> 6), lane = tid & 63, r = lane & 31, hh = lane >> 5;
    const int nN = N / 64, nunits = (TS / 64) * nN, kw = K / 8, nks = kw / 16;
    LDS float* RED = (LDS float*)lds;
    const int G = (int)gridDim.x;
    bf16x8 af[4][2], bfr[4][2];
    auto ldg = [&](int uu, int k0) {
        const int um = uu / nN, un = uu % nN;
        const bf16* ap = A + (size_t)(TP + um * 64 + r) * K + wid * kw + 8 * hh;
        const bf16* bp = Bt + (size_t)(un * 64 + r) * K + wid * kw + 8 * hh;
#pragma unroll
        for (int q = 0; q < 4; ++q) if (k0 + q < nks) {
#pragma unroll
            for (int t = 0; t < 2; ++t) { af[q][t] = ld8g(ap + (size_t)t * 32 * K + 16 * (k0 + q)); bfr[q][t] = ld8g(bp + (size_t)t * 32 * K + 16 * (k0 + q)); } } };
    int u = (int)((blockIdx.x + rot) % gridDim.x);
    if (u < nunits) ldg(u, 0);
    for (; u < nunits; u += G) {
        const int um = u / nN, un = u % nN;
        f32x16 acc[2][2];
#pragma unroll
        for (int i = 0; i < 2; ++i)
#pragma unroll
            for (int j = 0; j < 2; ++j) acc[i][j] = zero16();
        for (int k0 = 0; k0 < nks; k0 += 4) {
            bf16x8 ca[4][2], cb[4][2];
#pragma unroll
            for (int q = 0; q < 4; ++q)
#pragma unroll
                for (int t = 0; t < 2; ++t) { ca[q][t] = af[q][t]; cb[q][t] = bfr[q][t]; }
            if (k0 + 4 < nks) ldg(u, k0 + 4); else if (u + G < nunits) ldg(u + G, 0);
#pragma unroll
            for (int q = 0; q < 4; ++q) if (k0 + q < nks) {
#pragma unroll
                for (int mt = 0; mt < 2; ++mt)
#pragma unroll
                    for (int nt = 0; nt < 2; ++nt) acc[mt][nt] = mfma32(cb[q][nt], ca[q][mt], acc[mt][nt]); }
        }
#pragma unroll
        for (int mt = 0; mt < 2; ++mt)
#pragma unroll
            for (int nt = 0; nt < 2; ++nt)
#pragma unroll
                for (int g = 0; g < 4; ++g) *(LDS f32x4*)(RED + wid * 4096 + (32 * mt + r) * 64 + 32 * nt + 8 * g + 4 * hh) = (f32x4){acc[mt][nt][4 * g], acc[mt][nt][4 * g + 1], acc[mt][nt][4 * g + 2], acc[mt][nt][4 * g + 3]};
        bar_lds();
#pragma unroll
        for (int j = 0; j < 2; ++j) { const int gidx = tid + NTHREADS * j, row = gidx >> 4, c4 = (gidx & 15) * 4; f32x4 s = *(const LDS f32x4*)(RED + row * 64 + c4);
#pragma unroll
            for (int w = 1; w < 8; ++w) s += *(const LDS f32x4*)(RED + w * 4096 + row * 64 + c4);
            E.put(TP + um * 64 + row, un * 64 + c4, s); }
        bar_lds();
    }
}

DI const float* xrow(const Params& p, int t) { return t < TP ? p.xp + (size_t)t * DM : p.xs + (size_t)(t - TP) * DM; }
DI void rmsnorm_row_1024(const float* src, const float* g, bf16* dst, int lane) {
    f32x4 v[4]; float ss = 0.f;
#pragma unroll
    for (int i = 0; i < 4; ++i) { v[i] = *(const f32x4*)(src + 4 * (lane + 64 * i)); ss += v[i][0] * v[i][0] + v[i][1] * v[i][1] + v[i][2] * v[i][2] + v[i][3] * v[i][3]; }
    ss = wsum(ss); const float rs = rsqrtf(ss * (1.0f / 1024.0f) + EPS);
#pragma unroll
    for (int i = 0; i < 4; ++i) { const f32x4 gg = *(const f32x4*)(g + 4 * (lane + 64 * i)); u32x2 w; w[0] = pk2(v[i][0] * rs * gg[0], v[i][1] * rs * gg[1]); w[1] = pk2(v[i][2] * rs * gg[2], v[i][3] * rs * gg[3]);
        *(u32x2*)(dst + 4 * (lane + 64 * i)) = w; }
}
template <int NR> DI void rmsnorm_rows(const float* src, const float* g, bf16* dst, int row0, int rstride, int nrows, int lane) {
    f32x4 v[NR][4]; f32x4 gg[4];
#pragma unroll
    for (int j = 0; j < NR; ++j) { const int row = row0 + j * rstride;
#pragma unroll
        for (int i = 0; i < 4; ++i) v[j][i] = row < nrows ? *(const f32x4*)(src + (size_t)row * DM + 4 * (lane + 64 * i)) : (f32x4){0.f, 0.f, 0.f, 0.f}; }
#pragma unroll
    for (int i = 0; i < 4; ++i) gg[i] = *(const f32x4*)(g + 4 * (lane + 64 * i));
    float ss[NR];
#pragma unroll
    for (int j = 0; j < NR; ++j) { ss[j] = 0.f;
#pragma unroll
        for (int i = 0; i < 4; ++i) ss[j] += v[j][i][0] * v[j][i][0] + v[j][i][1] * v[j][i][1] + v[j][i][2] * v[j][i][2] + v[j][i][3] * v[j][i][3]; }
#pragma unroll
    for (int o = 32; o >= 1; o >>= 1) {
#pragma unroll
        for (int j = 0; j < NR; ++j) ss[j] += __shfl_xor(ss[j], o); }
#pragma unroll
    for (int j = 0; j < NR; ++j) { const int row = row0 + j * rstride; if (row < nrows) { const float rs = rsqrtf(ss[j] * (1.0f / 1024.0f) + EPS);
#pragma unroll
            for (int i = 0; i < 4; ++i) { u32x2 w; w[0] = pk2(v[j][i][0] * rs * gg[i][0], v[j][i][1] * rs * gg[i][1]); w[1] = pk2(v[j][i][2] * rs * gg[i][2], v[j][i][3] * rs * gg[i][3]);
                *(u32x2*)(dst + (size_t)row * DM + 4 * (lane + 64 * i)) = w; } } }
}
template <int K, int N, int NPAD> DI void prep_job(const float* W, bf16* Wt, LDS float* tl, int rot, const float* gk = nullptr) {
    const int tid = tid_opaque(); constexpr int nkt = K / 64, ntiles = (NPAD / 64) * nkt;
    const int kk = tid >> 3, n8 = (tid & 7) * 8, nn = tid >> 3, k8 = (tid & 7) * 8;
    const int step = 2 * (int)gridDim.x;
    f32x4 a0, b0, a1, b1;
    auto ld = [&](int t) {
        const int t2 = t + (int)gridDim.x; const bool two = t2 < ntiles;
        const int tn0 = t / nkt, tk0 = t % nkt, tn1 = two ? t2 / nkt : tn0, tk1 = two ? t2 % nkt : tk0;
        const f32x4 z = {0.f, 0.f, 0.f, 0.f}; a0 = z; b0 = z; a1 = z; b1 = z;
        { const int n = tn0 * 64 + n8; const float* s = W + (size_t)(tk0 * 64 + kk) * N + n; if (n < N) { a0 = *(const f32x4*)s; b0 = *(const f32x4*)(s + 4); } }
        if (two) { const int n = tn1 * 64 + n8; const float* s = W + (size_t)(tk1 * 64 + kk) * N + n; if (n < N) { a1 = *(const f32x4*)s; b1 = *(const f32x4*)(s + 4); } }
        if (gk) { const float g0 = gk[tk0 * 64 + kk], g1 = gk[tk1 * 64 + kk]; a0 *= g0; b0 *= g0; a1 *= g1; b1 *= g1; } };
    int tile = (int)((blockIdx.x + rot) % gridDim.x);
    if (tile < ntiles) ld(tile);
    for (; tile < ntiles; tile += step) {
        const int tile2 = tile + (int)gridDim.x; const bool two = tile2 < ntiles;
        const int tn0 = tile / nkt, tk0 = tile % nkt, tn1 = two ? tile2 / nkt : tn0, tk1 = two ? tile2 % nkt : tk0;
#pragma unroll
        for (int q = 0; q < 4; ++q) { tl[kk * 65 + n8 + q] = a0[q]; tl[kk * 65 + n8 + 4 + q] = b0[q]; tl[4160 + kk * 65 + n8 + q] = a1[q]; tl[4160 + kk * 65 + n8 + 4 + q] = b1[q]; }
        if (tile + step < ntiles) ld(tile + step);
        bar_lds();
        { u32x4 w;
#pragma unroll
            for (int q = 0; q < 4; ++q) w[q] = pk2(tl[(k8 + 2 * q) * 65 + nn], tl[(k8 + 2 * q + 1) * 65 + nn]);
            *(u32x4*)(Wt + (size_t)(tn0 * 64 + nn) * K + tk0 * 64 + k8) = w;
            if (two) {
#pragma unroll
                for (int q = 0; q < 4; ++q) w[q] = pk2(tl[4160 + (k8 + 2 * q) * 65 + nn], tl[4160 + (k8 + 2 * q + 1) * 65 + nn]);
                *(u32x4*)(Wt + (size_t)(tn1 * 64 + nn) * K + tk1 * 64 + k8) = w; } }
        bar_lds();
    }
}
DI void phase_prep(const Params& p, LDS unsigned char* lds) {
    const int tid = tid_opaque(), wid = __builtin_amdgcn_readfirstlane(tid >> 6), lane = tid & 63;
    LDS float* tl = (LDS float*)lds;
    prep_job<DM, DIN, DINP>(p.w_in, p.wt_in, tl, 0); prep_job<384, 768, 768>(p.w_qb, p.wt_qb, tl, 64); prep_job<256, 1024, 1024>(p.w_kvb, p.wt_kvb, tl, 136); prep_job<DM, DM, DM>(p.w_out, p.wt_out, tl, 200);
    prep_job<DM, 512, 512>(p.w_xq, p.wt_xq, tl, 0, p.g_x); prep_job<DM, 512, 512>(p.w_xk, p.wt_xkv, tl, 128); prep_job<DM, 512, 512>(p.w_xv, p.wt_xkv + (size_t)512 * DM, tl, 0); prep_job<512, DM, DM>(p.w_xo, p.wt_xo, tl, 128);
    prep_job<DM, DFF, DFF>(p.w_ff1, p.wt_ff1, tl, 0, p.g_ff); prep_job<DFF, DM, DM>(p.w_ff2, p.wt_ff2, tl, 0);
    if (blockIdx.x == 0 && tid == 0) { float a = 0.f, bq = 0.f; for (int i = 0; i < 64; ++i) a = fmaxf(a, fabsf(p.g_kn[i])); for (int i = 0; i < 32; ++i) bq = fmaxf(bq, fabsf(p.g_kr[i])); p.GMAX[0] = a; p.GMAX[1] = bq; }
    for (int e = blockIdx.x * NTHREADS + tid; e < (SEQ + DECS) * 16; e += gridDim.x * NTHREADS) { const int pi = e >> 4, i = e & 15; const int pos = pi < SEQ ? pi : PAST + (pi - SEQ);
        const float ang = (float)pos * expf(-(float)i * (9.210340371976184f / 16.0f)); p.ROPE[2 * e] = cosf(ang); p.ROPE[2 * e + 1] = sinf(ang); }
    { const int ws = gridDim.x * 8, w0 = blockIdx.x * 8 + wid;
        for (int row = w0; row < TP; row += 8 * ws) rmsnorm_rows<8>(p.xp, p.g_mix, p.H, row, ws, TP, lane);
        for (int row = w0; row < TS; row += 4 * ws) rmsnorm_rows<4>(p.xs, p.g_mix, p.H + (size_t)TP * DM, row, ws, TS, lane);
        for (int row = w0; row < MROWS; row += 4 * ws) rmsnorm_rows<4>(p.memp, p.g_mem, p.MEMN, row, ws, MROWS, lane); }
}

DI float rope32(const float* ROPE, float xn, int lane, int pidx) {
    const float partner = __shfl_xor(xn, 16);
    const float c = ROPE[(pidx * 16 + (lane & 15)) * 2], s = ROPE[(pidx * 16 + (lane & 15)) * 2 + 1];
    return (lane & 16) ? xn * c + partner * s : xn * c - partner * s;
}
DI int row_pidx(int t) { return t < TP ? (t % SEQ) : SEQ + ((t - TP) % DECS); }

DI void phase_post_in(const Params& p) {
    const int tid = tid_opaque(), wid = __builtin_amdgcn_readfirstlane(tid >> 6), lane = tid & 63;
    f32x4 w2[16];
#pragma unroll
    for (int i = 0; i < 16; ++i) w2[i] = *(const f32x4*)(p.w_a2 + i * 256 + 4 * lane);
    const f32x4 b2 = *(const f32x4*)(p.b_a + 4 * lane);
    for (int row = blockIdx.x * 8 + wid; row < T + MROWS; row += gridDim.x * 8) {
        if (row < T) {
            const int t = row; const bf16* z = p.Z + (size_t)t * DINP;
            const bf16x8 a0 = ld8g(z + ZA), a1 = ld8g(z + ZA + 8);
            bf16x8 cq = zero8(), ck = zero8(); if (lane < 48) cq = ld8g(z + ZQA + 8 * lane); if (lane < 32) ck = ld8g(z + ZKVA + 8 * lane);
            const float vp = lane < 32 ? bf2f(z[ZKPE + lane]) : 0.f;
            { f32x4 gp = b2;
#pragma unroll
                for (int i = 0; i < 8; ++i) { gp += bf2f((bf16)a0[i]) * w2[i]; gp += bf2f((bf16)a1[i]) * w2[8 + i]; }
                f32x4 la;
#pragma unroll
                for (int j = 0; j < 4; ++j) { const float x = gp[j]; la[j] = (fminf(x, 0.f) - 0.6931471805599453f * flog2(1.0f + fexp(-fabsf(x)))) * (1.0f / 16.0f); }
                *(f32x4*)(p.LOGA + (size_t)t * 256 + 4 * lane) = la; }
            float fq[8], fk[8]; float sq = 0.f, sk = 0.f;
#pragma unroll
            for (int j = 0; j < 8; ++j) { fq[j] = bf2f((bf16)cq[j]); fk[j] = bf2f((bf16)ck[j]); sq += fq[j] * fq[j]; sk += fk[j] * fk[j]; }
            float sp = vp * vp;
#pragma unroll
            for (int o = 32; o >= 1; o >>= 1) { sq += __shfl_xor(sq, o); sk += __shfl_xor(sk, o); sp += __shfl_xor(sp, o); }
            const float rq = rsqrtf(sq * (1.0f / 384.0f) + EPS), rk = rsqrtf(sk * (1.0f / 256.0f) + EPS), rp = rsqrtf(sp * (1.0f / 32.0f) + EPS);
            if (lane < 48) { const f32x4 g0 = *(const f32x4*)(p.g_qa + 8 * lane), g1 = *(const f32x4*)(p.g_qa + 8 * lane + 4);
                *(bf16x8*)(p.QAN + (size_t)t * 384 + 8 * lane) = pack8(fq[0] * rq * g0[0], fq[1] * rq * g0[1], fq[2] * rq * g0[2], fq[3] * rq * g0[3], fq[4] * rq * g1[0], fq[5] * rq * g1[1], fq[6] * rq * g1[2], fq[7] * rq * g1[3]); }
            if (lane < 32) { const f32x4 g0 = *(const f32x4*)(p.g_kva + 8 * lane), g1 = *(const f32x4*)(p.g_kva + 8 * lane + 4);
                const f32x4 c0 = {fk[0] * rk * g0[0], fk[1] * rk * g0[1], fk[2] * rk * g0[2], fk[3] * rk * g0[3]}, c1 = {fk[4] * rk * g1[0], fk[5] * rk * g1[1], fk[6] * rk * g1[2], fk[7] * rk * g1[3]};
                float* oc = t < TP ? p.o_ckvp + (size_t)t * 256 : p.o_ckvs + (size_t)(t - TP) * 256;
                *(f32x4*)(oc + 8 * lane) = c0; *(f32x4*)(oc + 8 * lane + 4) = c1;
                *(bf16x8*)(p.CKVB + (size_t)t * 256 + 8 * lane) = pack8(c0[0], c0[1], c0[2], c0[3], c1[0], c1[1], c1[2], c1[3]); }
            { const float xn = vp * rp * p.g_kr[lane & 31]; const float o = rope32(p.ROPE, xn, lane, row_pidx(t));
                if (lane < 32) { float* ok = t < TP ? p.o_kpep + (size_t)t * 32 : p.o_kpes + (size_t)(t - TP) * 32; ok[lane] = o; p.KPB[(size_t)t * 32 + lane] = f2bf(o); } }
        } else {
            const int r = row - T; const float* s = p.MKV + (size_t)r * 1024;
            const f32x4 k0 = *(const f32x4*)(s + lane * 8), k1 = *(const f32x4*)(s + lane * 8 + 4), v0 = *(const f32x4*)(s + 512 + lane * 8), v1 = *(const f32x4*)(s + 512 + lane * 8 + 4);
            float ss = k0[0] * k0[0] + k0[1] * k0[1] + k0[2] * k0[2] + k0[3] * k0[3] + k1[0] * k1[0] + k1[1] * k1[1] + k1[2] * k1[2] + k1[3] * k1[3];
            ss += __shfl_xor(ss, 1); ss += __shfl_xor(ss, 2); ss += __shfl_xor(ss, 4); ss += __shfl_xor(ss, 8);
            const float rs = rsqrtf(ss * (1.0f / 128.0f) + EPS); const int c = (lane * 8) & 127;
            const f32x4 g0 = *(const f32x4*)(p.g_xk + c), g1 = *(const f32x4*)(p.g_xk + c + 4);
            const f32x4 m0 = {k0[0] * rs * g0[0], k0[1] * rs * g0[1], k0[2] * rs * g0[2], k0[3] * rs * g0[3]}, m1 = {k1[0] * rs * g1[0], k1[1] * rs * g1[1], k1[2] * rs * g1[2], k1[3] * rs * g1[3]};
            *(f32x4*)(p.o_mkp + (size_t)r * 512 + lane * 8) = m0; *(f32x4*)(p.o_mkp + (size_t)r * 512 + lane * 8 + 4) = m1;
            *(bf16x8*)(p.MKB + (size_t)r * 512 + lane * 8) = pack8(m0[0], m0[1], m0[2], m0[3], m1[0], m1[1], m1[2], m1[3]);
            *(f32x4*)(p.o_mvp + (size_t)r * 512 + lane * 8) = v0; *(f32x4*)(p.o_mvp + (size_t)r * 512 + lane * 8 + 4) = v1;
            *(bf16x8*)(p.MVB + (size_t)r * 512 + lane * 8) = pack8(v0[0], v0[1], v0[2], v0[3], v1[0], v1[1], v1[2], v1[3]);
        }
    }
}

DI void phase_post_qkv(const Params& p) {
    const int tid = tid_opaque(), wid = __builtin_amdgcn_readfirstlane(tid >> 6), lane = tid & 63;
    for (int t = TP + blockIdx.x * 8 + wid; t < T; t += gridDim.x * 8) {
        const bf16* qf = p.QF + (size_t)t * 768; const int pos = row_pidx(t);
        for (int h = 0; h < 8; ++h) {
            const float v = bf2f(qf[h * 96 + lane]); const float ss = wsum(v * v); const float rs = rsqrtf(ss * (1.0f / 64.0f) + EPS);
            p.QN[((size_t)t * 8 + h) * 96 + lane] = f2bf(v * rs * p.g_qn[lane] * MLA_SCALE);
            const float vr = lane < 32 ? bf2f(qf[h * 96 + 64 + lane]) : 0.f; const float ssr = wsum(vr * vr); const float rsr = rsqrtf(ssr * (1.0f / 32.0f) + EPS);
            const float xr = vr * rsr * p.g_qr[lane & 31]; const float o = rope32(p.ROPE, xr, lane, pos);
            if (lane < 32) p.QN[((size_t)t * 8 + h) * 96 + 64 + lane] = f2bf(o * MLA_SCALE);
        }
    }
}
struct GlaUnit { int t0, h, nv; };
DI GlaUnit gla_unit(int u) { GlaUnit g; if (u < NGP) { const int b = u / (4 * NC), h = (u / NC) % 4, c = u % NC; g.t0 = b * SEQ + c * 64; g.h = h; g.nv = 64; } else { const int us = u - NGP; g.t0 = TP + (us >> 2) * DECS; g.h = us & 3; g.nv = DECS; } return g; }
constexpr int GL_QK = 0, GL_V = 16384, GL_S = 32768, GL_TOT = 49152, GL_SS = GL_TOT + 2048, GL_END = GL_SS + 1024;
static_assert(GL_END <= LDS_CTL, "GLA LDS map");
struct GlaIn { float la[8]; bf16 q[8], k[8]; bf16x8 v[2]; f32x4 s[4]; s16x4 rg[4]; };
template <bool PHASE_C> DI void gla_load(const Params& p, int u, int tid, GlaIn& in) {
    const GlaUnit g = gla_unit(u); const int c = tid & 63, sb = tid >> 6;
#pragma unroll
    for (int i = 0; i < 8; ++i) { const int s = 8 * sb + i; const bool ok = s < g.nv; const bf16* z = p.Z + (size_t)(g.t0 + (ok ? s : 0)) * DINP;
        in.la[i] = ok ? p.LOGA[(size_t)(g.t0 + s) * 256 + g.h * 64 + c] : 0.f; in.k[i] = ok ? z[ZK + g.h * 64 + c] : (bf16)0; if (PHASE_C) in.q[i] = ok ? z[ZQ + g.h * 64 + c] : (bf16)0; }
#pragma unroll
    for (int j = 0; j < 2; ++j) { const int cidx = tid + NTHREADS * j, s = cidx >> 4, ch = cidx & 15; in.v[j] = zero8(); if (s < g.nv) in.v[j] = ld8g(p.Z + (size_t)(g.t0 + s) * DINP + ZV + g.h * 128 + ch * 8); }
    if (PHASE_C) { const float* sp = u < NGP ? p.DS + (size_t)u * 8192 : p.sgla + (size_t)(u - NGP) * 8192;
#pragma unroll
        for (int j = 0; j < 2; ++j) { const int cidx = tid + NTHREADS * j, kd = cidx >> 4, ch = cidx & 15; in.s[2 * j] = *(const f32x4*)(sp + kd * 128 + ch * 8); in.s[2 * j + 1] = *(const f32x4*)(sp + kd * 128 + ch * 8 + 4); }
        const int wid = tid >> 6, lane = tid & 63, r = lane & 31, hh = lane >> 5, dvt = wid & 3, tt = wid >> 2, t = 32 * tt + r; const bool ok = t < g.nv;
        const bf16* z = p.Z + (size_t)(g.t0 + (ok ? t : 0)) * DINP + ZR + g.h * 128 + 32 * dvt + 4 * hh;
#pragma unroll
        for (int q = 0; q < 4; ++q) in.rg[q] = *(const s16x4*)(z + 8 * q); }
}
DI float gla_scan(LDS unsigned char* lds, int c, int sb, const float (&la)[8], float (&b)[8]) {
    LDS float* TOT = (LDS float*)(lds + GL_TOT); float a = 0.f;
#pragma unroll
    for (int i = 0; i < 8; ++i) { a += la[i]; b[i] = a; }
    TOT[sb * 64 + c] = a;
    bar_lds();
    float pre = 0.f, tot = 0.f;
#pragma unroll
    for (int q = 0; q < 8; ++q) { const float v = TOT[q * 64 + c]; tot += v; if (q < sb) pre += v; }
#pragma unroll
    for (int i = 0; i < 8; ++i) b[i] += pre;
    return tot;
}
DI void gla_put(LDS unsigned char* img, int row, int col, float v) { *(LDS bf16*)(img + imgb(row, col >> 3) + 2 * (col & 7)) = f2bf(v); }
DI unsigned tr_lane_off_nat(unsigned lane, unsigned c, unsigned plus4) {
    const unsigned hh = lane >> 5, blk = (lane >> 4) & 1, q = (lane & 15) >> 2, pp = lane & 3;
    return imgb(8 * hh + q + 4 * plus4, 4 * c + 2 * blk + (pp >> 1)) + 8 * (pp & 1);
}
DI void phase_gla_a(const Params& p, LDS unsigned char* lds) {
    const int tid = tid_opaque(), wid = __builtin_amdgcn_readfirstlane(tid >> 6), lane = tid & 63, r = lane & 31, hh = lane >> 5;
    const int c = tid & 63, sb = tid >> 6, mt = wid & 1, nt = wid >> 1;
    const LDS unsigned char* pa0 = lds + GL_QK + tr_lane_off_nat(lane, mt, 0); const LDS unsigned char* pa1 = lds + GL_QK + tr_lane_off_nat(lane, mt, 1);
    const LDS unsigned char* pb0 = lds + GL_V + tr_lane_off_nat(lane, nt, 0); const LDS unsigned char* pb1 = lds + GL_V + tr_lane_off_nat(lane, nt, 1);
    GlaIn nx; int u = blockIdx.x;
    if (u < NGU) gla_load<false>(p, u, tid, nx);
    for (; u < NGU; u += gridDim.x) {
        GlaIn in = nx; const int un = u + gridDim.x; if (un < NGU) gla_load<false>(p, un, tid, nx);
        float b[8]; const float bl = gla_scan(lds, c, sb, in.la, b);
#pragma unroll
        for (int i = 0; i < 8; ++i) gla_put(lds + GL_QK, 8 * sb + i, c, bf2f(in.k[i]) * fexp(bl - b[i]));
#pragma unroll
        for (int j = 0; j < 2; ++j) { const int cidx = tid + NTHREADS * j; *(LDS bf16x8*)(lds + GL_V + imgb(cidx >> 4, cidx & 15)) = in.v[j]; }
        if (tid < 64) p.DDEC[(size_t)u * 64 + tid] = fexp(bl);
        bar_lds();
        { f32x16 acc = zero16(); bf16x8 a0, b0, a1, b1;
            img_tr4p_pre<0, 16, false>(pa0, pa1, pb0, pb1, a0, b0, a1, b1); acc = mfma32(a0, b0, acc); acc = mfma32(a1, b1, acc);
            img_tr4p_pre<32, 48, false>(pa0, pa1, pb0, pb1, a0, b0, a1, b1); acc = mfma32(a0, b0, acc); acc = mfma32(a1, b1, acc);
            float* d = p.DS + (size_t)u * 8192;
#pragma unroll
            for (int i = 0; i < 16; ++i) d[(32 * mt + crow(i, hh)) * 128 + 32 * nt + r] = acc[i]; }
        bar_lds();
    }
}
DI void phase_gla_b(const Params& p) {
    const int gid = blockIdx.x * NTHREADS + tid_opaque(), gsz = gridDim.x * NTHREADS;
    for (int e4 = gid; e4 < BATCH * 4 * 2048; e4 += gsz) { const int bh = e4 >> 11, idx = (e4 & 2047) * 4, kd = idx >> 7; f32x4 S = {0.f, 0.f, 0.f, 0.f};
#pragma unroll 8
        for (int c = 0; c < NC; ++c) { const size_t u = (size_t)bh * NC + c; float* dp = p.DS + u * 8192 + idx; const f32x4 d = *(const f32x4*)dp; *(f32x4*)dp = S; S = S * p.DDEC[u * 64 + kd] + d; }
        *(f32x4*)(p.o_glap + (size_t)bh * 8192 + idx) = S; }
    for (int e4 = gid; e4 < DECB * 4 * 2048; e4 += gsz) { const int bh = e4 >> 11, idx = (e4 & 2047) * 4, kd = idx >> 7; const size_t u = (size_t)NGP + bh;
        *(f32x4*)(p.o_glas + (size_t)bh * 8192 + idx) = *(const f32x4*)(p.sgla + (size_t)bh * 8192 + idx) * p.DDEC[u * 64 + kd] + *(const f32x4*)(p.DS + u * 8192 + idx); }
}
DI void phase_gla_c(const Params& p, LDS unsigned char* lds) {
    const int tid = tid_opaque(), wid = __builtin_amdgcn_readfirstlane(tid >> 6), lane = tid & 63, r = lane & 31, hh = lane >> 5;
    const int c = tid & 63, sb = tid >> 6, dvt = wid & 3, tt = wid >> 2;
    const LDS unsigned char* ps0 = lds + GL_S + tr_lane_off_nat(lane, dvt, 0); const LDS unsigned char* ps1 = lds + GL_S + tr_lane_off_nat(lane, dvt, 1);
    const LDS unsigned char* pv0 = lds + GL_V + tr_lane_off(lane, dvt, 0); const LDS unsigned char* pv1 = lds + GL_V + tr_lane_off(lane, dvt, 1);
    unsigned xo[8];
#pragma unroll
    for (int ks = 0; ks < 8; ++ks) xo[ks] = imgb(r, 2 * ks + hh);
    GlaIn nx; int u = blockIdx.x;
    if (u < NGU) gla_load<true>(p, u, tid, nx);
    for (; u < NGU; u += gridDim.x) {
        GlaIn in = nx; const int un = u + gridDim.x; if (un < NGU) gla_load<true>(p, un, tid, nx);
        const GlaUnit g = gla_unit(u);
        { float b[8]; gla_scan(lds, c, sb, in.la, b);
#pragma unroll
            for (int i = 0; i < 8; ++i) { gla_put(lds + GL_QK, 8 * sb + i, c, bf2f(in.q[i]) * fexp(b[i]) * 0.125f); gla_put(lds + GL_QK, 8 * sb + i, 64 + c, bf2f(in.k[i]) * fexp(-b[i])); } }
#pragma unroll
        for (int j = 0; j < 2; ++j) { const int cidx = tid + NTHREADS * j; *(LDS bf16x8*)(lds + GL_V + imgb(cidx >> 4, cidx & 15)) = in.v[j];
            *(LDS bf16x8*)(lds + GL_S + imgb(cidx >> 4, cidx & 15)) = pack8(in.s[2 * j][0], in.s[2 * j][1], in.s[2 * j][2], in.s[2 * j][3], in.s[2 * j + 1][0], in.s[2 * j + 1][1], in.s[2 * j + 1][2], in.s[2 * j + 1][3]); }
        bar_lds();
        const LDS unsigned char* qk = lds + GL_QK + 8192 * tt;
#define GL_Q(ks) (*(const LDS bf16x8*)(qk + xo[ks]))
        f32x16 o = zero16();
        { bf16x8 a0, a1, a2, a3; img_tr4p_pre<0, 16, false>(ps0, ps1, ps0 + 256 * 32, ps1 + 256 * 32, a0, a2, a1, a3);
            o = mfma32(a0, GL_Q(0), o); o = mfma32(a1, GL_Q(1), o); o = mfma32(a2, GL_Q(2), o); o = mfma32(a3, GL_Q(3), o); }
#pragma unroll
        for (int st = 0; st < 2; ++st) if (st <= tt) {
            const LDS unsigned char* kk = lds + GL_QK + 8192 * st;
            f32x16 x = zero16();
#pragma unroll
            for (int ks = 0; ks < 4; ++ks) x = mfma32(*(const LDS bf16x8*)(kk + xo[4 + ks]), GL_Q(ks), x);
            if (st == tt) {
#pragma unroll
                for (int i = 0; i < 16; ++i) if (crow(i, hh) > r) x[i] = 0.f; }
            bf16x8 v0, v1, d0, d1;
            if (st == 0) img_tr4p_pre<0, 16, false>(pv0, pv1, pv0, pv1, v0, d0, v1, d1); else img_tr4p_pre<32, 48, false>(pv0, pv1, pv0, pv1, v0, d0, v1, d1);
            o = mfma32(v0, PACK(x, 0), o); o = mfma32(v1, PACK(x, 1), o);
        }
#undef GL_Q
        LDS float* SS = (LDS float*)(lds + GL_SS); float ss = 0.f;
#pragma unroll
        for (int i = 0; i < 16; ++i) ss += o[i] * o[i];
        ss = xsum32(ss); if (hh == 0) SS[dvt * 64 + 32 * tt + r] = ss;
        bar_lds();
        const int t = 32 * tt + r;
        if (t < g.nv) { const float rs = rsqrtf((SS[t] + SS[64 + t] + SS[128 + t] + SS[192 + t]) * (1.0f / 128.0f) + EPS);
            bf16* op = p.OMIX + (size_t)(g.t0 + t) * DM + g.h * 128 + 32 * dvt + 4 * hh; const float* gg = p.g_gla_o + 32 * dvt + 4 * hh;
#pragma unroll
            for (int q = 0; q < 4; ++q) { const f32x4 g4 = *(const f32x4*)(gg + 8 * q); float w[4];
#pragma unroll
                for (int j = 0; j < 4; ++j) { const float rr = bf2f((bf16)in.rg[q][j]); w[j] = o[4 * q + j] * rs * g4[j] * (rr / (1.0f + fexp(-rr))); }
                u32x2 pk; pk[0] = pk2(w[0], w[1]); pk[1] = pk2(w[2], w[3]); *(u32x2*)(op + 8 * q) = pk; } }
        bar_lds();
    }
}
constexpr int PA_IMG = 0, PA_KP = 2 * 32768, PA_END = PA_KP + 2 * 128 * 40 * 2;
static_assert(PA_END <= LDS_CTL, "prompt attention LDS map");
DI void pattn_stage_load(const Params& p, size_t kr0, int h, int tid, bf16x8 (&kv)[4], bf16x8& kp) {
#pragma unroll
    for (int j = 0; j < 4; ++j) { const int c = tid + NTHREADS * j, key = c >> 4, ch = c & 15; kv[j] = ld8g(p.KV + (kr0 + key) * 1024 + h * 128 + ch * 8); }
    kp = ld8g(p.KPB + (kr0 + (tid >> 2)) * 32 + (tid & 3) * 8);
}
DI void pattn_stage_store(const Params& p, LDS unsigned char* img, LDS bf16* kpl, int tid, const bf16x8 (&kv)[4], const bf16x8& kp) {
    const int ch = tid & 15;
    f32x4 g0 = {1.f, 1.f, 1.f, 1.f}, g1 = g0; if (ch < 8) { g0 = *(const f32x4*)(p.g_kn + ch * 8); g1 = *(const f32x4*)(p.g_kn + ch * 8 + 4); }
#pragma unroll
    for (int j = 0; j < 4; ++j) { const int key = (tid + NTHREADS * j) >> 4; float f[8]; float ss = 0.f;
#pragma unroll
        for (int q = 0; q < 8; ++q) { f[q] = bf2f((bf16)kv[j][q]); ss += f[q] * f[q]; }
        ss += __shfl_xor(ss, 1); ss += __shfl_xor(ss, 2); ss += __shfl_xor(ss, 4);
        const float rs = ch < 8 ? rsqrtf(ss * (1.0f / 64.0f) + EPS) : 1.0f;
        *(LDS bf16x8*)(img + imgb(key, ch)) = pack8(f[0] * rs * g0[0], f[1] * rs * g0[1], f[2] * rs * g0[2], f[3] * rs * g0[3], f[4] * rs * g1[0], f[5] * rs * g1[1], f[6] * rs * g1[2], f[7] * rs * g1[3]); }
    *(LDS bf16x8*)(kpl + (tid >> 2) * 40 + (tid & 3) * 8) = kp;
}
DI void pattn_unit(const Params& p, LDS unsigned char* lds, int u) {
    const int tid = tid_opaque(), wid = __builtin_amdgcn_readfirstlane(tid >> 6), lane = tid & 63, r = lane & 31, hh = lane >> 5;
    const int qb = NQB - 1 - u / (BATCH * 8), bh = u % (BATCH * 8), b = bh >> 3, h = bh & 7;
    const int qw0 = qb * 256 + 32 * wid, qpos = qw0 + r; const size_t trow = (size_t)b * SEQ + qpos;
    bf16x8 kvr[4], kpr;
    pattn_stage_load(p, (size_t)b * SEQ, h, tid, kvr, kpr);
    bf16x8 qf[6]; float mshift;
    { float ss = 0.f, sr = 0.f; float f[6][8];
#pragma unroll
        for (int ks = 0; ks < 6; ++ks) { const bf16x8 raw = ld8g(p.QF + trow * 768 + h * 96 + 16 * ks + 8 * hh);
#pragma unroll
            for (int j = 0; j < 8; ++j) { f[ks][j] = bf2f((bf16)raw[j]); if (ks < 4) ss += f[ks][j] * f[ks][j]; else sr += f[ks][j] * f[ks][j]; } }
        ss += __shfl_xor(ss, 32); sr += __shfl_xor(sr, 32);
        const float rs = rsqrtf(ss * (1.0f / 64.0f) + EPS) * (MLA_SCALE * 1.4426950408889634f), rr = rsqrtf(sr * (1.0f / 32.0f) + EPS) * (MLA_SCALE * 1.4426950408889634f);
#pragma unroll
        for (int ks = 0; ks < 4; ++ks) { const f32x4 g0 = *(const f32x4*)(p.g_qn + 16 * ks + 8 * hh), g1 = *(const f32x4*)(p.g_qn + 16 * ks + 8 * hh + 4);
            qf[ks] = pack8(f[ks][0] * rs * g0[0], f[ks][1] * rs * g0[1], f[ks][2] * rs * g0[2], f[ks][3] * rs * g0[3], f[ks][4] * rs * g1[0], f[ks][5] * rs * g1[1], f[ks][6] * rs * g1[2], f[ks][7] * rs * g1[3]); }
        float o1[8], o2[8];
#pragma unroll
        for (int j = 0; j < 8; ++j) { const int i = 8 * hh + j; const float x1 = f[4][j] * rr * p.g_qr[i], x2 = f[5][j] * rr * p.g_qr[16 + i];
            const float c = p.ROPE[(qpos * 16 + i) * 2], s = p.ROPE[(qpos * 16 + i) * 2 + 1];
            o1[j] = x1 * c - x2 * s; o2[j] = x2 * c + x1 * s; }
        qf[4] = pack8(o1[0], o1[1], o1[2], o1[3], o1[4], o1[5], o1[6], o1[7]); qf[5] = pack8(o2[0], o2[1], o2[2], o2[3], o2[4], o2[5], o2[6], o2[7]);
        float n2 = 0.f, r2 = 0.f;
#pragma unroll
        for (int ks = 0; ks < 4; ++ks)
#pragma unroll
            for (int j = 0; j < 8; ++j) { const float v = bf2f((bf16)qf[ks][j]); n2 += v * v; }
#pragma unroll
        for (int ks = 4; ks < 6; ++ks)
#pragma unroll
            for (int j = 0; j < 8; ++j) { const float v = bf2f((bf16)qf[ks][j]); r2 += v * v; }
        n2 = xsum32(n2); r2 = xsum32(r2);
        mshift = 1.02f * (sqrtf(n2) * 8.0f * p.GMAX[0] + sqrtf(r2) * 5.656854249f * p.GMAX[1]) + 0.01f; }
    f32x16 o0 = zero16(), o1 = zero16(); float l = 0.f;
    const int nkt = 2 * (qb + 1);
    unsigned xo[4];
#pragma unroll
    for (int ks = 0; ks < 4; ++ks) xo[ks] = imgb(r, 2 * ks + hh);
    const unsigned t0o = tr_lane_off(lane, 2, 0), t1o = tr_lane_off(lane, 2, 1), t2o = tr_lane_off(lane, 3, 0), t3o = tr_lane_off(lane, 3, 1);
    pattn_stage_store(p, lds + PA_IMG, (LDS bf16*)(lds + PA_KP), tid, kvr, kpr);
    bar_lds();
    for (int kt = 0; kt < nkt; ++kt) {
        const int k0 = kt * 128; LDS unsigned char* img = lds + PA_IMG + (kt & 1) * 32768; const LDS bf16* kpl = (const LDS bf16*)(lds + PA_KP) + (kt & 1) * 128 * 40;
        if (kt + 1 < nkt) pattn_stage_load(p, (size_t)b * SEQ + k0 + 128, h, tid, kvr, kpr);
        if (k0 <= qw0 + 31) {
            const bool hi = k0 + 64 <= qw0 + 31;
            const LDS unsigned char* rb0 = img + xo[0]; const LDS unsigned char* rb1 = img + xo[1]; const LDS unsigned char* rb2 = img + xo[2]; const LDS unsigned char* rb3 = img + xo[3];
            const LDS bf16* kr = kpl + r * 40 + 8 * hh;
#define PA_K(rb, j) (*(const LDS bf16x8*)((rb) + 8192 * (j)))
            f32x16 s0, s1, s2, s3;
#pragma unroll
            for (int i = 0; i < 16; ++i) { s0[i] = -mshift; s1[i] = -mshift; s2[i] = -mshift; s3[i] = -mshift; }
            s0 = mfma32(PA_K(rb0, 0), qf[0], s0); s1 = mfma32(PA_K(rb0, 1), qf[0], s1); s0 = mfma32(PA_K(rb1, 0), qf[1], s0); s1 = mfma32(PA_K(rb1, 1), qf[1], s1);
            s0 = mfma32(PA_K(rb2, 0), qf[2], s0); s1 = mfma32(PA_K(rb2, 1), qf[2], s1); s0 = mfma32(PA_K(rb3, 0), qf[3], s0); s1 = mfma32(PA_K(rb3, 1), qf[3], s1);
            s0 = mfma32(ld8(kr), qf[4], s0); s1 = mfma32(ld8(kr + 32 * 40), qf[4], s1); s0 = mfma32(ld8(kr + 16), qf[5], s0); s1 = mfma32(ld8(kr + 32 * 40 + 16), qf[5], s1);
            if (hi) {
                s2 = mfma32(PA_K(rb0, 2), qf[0], s2); s3 = mfma32(PA_K(rb0, 3), qf[0], s3); s2 = mfma32(PA_K(rb1, 2), qf[1], s2); s3 = mfma32(PA_K(rb1, 3), qf[1], s3);
                s2 = mfma32(PA_K(rb2, 2), qf[2], s2); s3 = mfma32(PA_K(rb2, 3), qf[2], s3); s2 = mfma32(PA_K(rb3, 2), qf[3], s2); s3 = mfma32(PA_K(rb3, 3), qf[3], s3);
                s2 = mfma32(ld8(kr + 64 * 40), qf[4], s2); s3 = mfma32(ld8(kr + 96 * 40), qf[4], s3); s2 = mfma32(ld8(kr + 64 * 40 + 16), qf[5], s2); s3 = mfma32(ld8(kr + 96 * 40 + 16), qf[5], s3); }
#undef PA_K
            if (k0 + 127 > qw0) {
#pragma unroll
                for (int i = 0; i < 16; ++i) { const int key = k0 + crow(i, hh); if (key > qpos) s0[i] = -INFINITY; if (key + 32 > qpos) s1[i] = -INFINITY; if (key + 64 > qpos) s2[i] = -INFINITY; if (key + 96 > qpos) s3[i] = -INFINITY; } }
            if (!hi) {
#pragma unroll
                for (int i = 0; i < 16; ++i) { s2[i] = -INFINITY; s3[i] = -INFINITY; } }
            float ps = 0.f;
#pragma unroll
            for (int i = 0; i < 16; ++i) { s0[i] = fexp2(s0[i]); s1[i] = fexp2(s1[i]); s2[i] = fexp2(s2[i]); s3[i] = fexp2(s3[i]); ps += (s0[i] + s1[i]) + (s2[i] + s3[i]); }
            l += ps;
            const LDS unsigned char* t0 = img + t0o; const LDS unsigned char* t1 = img + t1o; const LDS unsigned char* t2 = img + t2o; const LDS unsigned char* t3 = img + t3o;
            { bf16x8 v0, v1, v2, v3; img_tr4p_pre<0, 32, false>(t0, t1, t2, t3, v0, v1, v2, v3); bf16x8 pa = PACK(s0, 0), pb = PACK(s1, 0);
                o0 = mfma32(v0, pa, o0); o1 = mfma32(v1, pa, o1); o0 = mfma32(v2, pb, o0); o1 = mfma32(v3, pb, o1);
                img_tr4p_pre<16, 48, false>(t0, t1, t2, t3, v0, v1, v2, v3); pa = PACK(s0, 1); pb = PACK(s1, 1);
                o0 = mfma32(v0, pa, o0); o1 = mfma32(v1, pa, o1); o0 = mfma32(v2, pb, o0); o1 = mfma32(v3, pb, o1); }
            if (hi) { bf16x8 v0, v1, v2, v3; img_tr4p_pre<64, 96, false>(t0, t1, t2, t3, v0, v1, v2, v3); bf16x8 pa = PACK(s2, 0), pb = PACK(s3, 0);
                o0 = mfma32(v0, pa, o0); o1 = mfma32(v1, pa, o1); o0 = mfma32(v2, pb, o0); o1 = mfma32(v3, pb, o1);
                img_tr4p_pre<80, 112, false>(t0, t1, t2, t3, v0, v1, v2, v3); pa = PACK(s2, 1); pb = PACK(s3, 1);
                o0 = mfma32(v0, pa, o0); o1 = mfma32(v1, pa, o1); o0 = mfma32(v2, pb, o0); o1 = mfma32(v3, pb, o1); }
        }
        if (kt + 1 < nkt) pattn_stage_store(p, lds + PA_IMG + ((kt + 1) & 1) * 32768, (LDS bf16*)(lds + PA_KP) + ((kt + 1) & 1) * 128 * 40, tid, kvr, kpr);
        bar_lds();
    }
    l += __shfl_xor(l, 32); const float il = 1.0f / l;
    bf16* o = p.OMIX + trow * DM + 512 + h * 64;
#pragma unroll
    for (int g = 0; g < 4; ++g) { u32x2 w0, w1; w0[0] = pk2(o0[4 * g] * il, o0[4 * g + 1] * il); w0[1] = pk2(o0[4 * g + 2] * il, o0[4 * g + 3] * il); w1[0] = pk2(o1[4 * g] * il, o1[4 * g + 1] * il); w1[1] = pk2(o1[4 * g + 2] * il, o1[4 * g + 3] * il);
        *(u32x2*)(o + 8 * g + 4 * hh) = w0; *(u32x2*)(o + 32 + 8 * g + 4 * hh) = w1; }
}

constexpr int XA_K = 0, XA_V = 65536, XA_END = 131072;
static_assert(XA_END <= LDS_CTL, "cross-attention LDS map");
DI void xattn_unit(const Params& p, LDS unsigned char* lds, int u) {
    const int tid = tid_opaque(), wid = __builtin_amdgcn_readfirstlane(tid >> 6), lane = tid & 63, r = lane & 31, hh = lane >> 5;
    LDS unsigned char* KI = lds + XA_K; LDS unsigned char* VI = lds + XA_V;
    int b, h, nrows; size_t tbase;
    if (u < NU_XP) { b = u / (4 * NQB); h = (u / NQB) & 3; const int qc = u % NQB; nrows = 256; tbase = (size_t)b * SEQ + qc * 256;
#pragma unroll
        for (int j = 0; j < 8; ++j) { const int i = tid + NTHREADS * j, key = i >> 4, ch = i & 15; const size_t src = ((size_t)b * 256 + key) * 512 + h * 128 + ch * 8;
            *(LDS bf16x8*)(KI + imgb(key, ch)) = ld8g(p.MKB + src); *(LDS bf16x8*)(VI + imgb(key, ch)) = ld8g(p.MVB + src); }
    } else { const int us = u - NU_XP; b = us >> 2; h = us & 3; nrows = DECS; tbase = (size_t)TP + b * DECS;
#pragma unroll
        for (int j = 0; j < 8; ++j) { const int i = tid + NTHREADS * j, key = i >> 4, ch = i & 15; const size_t src = (((size_t)b * 256 + key) * 4 + h) * 128 + ch * 8;
            const f32x4 k0 = *(const f32x4*)(p.cmk + src), k1 = *(const f32x4*)(p.cmk + src + 4), v0 = *(const f32x4*)(p.cmv + src), v1 = *(const f32x4*)(p.cmv + src + 4);
            *(LDS bf16x8*)(KI + imgb(key, ch)) = pack8(k0[0], k0[1], k0[2], k0[3], k1[0], k1[1], k1[2], k1[3]); *(LDS bf16x8*)(VI + imgb(key, ch)) = pack8(v0[0], v0[1], v0[2], v0[3], v1[0], v1[1], v1[2], v1[3]); }
    }
    bar_lds();
    if (32 * wid < nrows) {
        const bool valid = 32 * wid + r < nrows; const size_t trow = tbase + 32 * wid + (valid ? r : 0);
        bf16x8 qf[8]; float ss = 0.f;
#pragma unroll
        for (int ks = 0; ks < 8; ++ks) { qf[ks] = ld8g(p.XQ + trow * 512 + h * 128 + 16 * ks + 8 * hh);
#pragma unroll
            for (int j = 0; j < 8; ++j) { const float v = bf2f((bf16)qf[ks][j]); ss += v * v; } }
        ss += __shfl_xor(ss, 32); const float rs = valid ? rsqrtf(ss * (1.0f / 128.0f) + EPS) * X_SCALE : 0.f;
#pragma unroll
        for (int ks = 0; ks < 8; ++ks) { float q[8];
#pragma unroll
            for (int j = 0; j < 8; ++j) q[j] = bf2f((bf16)qf[ks][j]) * rs * p.g_xq[16 * ks + 8 * hh + j];
            qf[ks] = pack8(q[0], q[1], q[2], q[3], q[4], q[5], q[6], q[7]); }
        f32x16 o[4];
#pragma unroll
        for (int d = 0; d < 4; ++d) o[d] = zero16();
        float m = -INFINITY, l = 0.f;
        unsigned xt[8];
#pragma unroll
        for (int q = 0; q < 8; ++q) xt[q] = tr_lane_off(lane, (q >> 2) * 2 + ((q >> 1) & 1), q & 1);
#pragma unroll 1
        for (int kt = 0; kt < 4; ++kt) {
            f32x16 s0 = zero16(), s1 = zero16();
#pragma unroll
            for (int ks = 0; ks < 8; ++ks) { s0 = mfma32(img_row(KI, 64 * kt + r, ks, hh), qf[ks], s0); s1 = mfma32(img_row(KI, 64 * kt + 32 + r, ks, hh), qf[ks], s1); }
            float tmax = -INFINITY;
#pragma unroll
            for (int i = 0; i < 16; ++i) tmax = fmaxf(tmax, fmaxf(s0[i], s1[i]));
            tmax = fmaxf(tmax, __shfl_xor(tmax, 32));
            const float mn = fmaxf(m, tmax), corr = fexp(m - mn); m = mn; float ps = 0.f;
#pragma unroll
            for (int i = 0; i < 16; ++i) { s0[i] = fexp(s0[i] - mn); s1[i] = fexp(s1[i] - mn); ps += s0[i] + s1[i]; }
            l = l * corr + ps;
#pragma unroll
            for (int d = 0; d < 4; ++d)
#pragma unroll
                for (int i = 0; i < 16; ++i) o[d][i] *= corr;
            { const LDS unsigned char* vb = VI + 256 * 64 * kt; bf16x8 v0, v1, v2, v3; bf16x8 pa = PACK(s0, 0), pb = PACK(s1, 0);
                img_tr4p_pre<0, 32, false>(vb + xt[0], vb + xt[1], vb + xt[2], vb + xt[3], v0, v1, v2, v3);
                o[0] = mfma32(v0, pa, o[0]); o[1] = mfma32(v1, pa, o[1]); o[0] = mfma32(v2, pb, o[0]); o[1] = mfma32(v3, pb, o[1]);
                img_tr4p_pre<0, 32, false>(vb + xt[4], vb + xt[5], vb + xt[6], vb + xt[7], v0, v1, v2, v3);
                o[2] = mfma32(v0, pa, o[2]); o[3] = mfma32(v1, pa, o[3]); o[2] = mfma32(v2, pb, o[2]); o[3] = mfma32(v3, pb, o[3]);
                pa = PACK(s0, 1); pb = PACK(s1, 1);
                img_tr4p_pre<16, 48, false>(vb + xt[0], vb + xt[1], vb + xt[2], vb + xt[3], v0, v1, v2, v3);
                o[0] = mfma32(v0, pa, o[0]); o[1] = mfma32(v1, pa, o[1]); o[0] = mfma32(v2, pb, o[0]); o[1] = mfma32(v3, pb, o[1]);
                img_tr4p_pre<16, 48, false>(vb + xt[4], vb + xt[5], vb + xt[6], vb + xt[7], v0, v1, v2, v3);
                o[2] = mfma32(v0, pa, o[2]); o[3] = mfma32(v1, pa, o[3]); o[2] = mfma32(v2, pb, o[2]); o[3] = mfma32(v3, pb, o[3]); }
        }
        l += __shfl_xor(l, 32); const float il = 1.0f / l;
        if (valid) { bf16* op = p.XO + trow * 512 + h * 128;
#pragma unroll
            for (int d = 0; d < 4; ++d)
#pragma unroll
                for (int g = 0; g < 4; ++g) { u32x2 w; w[0] = pk2(o[d][4 * g] * il, o[d][4 * g + 1] * il); w[1] = pk2(o[d][4 * g + 2] * il, o[d][4 * g + 3] * il); *(u32x2*)(op + 32 * d + 8 * g + 4 * hh) = w; } }
    }
}
constexpr int SA_CK = 0, SA_KP = 32768, SA_P = SA_KP + 64 * 40 * 2, SA_QS = SA_P + 64 * 72 * 2, SA_CORR = SA_QS + 65 * 104 * 2, SA_F32 = (SA_CORR + 1024 + 1023) / 1024 * 1024, SA_KPF = SA_F32 + 65536, SA_END = SA_KPF + 8192;
static_assert(SA_END <= LDS_CTL && SA_KP % 16 == 0 && SA_P % 16 == 0 && SA_QS % 16 == 0 && SA_CORR % 16 == 0 && SA_F32 % 1024 == 0 && SA_KPF % 1024 == 0, "sample attention LDS map");
DI void sattn_issue(const Params& p, LDS unsigned char* lds, int pid, int half, int wid, int lane) {
    const size_t key0 = (size_t)pid * PAGE + half * 64;
#pragma unroll
    for (int i = 0; i < 8; ++i) { const int key = wid * 8 + i; dma16(p.cckv + (key0 + key) * 256 + lane * 4, lds + SA_F32 + key * 1024); }
    dma16(p.ckpe + (key0 + wid * 8 + (lane >> 3)) * 32 + (lane & 7) * 4, lds + SA_KPF + wid * 1024);
}
struct SaConv { u32x4 w[4]; u32x2 kp; };
DI void sattn_conv_read(LDS unsigned char* lds, SaConv& c) {
    const int tid = tid_opaque(), w8 = (tid >> 6) * 8, lane = tid & 63, c32 = lane & 31;
#pragma unroll
    for (int j = 0; j < 4; ++j) { const int key = w8 + 2 * j + (lane >> 5);
        const f32x4 a = *(const LDS f32x4*)(lds + SA_F32 + key * 1024 + c32 * 32), bq = *(const LDS f32x4*)(lds + SA_F32 + key * 1024 + c32 * 32 + 16);
        c.w[j][0] = pk2(a[0], a[1]); c.w[j][1] = pk2(a[2], a[3]); c.w[j][2] = pk2(bq[0], bq[1]); c.w[j][3] = pk2(bq[2], bq[3]); }
    { const f32x4 v = *(const LDS f32x4*)(lds + SA_KPF + (tid >> 3) * 128 + (tid & 7) * 16); c.kp[0] = pk2(v[0], v[1]); c.kp[1] = pk2(v[2], v[3]); }
}
DI void sattn_conv_write(LDS unsigned char* lds, const SaConv& c) {
    const int tid = tid_opaque(), w8 = (tid >> 6) * 8, lane = tid & 63, c32 = lane & 31;
#pragma unroll
    for (int j = 0; j < 4; ++j) { const int key = w8 + 2 * j + (lane >> 5); *(LDS u32x4*)(lds + SA_CK + (c32 >> 4) * 16384 + imgb(key, c32 & 15)) = c.w[j]; }
    *(LDS u32x2*)(lds + SA_KP + ((tid >> 3) * 40 + (tid & 7) * 4) * 2) = c.kp;
}
DI void sattn_unit(const Params& p, LDS unsigned char* lds, int u) {
    const int tid = tid_opaque(), wid = __builtin_amdgcn_readfirstlane(tid >> 6), lane = tid & 63, r = lane & 31, hh = lane >> 5;
    LDS unsigned char* CK = lds + SA_CK; LDS bf16* KP = (LDS bf16*)(lds + SA_KP); LDS bf16* PA = (LDS bf16*)(lds + SA_P);
    LDS bf16* QS = (LDS bf16*)(lds + SA_QS); LDS float* CORR = (LDS float*)(lds + SA_CORR);
    const int b = u / NSPLIT, sp = u % NSPLIT; const int h = wid;
    STAMP(23);
    const int pidv = p.ptab[b * NPAGES + sp * PPS + (lane % PPS)];
    sattn_issue(p, lds, rdlane(pidv, 0), 0, wid, lane);
    for (int i = tid; i < 65 * 12; i += NTHREADS) { const int row = i / 12, c8 = (i % 12) * 8;
        bf16x8 o = zero8();
        if (row < 64) { const int hq = row >> 3, q = row & 7; const bf16x8 v = ld8g(p.QN + (((size_t)TP + b * DECS + q) * 8 + hq) * 96 + c8); float f[8];
#pragma unroll
            for (int j = 0; j < 8; ++j) { f[j] = bf2f((bf16)v[j]) * 1.4426950408889634f; if (c8 < 64) f[j] *= p.g_kn[c8 + j]; }
            o = pack8(f[0], f[1], f[2], f[3], f[4], f[5], f[6], f[7]); }
        *(LDS bf16x8*)(QS + row * 104 + c8) = o; }
    const int l15 = lane & 15, quad = lane >> 4;
    bf16x8 wk[4][8];
    { const bf16* wkp = p.wt_kvb + (size_t)(h * 128 + l15) * 256 + 8 * quad;
#pragma unroll
        for (int dt = 0; dt < 4; ++dt)
#pragma unroll
            for (int ks = 0; ks < 8; ++ks) wk[dt][ks] = ld8g(wkp + dt * 16 * 256 + 32 * ks); }
#ifndef EMU
#pragma unroll
    for (int dt = 0; dt < 4; ++dt)
#pragma unroll
        for (int ks = 0; ks < 8; ++ks) asm volatile("" : "+v"(wk[dt][ks]));
#endif
    const int qrow = l15 < 8 ? h * 8 + l15 : 64;
    f32x16 acc0 = zero16(), acc1 = zero16(); float m = -INFINITY, l = 0.f;
    const int npt = PPS * 2, ntile = npt + (sp == NSPLIT - 1 ? 1 : 0);
    { SaConv cv; wait_vm0(); sattn_conv_read(lds, cv); sattn_conv_write(lds, cv); } bar_lds();
    for (int tile = 0; tile < ntile; ++tile) {
        const bool newt = tile == npt;
        unsigned lo_ = lane;
#ifndef EMU
        asm volatile("" : "+v"(lo_));
#endif
        const unsigned l15o = lo_ & 15, quado = lo_ >> 4;
        const bool pre = tile + 1 < npt; const size_t nkey0 = pre ? (size_t)rdlane(pidv, (tile + 1) >> 1) * PAGE + ((tile + 1) & 1) * 64 : 0;
#pragma unroll 1
        for (int kg = 0; kg < 4; ++kg) {
            f32x4 x[4];
#pragma unroll
            for (int dt = 0; dt < 4; ++dt) x[dt] = (f32x4){0.f, 0.f, 0.f, 0.f};
#define SA_CB(ks) (*(const LDS bf16x8*)(CK + ((ks) >> 2) * 16384 + imgb(16 * kg + l15o, 4 * ((ks) & 3) + quado)))
#define SA_MM(ks, cbv) do { _Pragma("unroll") for (int dt = 0; dt < 4; ++dt) x[dt] = __builtin_amdgcn_mfma_f32_16x16x32_bf16(wk[dt][ks], cbv, x[dt], 0, 0, 0); } while (0)
            if (pre) { const int k0_ = wid * 8 + 2 * kg; dma16(p.cckv + (nkey0 + k0_) * 256 + lane * 4, lds + SA_F32 + k0_ * 1024); dma16(p.cckv + (nkey0 + k0_ + 1) * 256 + lane * 4, lds + SA_F32 + (k0_ + 1) * 1024);
                if (kg == 3) dma16(p.ckpe + (nkey0 + wid * 8 + (lane >> 3)) * 32 + (lane & 7) * 4, lds + SA_KPF + wid * 1024); }
            bf16x8 ca0 = SA_CB(0), ca1 = SA_CB(1), cb0 = SA_CB(2), cb1 = SA_CB(3); SCHED_FENCE();
            SA_MM(0, ca0); SA_MM(1, ca1); ca0 = SA_CB(4); ca1 = SA_CB(5); SCHED_FENCE();
            SA_MM(2, cb0); SA_MM(3, cb1); cb0 = SA_CB(6); cb1 = SA_CB(7); SCHED_FENCE();
            const s16x4 qa0 = *(const LDS s16x4*)(QS + qrow * 104 + 4 * quad), qa1 = *(const LDS s16x4*)(QS + qrow * 104 + 16 + 4 * quad), qb0 = *(const LDS s16x4*)(QS + qrow * 104 + 32 + 4 * quad), qb1 = *(const LDS s16x4*)(QS + qrow * 104 + 48 + 4 * quad);
            const bf16x8 kpf = ld8(KP + (16 * kg + l15) * 40 + 8 * quad), qrf = ld8(QS + qrow * 104 + 64 + 8 * quad);
            SA_MM(4, ca0); SA_MM(5, ca1); SCHED_FENCE();
            SA_MM(6, cb0); SA_MM(7, cb1); SCHED_FENCE();
#undef SA_CB
#undef SA_MM
            float ss = 0.f;
#pragma unroll
            for (int dt = 0; dt < 4; ++dt) ss += x[dt][0] * x[dt][0] + x[dt][1] * x[dt][1] + x[dt][2] * x[dt][2] + x[dt][3] * x[dt][3];
            ss = xsum32(xsum16(ss)); const float inv = rsqrtf(ss * (1.0f / 64.0f) + EPS);
            f32x4 z = {0.f, 0.f, 0.f, 0.f};
#pragma unroll
            for (int pp = 0; pp < 2; ++pp) {
                const bf16x8 a = pack8(x[2 * pp][0] * inv, x[2 * pp][1] * inv, x[2 * pp][2] * inv, x[2 * pp][3] * inv, x[2 * pp + 1][0] * inv, x[2 * pp + 1][1] * inv, x[2 * pp + 1][2] * inv, x[2 * pp + 1][3] * inv);
                z = __builtin_amdgcn_mfma_f32_16x16x32_bf16(a, pp == 0 ? __builtin_shufflevector(qa0, qa1, 0, 1, 2, 3, 4, 5, 6, 7) : __builtin_shufflevector(qb0, qb1, 0, 1, 2, 3, 4, 5, 6, 7), z, 0, 0, 0); }
            z = __builtin_amdgcn_mfma_f32_16x16x32_bf16(kpf, qrf, z, 0, 0, 0);
            if (newt) {
#pragma unroll
                for (int j = 0; j < 4; ++j) { const int key = 16 * kg + 4 * quad + j; if (key > l15 || key >= DECS) z[j] = -INFINITY; } }
            float tmax = fmaxf(fmaxf(z[0], z[1]), fmaxf(z[2], z[3]));
            tmax = fmaxf(xmax32(xmax16(tmax)), -1e30f);
            const float mn = fmaxf(m, tmax), corr = fexp2(m - mn); m = mn;
#pragma unroll
            for (int j = 0; j < 4; ++j) z[j] = fexp2(z[j] - mn);
            l = l * corr + (z[0] + z[1]) + (z[2] + z[3]);
            if (l15 < 8) { u32x2 w; w[0] = pk2(z[0], z[1]); w[1] = pk2(z[2], z[3]); *(LDS u32x2*)(PA + (h * 8 + l15) * 72 + 16 * kg + 4 * quad) = w;
                if (quad == 0) CORR[kg * 64 + h * 8 + l15] = corr; }
        }
        bar_lds();
        { bf16x8 av[4]; const LDS unsigned char* q0 = CK + (wid >> 2) * 16384 + tr_lane_off_nat(lo_, wid & 3, 0); const LDS unsigned char* q1 = CK + (wid >> 2) * 16384 + tr_lane_off_nat(lo_, wid & 3, 1);
            img_tr4p_pre<0, 16>(q0, q1, q0 + 256 * 32, q1 + 256 * 32, av[0], av[2], av[1], av[3]);
            float c0[4], c1[4];
#pragma unroll
            for (int ks = 0; ks < 4; ++ks) { c0[ks] = CORR[ks * 64 + r]; c1[ks] = CORR[ks * 64 + 32 + r]; }
#pragma unroll
            for (int ks = 0; ks < 4; ++ks) {
#pragma unroll
                for (int i = 0; i < 16; ++i) { acc0[i] *= c0[ks]; acc1[i] *= c1[ks]; }
                acc0 = mfma32(av[ks], ld8(PA + r * 72 + 16 * ks + 8 * hh), acc0); acc1 = mfma32(av[ks], ld8(PA + (32 + r) * 72 + 16 * ks + 8 * hh), acc1); } }
        if (tile + 1 < ntile) {
            if (tile + 1 < npt) { SaConv cv; wait_vm0(); sattn_conv_read(lds, cv); bar_lds(); sattn_conv_write(lds, cv); }
            else { bar_lds(); const size_t t0 = (size_t)TP + b * DECS;
                for (int i = tid; i < 64 * 32; i += NTHREADS) { const int key = i >> 5, c32 = i & 31; bf16x8 v = zero8(); if (key < DECS) v = ld8g(p.CKVB + (t0 + key) * 256 + c32 * 8);
                    *(LDS bf16x8*)(CK + (c32 >> 4) * 16384 + imgb(key, c32 & 15)) = v; }
                for (int i = tid; i < 64 * 32; i += NTHREADS) { const int key = i >> 5, c = i & 31; KP[key * 40 + c] = key < DECS ? p.KPB[(t0 + key) * 32 + c] : (bf16)0; } }
            bar_lds();
        }
    }
    STAMP(22);
    { const int t2 = tid_opaque(), w2 = __builtin_amdgcn_readfirstlane(t2 >> 6), l2 = t2 & 63, r2 = l2 & 31, h2 = l2 >> 5;
        float* pa = p.PACC + (size_t)u * 64 * 256;
#pragma unroll
        for (int g = 0; g < 4; ++g) { f32x4 v0 = {acc0[4 * g], acc0[4 * g + 1], acc0[4 * g + 2], acc0[4 * g + 3]}, v1 = {acc1[4 * g], acc1[4 * g + 1], acc1[4 * g + 2], acc1[4 * g + 3]};
            *(f32x4*)(pa + (size_t)r2 * 256 + 32 * w2 + 8 * g + 4 * h2) = v0; *(f32x4*)(pa + (size_t)(32 + r2) * 256 + 32 * w2 + 8 * g + 4 * h2) = v1; }
        l += __shfl_xor(l, 16); l += __shfl_xor(l, 32);
        if (l2 < 8) { p.PML[((size_t)u * 64 + w2 * 8 + r2) * 2] = m; p.PML[((size_t)u * 64 + w2 * 8 + r2) * 2 + 1] = l; } }
    LDS unsigned* tick = (LDS unsigned*)(lds + LDS_CTL + 128);
    wait_vm0(); __syncthreads();
    if (threadIdx.x == 0) {
#ifndef EMU
        __builtin_amdgcn_fence(__ATOMIC_RELEASE, "agent"); asm volatile("s_waitcnt vmcnt(0)" ::: "memory");
        *tick = __hip_atomic_fetch_add(p.ctl + CW_SC + b, 1u, __ATOMIC_RELAXED, __HIP_MEMORY_SCOPE_AGENT);
#else
        *tick = atomicAdd(p.ctl + CW_SC + b, 1u);
#endif
    }
    __syncthreads();
    if (*tick == (unsigned)(NSPLIT - 1)) {
#ifndef EMU
        __builtin_amdgcn_fence(__ATOMIC_ACQUIRE, "agent"); asm volatile("s_waitcnt vmcnt(0)" ::: "memory");
#endif
        const int t3 = tid_opaque(), w3 = __builtin_amdgcn_readfirstlane(t3 >> 6), l3 = t3 & 63, l15c = l3 & 15, quadc = l3 >> 4;
        LDS bf16* ACB = (LDS bf16*)lds;
        { const int hq = t3 >> 3, sub = t3 & 7; float mj[NSPLIT], lj[NSPLIT], M = -INFINITY;
#pragma unroll
            for (int j = 0; j < NSPLIT; ++j) { mj[j] = p.PML[((size_t)(b * NSPLIT + j) * 64 + hq) * 2]; lj[j] = p.PML[((size_t)(b * NSPLIT + j) * 64 + hq) * 2 + 1]; M = fmaxf(M, mj[j]); }
            float L = 0.f, w[NSPLIT];
#pragma unroll
            for (int j = 0; j < NSPLIT; ++j) { w[j] = fexp2(mj[j] - M); L += w[j] * lj[j]; }
            const float iL = 1.0f / L; f32x4 a[8];
#pragma unroll
            for (int q = 0; q < 8; ++q) a[q] = (f32x4){0.f, 0.f, 0.f, 0.f};
#pragma unroll
            for (int j = 0; j < NSPLIT; ++j) { const float* pp = p.PACC + ((size_t)(b * NSPLIT + j) * 64 + hq) * 256 + sub * 32; const float wj = w[j] * iL;
#pragma unroll
                for (int q = 0; q < 8; ++q) a[q] += wj * *(const f32x4*)(pp + 4 * q); }
#pragma unroll
            for (int q = 0; q < 4; ++q) *(LDS bf16x8*)(ACB + hq * 264 + sub * 32 + 8 * q) = pack8(a[2 * q][0], a[2 * q][1], a[2 * q][2], a[2 * q][3], a[2 * q + 1][0], a[2 * q + 1][1], a[2 * q + 1][2], a[2 * q + 1][3]);
            if (t3 < 132) ((LDS unsigned*)(ACB + 64 * 264))[t3] = 0u; }
        __syncthreads();
        { const int hc = w3; const LDS bf16* ar = ACB + (l15c < 8 ? hc * 8 + l15c : 64) * 264 + 8 * quadc;
            f32x4 o4[4];
#pragma unroll
            for (int nt = 0; nt < 4; ++nt) o4[nt] = (f32x4){0.f, 0.f, 0.f, 0.f};
#pragma unroll
            for (int ks = 0; ks < 8; ++ks) { const bf16x8 af = ld8(ar + 32 * ks);
#pragma unroll
                for (int nt = 0; nt < 4; ++nt) o4[nt] = __builtin_amdgcn_mfma_f32_16x16x32_bf16(af, ld8g(p.wt_kvb + (size_t)(hc * 128 + 64 + 16 * nt + l15c) * 256 + 32 * ks + 8 * quadc), o4[nt], 0, 0, 0); }
            if (quadc < 2) {
#pragma unroll
                for (int nt = 0; nt < 4; ++nt)
#pragma unroll
                    for (int j = 0; j < 4; ++j) p.OMIX[((size_t)TP + b * DECS + 4 * quadc + j) * DM + 512 + hc * 64 + 16 * nt + l15c] = f2bf(o4[nt][j]); } }
    }
}
DI void phase_sattn_combine(const Params& p, LDS unsigned char* lds) {
    const int tid = tid_opaque();
    LDS float* AC = (LDS float*)lds; LDS float* WS = (LDS float*)(lds + 8 * 256 * 4);
    for (int u = blockIdx.x; u < DECB * 8; u += gridDim.x) { const int b = u >> 3, h = u & 7;
        if (tid < 8) { const int hq = h * 8 + tid; float M = -INFINITY; for (int j = 0; j < NSPLIT; ++j) M = fmaxf(M, p.PML[((size_t)(b * NSPLIT + j) * 64 + hq) * 2]);
            float L = 0.f; for (int j = 0; j < NSPLIT; ++j) { const float w = exp2f(p.PML[((size_t)(b * NSPLIT + j) * 64 + hq) * 2] - M);     WS[tid * NSPLIT + j] = w; L += w * p.PML[((size_t)(b * NSPLIT + j) * 64 + hq) * 2 + 1]; }
            const float iL = 1.0f / L; for (int j = 0; j < NSPLIT; ++j) WS[tid * NSPLIT + j] *= iL; }
        __syncthreads();
        { const int q = tid >> 6, l4 = (tid & 63) * 4; f32x4 s = {0.f, 0.f, 0.f, 0.f};
#pragma unroll
            for (int j = 0; j < NSPLIT; ++j) s += WS[q * NSPLIT + j] * *(const f32x4*)(p.PACC + ((size_t)(b * NSPLIT + j) * 64 + h * 8 + q) * 256 + l4);
            *(LDS f32x4*)(AC + q * 256 + l4) = s; }
        __syncthreads();
        { const int q = tid >> 6, dv = tid & 63; const bf16* w = p.wt_kvb + (size_t)(h * 128 + 64 + dv) * 256; float s = 0.f;
#pragma unroll 4
            for (int c = 0; c < 32; ++c) { const bf16x8 wv = ld8g(w + 8 * c); const f32x4 a0 = *(const LDS f32x4*)(AC + q * 256 + 8 * c), a1 = *(const LDS f32x4*)(AC + q * 256 + 8 * c + 4);
                s += a0[0] * bf2f((bf16)wv[0]) + a0[1] * bf2f((bf16)wv[1]) + a0[2] * bf2f((bf16)wv[2]) + a0[3] * bf2f((bf16)wv[3]) + a1[0] * bf2f((bf16)wv[4]) + a1[1] * bf2f((bf16)wv[5]) + a1[2] * bf2f((bf16)wv[6]) + a1[3] * bf2f((bf16)wv[7]); }
            p.OMIX[((size_t)TP + b * DECS + q) * DM + 512 + h * 64 + dv] = f2bf(s); }
        __syncthreads();
    }
}
#ifndef EMU
#define XB_TMO      128
#define XB_XCNT(j)  (256  + 64 * (j))
#define XB_XSUB(j)  (1280 + 64 * (j))
#define XB_XGEN(j)  (2304 + 64 * (j))
#define XB_TOP      3328
#define XB_TOPGEN   3392
#define XCD_BAR_WORDS 3456
#define XB_SPIN_CAP (1u << 18)
#define LAS __attribute__((address_space(3)))
__device__ __forceinline__ unsigned xb_ld(unsigned* p)              { return __hip_atomic_load(p, __ATOMIC_RELAXED, __HIP_MEMORY_SCOPE_AGENT); }
__device__ __forceinline__ unsigned xb_add(unsigned* p, unsigned v) { return __hip_atomic_fetch_add(p, v, __ATOMIC_RELAXED, __HIP_MEMORY_SCOPE_AGENT); }
__device__ __forceinline__ unsigned xb_xcc_id() { return (unsigned)__builtin_amdgcn_s_getreg((3 << 11) | 20) & 0xFu; }
#define XB_SPIN(cond, bar) do { unsigned _sp = 0; while (cond) { __builtin_amdgcn_s_sleep(1); \
    if ((++_sp & 255u) == 0u) { if (xb_ld(&(bar)[XB_TMO])) break; if (_sp > XB_SPIN_CAP) { atomicAdd(&(bar)[XB_TMO], 1u); break; } } } } while (0)
struct XcdBarrier { unsigned* bar; unsigned x; volatile LAS unsigned* st; };
__device__ __forceinline__ XcdBarrier xcd_barrier_post(unsigned* bar, volatile LAS unsigned* st) {
    XcdBarrier b; b.bar = bar; b.x = xb_xcc_id(); b.st = st;
    if (threadIdx.x == 0) (void)xb_add(&bar[XB_XCNT(b.x)], 1u);
    return b;
}
__device__ __forceinline__ void xcd_barrier_complete(unsigned* bar, unsigned x, unsigned& nloc, unsigned& nx) {
    const unsigned G = gridDim.x * gridDim.y * gridDim.z;
    unsigned sum, cnt, mine, sp = 0u;
    for (;;) {
        sum = 0u; cnt = 0u; mine = 0u;
#pragma unroll
        for (unsigned j = 0; j < 16; ++j) { const unsigned c = xb_ld(&bar[XB_XCNT(j)]); sum += c; cnt += (c > 0u) ? 1u : 0u; mine = (j == x) ? c : mine; }
        if (sum == G) break;
        __builtin_amdgcn_s_sleep(1);
        if ((++sp & 255u) == 0u) { if (xb_ld(&bar[XB_TMO])) break; if (sp > XB_SPIN_CAP) { atomicAdd(&bar[XB_TMO], 1u); break; } }
    }
    nloc = mine > 0u ? mine : 1u; nx = cnt > 0u ? cnt : 1u;
}
__device__ __forceinline__ void xcd_barrier(const XcdBarrier& b) {
    asm volatile("s_waitcnt vmcnt(0)" ::: "memory");
    __syncthreads();
    if (threadIdx.x == 0) {
        unsigned* bar = b.bar;
        __builtin_amdgcn_s_waitcnt(0);
        unsigned nloc = b.st[0], nx = b.st[1];
        if (nloc == 0u) { xcd_barrier_complete(bar, b.x, nloc, nx); b.st[0] = nloc; b.st[1] = nx; }
        const unsigned old = xb_add(&bar[XB_XSUB(b.x)], 1u);
        const unsigned gen = old / nloc;
        if (old + 1u == (gen + 1u) * nloc) {
            __builtin_amdgcn_fence(__ATOMIC_RELEASE, "agent");
            asm volatile("s_waitcnt vmcnt(0)" ::: "memory");
            const unsigned og = xb_add(&bar[XB_TOP], 1u);
            const unsigned tg = og / nx;
            if (og + 1u == (tg + 1u) * nx) xb_add(&bar[XB_TOPGEN], 1u);
            else XB_SPIN(xb_ld(&bar[XB_TOPGEN]) == tg, bar);
            __builtin_amdgcn_fence(__ATOMIC_ACQUIRE, "agent");
            xb_add(&bar[XB_XGEN(b.x)], 1u);
            asm volatile("s_waitcnt vmcnt(0)" ::: "memory");
        } else {
            XB_SPIN(xb_ld(&bar[XB_XGEN(b.x)]) == gen, bar);
            __builtin_amdgcn_fence(__ATOMIC_ACQUIRE, "agent");
            asm volatile("s_waitcnt vmcnt(0)" ::: "memory");
        }
    }
    __syncthreads();
}
#endif

DI unsigned wq_issue(unsigned* ctr) { return threadIdx.x == 0 ? atomicAdd(ctr, 1u) : 0u; }
DI int wq_publish(unsigned v, LDS unsigned* slot) {
    bar_lds();
    if (threadIdx.x == 0) *slot = v;
    bar_lds();
    return __builtin_amdgcn_readfirstlane((int)*slot);
}
DI int wq_next(unsigned* ctr, LDS unsigned* slot) {
    __syncthreads();
    if (threadIdx.x == 0) *slot = atomicAdd(ctr, 1u);
    __syncthreads();
    return __builtin_amdgcn_readfirstlane((int)*slot);
}
struct EpiResF32 {
    static constexpr bool PERM = false, AFTER_DRAIN = false;
    float* C; const float* R0; const float* R1; int split;
    DI void operator()(const f32x4 (&acc)[2][2][4][2], const pg8::Unit& u, int wr, int wc, int fr, int fq) const {
        const int row0 = u.pm * 256 + wr * 64 + fr, col0 = u.pn * 256 + wc * 32 + 4 * fq;
        const float* R = row0 < split ? R0 : R1 - (size_t)split * DM;
#pragma unroll
        for (int ai = 0; ai < 2; ++ai)
#pragma unroll
            for (int mp = 0; mp < 2; ++mp) { f32x4 rr[2][2][2];
#pragma unroll
                for (int mm = 0; mm < 2; ++mm) { const size_t off = (size_t)(row0 + ai * 128 + (2 * mp + mm) * 16) * DM + col0;
#pragma unroll
                    for (int bj = 0; bj < 2; ++bj)
#pragma unroll
                        for (int n = 0; n < 2; ++n) rr[mm][bj][n] = *(const f32x4*)(R + off + bj * 128 + n * 16); }
#pragma unroll
                for (int mm = 0; mm < 2; ++mm) { const size_t off = (size_t)(row0 + ai * 128 + (2 * mp + mm) * 16) * DM + col0;
#pragma unroll
                    for (int bj = 0; bj < 2; ++bj)
#pragma unroll
                        for (int n = 0; n < 2; ++n) *(f32x4*)(C + off + bj * 128 + n * 16) = acc[ai][bj][2 * mp + mm][n] + rr[mm][bj][n]; }
#ifndef EMU
                asm volatile("" ::: "memory");
#endif
            }
    }
};

struct EpiResInBf16Out {
    static constexpr bool PERM = true, AFTER_DRAIN = false;
    bf16* O; const float* R0; const float* R1; int split; float* SS;
    DI void operator()(const f32x4 (&acc)[2][2][4][2], const pg8::Unit& u, int wr, int wc, int fr, int fq) const {
        const int row0 = u.pm * 256 + wr * 64 + fr, col0 = u.pn * 256 + wc * 32 + 8 * fq;
        const float* R = row0 < split ? R0 : R1 - (size_t)split * DM;
#pragma unroll
        for (int ai = 0; ai < 2; ++ai) { f32x4 rr[4][2][2]; float sq[4];
#pragma unroll
            for (int m = 0; m < 4; ++m) { const size_t off = (size_t)(row0 + ai * 128 + m * 16) * DM + col0;
#pragma unroll
                for (int bj = 0; bj < 2; ++bj) { rr[m][bj][0] = *(const f32x4*)(R + off + bj * 128); rr[m][bj][1] = *(const f32x4*)(R + off + bj * 128 + 4); } }
#pragma unroll
            for (int m = 0; m < 4; ++m) { const size_t off = (size_t)(row0 + ai * 128 + m * 16) * DM + col0; sq[m] = 0.f;
#pragma unroll
                for (int bj = 0; bj < 2; ++bj) { const f32x4 v0 = acc[ai][bj][m][0] + rr[m][bj][0], v1 = acc[ai][bj][m][1] + rr[m][bj][1];
                    sq[m] += (v0[0] * v0[0] + v0[1] * v0[1]) + (v0[2] * v0[2] + v0[3] * v0[3]) + (v1[0] * v1[0] + v1[1] * v1[1]) + (v1[2] * v1[2] + v1[3] * v1[3]);
                    u32x4 w; w[0] = pk2(v0[0], v0[1]); w[1] = pk2(v0[2], v0[3]); w[2] = pk2(v1[0], v1[1]); w[3] = pk2(v1[2], v1[3]); *(u32x4*)(O + off + bj * 128) = w; } }
#pragma unroll
            for (int m = 0; m < 4; ++m) { const float q = xsum32(xsum16(sq[m])); if (fq == 0) SS[(size_t)(row0 + ai * 128 + m * 16) * 16 + u.pn * 4 + wc] = q; }
#ifndef EMU
            asm volatile("" ::: "memory");
#endif
        }
    }
};
struct EpiResBf16 {
    static constexpr bool PERM = true, AFTER_DRAIN = false;
    bf16* O; const bf16* R; float* SS;
    DI void operator()(const f32x4 (&acc)[2][2][4][2], const pg8::Unit& u, int wr, int wc, int fr, int fq) const {
        const int row0 = u.pm * 256 + wr * 64 + fr, col0 = u.pn * 256 + wc * 32 + 8 * fq;
        bf16x8 rr[2][4][2];
#pragma unroll
        for (int ai = 0; ai < 2; ++ai)
#pragma unroll
            for (int m = 0; m < 4; ++m) { const size_t off = (size_t)(row0 + ai * 128 + m * 16) * DM + col0; rr[ai][m][0] = ld8g(R + off); rr[ai][m][1] = ld8g(R + off + 128); }
#pragma unroll
        for (int ai = 0; ai < 2; ++ai)
#pragma unroll
            for (int m = 0; m < 4; ++m) { const size_t off = (size_t)(row0 + ai * 128 + m * 16) * DM + col0; float sq = 0.f;
#pragma unroll
                for (int bj = 0; bj < 2; ++bj) { const f32x4 a0 = acc[ai][bj][m][0], a1 = acc[ai][bj][m][1]; const bf16x8 q = rr[ai][m][bj]; float v[8];
#pragma unroll
                    for (int j = 0; j < 4; ++j) { v[j] = a0[j] + bf2f((bf16)q[j]); v[4 + j] = a1[j] + bf2f((bf16)q[4 + j]); }
                    sq += (v[0] * v[0] + v[1] * v[1]) + (v[2] * v[2] + v[3] * v[3]) + (v[4] * v[4] + v[5] * v[5]) + (v[6] * v[6] + v[7] * v[7]);
                    *(bf16x8*)(O + off + bj * 128) = pack8(v[0], v[1], v[2], v[3], v[4], v[5], v[6], v[7]); }
                sq = xsum32(xsum16(sq)); if (fq == 0) SS[(size_t)(row0 + ai * 128 + m * 16) * 16 + u.pn * 4 + wc] = sq; }
    }
};
struct EpiResBf16InF32Out {
    static constexpr bool PERM = false, AFTER_DRAIN = false;
    float* C; const bf16* R;
    DI void operator()(const f32x4 (&acc)[2][2][4][2], const pg8::Unit& u, int wr, int wc, int fr, int fq) const {
        const int row0 = u.pm * 256 + wr * 64 + fr, col0 = u.pn * 256 + wc * 32 + 4 * fq;
        s16x4 rr[2][4][2][2];
#pragma unroll
        for (int ai = 0; ai < 2; ++ai)
#pragma unroll
            for (int m = 0; m < 4; ++m) { const size_t off = (size_t)(row0 + ai * 128 + m * 16) * DM + col0;
#pragma unroll
                for (int bj = 0; bj < 2; ++bj)
#pragma unroll
                    for (int n = 0; n < 2; ++n) rr[ai][m][bj][n] = *(const s16x4*)(R + off + bj * 128 + n * 16); }
#pragma unroll
        for (int ai = 0; ai < 2; ++ai)
#pragma unroll
            for (int m = 0; m < 4; ++m) { const size_t off = (size_t)(row0 + ai * 128 + m * 16) * DM + col0;
#pragma unroll
                for (int bj = 0; bj < 2; ++bj)
#pragma unroll
                    for (int n = 0; n < 2; ++n) { const s16x4 q = rr[ai][m][bj][n]; f32x4 v = acc[ai][bj][m][n]; v[0] += bf2f((bf16)q[0]); v[1] += bf2f((bf16)q[1]); v[2] += bf2f((bf16)q[2]); v[3] += bf2f((bf16)q[3]);
                        *(f32x4*)(C + off + bj * 128 + n * 16) = v; } }
    }
};
DI void sepi_rowsq(float* SS, int row, int col, const f32x4& v) {
    float q = (v[0] * v[0] + v[1] * v[1]) + (v[2] * v[2] + v[3] * v[3]); q += __shfl_xor(q, 1); q += __shfl_xor(q, 2); q += __shfl_xor(q, 4); q += __shfl_xor(q, 8);
    if ((col & 63) == 0) SS[(size_t)row * 16 + (col >> 6)] = q; }
struct SEpiResInBf16Out { bf16* O; const float* R; float* SS;
    DI void put(int row, int col, f32x4 v) const { v += *(const f32x4*)(R + (size_t)row * DM + col); sepi_rowsq(SS, row, col, v); u32x2 w; w[0] = pk2(v[0], v[1]); w[1] = pk2(v[2], v[3]); *(u32x2*)(O + (size_t)row * DM + col) = w; } };
struct SEpiResBf16 { bf16* O; const bf16* R; float* SS;
    DI void put(int row, int col, f32x4 v) const { const s16x4 q = *(const s16x4*)(R + (size_t)row * DM + col); v[0] += bf2f((bf16)q[0]); v[1] += bf2f((bf16)q[1]); v[2] += bf2f((bf16)q[2]); v[3] += bf2f((bf16)q[3]); sepi_rowsq(SS, row, col, v);
        u32x2 w; w[0] = pk2(v[0], v[1]); w[1] = pk2(v[2], v[3]); *(u32x2*)(O + (size_t)row * DM + col) = w; } };
struct SEpiResBf16InF32Out { float* C; const bf16* R;
    DI void put(int row, int col, f32x4 v) const { const s16x4 q = *(const s16x4*)(R + (size_t)row * DM + col); v[0] += bf2f((bf16)q[0]); v[1] += bf2f((bf16)q[1]); v[2] += bf2f((bf16)q[2]); v[3] += bf2f((bf16)q[3]); *(f32x4*)(C + (size_t)row * DM + col) = v; } };
template <int NR> DI void rmsnorm_rows_b16(const bf16* src, const float* g, bf16* dst, int row0, int rstride, int nrows, int lane) {
    bf16x8 v[NR][2]; f32x4 gg[4];
#pragma unroll
    for (int j = 0; j < NR; ++j) { const int row = row0 + j * rstride;
#pragma unroll
        for (int i = 0; i < 2; ++i) v[j][i] = row < nrows ? ld8g(src + (size_t)row * DM + 8 * (lane + 64 * i)) : zero8(); }
#pragma unroll
    for (int i = 0; i < 2; ++i) { gg[2 * i] = *(const f32x4*)(g + 8 * (lane + 64 * i)); gg[2 * i + 1] = *(const f32x4*)(g + 8 * (lane + 64 * i) + 4); }
    float ss[NR];
#pragma unroll
    for (int j = 0; j < NR; ++j) { ss[j] = 0.f;
#pragma unroll
        for (int i = 0; i < 2; ++i)
#pragma unroll
            for (int q = 0; q < 8; ++q) { const float f = bf2f((bf16)v[j][i][q]); ss[j] += f * f; } }
#pragma unroll
    for (int o = 32; o >= 1; o >>= 1) {
#pragma unroll
        for (int j = 0; j < NR; ++j) ss[j] += __shfl_xor(ss[j], o); }
#pragma unroll
    for (int j = 0; j < NR; ++j) { const int row = row0 + j * rstride; if (row < nrows) { const float rs = rsqrtf(ss[j] * (1.0f / 1024.0f) + EPS);
#pragma unroll
            for (int i = 0; i < 2; ++i) { const bf16x8 q = v[j][i]; const f32x4 g0 = gg[2 * i], g1 = gg[2 * i + 1];
                *(bf16x8*)(dst + (size_t)row * DM + 8 * (lane + 64 * i)) = pack8(bf2f((bf16)q[0]) * rs * g0[0], bf2f((bf16)q[1]) * rs * g0[1], bf2f((bf16)q[2]) * rs * g0[2], bf2f((bf16)q[3]) * rs * g0[3], bf2f((bf16)q[4]) * rs * g1[0], bf2f((bf16)q[5]) * rs * g1[1], bf2f((bf16)q[6]) * rs * g1[2], bf2f((bf16)q[7]) * rs * g1[3]); } } }
}
DI void phase_norm_rows_b16(const Params& p, const bf16* X, const float* g) {
    const int tid = tid_opaque(), wid = __builtin_amdgcn_readfirstlane(tid >> 6), lane = tid & 63;
    { const int ws = gridDim.x * 8, w0 = blockIdx.x * 8 + wid; for (int row = w0; row < T; row += 8 * ws) rmsnorm_rows_b16<8>(X, g, p.H, row, ws, T, lane); }
}
DI void phase_norm_rows(const Params& p, const float* X, const float* g) {
    const int tid = tid_opaque(), wid = __builtin_amdgcn_readfirstlane(tid >> 6), lane = tid & 63;
    { const int ws = gridDim.x * 8, w0 = blockIdx.x * 8 + wid; for (int row = w0; row < T; row += 4 * ws) rmsnorm_rows<4>(X, g, p.H, row, ws, T, lane); }
}
constexpr int NPHASE = 15;
template <int PH> DI void run_phase(const Params& p, LDS unsigned char* lds) {
    LDS unsigned* slot = (LDS unsigned*)(lds + LDS_CTL + 64);
    if constexpr (PH == 0) phase_prep(p, lds);
    else if constexpr (PH == 1) { run_gemm(lds, p.H, p.wt_in, TP, DINP, DM, EpiStoreBf16<0>{p.Z, DINP}, 0); run_gemm(lds, p.MEMN, p.wt_xkv, MROWS, 1024, DM, EpiStoreF32{p.MKV, nullptr, 1024}, 128);
        small_gemm(lds, p.H, p.wt_in, DINP, DM, SEpiBf16{p.Z, DINP, 0}, 64); }
    else if constexpr (PH == 2) { phase_post_in(p); if (DUPM & 8) phase_post_in(p); }
    else if constexpr (PH == 3) { run_gemm(lds, p.QAN, p.wt_qb, TP, 768, 384, EpiStoreBf16<0>{p.QF, 768}, 0); run_gemm(lds, p.CKVB, p.wt_kvb, TP, 1024, 256, EpiStoreBf16<0>{p.KV, 1024}, 128);
        small_gemm(lds, p.QAN, p.wt_qb, 768, 384, SEpiBf16{p.QF, 768, 0}, 0); __syncthreads(); phase_gla_a(p, lds); }
    else if constexpr (PH == 4) { phase_post_qkv(p); if (DUPM & 16) phase_post_qkv(p); phase_gla_b(p); }
    else if constexpr (PH == 5) {
        for (int rep = 0; rep < ((DUPM & 1) ? 2 : 1); ++rep) for (int u = blockIdx.x; u < NU_SA; u += gridDim.x) { __syncthreads(); sattn_unit(p, lds, u); }
        STAMP(20);
        for (int rep = 0; rep < ((DUPM & 2) ? 2 : 1); ++rep) { unsigned* ctr = p.ctl + CW_Q5 + 64 + 192 * rep; unsigned nx = wq_issue(ctr); for (;;) { const int u = wq_publish(nx, slot); if (u >= NU_PA) break; nx = wq_issue(ctr); pattn_unit(p, lds, u); } }
        STAMP(21);
        __syncthreads(); phase_gla_c(p, lds); }
    else if constexpr (PH == 6) {}
    else if constexpr (PH == 7) { run_gemm(lds, p.OMIX, p.wt_out, TP, DM, DM, EpiResInBf16Out{p.X1B, p.xp, p.xs, TP, p.SS1}, 0); small_gemm(lds, p.OMIX, p.wt_out, DM, DM, SEpiResInBf16Out{p.X1B, p.xs - (size_t)TP * DM, p.SS1}, 0); }
    else if constexpr (PH == 8) {}
    else if constexpr (PH == 9) { run_gemm(lds, p.X1B, p.wt_xq, TP, 512, DM, EpiStoreBf16<0, true>{p.XQ, 512, p.SS1}, 0); small_gemm(lds, p.X1B, p.wt_xq, 512, DM, SEpiBf16{p.XQ, 512, 0, p.SS1}, 0); }
    else if constexpr (PH == 10) { unsigned* ctr = p.ctl + CW_QX; if (DUPP & (1 << 10)) { __syncthreads(); if (*(volatile unsigned*)ctr >= (unsigned)(NU_XS + NU_XP) ) ctr += 64; }
        unsigned nx = wq_issue(ctr); for (;;) { const int u = wq_publish(nx, slot); if (u >= NU_XS + NU_XP) break; nx = wq_issue(ctr); xattn_unit(p, lds, u < NU_XS ? NU_XP + u : u - NU_XS); } }
    else if constexpr (PH == 11) { run_gemm(lds, p.XO, p.wt_xo, TP, DM, 512, EpiResBf16{p.X2B, p.X1B, p.SS2}, 0); small_gemm(lds, p.XO, p.wt_xo, DM, 512, SEpiResBf16{p.X2B, p.X1B, p.SS2}, 0); }
    else if constexpr (PH == 12) {}
    else if constexpr (PH == 13) { run_gemm(lds, p.X2B, p.wt_ff1, TP, DFF, DM, EpiStoreBf16<1, true>{p.U, DFF, p.SS2}, 0); small_gemm(lds, p.X2B, p.wt_ff1, DFF, DM, SEpiBf16{p.U, DFF, 1, p.SS2}, 0); }
    else if constexpr (PH == 14) { run_gemm(lds, p.U, p.wt_ff2, TP, DM, DFF, EpiResBf16InF32Out{p.y, p.X2B}, 0); small_gemm(lds, p.U, p.wt_ff2, DM, DFF, SEpiResBf16InF32Out{p.y, p.X2B}, 0); }
}
#ifdef EMU
#define GET_LDS() ((LDS unsigned char*)EMU_SMEM())
#define GRID_BAR() emu_grid_barrier()
#else
#define GET_LDS() ((LDS unsigned char*)lds_raw)
#define GRID_BAR() xcd_barrier(bar)
#endif
template <int PH> __global__ void __launch_bounds__(NTHREADS, 2) k_phase(Params p) {
#ifndef EMU
    extern __shared__ __attribute__((aligned(16))) unsigned char lds_raw[];
#endif
    run_phase<PH>(p, GET_LDS());
}
#if N_LAUNCH_MODE == 1
__global__ void __launch_bounds__(NTHREADS, 2) k_mega(Params p) {
#ifndef EMU
    extern __shared__ __attribute__((aligned(16))) unsigned char lds_raw[];
    LDS unsigned char* lds = GET_LDS();
    if (threadIdx.x < 64) ((LDS unsigned*)(lds + LDS_CTL))[threadIdx.x] = 0u;
    __syncthreads();
    XcdBarrier bar = xcd_barrier_post(p.ctl + CW_BAR, (volatile LDS unsigned*)(lds + LDS_CTL));
#else
    LDS unsigned char* lds = GET_LDS();
#endif
    STAMP(0);
    run_phase<0>(p, lds); if (DUPP & (1 << 0)) run_phase<0>(p, lds); GRID_BAR();
    STAMP(1);
    run_phase<1>(p, lds); if (DUPP & (1 << 1)) run_phase<1>(p, lds); GRID_BAR();
    STAMP(2);
    run_phase<2>(p, lds); if (DUPP & (1 << 2)) run_phase<2>(p, lds); GRID_BAR();
    STAMP(3);
    run_phase<3>(p, lds); if (DUPP & (1 << 3)) run_phase<3>(p, lds); GRID_BAR();
    STAMP(4);
    run_phase<4>(p, lds); GRID_BAR();
    STAMP(5);
    run_phase<5>(p, lds); GRID_BAR();
    STAMP(6);
    run_phase<7>(p, lds); if (DUPP & (1 << 7)) run_phase<7>(p, lds); GRID_BAR();
    STAMP(8);
    STAMP(9);
    run_phase<9>(p, lds); if (DUPP & (1 << 9)) run_phase<9>(p, lds); GRID_BAR();
    STAMP(10);
    run_phase<10>(p, lds); if (DUPP & (1 << 10)) run_phase<10>(p, lds); GRID_BAR();
    STAMP(11);
    run_phase<11>(p, lds); if (DUPP & (1 << 11)) run_phase<11>(p, lds); GRID_BAR();
    STAMP(12);
    STAMP(13);
    run_phase<13>(p, lds); if (DUPP & (1 << 13)) run_phase<13>(p, lds); GRID_BAR();
    STAMP(14);
    run_phase<14>(p, lds); if (DUPP & (1 << 14)) run_phase<14>(p, lds);
    STAMP(15);
#ifndef EMU
    if (PROBE_A >= 0 && blockIdx.x == 0 && threadIdx.x == 0) { volatile unsigned long long* st = (volatile unsigned long long*)(p.ctl + CW_STAMP); const unsigned long long span = st[PROBE_B] - st[PROBE_A], t0 = wall_clock64();
        while (wall_clock64() - t0 < PROBE_K * span) __builtin_amdgcn_s_sleep(32); }
#endif
}
#endif

static size_t ws_take(size_t& off, size_t bytes) { const size_t o = off; off = (off + bytes + 255) & ~(size_t)255; return o; }
template <int PH> static void launch_phase(const Params& p, int grid, hipStream_t stream) {
#ifndef EMU
    static bool attr = false; if (!attr) { (void)hipFuncSetAttribute((const void*)k_phase<PH>, hipFuncAttributeMaxDynamicSharedMemorySize, LDS_BYTES); attr = true; }
#endif
    LAUNCH(k_phase<PH>, dim3(grid), dim3(NTHREADS), LDS_BYTES, stream, p);
}
extern "C" void kernel_launch(void* const* d_in, const int* in_sizes, int n_in, void* d_out, int out_size, void* d_ws, size_t ws_size, hipStream_t stream) {
    Params p{};
    const float* const* in = (const float* const*)d_in;
    p.xp = in[0]; p.xs = in[1]; p.memp = in[2]; p.cckv = in[3]; p.ckpe = in[4]; p.cmk = in[5]; p.cmv = in[6]; p.sgla = in[7]; p.ptab = (const int*)d_in[8];
    p.g_mix = in[9]; p.w_a2 = in[11]; p.b_a = in[12]; p.g_gla_o = in[13]; p.g_qa = in[14]; p.g_kva = in[16]; p.g_qn = in[18]; p.g_kn = in[19]; p.g_qr = in[20]; p.g_kr = in[21];
    p.g_x = in[23]; p.g_mem = in[24]; p.g_xq = in[28]; p.g_xk = in[29]; p.g_ff = in[31];
    float* out = (float*)d_out; size_t oo = 0;
    p.y = out; oo += (size_t)T * DM; p.o_ckvp = out + oo; oo += (size_t)TP * 256; p.o_kpep = out + oo; oo += (size_t)TP * 32; p.o_mkp = out + oo; oo += (size_t)MROWS * 512; p.o_mvp = out + oo; oo += (size_t)MROWS * 512;
    p.o_glap = out + oo; oo += (size_t)BATCH * 4 * 8192; p.o_ckvs = out + oo; oo += (size_t)TS * 256; p.o_kpes = out + oo; oo += (size_t)TS * 32; p.o_glas = out + oo; oo += (size_t)DECB * 4 * 8192;
    if ((size_t)out_size != oo || n_in != 34) { fprintf(stderr, "kernel_launch: unexpected sizes (out %d vs %zu, n_in %d)\n", out_size, oo, n_in); }
    unsigned char* ws = (unsigned char*)d_ws; size_t off = 0;
    p.ctl = (unsigned*)(ws + ws_take(off, 1 << 20));
#define WSB(name, elems) p.name = (bf16*)(ws + ws_take(off, (size_t)(elems) * 2))
#define WSF(name, elems) p.name = (float*)(ws + ws_take(off, (size_t)(elems) * 4))
    WSB(wt_in, (size_t)DINP * DM); WSB(wt_qb, 768 * 384); WSB(wt_kvb, 1024 * 256); WSB(wt_out, DM * DM); WSB(wt_xq, 512 * DM); WSB(wt_xkv, 1024 * DM); WSB(wt_xo, DM * 512); WSB(wt_ff1, (size_t)DFF * DM); WSB(wt_ff2, (size_t)DM * DFF);
    WSB(H, (size_t)T * DM); WSB(MEMN, (size_t)MROWS * DM); WSB(Z, (size_t)T * DINP); WSB(QAN, (size_t)T * 384); WSB(CKVB, (size_t)T * 256); WSB(KPB, (size_t)T * 32); WSB(MKB, (size_t)MROWS * 512); WSB(MVB, (size_t)MROWS * 512);
    WSB(QF, (size_t)T * 768); WSB(KV, (size_t)T * 1024); WSB(QN, (size_t)T * 768); WSB(KN, (size_t)T * 512); WSB(OMIX, (size_t)T * DM); WSB(XQ, (size_t)T * 512); WSB(X1B, (size_t)T * DM); WSB(X2B, (size_t)T * DM); WSB(XO, (size_t)T * 512); WSB(U, (size_t)T * DFF);
    WSF(MKV, (size_t)MROWS * 1024); WSF(ROPE, (size_t)(SEQ + DECS) * 32); WSF(GMAX, 64); WSF(LOGA, (size_t)T * 256); WSF(DS, (size_t)NGU * 8192); WSF(DDEC, (size_t)NGU * 64); WSF(X1, (size_t)T * DM); WSF(X2, (size_t)T * DM); WSF(PACC, (size_t)NU_SA * 64 * 256); WSF(PML, (size_t)NU_SA * 128); WSF(SS1, (size_t)T * 16); WSF(SS2, (size_t)T * 16);
    if (off > ws_size) { fprintf(stderr, "kernel_launch: workspace too small (%zu > %zu)\n", off, ws_size); return; }
    p.w_in = in[10]; p.w_qb = in[15]; p.w_kvb = in[17]; p.w_out = in[22]; p.w_xq = in[25]; p.w_xk = in[26]; p.w_xv = in[27]; p.w_xo = in[30]; p.w_ff1 = in[32]; p.w_ff2 = in[33];
    (void)hipMemsetAsync(p.ctl, 0, 1 << 20, stream);
#ifdef EMU
    const int grid = EMU_GRID;
#else
    static int grid = 0;
    if (!grid) { int dev = 0, cus = 0; (void)hipGetDevice(&dev); (void)hipDeviceGetAttribute(&cus, hipDeviceAttributeMultiprocessorCount, dev); grid = cus > 0 ? cus : 256;
#if N_LAUNCH_MODE == 1
        (void)hipFuncSetAttribute((const void*)k_mega, hipFuncAttributeMaxDynamicSharedMemorySize, LDS_BYTES);
        int per_cu = 0; if (hipOccupancyMaxActiveBlocksPerMultiprocessor(&per_cu, (const void*)k_mega, NTHREADS, LDS_BYTES) != hipSuccess || per_cu < 1) fprintf(stderr, "kernel_launch: occupancy query reports %d workgroups per CU\n", per_cu);
#endif
    }
#endif
#if N_LAUNCH_MODE == 1
    LAUNCH(k_mega, dim3(grid), dim3(NTHREADS), LDS_BYTES, stream, p);
#else
    launch_phase<0>(p, grid, stream); launch_phase<1>(p, grid, stream); launch_phase<2>(p, grid, stream); launch_phase<3>(p, grid, stream); launch_phase<4>(p, grid, stream);
    launch_phase<5>(p, grid, stream); launch_phase<6>(p, grid, stream); launch_phase<7>(p, grid, stream); launch_phase<8>(p, grid, stream); launch_phase<9>(p, grid, stream);
    launch_phase<10>(p, grid, stream); launch_phase<11>(p, grid, stream); launch_phase<12>(p, grid, stream); launch_phase<13>(p, grid, stream); launch_phase<14>(p, grid, stream);
#endif
}
```
